# Optimizing an MI355X kernel written in HIP

```python
import jax, jax.numpy as jnp
from jax import lax
import numpy as np

D_MODEL = 1024
BATCH = 8
SEQ = 4096
DEPTH = 1

ROPE_THETA = 500000.0
NORM_EPS = 1e-5
NEG_INF = -1e30
POS_INF = 1e30
Q_BLOCK = 128

MLA_HEADS = 8
MLA_NOPE_DIM = 64
MLA_ROPE_DIM = 32
MLA_V_DIM = 64
MLA_Q_RANK = 256
MLA_KV_RANK = 128

NSA_HEADS = 8
NSA_KV_HEADS = 2
NSA_GROUP = NSA_HEADS // NSA_KV_HEADS
NSA_HEAD_DIM = 64
NSA_ROPE_DIM = NSA_HEAD_DIM // 4
CMP_BLOCK = 32
CMP_STRIDE = 16
CMP_HIDDEN = 2 * NSA_HEAD_DIM
SEL_BLOCK = 64
N_SEL = 16
N_LOCAL_SEL = 2
WINDOW = 512
NSA_Q_BLOCK = 64

MIX_WIDTH = MLA_HEADS * MLA_V_DIM + NSA_HEADS * NSA_HEAD_DIM
NSA_KV_WIDTH = NSA_KV_HEADS * NSA_HEAD_DIM
IN_SPLITS = (MLA_Q_RANK, MLA_KV_RANK, MLA_ROPE_DIM, NSA_HEADS * NSA_HEAD_DIM) + (NSA_KV_WIDTH,) * 6 + (3 * NSA_HEADS,)
IN_COLS = sum(IN_SPLITS)

N_EXPERTS = 32
TOP_K = 4
D_FF = D_MODEL
SWIGLU_LIMIT = 7.0
SWIGLU_ALPHA = 1.702
MOE_BLOCK = 128

kernel_name = 'hybrid_mla_nsa_moe_layer'


def rms_norm(x, g):
    xf = x.astype(jnp.float32)
    y = xf * lax.rsqrt(jnp.mean(xf * xf, axis=-1, keepdims=True) + NORM_EPS)
    return (y * g.astype(jnp.float32)).astype(x.dtype)


def rope_cos_sin(pos, rot_dim):
    inv_freq = ROPE_THETA ** (-jnp.arange(0, rot_dim, 2, dtype=jnp.float32) / rot_dim)
    ang = pos.astype(jnp.float32)[..., None] * inv_freq
    return jnp.cos(ang), jnp.sin(ang)


def apply_rope(x, cos, sin):
    half = cos.shape[-1]
    c = cos[:, :, None, :].astype(x.dtype)
    s = sin[:, :, None, :].astype(x.dtype)
    x1, x2, rest = x[..., :half], x[..., half:2 * half], x[..., 2 * half:]
    return jnp.concatenate([x1 * c - x2 * s, x2 * c + x1 * s, rest], axis=-1)


def masked_softmax(s, mask):
    return jax.nn.softmax(jnp.where(mask, s, NEG_INF), axis=-1)


def mla_mixer(q_lat, kv_lat, k_pe, cos, sin, q_norm, w_q_up, kv_norm, w_kv_up):
    B, S, _ = q_lat.shape
    q = (rms_norm(q_lat, q_norm) @ w_q_up).reshape(B, S, MLA_HEADS, MLA_NOPE_DIM + MLA_ROPE_DIM)
    kv = (rms_norm(kv_lat, kv_norm) @ w_kv_up).reshape(B, S, MLA_HEADS, MLA_NOPE_DIM + MLA_V_DIM)
    k_nope, v = kv[..., :MLA_NOPE_DIM], kv[..., MLA_NOPE_DIM:]
    q = jnp.concatenate([q[..., :MLA_NOPE_DIM], apply_rope(q[..., MLA_NOPE_DIM:], cos, sin)], axis=-1)
    k_pe = apply_rope(k_pe[:, :, None, :], cos, sin)
    k = jnp.concatenate([k_nope, jnp.broadcast_to(k_pe, (B, S, MLA_HEADS, MLA_ROPE_DIM))], axis=-1)
    scale = (MLA_NOPE_DIM + MLA_ROPE_DIM) ** -0.5
    k_pos = jnp.arange(S)

    def block(i):
        q0 = i * Q_BLOCK
        qb = lax.dynamic_slice_in_dim(q, q0, Q_BLOCK, axis=1)
        s = jnp.einsum('bqhd,bkhd->bhqk', qb, k).astype(jnp.float32) * scale
        q_pos = q0 + jnp.arange(Q_BLOCK)
        p = masked_softmax(s, k_pos[None, :] <= q_pos[:, None])
        return jnp.einsum('bhqk,bkhd->bqhd', p.astype(v.dtype), v)

    o = lax.map(block, jnp.arange(S // Q_BLOCK))
    return jnp.moveaxis(o, 0, 1).reshape(B, S, MLA_HEADS * MLA_V_DIM)


def compress(kv, pos_emb, w1, w2):
    S = kv.shape[1]
    n_cmp = (S - CMP_BLOCK) // CMP_STRIDE + 1
    idx = jnp.arange(n_cmp)[:, None] * CMP_STRIDE + jnp.arange(CMP_BLOCK)[None, :]
    blocks = kv[:, idx] + pos_emb[:, None, :]
    hid = jax.nn.silu(jnp.einsum('bnlgd,ldh->bngh', blocks, w1))
    return hid @ w2


def nsa_mixer(q, k_c, v_c, k_s, v_s, k_w, v_w, gate_logits, pos, cos, sin, cmp_pos, cmp_w1, cmp_w2):
    B, S, _ = q.shape
    G, Hg, dh = NSA_KV_HEADS, NSA_GROUP, NSA_HEAD_DIM
    scale = dh ** -0.5
    q = apply_rope(q.reshape(B, S, NSA_HEADS, dh), cos, sin).reshape(B, S, G, Hg, dh)
    kv_shape = (B, S, G, dh)
    k_c, v_c, k_s, v_s, k_w, v_w = [t.reshape(kv_shape) for t in (k_c, v_c, k_s, v_s, k_w, v_w)]
    k_s = apply_rope(k_s, cos, sin)
    k_w = apply_rope(k_w, cos, sin)
    t = jnp.arange(S)

    n_cmp = (S - CMP_BLOCK) // CMP_STRIDE + 1
    cmp_start = jnp.arange(n_cmp) * CMP_STRIDE
    cmp_end = cmp_start + CMP_BLOCK - 1
    kc = compress(k_c, cmp_pos[0], cmp_w1[0], cmp_w2[0])
    vc = compress(v_c, cmp_pos[1], cmp_w1[1], cmp_w2[1])
    ccos, csin = rope_cos_sin(pos[:, cmp_end], NSA_ROPE_DIM)
    kc = apply_rope(kc, ccos, csin)
    s_cmp = jnp.einsum('bsghd,bngd->bghsn', q, kc).astype(jnp.float32) * scale
    p_cmp = masked_softmax(s_cmp, cmp_end[None, :] <= t[:, None]) * (t >= CMP_BLOCK - 1)[:, None]
    o_cmp = jnp.einsum('bghsn,bngd->bsghd', p_cmp.astype(vc.dtype), vc)

    n_sel = S // SEL_BLOCK
    j = jnp.arange(n_sel)
    overlap = ((cmp_start[:, None] < (j[None, :] + 1) * SEL_BLOCK)
               & (cmp_start[:, None] + CMP_BLOCK > j[None, :] * SEL_BLOCK)).astype(jnp.float32)
    imp = jnp.einsum('bghsn,nj->bgsj', p_cmp, overlap)
    cur = (t // SEL_BLOCK)[:, None]
    forced = (j[None, :] == 0) | ((j[None, :] <= cur) & (j[None, :] > cur - N_LOCAL_SEL))
    imp = jnp.where(forced, POS_INF, jnp.where(j[None, :] <= cur, imp, NEG_INF))
    k_top = min(N_SEL, n_sel)
    _, sel_idx = lax.top_k(imp, k_top)

    ks_blocks = k_s.reshape(B, n_sel, SEL_BLOCK, G, dh).transpose(0, 3, 1, 2, 4)
    vs_blocks = v_s.reshape(B, n_sel, SEL_BLOCK, G, dh).transpose(0, 3, 1, 2, 4)
    gather = jax.vmap(jax.vmap(lambda blk, ix: blk[ix]))
    k_w_pad = jnp.pad(k_w, ((0, 0), (WINDOW, 0), (0, 0), (0, 0)))
    v_w_pad = jnp.pad(v_w, ((0, 0), (WINDOW, 0), (0, 0), (0, 0)))
    n_keys_sel = k_top * SEL_BLOCK

    def block(i):
        q0 = i * NSA_Q_BLOCK
        qb = lax.dynamic_slice_in_dim(q, q0, NSA_Q_BLOCK, axis=1)
        q_pos = q0 + jnp.arange(NSA_Q_BLOCK)
        ib = lax.dynamic_slice_in_dim(sel_idx, q0, NSA_Q_BLOCK, axis=2)
        kg = gather(ks_blocks, ib).reshape(B, G, NSA_Q_BLOCK, n_keys_sel, dh)
        vg = gather(vs_blocks, ib).reshape(B, G, NSA_Q_BLOCK, n_keys_sel, dh)
        key_pos = (ib[..., None] * SEL_BLOCK + jnp.arange(SEL_BLOCK)).reshape(B, G, NSA_Q_BLOCK, n_keys_sel)
        s_sel = jnp.einsum('bqghd,bgqkd->bghqk', qb, kg).astype(jnp.float32) * scale
        p_sel = masked_softmax(s_sel, (key_pos <= q_pos[:, None])[:, :, None])
        o_sel = jnp.einsum('bghqk,bgqkd->bqghd', p_sel.astype(vg.dtype), vg)
        kwb = lax.dynamic_slice_in_dim(k_w_pad, q0, NSA_Q_BLOCK + WINDOW, axis=1)
        vwb = lax.dynamic_slice_in_dim(v_w_pad, q0, NSA_Q_BLOCK + WINDOW, axis=1)
        w_pos = q0 - WINDOW + jnp.arange(NSA_Q_BLOCK + WINDOW)
        w_mask = ((w_pos[None, :] <= q_pos[:, None]) & (w_pos[None, :] > q_pos[:, None] - WINDOW)
                  & (w_pos[None, :] >= 0))
        s_win = jnp.einsum('bqghd,bkgd->bghqk', qb, kwb).astype(jnp.float32) * scale
        p_win = masked_softmax(s_win, w_mask)
        o_win = jnp.einsum('bghqk,bkgd->bqghd', p_win.astype(vwb.dtype), vwb)
        return o_sel, o_win

    o_sel, o_win = lax.map(block, jnp.arange(S // NSA_Q_BLOCK))
    o_sel = jnp.moveaxis(o_sel, 0, 1).reshape(B, S, G, Hg, dh)
    o_win = jnp.moveaxis(o_win, 0, 1).reshape(B, S, G, Hg, dh)
    gates = jax.nn.sigmoid(gate_logits.astype(jnp.float32)).reshape(B, S, G, Hg, 3).astype(q.dtype)
    o = gates[..., 0:1] * o_cmp + gates[..., 1:2] * o_sel + gates[..., 2:3] * o_win
    return o.reshape(B, S, NSA_HEADS * dh)


def moe_ffn(h, router_w, router_b, w1, b1, w2, b2):
    B, S, D = h.shape
    xt = h.reshape(-1, D)
    N = xt.shape[0]
    logits = (xt @ router_w + router_b).astype(jnp.float32)
    top_val, top_idx = lax.top_k(logits, TOP_K)
    gate = jax.nn.softmax(top_val, axis=-1)
    flat_e = top_idx.reshape(-1)
    flat_tok = jnp.repeat(jnp.arange(N, dtype=jnp.int32), TOP_K)
    order = jnp.argsort(flat_e)
    se, stok, sgate = flat_e[order], flat_tok[order], gate.reshape(-1)[order]
    counts = jnp.bincount(flat_e, length=N_EXPERTS)
    padded = ((counts + MOE_BLOCK - 1) // MOE_BLOCK) * MOE_BLOCK
    start = jnp.cumsum(counts) - counts
    pend = jnp.cumsum(padded)
    pstart = pend - padded
    dest = pstart[se] + (jnp.arange(N * TOP_K) - start[se])
    n_blocks = -(-(N * TOP_K) // MOE_BLOCK) + N_EXPERTS
    n_rows = n_blocks * MOE_BLOCK
    row_tok = jnp.zeros((n_rows,), jnp.int32).at[dest].set(stok)
    row_gate = jnp.zeros((n_rows,), xt.dtype).at[dest].set(sgate.astype(xt.dtype))
    block_expert = jnp.minimum(jnp.searchsorted(pend, jnp.arange(n_blocks) * MOE_BLOCK, side='right'),
                               N_EXPERTS - 1)

    def expert_block(args):
        tok, e, g = args
        hcat = xt[tok] @ w1[e] + b1[e]
        a = jnp.minimum(hcat[:, :D_FF], SWIGLU_LIMIT)
        up = jnp.clip(hcat[:, D_FF:], -SWIGLU_LIMIT, SWIGLU_LIMIT)
        glu = a * jax.nn.sigmoid(SWIGLU_ALPHA * a)
        return (((up + 1.0) * glu) @ w2[e] + b2[e]) * g[:, None]

    y = lax.map(expert_block, (row_tok.reshape(n_blocks, MOE_BLOCK), block_expert,
                               row_gate.reshape(n_blocks, MOE_BLOCK)))
    out = jax.ops.segment_sum(y.reshape(n_rows, D), row_tok, num_segments=N)
    return out.reshape(B, S, D)


def setup_inputs(seed: int = 0) -> dict:
    key = jax.random.key(seed)
    ks = jax.random.split(key, 24)
    f32 = jnp.float32
    L = DEPTH

    def normal(k, shape, scale):
        return jax.random.normal(k, shape, f32) * scale

    def gain(k, shape):
        return 1.0 + 0.02 * jax.random.normal(k, shape, f32)

    x = normal(ks[0], (BATCH, SEQ, D_MODEL), 1.0)
    positions = (jnp.arange(SEQ, dtype=jnp.int32)[None, :]
                 + jax.random.randint(ks[1], (BATCH, 1), 0, 1024, dtype=jnp.int32))
    return {
        'x': x,
        'positions': positions,
        'attn_norm': gain(ks[2], (L, D_MODEL)),
        'w_in': normal(ks[3], (L, D_MODEL, IN_COLS), D_MODEL ** -0.5),
        'mla_q_norm': gain(ks[4], (L, MLA_Q_RANK)),
        'mla_w_q_up': normal(ks[5], (L, MLA_Q_RANK, MLA_HEADS * (MLA_NOPE_DIM + MLA_ROPE_DIM)), MLA_Q_RANK ** -0.5),
        'mla_kv_norm': gain(ks[6], (L, MLA_KV_RANK)),
        'mla_w_kv_up': normal(ks[7], (L, MLA_KV_RANK, MLA_HEADS * (MLA_NOPE_DIM + MLA_V_DIM)), MLA_KV_RANK ** -0.5),
        'nsa_cmp_pos': normal(ks[8], (L, 2, CMP_BLOCK, NSA_HEAD_DIM), 0.1),
        'nsa_cmp_w1': normal(ks[9], (L, 2, CMP_BLOCK, NSA_HEAD_DIM, CMP_HIDDEN), (CMP_BLOCK * NSA_HEAD_DIM) ** -0.5),
        'nsa_cmp_w2': normal(ks[10], (L, 2, CMP_HIDDEN, NSA_HEAD_DIM), CMP_HIDDEN ** -0.5),
        'w_out': normal(ks[11], (L, MIX_WIDTH, D_MODEL), MIX_WIDTH ** -0.5),
        'ffn_norm': gain(ks[12], (L, D_MODEL)),
        'router_w': normal(ks[13], (L, D_MODEL, N_EXPERTS), D_MODEL ** -0.5),
        'router_b': normal(ks[14], (L, N_EXPERTS), 0.01),
        'moe_w1': normal(ks[15], (L, N_EXPERTS, D_MODEL, 2 * D_FF), D_MODEL ** -0.5),
        'moe_b1': normal(ks[16], (L, N_EXPERTS, 2 * D_FF), 0.02),
        'moe_w2': normal(ks[17], (L, N_EXPERTS, D_FF, D_MODEL), D_FF ** -0.5),
        'moe_b2': normal(ks[18], (L, N_EXPERTS, D_MODEL), 0.02),
        'final_norm': gain(ks[19], (D_MODEL,)),
    }


def reference(x, positions, attn_norm, w_in, mla_q_norm, mla_w_q_up, mla_kv_norm, mla_w_kv_up,
              nsa_cmp_pos, nsa_cmp_w1, nsa_cmp_w2, w_out, ffn_norm, router_w, router_b,
              moe_w1, moe_b1, moe_w2, moe_b2, final_norm):
    cos_mla, sin_mla = rope_cos_sin(positions, MLA_ROPE_DIM)
    cos_nsa, sin_nsa = rope_cos_sin(positions, NSA_ROPE_DIM)
    split_at = np.cumsum(IN_SPLITS)[:-1].tolist()
    h = x
    for l in range(DEPTH):
        u = rms_norm(h, attn_norm[l])
        (q_lat, kv_lat, k_pe, q_nsa, k_c, v_c, k_s, v_s, k_w, v_w, g_nsa) = jnp.split(u @ w_in[l], split_at, axis=-1)
        o_mla = mla_mixer(q_lat, kv_lat, k_pe, cos_mla, sin_mla,
                          mla_q_norm[l], mla_w_q_up[l], mla_kv_norm[l], mla_w_kv_up[l])
        o_nsa = nsa_mixer(q_nsa, k_c, v_c, k_s, v_s, k_w, v_w, g_nsa, positions, cos_nsa, sin_nsa,
                          nsa_cmp_pos[l], nsa_cmp_w1[l], nsa_cmp_w2[l])
        h = h + jnp.concatenate([o_mla, o_nsa], axis=-1) @ w_out[l]
        h = h + moe_ffn(rms_norm(h, ffn_norm[l]), router_w[l], router_b[l],
                        moe_w1[l], moe_b1[l], moe_w2[l], moe_b2[l])
    return rms_norm(h, final_norm)
```

```cpp
#include <hip/hip_runtime.h>
#include <hip/hip_cooperative_groups.h>
#include <cstdint>
#include <cstdio>
#include <cstring>
namespace cg = cooperative_groups;

#ifndef MK_ONE_LAUNCH
#define MK_ONE_LAUNCH 1
#endif

#define LAS __attribute__((address_space(3)))
#define DEV __device__ __forceinline__
typedef unsigned short bf16_t;
typedef short bf16x8 __attribute__((ext_vector_type(8)));
typedef float f32x4 __attribute__((ext_vector_type(4)));
typedef float f32x2 __attribute__((ext_vector_type(2)));
typedef unsigned u32x4 __attribute__((ext_vector_type(4)));
typedef unsigned u32x2 __attribute__((ext_vector_type(2)));

constexpr int BATCH = 8, SEQ = 4096, NTOK = BATCH * SEQ, DM = 1024;
constexpr int INC = 1720, INP = 1792;
constexpr int C_QLAT = 0, C_KVLAT = 256, C_KPE = 384, C_QNSA = 416, C_KC = 928, C_VC = 1056, C_KS = 1184, C_VS = 1312, C_KW = 1440, C_VW = 1568, C_G = 1696;
constexpr int NEXP = 32, TOPK = 4, DFF = 1024;
constexpr int NCMP = 255, NCMPP = 256;
constexpr int MAXROWS = 139264;
constexpr float LOG2E = 1.4426950408889634f;
constexpr float MLA_QSCALE = 0.10206207261596577f * LOG2E;
constexpr float NSA_QSCALE = 0.125f * LOG2E;

constexpr size_t MiB = 1ull << 20;
constexpr size_t OFF_W1T = 0;
constexpr size_t OFF_W2T = 128 * MiB;
constexpr size_t OFF_WINT = 192 * MiB;
constexpr size_t OFF_WQUPT = 196 * MiB;
constexpr size_t OFF_WKVUPT = 197 * MiB;
constexpr size_t OFF_WOUTT = 198 * MiB;
constexpr size_t OFF_CW1T = 200 * MiB;
constexpr size_t OFF_MISC = 202 * MiB;
constexpr size_t OFF_CB = OFF_MISC + 8192;
constexpr size_t OFF_CNT = OFF_MISC + 4096;
constexpr size_t OFF_BAR = OFF_MISC + 16384;
constexpr size_t OFF_TOPI = OFF_MISC + 64 * 1024;
constexpr size_t OFF_TOPG = OFF_TOPI + (size_t)NTOK * 16;
constexpr size_t OFF_POS = OFF_TOPG + (size_t)NTOK * 16;
constexpr size_t OFF_ROWGATE = OFF_POS + (size_t)NTOK * 16;
constexpr size_t OFF_SXROW = OFF_ROWGATE + (size_t)MAXROWS * 4;
constexpr size_t OFF_SXTOK = OFF_SXROW + (size_t)MAXROWS * 4;
constexpr size_t OFF_SW1 = OFF_SXTOK + (size_t)NTOK * 4;
constexpr size_t OFF_H1 = 206 * MiB;
constexpr size_t OFF_R1 = 334 * MiB;
constexpr size_t OFF_R2 = 606 * MiB;
constexpr size_t WS_END = 878 * MiB;
constexpr size_t OFF_U = OFF_R1;
constexpr size_t OFF_QM = OFF_R1;
constexpr size_t OFF_OCAT = OFF_R1 + 64 * MiB;
constexpr size_t OFF_OCMP = OFF_R1 + 160 * MiB;
constexpr size_t OFF_KCC = OFF_R1 + 128 * MiB;
constexpr size_t OFF_VCC = OFF_R1 + 136 * MiB;
constexpr size_t OFF_VSC = OFF_R1 + 144 * MiB;
constexpr size_t OFF_VWC = OFF_R1 + 152 * MiB;
constexpr size_t OFF_SELM = OFF_R1 + 240 * MiB;
constexpr size_t OFF_KC = OFF_R1 + 241 * MiB;
constexpr size_t OFF_VC = OFF_R1 + 242 * MiB;
constexpr size_t OFF_GATES = OFF_R1 + 243 * MiB;
constexpr size_t OFF_ROPEM = OFF_R1 + 246 * MiB;
constexpr size_t OFF_KSR = OFF_R1 + 250 * MiB;
constexpr size_t OFF_KWR = OFF_R1 + 258 * MiB;
constexpr size_t OFF_PROJ = OFF_R2;
constexpr size_t OFF_NQ = OFF_R2 + 112 * MiB;
constexpr size_t OFF_QN = OFF_R2 + 144 * MiB;
constexpr size_t OFF_KVN = OFF_R2 + 160 * MiB;
constexpr size_t OFF_KM = OFF_R2 + 176 * MiB;
constexpr size_t OFF_VM = OFF_R2 + 224 * MiB;
constexpr size_t OFF_QUP = OFF_R2 + 256 * MiB;
constexpr size_t OFF_KVUP = OFF_R2 + 256 * MiB;
constexpr size_t OFF_KPE = OFF_R2 + 256 * MiB;
constexpr size_t OFF_XN = OFF_R2 + 0;
constexpr size_t OFF_XG = OFF_R1;
constexpr size_t OFF_Y = OFF_R1;
constexpr size_t OFF_HMID = OFF_R2;

struct Params {
    const float* x; const int* pos; const float* attn_norm; const float* w_in; const float* q_norm; const float* w_q_up; const float* kv_norm; const float* w_kv_up;
    const float* cmp_pos; const float* cmp_w1; const float* cmp_w2; const float* w_out; const float* ffn_norm; const float* router_w; const float* router_b;
    const float* moe_w1; const float* moe_b1; const float* moe_w2; const float* moe_b2; const float* final_norm;
    float* out; unsigned char* ws;
};

DEV float bf2f(bf16_t b) { return __uint_as_float((unsigned)b << 16); }
DEV float bflo(unsigned u) { return __uint_as_float(u << 16); }
DEV float bfhi(unsigned u) { return __uint_as_float(u & 0xffff0000u); }
DEV unsigned pk2(float lo, float hi) { unsigned r; asm volatile("v_cvt_pk_bf16_f32 %0, %1, %2" : "=v"(r) : "v"(lo), "v"(hi)); return r; }
DEV bf16_t f2bf(float f) { return (bf16_t)(pk2(f, 0.f) & 0xffffu); }
DEV float wave_sum(float v) {
#pragma unroll
    for (int o = 1; o < 64; o <<= 1) v += __shfl_xor(v, o);
    return v;
}
DEV float fast_exp2(float x) { return __builtin_amdgcn_exp2f(x); }
DEV int opaque_tid() { int t = threadIdx.x; asm volatile("" : "+v"(t)); return t; }

#define XB_TMO      128
#define XB_XCNT(j)  (256  + 64 * (j))
#define XB_XSUB(j)  (1280 + 64 * (j))
#define XB_XGEN(j)  (2304 + 64 * (j))
#define XB_TOP      3328
#define XB_TOPGEN   3392
#define XCD_BAR_WORDS 3456
#define XB_SPIN_CAP (1u << 22)
DEV unsigned xb_ld(unsigned* p) { return __hip_atomic_load(p, __ATOMIC_RELAXED, __HIP_MEMORY_SCOPE_AGENT); }
DEV unsigned xb_add(unsigned* p, unsigned v) { return __hip_atomic_fetch_add(p, v, __ATOMIC_RELAXED, __HIP_MEMORY_SCOPE_AGENT); }
DEV unsigned xb_xcc_id() { return (unsigned)__builtin_amdgcn_s_getreg((3 << 11) | 20) & 0xFu; }
#define XB_SPIN(cond, bar) do { unsigned _sp = 0; while (cond) { __builtin_amdgcn_s_sleep(1); \
    if ((++_sp & 255u) == 0u) { if (xb_ld(&(bar)[XB_TMO])) break; if (_sp > XB_SPIN_CAP) { atomicAdd(&(bar)[XB_TMO], 1u); break; } } } } while (0)
struct XcdBarrier { unsigned* bar; unsigned x; volatile LAS unsigned* st; };
DEV XcdBarrier xcd_barrier_post(unsigned* bar, volatile LAS unsigned* st) {
    XcdBarrier b; b.bar = bar; b.x = xb_xcc_id(); b.st = st;
    if (threadIdx.x == 0) (void)xb_add(&bar[XB_XCNT(b.x)], 1u);
    return b;
}
DEV void xcd_barrier_complete(unsigned* bar, unsigned x, unsigned& nloc, unsigned& nx) {
    const unsigned G = gridDim.x * gridDim.y * gridDim.z;
    unsigned sum, cnt, mine, sp = 0u;
    for (;;) {
        sum = 0u; cnt = 0u; mine = 0u;
#pragma unroll
        for (unsigned j = 0; j < 16; ++j) { const unsigned c = xb_ld(&bar[XB_XCNT(j)]); sum += c; cnt += (c > 0u) ? 1u : 0u; mine = (j == x) ? c : mine; }
        if (sum == G) break;
        __builtin_amdgcn_s_sleep(1);
        if ((++sp & 255u) == 0u) { if (xb_ld(&bar[XB_TMO])) break; if (sp > XB_SPIN_CAP) { atomicAdd(&bar[XB_TMO], 1u); break; } }
    }
    nloc = mine > 0u ? mine : 1u; nx = cnt > 0u ? cnt : 1u;
}
DEV void xcd_barrier(const XcdBarrier& b) {
    asm volatile("s_waitcnt vmcnt(0)" ::: "memory");
    __syncthreads();
    if (threadIdx.x == 0) {
        unsigned* bar = b.bar;
        __builtin_amdgcn_s_waitcnt(0);
        unsigned nloc = b.st[0], nx = b.st[1];
        if (nloc == 0u) { xcd_barrier_complete(bar, b.x, nloc, nx); b.st[0] = nloc; b.st[1] = nx; }
        const unsigned old = xb_add(&bar[XB_XSUB(b.x)], 1u);
        const unsigned gen = old / nloc;
        if (old + 1u == (gen + 1u) * nloc) {
            __builtin_amdgcn_fence(__ATOMIC_RELEASE, "agent");
            asm volatile("s_waitcnt vmcnt(0)" ::: "memory");
            const unsigned og = xb_add(&bar[XB_TOP], 1u);
            const unsigned tg = og / nx;
            if (og + 1u == (tg + 1u) * nx) xb_add(&bar[XB_TOPGEN], 1u);
            else XB_SPIN(xb_ld(&bar[XB_TOPGEN]) == tg, bar);
            __builtin_amdgcn_fence(__ATOMIC_ACQUIRE, "agent");
            xb_add(&bar[XB_XGEN(b.x)], 1u);
            asm volatile("s_waitcnt vmcnt(0)" ::: "memory");
        } else {
            XB_SPIN(xb_ld(&bar[XB_XGEN(b.x)]) == gen, bar);
            __builtin_amdgcn_fence(__ATOMIC_ACQUIRE, "agent");
            asm volatile("s_waitcnt vmcnt(0)" ::: "memory");
        }
    }
    __syncthreads();
}

namespace pg8 {
constexpr int BM = 256, BK = 64, HALF = 128, HTB = HALF * BK * 2, STAGE_BYTES = 8 * HTB, NXCD = 8, WGM = 8;
DEV int lds_byte(int r, int c) { const int st = (r >> 4) * 2 + (c >> 5), rr = r & 15, cc = c & 31, ob = rr * 64 + cc * 2; return st * 1024 + (ob ^ (((ob >> 9) & 1) << 5)); }
DEV void stage_rc(int b, int& R, int& C) { const int st = b / 1024, sb = b % 1024, swz = sb ^ (((sb >> 9) & 1) << 5); R = (st >> 1) * 16 + swz / 64; C = (st & 1) * 32 + (swz % 64) / 2; }

struct Unit { int pm, pn, e; const char* a; const char* b; };
struct Gemm { int K; int amode; };

struct DenseOrder {
    int nM, nN, nwg, G, c; const char* A; const char* Bt; size_t tstep;
    DEV void init(const void* A_, const void* Bt_, int K, int M, int N, int G_, int c_) { A = (const char*)A_; Bt = (const char*)Bt_; tstep = (size_t)BM * K * 2; nM = M / BM; nN = N / BM; nwg = nM * nN; G = G_; c = c_; }
    DEV bool next(int i, Unit& u) const {
        const long L = (long)i * G + c; if (L >= nwg) return false;
        int wgid = (int)L; { const int q = nwg / NXCD, r = nwg % NXCD, xcd = wgid % NXCD, off = wgid / NXCD; wgid = (xcd < r ? xcd * (q + 1) : r * (q + 1) + (xcd - r) * q) + off; }
        const int nig = WGM * nN, gid = wgid / nig, fm = gid * WGM, gsz = (nM - fm) < WGM ? (nM - fm) : WGM;
        u.pm = fm + ((wgid % nig) % gsz); u.pn = (wgid % nig) / gsz; u.e = 0; u.a = A + (size_t)u.pm * tstep; u.b = Bt + (size_t)u.pn * tstep; return true;
    }
};
struct MoeOrder {
    DenseOrder d; const LAS unsigned* tend;
    int nNt;
    DEV bool next(int i, Unit& u) const {
        if (!d.next(i, u)) return false;
        const int e = __builtin_popcountll(__ballot(u.pm >= (int)tend[threadIdx.x & 31]) & 0xffffffffull);
        u.e = e; u.b = d.Bt + (size_t)(e * nNt + u.pn) * d.tstep; return true;
    }
};

struct CmpOrder {
    const char* KCC; const char* VCC; const char* W; int k;
    DEV bool next(int i, Unit& u) const {
        if (i != 0 || k < 0) return false;
        const int c = k >> 4, pm = k & 15, b = pm >> 1, n0 = (pm & 1) * 128;
        u.pm = pm; u.pn = 0; u.e = c; u.a = (c == 0 ? KCC : VCC) + (size_t)(b * SEQ + 16 * n0) * 128 * 2; u.b = W + (size_t)c * 256 * 2048 * 2; return true;
    }
};

typedef int i32x4 __attribute__((ext_vector_type(4)));
template <class Epi, class Sched, bool I8 = false>
DEV void gemm_phase(LAS unsigned char* lds, const Gemm g, const Sched& S, const Epi& E) {
    const int tid = opaque_tid(), wid = __builtin_amdgcn_readfirstlane(tid >> 6), lane = tid & 63, wr = wid >> 2, wc = wid & 3, fr = lane & 15, fq = lane >> 4;
    const int K = g.K; int nt = K / BK; asm volatile("" : "+s"(nt));
    unsigned voffA[2], voffB[2];
#pragma unroll
    for (int i = 0; i < 2; ++i) { int R, C; stage_rc(tid * 16 + i * 8192, R, C); voffB[i] = (unsigned)(R * K + C) * 2u;
        voffA[i] = (g.amode == 0) ? voffB[i] : (unsigned)((R >> 1) * 16 * 128 + (R & 1) * 64 + C) * 2u; }
    const size_t kstepB = (size_t)(BK * 2), kstepA = (g.amode == 0) ? kstepB : (size_t)128 * 2;
    const size_t hstepB = (size_t)HALF * K * 2, hstepA = (g.amode == 0) ? hstepB : (size_t)64 * 16 * 128 * 2;
    const unsigned ldsw = (unsigned)wid * 1024u;
    const int aoff = lds_byte(wr * 64 + fr, fq * 8), boff = lds_byte(wc * 32 + fr, fq * 8);
#define PG8_SA(b, h) (((b) * 2 + (h)) * HTB)
#define PG8_SB(b, h) ((4 + (b) * 2 + (h)) * HTB)
#define PG8_STAGE(bufoff, gbase, voff) do { _Pragma("unroll") for (int _i = 0; _i < 2; ++_i) \
        __builtin_amdgcn_global_load_lds((const unsigned*)((const char*)(gbase) + (voff)[_i]), (LAS unsigned*)(lds + (bufoff) + ldsw + _i * 8192), 16, 0, 0); } while (0)
#define PG8_LDA(dst, b, h) do { _Pragma("unroll") for (int m = 0; m < 4; ++m) _Pragma("unroll") for (int k = 0; k < 2; ++k) dst[m][k] = *(const LAS bf16x8*)(lds + PG8_SA(b, h) + aoff + m * 2048 + k * 1024); } while (0)
#define PG8_LDB(dst, b, h) do { _Pragma("unroll") for (int n = 0; n < 2; ++n) _Pragma("unroll") for (int k = 0; k < 2; ++k) dst[n][k] = *(const LAS bf16x8*)(lds + PG8_SB(b, h) + boff + n * 2048 + k * 1024); } while (0)
#define PG8_MMA(ai, bj, At, Bt) do { __builtin_amdgcn_s_setprio(1); _Pragma("unroll") for (int m = 0; m < 4; ++m) _Pragma("unroll") for (int n = 0; n < 2; ++n) _Pragma("unroll") for (int k = 0; k < 2; ++k) { \
        if constexpr (I8) acc[ai][bj][m][n] = __builtin_bit_cast(f32x4, __builtin_amdgcn_mfma_i32_16x16x64_i8(__builtin_bit_cast(i32x4, Bt[n][k]), __builtin_bit_cast(i32x4, At[m][k]), __builtin_bit_cast(i32x4, acc[ai][bj][m][n]), 0, 0, 0)); \
        else acc[ai][bj][m][n] = __builtin_amdgcn_mfma_f32_16x16x32_bf16(Bt[n][k], At[m][k], acc[ai][bj][m][n], 0, 0, 0); } __builtin_amdgcn_s_setprio(0); } while (0)
#define PG8_WAIT_V(n) asm volatile("s_waitcnt vmcnt(" #n ")" ::: "memory")
#define PG8_WAIT_L(n) asm volatile("s_waitcnt lgkmcnt(" #n ")" ::: "memory")
#define PG8_BAR __builtin_amdgcn_s_barrier()
#define PG8_SCHED __builtin_amdgcn_sched_barrier(0)
    Unit cur, nxt; int ui = 0;
    if (!S.next(0, cur)) return;
    f32x4 acc[2][2][4][2];
#pragma unroll
    for (int a = 0; a < 2; ++a)
#pragma unroll
        for (int b = 0; b < 2; ++b)
#pragma unroll
            for (int m = 0; m < 4; ++m)
#pragma unroll
                for (int n = 0; n < 2; ++n) acc[a][b][m][n] = (f32x4){0.f, 0.f, 0.f, 0.f};
    bf16x8 At[4][2], B0[2][2], B1[2][2];
    const char* cA = cur.a; const char* cB = cur.b;
    PG8_STAGE(PG8_SB(0, 0), cB, voffB); PG8_STAGE(PG8_SB(0, 1), cB + hstepB, voffB); PG8_STAGE(PG8_SA(0, 0), cA, voffA); PG8_STAGE(PG8_SA(0, 1), cA + hstepA, voffA);
    if (wr == 1) PG8_BAR;
    PG8_WAIT_V(2); PG8_BAR;
    PG8_STAGE(PG8_SB(1, 0), cB + kstepB, voffB); PG8_STAGE(PG8_SA(1, 0), cA + kstepA, voffA); PG8_STAGE(PG8_SB(1, 1), cB + hstepB + kstepB, voffB);
    PG8_WAIT_V(6); PG8_BAR;
    for (;;) {
        const bool has_next = S.next(ui + 1, nxt);
        const char* nA = has_next ? nxt.a : cA; const char* nB = has_next ? nxt.b : cB;
#pragma unroll 1
        for (int t = 0; t < nt; t += 2) {
            const bool last = (t == nt - 2);
            const char* a1 = cA + (size_t)(t + 1) * kstepA;
            const char* a2 = last ? nA : cA + (size_t)(t + 2) * kstepA; const char* b2 = last ? nB : cB + (size_t)(t + 2) * kstepB;
            const char* a3 = a2 + kstepA; const char* b3 = b2 + kstepB;
            PG8_LDB(B0, 0, 0); PG8_LDB(B1, 0, 1); PG8_SCHED; PG8_LDA(At, 0, 0); PG8_STAGE(PG8_SA(1, 1), a1 + hstepA, voffA);
            PG8_WAIT_V(8); PG8_WAIT_L(0); PG8_BAR; PG8_MMA(0, 0, At, B0); PG8_MMA(0, 1, At, B1); PG8_BAR; PG8_SCHED;
            PG8_LDA(At, 0, 1); PG8_STAGE(PG8_SB(0, 0), b2, voffB); PG8_STAGE(PG8_SB(0, 1), b2 + hstepB, voffB); PG8_STAGE(PG8_SA(0, 0), a2, voffA);
            PG8_WAIT_V(8); PG8_WAIT_L(0); PG8_BAR; PG8_MMA(1, 0, At, B0); PG8_MMA(1, 1, At, B1); PG8_BAR; PG8_SCHED;
            PG8_LDB(B0, 1, 0); PG8_LDB(B1, 1, 1); PG8_SCHED; PG8_LDA(At, 1, 0); PG8_STAGE(PG8_SA(0, 1), a2 + hstepA, voffA);
            PG8_WAIT_V(8); PG8_WAIT_L(0); PG8_BAR; PG8_MMA(0, 0, At, B0); PG8_MMA(0, 1, At, B1); PG8_BAR; PG8_SCHED;
            PG8_LDA(At, 1, 1); PG8_STAGE(PG8_SB(1, 0), b3, voffB); PG8_STAGE(PG8_SB(1, 1), b3 + hstepB, voffB); PG8_STAGE(PG8_SA(1, 0), a3, voffA);
            PG8_WAIT_V(8); PG8_WAIT_L(0); PG8_BAR; PG8_MMA(1, 0, At, B0); PG8_MMA(1, 1, At, B1); PG8_BAR; PG8_SCHED;
        }
        if (wr == 0) PG8_BAR;
        if constexpr (!Epi::AFTER_DRAIN) E(acc, cur, wr, wc, fr, fq);
        if (!has_next) break;
#pragma unroll
        for (int a = 0; a < 2; ++a)
#pragma unroll
            for (int b = 0; b < 2; ++b)
#pragma unroll
                for (int m = 0; m < 4; ++m)
#pragma unroll
                    for (int n = 0; n < 2; ++n) acc[a][b][m][n] = (f32x4){0.f, 0.f, 0.f, 0.f};
        cur = nxt; cA = nA; cB = nB; ++ui;
        if (wr == 1) PG8_BAR;
    }
    PG8_WAIT_V(0);
    PG8_BAR;
    if constexpr (Epi::AFTER_DRAIN) E.fused(acc, cur, wr, wc, fr, fq, lds);
#undef PG8_SA
#undef PG8_SB
#undef PG8_STAGE
#undef PG8_LDA
#undef PG8_LDB
#undef PG8_MMA
#undef PG8_WAIT_V
#undef PG8_WAIT_L
#undef PG8_BAR
#undef PG8_SCHED
}
struct EpiBf16 {
    static constexpr bool AFTER_DRAIN = false;
    bf16_t* O; int ldc;
    DEV void operator()(const f32x4 (&acc)[2][2][4][2], const Unit& u, int wr, int wc, int fr, int fq) const {
#pragma unroll
        for (int ai = 0; ai < 2; ++ai)
#pragma unroll
            for (int m = 0; m < 4; ++m) { bf16_t* rowp = O + (size_t)(u.pm * BM + ai * HALF + wr * 64 + m * 16 + fr) * ldc + u.pn * BM + wc * 32 + 4 * fq;
#pragma unroll
                for (int bj = 0; bj < 2; ++bj)
#pragma unroll
                    for (int n = 0; n < 2; ++n) { const f32x4 v = acc[ai][bj][m][n]; u32x2 w; w.x = pk2(v[0], v[1]); w.y = pk2(v[2], v[3]); *(u32x2*)(rowp + bj * HALF + n * 16) = w; } }
    }
};
struct EpiResF32 {
    static constexpr bool AFTER_DRAIN = false;
    const float* base; float* out; int ldc;
    DEV void operator()(const f32x4 (&acc)[2][2][4][2], const Unit& u, int wr, int wc, int fr, int fq) const {
#pragma unroll
        for (int ai = 0; ai < 2; ++ai) { f32x4 b[4][2][2];
#pragma unroll
            for (int m = 0; m < 4; ++m) { const size_t off = (size_t)(u.pm * BM + ai * HALF + wr * 64 + m * 16 + fr) * ldc + u.pn * BM + wc * 32 + 4 * fq;
#pragma unroll
                for (int bj = 0; bj < 2; ++bj)
#pragma unroll
                    for (int n = 0; n < 2; ++n) b[m][bj][n] = *(const f32x4*)(base + off + bj * HALF + n * 16); }
#pragma unroll
            for (int m = 0; m < 4; ++m) { const size_t off = (size_t)(u.pm * BM + ai * HALF + wr * 64 + m * 16 + fr) * ldc + u.pn * BM + wc * 32 + 4 * fq;
#pragma unroll
                for (int bj = 0; bj < 2; ++bj)
#pragma unroll
                    for (int n = 0; n < 2; ++n) *(f32x4*)(out + off + bj * HALF + n * 16) = b[m][bj][n] + acc[ai][bj][m][n]; } }
    }
};
struct EpiMoe1 {
    static constexpr bool AFTER_DRAIN = false;
    bf16_t* O; const float* b1; const float* sw; const float* sx;
    DEV void operator()(const f32x4 (&acc)[2][2][4][2], const Unit& u, int wr, int wc, int fr, int fq) const {
        const float* bb = b1 + (size_t)u.e * 2048; const float* ss = sw + (size_t)u.e * 2048 + u.pn * BM;
        f32x4 ba[2], bu[2], sa[2], su[2];
#pragma unroll
        for (int n = 0; n < 2; ++n) { const int c = wc * 32 + n * 16 + 4 * fq; ba[n] = *(const f32x4*)(bb + u.pn * HALF + c); bu[n] = *(const f32x4*)(bb + 1024 + u.pn * HALF + c); sa[n] = *(const f32x4*)(ss + c); su[n] = *(const f32x4*)(ss + HALF + c); }
        float srv[2][4];
#pragma unroll
        for (int ai = 0; ai < 2; ++ai)
#pragma unroll
            for (int m = 0; m < 4; ++m) srv[ai][m] = sx[u.pm * BM + ai * HALF + wr * 64 + m * 16 + fr];
#pragma unroll
        for (int ai = 0; ai < 2; ++ai)
#pragma unroll
            for (int m = 0; m < 4; ++m) { const int row = u.pm * BM + ai * HALF + wr * 64 + m * 16 + fr; const float sr = srv[ai][m]; bf16_t* rowp = O + (size_t)row * DFF + u.pn * HALF + wc * 32 + 4 * fq;
#pragma unroll
                for (int n = 0; n < 2; ++n) { const i32x4 ia = __builtin_bit_cast(i32x4, acc[ai][0][m][n]), iu = __builtin_bit_cast(i32x4, acc[ai][1][m][n]); float r[4];
#pragma unroll
                    for (int j = 0; j < 4; ++j) { const float a = fminf((float)ia[j] * (sr * sa[n][j]) + ba[n][j], 7.0f), up = fminf(fmaxf((float)iu[j] * (sr * su[n][j]) + bu[n][j], -7.0f), 7.0f);
                        const float glu = a * __builtin_amdgcn_rcpf(1.0f + __expf(-1.702f * a)); r[j] = (up + 1.0f) * glu; }
                    u32x2 w; w.x = pk2(r[0], r[1]); w.y = pk2(r[2], r[3]); *(u32x2*)(rowp + n * 16) = w; } }
    }
};
struct EpiMoe2 {
    static constexpr bool AFTER_DRAIN = false;
    bf16_t* O; const float* b2; const float* rowgate;
    DEV void operator()(const f32x4 (&acc)[2][2][4][2], const Unit& u, int wr, int wc, int fr, int fq) const {
        const float* bb = b2 + (size_t)u.e * 1024;
        float gtv[2][4]; f32x4 bvv[2][2];
#pragma unroll
        for (int ai = 0; ai < 2; ++ai)
#pragma unroll
            for (int m = 0; m < 4; ++m) gtv[ai][m] = rowgate[u.pm * BM + ai * HALF + wr * 64 + m * 16 + fr];
#pragma unroll
        for (int bj = 0; bj < 2; ++bj)
#pragma unroll
            for (int n = 0; n < 2; ++n) bvv[bj][n] = *(const f32x4*)(bb + u.pn * BM + bj * HALF + wc * 32 + n * 16 + 4 * fq);
#pragma unroll
        for (int ai = 0; ai < 2; ++ai)
#pragma unroll
            for (int m = 0; m < 4; ++m) { const int row = u.pm * BM + ai * HALF + wr * 64 + m * 16 + fr; const float gt = gtv[ai][m]; bf16_t* rowp = O + (size_t)row * DM + u.pn * BM + wc * 32 + 4 * fq;
#pragma unroll
                for (int bj = 0; bj < 2; ++bj)
#pragma unroll
                    for (int n = 0; n < 2; ++n) { const f32x4 v = (acc[ai][bj][m][n] + bvv[bj][n]) * gt;
                        u32x2 w; w.x = pk2(v[0], v[1]); w.y = pk2(v[2], v[3]); *(u32x2*)(rowp + bj * HALF + n * 16) = w; } }
    }
};
struct EpiQup {
    static constexpr bool AFTER_DRAIN = false;
    bf16_t* O; const float* ropem;
    DEV void operator()(const f32x4 (&acc)[2][2][4][2], const Unit& u, int wr, int wc, int fr, int fq) const {
        const bool rope0 = ((u.pn * 8 + wc) % 3) == 2, rope1 = ((u.pn * 8 + 4 + wc) % 3) == 2;
        f32x4 cs[2][4], sn[2][4];
        if (rope0 || rope1) {
#pragma unroll
            for (int ai = 0; ai < 2; ++ai)
#pragma unroll
                for (int m = 0; m < 4; ++m) { const int row = u.pm * BM + ai * HALF + wr * 64 + m * 16 + fr; cs[ai][m] = *(const f32x4*)(ropem + (size_t)row * 32 + 4 * fq); sn[ai][m] = *(const f32x4*)(ropem + (size_t)row * 32 + 16 + 4 * fq); } }
#pragma unroll
        for (int bj = 0; bj < 2; ++bj) { const int g32 = u.pn * 8 + bj * 4 + wc; const bool rope = bj ? rope1 : rope0;
#pragma unroll
            for (int ai = 0; ai < 2; ++ai)
#pragma unroll
                for (int m = 0; m < 4; ++m) { const int row = u.pm * BM + ai * HALF + wr * 64 + m * 16 + fr; bf16_t* rowp = O + (size_t)row * 768 + g32 * 32 + 4 * fq;
                    f32x4 v0 = acc[ai][bj][m][0], v1 = acc[ai][bj][m][1];
                    if (rope) { const f32x4 c = cs[ai][m], s_ = sn[ai][m]; const f32x4 x1 = v0, x2 = v1; v0 = x1 * c - x2 * s_; v1 = x2 * c + x1 * s_; }
                    v0 = v0 * MLA_QSCALE; v1 = v1 * MLA_QSCALE;
                    u32x2 w; w.x = pk2(v0[0], v0[1]); w.y = pk2(v0[2], v0[3]); *(u32x2*)(rowp) = w; w.x = pk2(v1[0], v1[1]); w.y = pk2(v1[2], v1[3]); *(u32x2*)(rowp + 16) = w; } }
    }
};
struct EpiKvup {
    static constexpr bool AFTER_DRAIN = false;
    bf16_t* KM; bf16_t* VM;
    DEV void operator()(const f32x4 (&acc)[2][2][4][2], const Unit& u, int wr, int wc, int fr, int fq) const {
#pragma unroll
        for (int bj = 0; bj < 2; ++bj) { const int head = u.pn * 2 + bj;
#pragma unroll
            for (int ai = 0; ai < 2; ++ai)
#pragma unroll
                for (int m = 0; m < 4; ++m) { const int row = u.pm * BM + ai * HALF + wr * 64 + m * 16 + fr;
                    bf16_t* rowp = (wc < 2) ? KM + (size_t)row * 768 + head * 96 + wc * 32 + 4 * fq : VM + (size_t)row * 512 + head * 64 + (wc - 2) * 32 + 4 * fq;
#pragma unroll
                    for (int n = 0; n < 2; ++n) { const f32x4 v = acc[ai][bj][m][n]; u32x2 w; w.x = pk2(v[0], v[1]); w.y = pk2(v[2], v[3]); *(u32x2*)(rowp + n * 16) = w; } } }
    }
};
struct EpiCmp {
    static constexpr bool AFTER_DRAIN = true;
    const float* cb; const float* w2; const int* pos; bf16_t* KC; bf16_t* VC;
    DEV void fused(const f32x4 (&acc)[2][2][4][2], const Unit& u, int wr, int wc, int fr, int fq, LAS unsigned char* lds) const {
        const int c = u.e, tid = opaque_tid();
        LAS bf16_t* Hs = (LAS bf16_t*)lds;
        LAS float* W2s = (LAS float*)(lds + 256 * 136 * 2);
        { const f32x4* src = (const f32x4*)(w2 + (size_t)c * 128 * 64) + tid;
#pragma unroll
          for (int i = 0; i < 4; ++i) *((LAS f32x4*)W2s + tid + i * 512) = src[i * 512]; }
        f32x4 bb[2];
#pragma unroll
        for (int n = 0; n < 2; ++n) { bb[n] = *(const f32x4*)(cb + c * 128 + wc * 32 + n * 16 + 4 * fq);
#pragma unroll
            for (int part = 1; part < 8; ++part) bb[n] += *(const f32x4*)(cb + part * 256 + c * 128 + wc * 32 + n * 16 + 4 * fq); }
#pragma unroll
        for (int ai = 0; ai < 2; ++ai)
#pragma unroll
            for (int m = 0; m < 4; ++m) { const int row = ai * HALF + wr * 64 + m * 16 + fr;
#pragma unroll
                for (int n = 0; n < 2; ++n) { const f32x4 v = acc[ai][0][m][n] + bb[n]; float r[4];
#pragma unroll
                    for (int j = 0; j < 4; ++j) r[j] = v[j] / (1.0f + __expf(-v[j]));
                    u32x2 w; w.x = pk2(r[0], r[1]); w.y = pk2(r[2], r[3]); *(LAS u32x2*)(Hs + row * 136 + wc * 32 + n * 16 + 4 * fq) = w; } }
        __syncthreads();
        const int row = tid >> 1, dh = tid & 1; float o[32];
#pragma unroll
        for (int d = 0; d < 32; ++d) o[d] = 0.f;
#pragma unroll 2
        for (int h = 0; h < 128; ++h) { const float hv = bf2f(Hs[row * 136 + h]); const LAS f32x4* wrow = (const LAS f32x4*)(W2s + h * 64 + dh * 32);
#pragma unroll
            for (int q = 0; q < 8; ++q) { const f32x4 w = wrow[q]; o[4 * q] += hv * w.x; o[4 * q + 1] += hv * w.y; o[4 * q + 2] += hv * w.z; o[4 * q + 3] += hv * w.w; } }
        const int r = u.pm * BM + row, b = r >> 9, n = (r >> 1) & 255;
        if (c == 0 && dh == 0 && n < 255) { const float fpos = (float)pos[b * SEQ + 16 * n + 31];
#pragma unroll
            for (int i = 0; i < 8; ++i) { const float invf = powf(500000.0f, -(float)(2 * i) / 16.0f); float cs, sn; sincosf(fpos * invf, &sn, &cs); const float x1 = o[i], x2 = o[8 + i]; o[i] = x1 * cs - x2 * sn; o[8 + i] = x2 * cs + x1 * sn; } }
        bf16_t* dst = (c == 0 ? KC : VC) + (size_t)r * 64 + dh * 32;
#pragma unroll
        for (int q = 0; q < 4; ++q) { u32x4 w;
            if (n < 255) { w.x = pk2(o[8 * q], o[8 * q + 1]); w.y = pk2(o[8 * q + 2], o[8 * q + 3]); w.z = pk2(o[8 * q + 4], o[8 * q + 5]); w.w = pk2(o[8 * q + 6], o[8 * q + 7]); } else w = (u32x4){0u, 0u, 0u, 0u};
            *(u32x4*)(dst + 8 * q) = w; }
        __syncthreads();
    }
};
}

DEV void transpose_item(const float* W, int Ksrc, int Nsrc, int k0, int n0, bf16_t* WT, int ldk, int drow0, LAS float* scr, int lane) {
    { const int kr = lane >> 3, nc = 4 * (lane & 7); f32x4 v[8];
#pragma unroll
      for (int i = 0; i < 8; ++i) { const int k = k0 + 8 * i + kr; v[i] = (k < Ksrc && n0 + nc < Nsrc) ? *(const f32x4*)(W + (size_t)k * Nsrc + n0 + nc) : (f32x4){0.f, 0.f, 0.f, 0.f}; }
#pragma unroll
      for (int i = 0; i < 8; ++i) { LAS float* d = scr + (8 * i + kr) * 33 + nc; d[0] = v[i].x; d[1] = v[i].y; d[2] = v[i].z; d[3] = v[i].w; } }
    asm volatile("s_waitcnt lgkmcnt(0)" ::: "memory");
    const int c = lane & 7;
#pragma unroll
    for (int j = 0; j < 4; ++j) { const int n = (lane >> 3) + 8 * j; const LAS float* s = scr + (8 * c) * 33 + n;
        u32x4 o; o.x = pk2(s[0 * 33], s[1 * 33]); o.y = pk2(s[2 * 33], s[3 * 33]); o.z = pk2(s[4 * 33], s[5 * 33]); o.w = pk2(s[6 * 33], s[7 * 33]);
        *(u32x4*)(WT + (size_t)(drow0 + n) * ldk + k0 + 8 * c) = o; }
    asm volatile("s_waitcnt lgkmcnt(0)" ::: "memory");
}
DEV void rms_row_to_bf16(const float* xrow, const float* g, bf16_t* orow, int lane) {
    const f32x4* xr = (const f32x4*)xrow + lane; const f32x4* gr = (const f32x4*)g + lane;
    f32x4 v[4]; float s = 0.f;
#pragma unroll
    for (int j = 0; j < 4; ++j) { v[j] = xr[64 * j]; s += (v[j].x * v[j].x + v[j].y * v[j].y) + (v[j].z * v[j].z + v[j].w * v[j].w); }
    const float rstd = rsqrtf(wave_sum(s) * (1.f / 1024.f) + 1e-5f);
    u32x2* o8 = (u32x2*)orow + lane;
#pragma unroll
    for (int j = 0; j < 4; ++j) { const f32x4 gg = gr[64 * j]; u32x2 w; w.x = pk2(v[j].x * rstd * gg.x, v[j].y * rstd * gg.y); w.y = pk2(v[j].z * rstd * gg.z, v[j].w * rstd * gg.w); o8[64 * j] = w; }
}
DEV void w1_quant_item(const float* W, unsigned char* WQ, float* SW, int n0, int drow0, LAS unsigned char* lds, int tid) {
    LAS unsigned* qs = (LAS unsigned*)lds;
    LAS float* red = (LAS float*)(lds + 32 * 1040);
    const int kg = tid >> 3, c = tid & 7, wv = tid >> 6;
    f32x4 v[4][4];
#pragma unroll
    for (int i = 0; i < 4; ++i)
#pragma unroll
        for (int q = 0; q < 4; ++q) v[i][q] = *(const f32x4*)(W + (size_t)(4 * (64 * i + kg) + q) * 2048 + n0 + 4 * c);
    float mx[4] = {0.f, 0.f, 0.f, 0.f};
#pragma unroll
    for (int i = 0; i < 4; ++i)
#pragma unroll
        for (int q = 0; q < 4; ++q) { mx[0] = fmaxf(mx[0], fabsf(v[i][q].x)); mx[1] = fmaxf(mx[1], fabsf(v[i][q].y)); mx[2] = fmaxf(mx[2], fabsf(v[i][q].z)); mx[3] = fmaxf(mx[3], fabsf(v[i][q].w)); }
#pragma unroll
    for (int j = 0; j < 4; ++j) { mx[j] = fmaxf(mx[j], __shfl_xor(mx[j], 8)); mx[j] = fmaxf(mx[j], __shfl_xor(mx[j], 16)); mx[j] = fmaxf(mx[j], __shfl_xor(mx[j], 32)); }
    if ((tid & 63) < 8) *(LAS f32x4*)(red + wv * 32 + 4 * c) = (f32x4){mx[0], mx[1], mx[2], mx[3]};
    __syncthreads();
    float inv[4];
    { f32x4 m = *(const LAS f32x4*)(red + 4 * c);
#pragma unroll
      for (int w_ = 1; w_ < 8; ++w_) { const f32x4 o = *(const LAS f32x4*)(red + w_ * 32 + 4 * c); m.x = fmaxf(m.x, o.x); m.y = fmaxf(m.y, o.y); m.z = fmaxf(m.z, o.z); m.w = fmaxf(m.w, o.w); }
      m.x = fmaxf(m.x, 1e-30f); m.y = fmaxf(m.y, 1e-30f); m.z = fmaxf(m.z, 1e-30f); m.w = fmaxf(m.w, 1e-30f);
      inv[0] = 127.0f / m.x; inv[1] = 127.0f / m.y; inv[2] = 127.0f / m.z; inv[3] = 127.0f / m.w;
      if (tid < 8) *(f32x4*)(SW + drow0 + 4 * c) = m * (1.0f / 127.0f); }
#pragma unroll
    for (int i = 0; i < 4; ++i) {
#pragma unroll
        for (int j = 0; j < 4; ++j) { unsigned x = 0u;
#pragma unroll
            for (int q = 0; q < 4; ++q) { const int b = __float2int_rn(v[i][q][j] * inv[j]); x |= ((unsigned)b & 255u) << (8 * q); }
            qs[(4 * c + j) * 260 + 64 * i + kg] = x; } }
    __syncthreads();
#pragma unroll
    for (int t_ = 0; t_ < 4; ++t_) { const int id = tid + 512 * t_, n = id >> 6, ch = id & 63;
        *(u32x4*)(WQ + (size_t)(drow0 + n) * 1024 + ch * 16) = *(const LAS u32x4*)(lds + n * 1040 + ch * 16); }
    __syncthreads();
}
DEV void prep_w1_items(const Params& p, LAS unsigned char* lds) {
    const int tid = opaque_tid();
    unsigned* ctr = (unsigned*)(p.ws + OFF_CNT) + 40; LAS int* slot = (LAS int*)(lds + 40960);
    for (;;) {
        if (tid == 0) *slot = (int)__hip_atomic_fetch_add(ctr, 1u, __ATOMIC_RELAXED, __HIP_MEMORY_SCOPE_AGENT);
        __syncthreads();
        const int it = *slot;
        __syncthreads();
        if (it >= 32 * 64) break;
        const int e = it >> 6, nb = it & 63, n0 = nb * 32;
        const int bj = n0 >> 10, rr = n0 & 1023, drow = 256 * (rr >> 7) + 128 * bj + (rr & 127);
        w1_quant_item(p.moe_w1 + (size_t)e * 1024 * 2048, p.ws + OFF_W1T + (size_t)e * 2048 * 1024, (float*)(p.ws + OFF_SW1) + (size_t)e * 2048, n0, drow, lds, tid); }
}
DEV void prep_w2_items(const Params& p, LAS unsigned char* lds, int firstw, int stridew) {
    const int tid = opaque_tid(), wid = tid >> 6, lane = tid & 63;
    LAS float* scr = (LAS float*)(lds + wid * 16384); bf16_t* W2T = (bf16_t*)(p.ws + OFF_W2T);
    for (int r = firstw + wid; r < 32 * 16 * 32; r += stridew) { const int e = r / (16 * 32), q = r % (16 * 32), kb = q / 32, nb = q % 32;
        transpose_item(p.moe_w2 + (size_t)e * 1024 * 1024, 1024, 1024, kb * 64, nb * 32, W2T + (size_t)e * 1024 * 1024, 1024, nb * 32, scr, lane); }
}
DEV void phase0(const Params& p, LAS unsigned char* lds) {
    const int tid = opaque_tid(), wid = tid >> 6, lane = tid & 63;
    LAS float* scr = (LAS float*)(lds + wid * 16384);
    const int gw = blockIdx.x * 8 + wid, NGW = gridDim.x * 8;
    bf16_t* WINT = (bf16_t*)(p.ws + OFF_WINT);
    bf16_t* WQUPT = (bf16_t*)(p.ws + OFF_WQUPT); bf16_t* WKVUPT = (bf16_t*)(p.ws + OFF_WKVUPT); bf16_t* WOUTT = (bf16_t*)(p.ws + OFF_WOUTT);
    constexpr int I_IN = 16 * 56, I_QUP = 4 * 24, I_KVUP = 4 * 32, I_OUT = 16 * 32, I_CW1 = 2 * 32 * 8, I_ROWS = NTOK;
    constexpr int NITEMS = I_IN + I_QUP + I_KVUP + I_OUT + I_CW1;
    for (int it = gw; it < NITEMS; it += NGW) {
        int r = it;
        if (r < I_IN) { const int kb = r / 56, nb = r % 56; transpose_item(p.w_in, 1024, INC, kb * 64, nb * 32, WINT, 1024, nb * 32, scr, lane); continue; } r -= I_IN;
        if (r < I_QUP) { const int kb = r / 24, nb = r % 24; transpose_item(p.w_q_up, 256, 768, kb * 64, nb * 32, WQUPT, 256, nb * 32, scr, lane); continue; } r -= I_QUP;
        if (r < I_KVUP) { const int kb = r / 32, nb = r % 32; transpose_item(p.w_kv_up, 128, 1024, kb * 64, nb * 32, WKVUPT, 256, nb * 32, scr, lane); continue; } r -= I_KVUP;
        if (r < I_OUT) { const int kb = r / 32, nb = r % 32; transpose_item(p.w_out, 1024, 1024, kb * 64, nb * 32, WOUTT, 1024, nb * 32, scr, lane); continue; } r -= I_OUT;
        if (r < I_CW1) { const int c = r / 256, q = r % 256, kb = q / 8, nb = q % 8; transpose_item(p.cmp_w1 + (size_t)c * 2048 * 128, 2048, 128, kb * 64, nb * 32, (bf16_t*)(p.ws + OFF_CW1T) + (size_t)c * 256 * 2048, 2048, nb * 32, scr, lane); continue; } r -= I_CW1;
        break;
    }
    { const f32x4* gr = (const f32x4*)p.attn_norm + lane; f32x4 gg[4];
#pragma unroll
      for (int j = 0; j < 4; ++j) gg[j] = gr[64 * j];
      for (int r0 = gw * 4; r0 < NTOK; r0 += NGW * 4) { f32x4 v[4][4];
#pragma unroll
          for (int q = 0; q < 4; ++q) { const f32x4* xr = (const f32x4*)(p.x + (size_t)(r0 + q) * DM) + lane;
#pragma unroll
              for (int j = 0; j < 4; ++j) v[q][j] = xr[64 * j]; }
#pragma unroll
          for (int q = 0; q < 4; ++q) { float s_ = 0.f;
#pragma unroll
              for (int j = 0; j < 4; ++j) s_ += (v[q][j].x * v[q][j].x + v[q][j].y * v[q][j].y) + (v[q][j].z * v[q][j].z + v[q][j].w * v[q][j].w);
              const float rstd = rsqrtf(wave_sum(s_) * (1.f / 1024.f) + 1e-5f); u32x2* o8 = (u32x2*)((bf16_t*)(p.ws + OFF_U) + (size_t)(r0 + q) * DM) + lane;
#pragma unroll
              for (int j = 0; j < 4; ++j) { u32x2 w; w.x = pk2(v[q][j].x * rstd * gg[j].x, v[q][j].y * rstd * gg[j].y); w.y = pk2(v[q][j].z * rstd * gg[j].z, v[q][j].w * rstd * gg[j].w); o8[64 * j] = w; } } } }
    float* cb = (float*)(p.ws + OFF_CB);
    for (int o8 = gw; o8 < 2048; o8 += NGW) { const int o = o8 & 255, part = o8 >> 8, c = o >> 7, h = o & 127; float s = 0.f;
#pragma unroll
        for (int q = 0; q < 4; ++q) { const int i = part * 256 + q * 64 + lane; s += p.cmp_pos[c * 2048 + i] * p.cmp_w1[((size_t)c * 2048 + i) * 128 + h]; }
        s = wave_sum(s); if (lane == 0) cb[part * 256 + o] = s; }
    if (blockIdx.x == 0 && tid < 64) ((unsigned*)(p.ws + OFF_CNT))[tid] = 0u;
}

struct P2In { u32x2 wq; unsigned wkv; unsigned kp; u32x4 wqn; u32x4 wk; u32x4 wc4; unsigned gt; int pos; };
DEV void phase2(const Params& p) {
    const int tid = opaque_tid(), wid = tid >> 6, lane = tid & 63;
    const int gw = blockIdx.x * 8 + wid, NGW = gridDim.x * 8;
    const bf16_t* PROJ = (const bf16_t*)(p.ws + OFF_PROJ);
    bf16_t* QN = (bf16_t*)(p.ws + OFF_QN); bf16_t* KVN = (bf16_t*)(p.ws + OFF_KVN); bf16_t* KM = (bf16_t*)(p.ws + OFF_KM); float* ROPEM = (float*)(p.ws + OFF_ROPEM); bf16_t* NQ = (bf16_t*)(p.ws + OFF_NQ);
    bf16_t* KSR = (bf16_t*)(p.ws + OFF_KSR); bf16_t* KWR = (bf16_t*)(p.ws + OFF_KWR); float* GATES = (float*)(p.ws + OFF_GATES);
    const float invf_m = powf(500000.0f, -(float)(2 * (lane & 15)) / 32.0f);
    const float invf_n = powf(500000.0f, -(float)(2 * (lane & 7)) / 16.0f);
    const f32x4 gq = *(const f32x4*)(p.q_norm + lane * 4); const f32x2 gkv = *(const f32x2*)(p.kv_norm + lane * 2);
    const int l16 = lane & 15, sub = lane & 7, d32 = lane & 31; const int cbase = (lane < 16) ? C_KS : C_KW;
    const int grp4 = lane >> 4; const int ccol4 = (grp4 == 0) ? C_KC : (grp4 == 1) ? C_VC : (grp4 == 2) ? C_VS : C_VW;
    bf16_t* cdst4 = (bf16_t*)(p.ws + (grp4 == 0 ? OFF_KCC : grp4 == 1 ? OFF_VCC : grp4 == 2 ? OFF_VSC : OFF_VWC));
    auto load = [&](int tok) -> P2In { const bf16_t* row = PROJ + (size_t)tok * INP; P2In in;
        in.wq = *(const u32x2*)(row + C_QLAT + lane * 4); in.wkv = *(const unsigned*)(row + C_KVLAT + lane * 2);
        in.kp = (unsigned)row[C_KPE + d32] | ((unsigned)row[C_KPE + (d32 ^ 16)] << 16);
        in.wqn = *(const u32x4*)(row + C_QNSA + lane * 8); in.wk = *(const u32x4*)(row + cbase + l16 * 8); in.wc4 = *(const u32x4*)(row + ccol4 + l16 * 8);
        in.gt = row[C_G + (lane < 24 ? lane : 23)]; in.pos = p.pos[tok]; return in; };
    P2In cur = load(gw < NTOK ? gw : 0);
#pragma unroll 1
    for (int tok = gw; tok < NTOK; tok += NGW) {
        const P2In nxt = load(tok + NGW < NTOK ? tok + NGW : tok);
        const float fpos = (float)cur.pos;
        float cm, sm, cn, sn; __sincosf(fpos * invf_m, &sm, &cm); __sincosf(fpos * invf_n, &sn, &cn);
        { const u32x2 w = cur.wq; const float a = bflo(w.x), b = bfhi(w.x), c = bflo(w.y), d = bfhi(w.y);
          const float rstd = rsqrtf(wave_sum(a * a + b * b + c * c + d * d) * (1.f / 256.f) + 1e-5f);
          u32x2 o; o.x = pk2(a * rstd * gq.x, b * rstd * gq.y); o.y = pk2(c * rstd * gq.z, d * rstd * gq.w); *(u32x2*)(QN + (size_t)tok * 256 + lane * 4) = o; }
        { const unsigned w = cur.wkv; const float a = bflo(w), b = bfhi(w);
          const float rstd = rsqrtf(wave_sum(a * a + b * b) * (1.f / 128.f) + 1e-5f);
          *(unsigned*)(KVN + (size_t)tok * 256 + lane * 2) = pk2(a * rstd * gkv.x, b * rstd * gkv.y); *(unsigned*)(KVN + (size_t)tok * 256 + 128 + lane * 2) = 0u; }
        { const float xs_ = bflo(cur.kp), xo = bfhi(cur.kp); const float val = (d32 < 16) ? xs_ * cm - xo * sm : xs_ * cm + xo * sm;
          const int hh = lane >> 3, part = lane & 7; const float a0 = __shfl(val, 4 * part), a1 = __shfl(val, 4 * part + 1), a2 = __shfl(val, 4 * part + 2), a3 = __shfl(val, 4 * part + 3);
          u32x2 w; w.x = pk2(a0, a1); w.y = pk2(a2, a3); *(u32x2*)(KM + (size_t)tok * 768 + hh * 96 + 64 + 4 * part) = w;
          if (lane < 16) { ROPEM[(size_t)tok * 32 + lane] = cm; ROPEM[(size_t)tok * 32 + 16 + lane] = sm; } }
        { const u32x4 w = cur.wqn; float v[8] = {bflo(w.x), bfhi(w.x), bflo(w.y), bfhi(w.y), bflo(w.z), bfhi(w.z), bflo(w.w), bfhi(w.w)};
#pragma unroll
          for (int i = 0; i < 8; ++i) { const float other = __shfl_xor(v[i], 1); const float c = __shfl(cn, i), s = __shfl(sn, i);
              if (sub == 0) v[i] = v[i] * c - other * s; else if (sub == 1) v[i] = v[i] * c + other * s; }
          u32x4 o; o.x = pk2(v[0] * NSA_QSCALE, v[1] * NSA_QSCALE); o.y = pk2(v[2] * NSA_QSCALE, v[3] * NSA_QSCALE); o.z = pk2(v[4] * NSA_QSCALE, v[5] * NSA_QSCALE); o.w = pk2(v[6] * NSA_QSCALE, v[7] * NSA_QSCALE);
          *(u32x4*)(NQ + (size_t)tok * 512 + lane * 8) = o; }
        { const u32x4 w = cur.wk;
          float v[8] = {bflo(w.x), bfhi(w.x), bflo(w.y), bfhi(w.y), bflo(w.z), bfhi(w.z), bflo(w.w), bfhi(w.w)};
#pragma unroll
          for (int i = 0; i < 8; ++i) { const float other = __shfl_xor(v[i], 1); const float c = __shfl(cn, i), s = __shfl(sn, i);
              if (sub == 0) v[i] = v[i] * c - other * s; else if (sub == 1) v[i] = v[i] * c + other * s; }
          if (lane < 32) { u32x4 o; o.x = pk2(v[0], v[1]); o.y = pk2(v[2], v[3]); o.z = pk2(v[4], v[5]); o.w = pk2(v[6], v[7]);
              *(u32x4*)(((lane < 16) ? KSR : KWR) + (size_t)tok * 128 + l16 * 8) = o; } }
        *(u32x4*)(cdst4 + (size_t)tok * 128 + l16 * 8) = cur.wc4;
        if (lane < 24) GATES[(size_t)tok * 24 + lane] = __builtin_amdgcn_rcpf(1.0f + __expf(-bflo(cur.gt)));
        cur = nxt;
    }
}

DEV void phase4(const Params& p, LAS unsigned char* lds) {
    const int tid = opaque_tid();
    if (blockIdx.x < BATCH * 2 && tid < 128) { const int bb = blockIdx.x >> 1, c_ = blockIdx.x & 1; ((bf16_t*)(p.ws + (c_ == 0 ? OFF_KC : OFF_VC)))[((size_t)(bb * NCMPP + 255) * 2) * 64 + tid] = 0; }
    const bf16_t* PROJ = (const bf16_t*)(p.ws + OFF_PROJ); const float* cb = (const float*)(p.ws + OFF_CB);
    LAS float* hid = (LAS float*)lds;
    const int sub = tid >> 7, h = tid & 127;
    constexpr int NU = 2 * BATCH * NCMP * 2;
    for (int u0 = blockIdx.x * 4; u0 < NU; u0 += gridDim.x * 4) {
        const int u = u0 + sub; const bool act = u < NU;
        int c = 0, b = 0, n = 0, g = 0;
        if (act) { c = u / (BATCH * NCMP * 2); int r = u % (BATCH * NCMP * 2); b = r / (NCMP * 2); r %= (NCMP * 2); n = r >> 1; g = r & 1; }
        float acc = 0.f;
        if (act) {
            const bf16_t* src = PROJ + (size_t)(b * SEQ + n * 16) * INP + (c == 0 ? C_KC : C_VC) + g * 64;
            const float* w1 = p.cmp_w1 + (size_t)c * 2048 * 128 + h;
            for (int l = 0; l < 32; ++l) { const bf16_t* sr = src + (size_t)l * INP;
#pragma unroll 8
                for (int d = 0; d < 64; d += 2) { const unsigned w = *(const unsigned*)(sr + d); acc += bflo(w) * w1[(size_t)(l * 64 + d) * 128] + bfhi(w) * w1[(size_t)(l * 64 + d + 1) * 128]; } }
            acc += cb[c * 128 + h];
            acc = acc / (1.0f + __expf(-acc));
        }
        hid[sub * 128 + h] = acc;
        __syncthreads();
        if (act && h < 64) {
            const float* w2 = p.cmp_w2 + (size_t)c * 128 * 64 + h; float o = 0.f;
            for (int k = 0; k < 128; ++k) o += hid[sub * 128 + k] * w2[k * 64];
            LAS float* ob = (LAS float*)(lds + 4096) + sub * 64; ob[h] = o;
            asm volatile("s_waitcnt lgkmcnt(0)" ::: "memory");
            if (c == 0 && h < 16) { const int i = h & 7; const float fpos = (float)p.pos[b * SEQ + 16 * n + 31]; const float invf = powf(500000.0f, -(float)(2 * i) / 16.0f);
                float cs, sn; sincosf(fpos * invf, &sn, &cs); const float x1 = ob[i], x2 = ob[8 + i]; o = (h < 8) ? (x1 * cs - x2 * sn) : (x2 * cs + x1 * sn); }
            ((bf16_t*)(p.ws + (c == 0 ? OFF_KC : OFF_VC)))[((size_t)(b * NCMPP + n) * 2 + g) * 64 + h] = f2bf(o);
        }
        __syncthreads();
    }
}

template <int DQK, int DV, class KF, class VF, class MF>
DEV void naive_attn_range(const float (&q)[DQK], float (&o)[DV], float& m, float& l, int jlo, int jhi, KF kf, VF vf, MF valid) {
#pragma unroll 1
    for (int j0 = jlo; j0 < jhi; j0 += 2) {
        const int ja = __builtin_amdgcn_readfirstlane(j0), jb = __builtin_amdgcn_readfirstlane((j0 + 1 < jhi) ? j0 + 1 : j0);
        float s0 = 0.f, s1 = 0.f;
#pragma unroll
        for (int i = 0; i < DQK / 2; ++i) { const unsigned w = kf(ja, i); s0 += q[2 * i] * bflo(w); s0 += q[2 * i + 1] * bfhi(w); }
#pragma unroll
        for (int i = 0; i < DQK / 2; ++i) { const unsigned w = kf(jb, i); s1 += q[2 * i] * bflo(w); s1 += q[2 * i + 1] * bfhi(w); }
        if (!valid(ja)) s0 = -INFINITY;
        if (!(j0 + 1 < jhi && valid(jb))) s1 = -INFINITY;
        const float mn = fmaxf(m, fmaxf(s0, s1));
        const bool live = mn != -INFINITY;
        const float alpha = live ? fast_exp2(m - mn) : 1.f, p0 = live ? fast_exp2(s0 - mn) : 0.f, p1 = live ? fast_exp2(s1 - mn) : 0.f;
        l = l * alpha + p0 + p1; m = mn;
#pragma unroll
        for (int i = 0; i < DV / 2; ++i) { const unsigned w0 = vf(ja, i), w1 = vf(jb, i);
            o[2 * i] = o[2 * i] * alpha + p0 * bflo(w0) + p1 * bflo(w1); o[2 * i + 1] = o[2 * i + 1] * alpha + p0 * bfhi(w0) + p1 * bfhi(w1); }
    }
}

DEV void phase3b(const Params& p) {
    const bf16_t* QUP = (const bf16_t*)(p.ws + OFF_QUP); const bf16_t* KVUP = (const bf16_t*)(p.ws + OFF_KVUP); const bf16_t* KPE = (const bf16_t*)(p.ws + OFF_KPE);
    bf16_t* QM = (bf16_t*)(p.ws + OFF_QM); bf16_t* KM = (bf16_t*)(p.ws + OFF_KM);
    for (int id = blockIdx.x * 512 + opaque_tid(); id < NTOK * 8; id += gridDim.x * 512) {
        const int tok = id >> 3, h = id & 7;
        const u32x4* qs = (const u32x4*)(QUP + (size_t)tok * 768 + h * 96); u32x4* qd = (u32x4*)(QM + (size_t)tok * 768 + h * 96);
        const u32x4* ks = (const u32x4*)(KVUP + (size_t)tok * 1024 + h * 128); u32x4* kd = (u32x4*)(KM + (size_t)tok * 768 + h * 96);
#pragma unroll 1
        for (int c = 0; c < 8; ++c) { const u32x4 w = qs[c]; u32x4 o;
            o.x = pk2(bflo(w.x) * MLA_QSCALE, bfhi(w.x) * MLA_QSCALE); o.y = pk2(bflo(w.y) * MLA_QSCALE, bfhi(w.y) * MLA_QSCALE);
            o.z = pk2(bflo(w.z) * MLA_QSCALE, bfhi(w.z) * MLA_QSCALE); o.w = pk2(bflo(w.w) * MLA_QSCALE, bfhi(w.w) * MLA_QSCALE); qd[c] = o; kd[c] = ks[c]; }
        const u32x4* pe = (const u32x4*)(KPE + (size_t)tok * 32);
#pragma unroll 1
        for (int c = 0; c < 4; ++c) kd[8 + c] = pe[c];
        const float fpos = (float)p.pos[tok]; const bf16_t* qr = QUP + (size_t)tok * 768 + h * 96 + 64; bf16_t* qo = QM + (size_t)tok * 768 + h * 96 + 64;
#pragma unroll 1
        for (int i = 0; i < 16; ++i) { const float invf = powf(500000.0f, -(float)(2 * i) / 32.0f); float c, sn; sincosf(fpos * invf, &sn, &c);
            const float x1 = bf2f(qr[i]), x2 = bf2f(qr[16 + i]); qo[i] = f2bf((x1 * c - x2 * sn) * MLA_QSCALE); qo[16 + i] = f2bf((x2 * c + x1 * sn) * MLA_QSCALE); }
    }
}

DEV void phase5_mla(const Params& p) {
    const int tid = opaque_tid(), wid = __builtin_amdgcn_readfirstlane(tid >> 6), lane = tid & 63;
    const int gw = blockIdx.x * 8 + wid, NGW = gridDim.x * 8;
    const bf16_t* QM = (const bf16_t*)(p.ws + OFF_QM); const bf16_t* KM = (const bf16_t*)(p.ws + OFF_KM); const bf16_t* KVUP = (const bf16_t*)(p.ws + OFF_KVUP);
    bf16_t* OCAT = (bf16_t*)(p.ws + OFF_OCAT);
    constexpr int NUNIT = BATCH * 8 * (SEQ / 64);
#pragma unroll 1
    for (int uu = gw; uu < NUNIT; uu += NGW) {
        const int u = (uu & 1) ? (NUNIT - 1 - (uu >> 1)) : (uu >> 1);
        const int tb = u % (SEQ / 64), h = (u / (SEQ / 64)) & 7, b = u / (SEQ / 64 * 8);
        const int t = tb * 64 + lane; const size_t tok = (size_t)b * SEQ + t;
        unsigned qp[48];
        { const bf16_t* qr = QM + tok * 768 + h * 96;
#pragma unroll
          for (int i = 0; i < 48; ++i) qp[i] = *(const unsigned*)(qr + 2 * i); }
        float o[64];
#pragma unroll
        for (int d = 0; d < 64; ++d) o[d] = 0.f;
        float m = -INFINITY, l = 0.f;
        const bf16_t* kb = KM + (size_t)b * SEQ * 768 + h * 96; const bf16_t* vb = KVUP + (size_t)b * SEQ * 1024 + h * 128 + 64;
        const int jhi = tb * 64 + 64;
#pragma unroll 1
        for (int j0 = 0; j0 < jhi; ++j0) {
            const int j = __builtin_amdgcn_readfirstlane(j0);
            const unsigned* kr = (const unsigned*)(kb + (size_t)j * 768); const unsigned* vr = (const unsigned*)(vb + (size_t)j * 1024);
            float s0 = 0.f;
#pragma unroll
            for (int i = 0; i < 48; ++i) { const unsigned w = kr[i]; s0 += bflo(qp[i]) * bflo(w); s0 += bfhi(qp[i]) * bfhi(w); }
            if (j > t) s0 = -INFINITY;
            const float mn = fmaxf(m, s0);
            const float alpha = fast_exp2(m - mn), p0 = fast_exp2(s0 - mn);
            l = l * alpha + p0; m = mn;
#pragma unroll
            for (int i = 0; i < 32; ++i) { const unsigned w0 = vr[i]; o[2 * i] = o[2 * i] * alpha + p0 * bflo(w0); o[2 * i + 1] = o[2 * i + 1] * alpha + p0 * bfhi(w0); }
        }
        const float rl = 1.0f / l;
        bf16_t* orow = OCAT + tok * 1024 + h * 64;
#pragma unroll
        for (int i = 0; i < 32; ++i) *(unsigned*)(orow + 2 * i) = pk2(o[2 * i] * rl, o[2 * i + 1] * rl);
    }
}

namespace fa {
typedef float f32x16 __attribute__((ext_vector_type(16)));
typedef short s16x4 __attribute__((ext_vector_type(4)));
constexpr int KSLOT = 12288, VSLOT = 8192;
constexpr int L_K = 0, L_V = 2 * KSLOT, L_WSF = L_V + 3 * VSLOT, L_OST = L_WSF + 8 * 512, L_MASK = L_OST + 8 * 4096, L_SEQ = L_MASK + 512, L_VAL = L_MASK + 1024, L_IMPH = L_VAL + 0;
constexpr int L_END = L_IMPH + 65536;
#define FA_MFMA(a, b, c) __builtin_amdgcn_mfma_f32_32x32x16_bf16(a, b, c, 0, 0, 0)
DEV int crow(int r, int hi) { return (r & 3) + 8 * (r >> 2) + 4 * hi; }
DEV s16x4 vtr(const LAS unsigned char* p) { return __builtin_bit_cast(s16x4, __builtin_amdgcn_ds_read_tr16_b64_v4i16((LAS s16x4*)p)); }
DEV float xhalf_max(float m) { auto rr = __builtin_amdgcn_permlane32_swap(__float_as_uint(m), __float_as_uint(m), false, false); return fmaxf(__uint_as_float(rr[0]), __uint_as_float(rr[1])); }
DEV float xhalf_sum(float m) { auto rr = __builtin_amdgcn_permlane32_swap(__float_as_uint(m), __float_as_uint(m), false, false); return __uint_as_float(rr[0]) + __uint_as_float(rr[1]); }

template <int NCH> struct KVRegs { u32x4 k0, k1, v; };
template <int NCH> DEV void stage_load(KVRegs<NCH>& r, const bf16_t* Kb, int kpitch, const bf16_t* Vb, int vpitch, int key0, int wid, int lane) {
    r.k0 = *(const u32x4*)(Kb + (size_t)(key0 + lane) * kpitch + wid * 8);
    if (NCH > 8 && wid < NCH - 8) r.k1 = *(const u32x4*)(Kb + (size_t)(key0 + lane) * kpitch + (8 + wid) * 8);
    r.v = *(const u32x4*)(Vb + (size_t)(key0 + 16 * (wid & 3) + (lane >> 2)) * vpitch + (wid >> 2) * 32 + (lane & 3) * 8);
}
template <int NCH> DEV void stage_write(const KVRegs<NCH>& r, LAS unsigned char* lds, int buf, int wid, int lane) {
    *(LAS u32x4*)(lds + L_K + buf * KSLOT + wid * 1024 + lane * 16) = r.k0;
    if (NCH > 8 && wid < NCH - 8) *(LAS u32x4*)(lds + L_K + buf * KSLOT + (8 + wid) * 1024 + lane * 16) = r.k1;
    *(LAS u32x4*)(lds + L_V + buf * VSLOT + wid * 1024 + lane * 16) = r.v;
}
template <int ND0> DEV void qk_tile(const LAS unsigned char* kbuf, int kp0, const bf16x8 (&qr)[ND0], f32x16& p0, f32x16& p1) {
#pragma unroll
    for (int r = 0; r < 16; ++r) { p0[r] = 0.f; p1[r] = 0.f; }
#pragma unroll
    for (int d0 = 0; d0 < ND0; ++d0) { const bf16x8 k0 = *(const LAS bf16x8*)(kbuf + kp0 + d0 * 2048), k1 = *(const LAS bf16x8*)(kbuf + kp0 + d0 * 2048 + 512);
        p0 = FA_MFMA(k0, qr[d0], p0); p1 = FA_MFMA(k1, qr[d0], p1); }
}
DEV float rowmax32(const f32x16& p0, const f32x16& p1) {
    float a = fmaxf(p0[0], p1[0]);
#pragma unroll
    for (int r = 1; r < 16; ++r) a = fmaxf(a, fmaxf(p0[r], p1[r]));
    return xhalf_max(a);
}
struct SmState { float mhat, l; f32x16 o[2]; };
DEV void sm_init(SmState& st) { st.mhat = -1e30f; st.l = 0.f;
#pragma unroll
    for (int r = 0; r < 16; ++r) { st.o[0][r] = 0.f; st.o[1][r] = 0.f; } }
DEV void sm_pv_tile(SmState& st, f32x16& p0, f32x16& p1, const LAS unsigned char* vbuf, int vp0, LAS float* wsf, int r32, int hi) {
    const float rm = rowmax32(p0, p1);
    const float newm = fmaxf(st.mhat, rm);
    if (__any(newm - st.mhat > 8.0f)) {
        const float f = fast_exp2(st.mhat - newm); st.mhat = newm; st.l *= f;
        if (hi == 0) wsf[r32] = f;
        asm volatile("s_waitcnt lgkmcnt(0)" ::: "memory");
#pragma unroll
        for (int r = 0; r < 16; ++r) { const float fr = wsf[crow(r, hi)]; st.o[0][r] *= fr; st.o[1][r] *= fr; }
        asm volatile("s_waitcnt lgkmcnt(0)" ::: "memory");
    }
    const float nm = -st.mhat; float sacc = 0.f;
#pragma unroll
    for (int r = 0; r < 16; ++r) { p0[r] = fast_exp2(p0[r] + nm); p1[r] = fast_exp2(p1[r] + nm); sacc += p0[r] + p1[r]; }
    st.l += sacc;
    u32x4 pw[4];
#pragma unroll
    for (int k = 0; k < 2; ++k) { pw[k] = (u32x4){pk2(p0[8 * k], p0[8 * k + 1]), pk2(p0[8 * k + 2], p0[8 * k + 3]), pk2(p0[8 * k + 4], p0[8 * k + 5]), pk2(p0[8 * k + 6], p0[8 * k + 7])};
        pw[2 + k] = (u32x4){pk2(p1[8 * k], p1[8 * k + 1]), pk2(p1[8 * k + 2], p1[8 * k + 3]), pk2(p1[8 * k + 4], p1[8 * k + 5]), pk2(p1[8 * k + 6], p1[8 * k + 7])}; }
#pragma unroll
    for (int dh = 0; dh < 2; ++dh)
#pragma unroll
        for (int ks = 0; ks < 4; ++ks) { const s16x4 lo = vtr(vbuf + vp0 + dh * 4096 + ks * 1024), hi4 = vtr(vbuf + vp0 + dh * 4096 + ks * 1024 + 512);
            const bf16x8 vf = (bf16x8){lo[0], lo[1], lo[2], lo[3], hi4[0], hi4[1], hi4[2], hi4[3]};
            st.o[dh] = FA_MFMA(__builtin_bit_cast(bf16x8, pw[ks]), vf, st.o[dh]); }
}
#define FA_MX3(a, b, c) __builtin_fmaxf(__builtin_fmaxf((a), (b)), (c))
template <int ND0> DEV void qk_tile_rel(const LAS unsigned char* kbuf, int kp0, const bf16x8 (&qr)[ND0], const f32x16& mC, f32x16& p0, f32x16& p1) {
    p0 = mC; p1 = mC;
#pragma unroll
    for (int d0 = 0; d0 < ND0; ++d0) { const bf16x8 k0 = *(const LAS bf16x8*)(kbuf + kp0 + d0 * 2048), k1 = *(const LAS bf16x8*)(kbuf + kp0 + d0 * 2048 + 512);
        p0 = FA_MFMA(k0, qr[d0], p0); p1 = FA_MFMA(k1, qr[d0], p1); }
}
DEV void sm_decide(SmState& st, f32x16& mC, f32x16& p0, f32x16& p1, bool firsttile, LAS float* wsf, int r32, int hi) {
    float a = FA_MX3(p0[0], p1[0], p0[1]), b = FA_MX3(p1[1], p0[2], p1[2]);
#pragma unroll
    for (int r = 3; r < 15; r += 2) { a = FA_MX3(a, p0[r], p1[r]); b = FA_MX3(b, p0[r + 1], p1[r + 1]); }
    a = FA_MX3(a, p0[15], p1[15]);
    const float rm = xhalf_max(fmaxf(a, b));
    if (firsttile) { const float m0 = (rm > -1e30f) ? rm : 0.f; st.mhat = m0;
#pragma unroll
        for (int r = 0; r < 16; ++r) { p0[r] -= m0; p1[r] -= m0; mC[r] = -m0; }
    } else if (__any(rm > 8.0f)) {
        const float dl = fmaxf(rm, 0.f); const float f = fast_exp2(-dl); st.mhat += dl; st.l *= f;
        if (hi == 0) wsf[r32] = f;
        asm volatile("s_waitcnt lgkmcnt(0)" ::: "memory");
#pragma unroll
        for (int r = 0; r < 16; ++r) { const float fr = wsf[crow(r, hi)]; st.o[0][r] *= fr; st.o[1][r] *= fr; p0[r] -= dl; p1[r] -= dl; mC[r] = -st.mhat; }
        asm volatile("s_waitcnt lgkmcnt(0)" ::: "memory");
    }
}
DEV void sm_exp_pv(SmState& st, f32x16& p0, f32x16& p1, const LAS unsigned char* vbuf, int vp0) {
    float s0 = 0.f, s1 = 0.f;
#pragma unroll
    for (int r = 0; r < 16; ++r) { p0[r] = fast_exp2(p0[r]); p1[r] = fast_exp2(p1[r]); s0 += p0[r]; s1 += p1[r]; }
    st.l += s0 + s1;
    u32x4 pw[4];
#pragma unroll
    for (int k = 0; k < 2; ++k) { pw[k] = (u32x4){pk2(p0[8 * k], p0[8 * k + 1]), pk2(p0[8 * k + 2], p0[8 * k + 3]), pk2(p0[8 * k + 4], p0[8 * k + 5]), pk2(p0[8 * k + 6], p0[8 * k + 7])};
        pw[2 + k] = (u32x4){pk2(p1[8 * k], p1[8 * k + 1]), pk2(p1[8 * k + 2], p1[8 * k + 3]), pk2(p1[8 * k + 4], p1[8 * k + 5]), pk2(p1[8 * k + 6], p1[8 * k + 7])}; }
#pragma unroll
    for (int dh = 0; dh < 2; ++dh)
#pragma unroll
        for (int ks = 0; ks < 4; ++ks) { const s16x4 lo = vtr(vbuf + vp0 + dh * 4096 + ks * 1024), hi4 = vtr(vbuf + vp0 + dh * 4096 + ks * 1024 + 512);
            const bf16x8 vf = (bf16x8){lo[0], lo[1], lo[2], lo[3], hi4[0], hi4[1], hi4[2], hi4[3]};
            st.o[dh] = FA_MFMA(__builtin_bit_cast(bf16x8, pw[ks]), vf, st.o[dh]); }
}
DEV void row_to_olayout(float fq, float (&out)[16], LAS float* wsf, int r32, int hi) {
    if (hi == 0) wsf[32 + r32] = fq;
    asm volatile("s_waitcnt lgkmcnt(0)" ::: "memory");
#pragma unroll
    for (int r = 0; r < 16; ++r) out[r] = wsf[32 + crow(r, hi)];
    asm volatile("s_waitcnt lgkmcnt(0)" ::: "memory");
}
DEV void store_o_rows(const f32x16 (&o)[2], bf16_t* dst, size_t pitch, LAS unsigned char* ost, int lane, int r32, int hi) {
    LAS bf16_t* stg = (LAS bf16_t*)ost;
#pragma unroll
    for (int r = 0; r < 16; ++r) { const int orow = crow(r, hi);
#pragma unroll
        for (int d0 = 0; d0 < 2; ++d0) stg[orow * 64 + d0 * 32 + r32] = f2bf(o[d0][r]); }
    asm volatile("s_waitcnt lgkmcnt(0)" ::: "memory");
#pragma unroll
    for (int i = 0; i < 4; ++i) { const int row = i * 8 + (lane >> 3), ch = lane & 7; *(u32x4*)(dst + (size_t)row * pitch + ch * 8) = *(const LAS u32x4*)(stg + row * 64 + ch * 8); }
    asm volatile("s_waitcnt lgkmcnt(0)" ::: "memory");
}

#define FT_SBAR() __builtin_amdgcn_sched_barrier(0)
#define FT_PIN(x) asm volatile("" : "+v"(x))
#define FT_WAIT_BAR(N) asm volatile("s_waitcnt vmcnt(" #N ") lgkmcnt(0)\n\ts_barrier" ::: "memory")
DEV unsigned ft_cvtpk(float lo, float hi) { unsigned r; asm("v_cvt_pk_bf16_f32 %0, %1, %2" : "=v"(r) : "v"(lo), "v"(hi)); return r; }
DEV void ft_glds16(const void* g, unsigned lds_base) { unsigned sv; asm volatile("s_mov_b32 %0, m0\n\ts_mov_b32 m0, %2\n\ts_nop 0\n\tglobal_load_lds_dwordx4 %1, off\n\ts_mov_b32 m0, %0" : "=&s"(sv) : "v"(g), "s"(lds_base) : "memory"); }
typedef LAS const char* ft_cptr;
DEV void ft_kload2(bf16x8* kf, ft_cptr kp, int d0) { kf[2 * d0] = *(const LAS bf16x8*)(kp + d0 * 2048); kf[2 * d0 + 1] = *(const LAS bf16x8*)(kp + d0 * 2048 + 512); }
DEV s16x4 ft_vtr(ft_cptr p) { return __builtin_bit_cast(s16x4, __builtin_amdgcn_ds_read_tr16_b64_v4i16((LAS s16x4*)p)); }
DEV float ft_rowmax(const f32x16& p0, const f32x16& p1) {
    float a = FA_MX3(p0[0], p0[1], p1[0]), b = FA_MX3(p0[2], p0[3], p1[1]); a = FA_MX3(a, p1[2], p1[3]);
#pragma unroll
    for (int r = 4; r < 16; r += 4) { a = FA_MX3(a, p0[r], p0[r + 1]); b = FA_MX3(b, p0[r + 2], p0[r + 3]); a = FA_MX3(a, p1[r], p1[r + 1]); b = FA_MX3(b, p1[r + 2], p1[r + 3]); }
    return xhalf_max(__builtin_fmaxf(a, b)); }
template <int MODE>
DEV void fa64_tuned(f32x16 (&o)[2], float& l_out, const bf16x8 (&qr)[4], const bf16_t* Kb, int kpitch, const bf16_t* Vb, int vpitch, unsigned long long um, int jlast, int NT,
                    unsigned long long rowmask, int tb, int tokl, LAS unsigned char* lds, LAS float* wsf, int wid, int lane, int r32, int hi) {
    constexpr int SLOTB = 8192; constexpr float THR = 8.0f;
    const unsigned lds0 = (unsigned)(uintptr_t)lds;
    const bf16_t* ksrc = Kb + (size_t)lane * kpitch + wid * 8;
    const bf16_t* vsrc = Vb + (size_t)(16 * (wid & 3) + (lane >> 2)) * vpitch + (wid >> 2) * 32 + (lane & 3) * 8;
    const unsigned kdst = lds0 + L_K + wid * 1024, vdst = lds0 + L_V + wid * 1024;
    unsigned long long rem_ = um; int jn_ = tb;
    auto gen = [&]() -> int { if (MODE == 0) { if (rem_ == 0ull) return 128; const int j = (int)__builtin_ctzll(rem_); rem_ &= rem_ - 1ull; return j; } else { if (jn_ < jlast) return 128; return jn_--; } };
    int w0 = gen(), w1 = gen(), w2 = gen(), w3 = gen();
#define FT_SHIFT() do { w0 = w1; w1 = w2; w2 = w3; w3 = gen(); } while (0)
#define FT_DMA_K(id, slot) ft_glds16(ksrc + (size_t)(((id) & 63) * 64) * kpitch, (unsigned)__builtin_amdgcn_readfirstlane(kdst + (slot)))
#define FT_DMA_V(id, slot) ft_glds16(vsrc + (size_t)(((id) & 63) * 64) * vpitch, (unsigned)__builtin_amdgcn_readfirstlane(vdst + (slot)))
    const ft_cptr vp0 = (ft_cptr)lds + L_V + ((lane >> 4) & 1) * 32 + (lane & 3) * 8 + (4 * hi + ((lane & 15) >> 2)) * 64;
    const ft_cptr kp0 = (ft_cptr)lds + L_K + hi * 1024 + r32 * 16;
    FT_DMA_K(w0, 0); FT_DMA_V(w0, 0); FT_DMA_K(w1, SLOTB); FT_DMA_K(w2, 2 * SLOTB);
    float mhat = 0.f, l_reg = 0.f; o[0] = f32x16{}; o[1] = f32x16{};
    const f32x16 zero16 = f32x16{};
    bool resc = false;
    f32x16 pA0, pA1, pB0, pB1; bf16x8 kf[8]; s16x4 vlo[8], vhi[8]; u32x4 pw0, pw1, pw2, pw3;
    int sl_prev = 0, sl_cur = 0, sl_next = SLOTB;
#define FT_ROT() do { sl_prev = sl_cur; sl_cur = sl_next; sl_next = (sl_next == 2 * SLOTB) ? 0 : sl_next + SLOTB; } while (0)
#define FT_EX(v) __builtin_amdgcn_exp2f((v) + nmh)
#define FT_RESC() do { if (resc) { _Pragma("unroll") for (int d_ = 0; d_ < 2; ++d_) _Pragma("unroll") for (int r = 0; r < 16; ++r) o[d_][r] *= wsf[crow(r, hi)]; } } while (0)
    auto emask = [&](int id, f32x16& p0, f32x16& p1) {
        const int j = id & 63, kb = 4 * hi;
        if (j == tb) {
#pragma unroll
            for (int r = 0; r < 16; ++r) { const int kv_ = kb + (r & 3) + 8 * (r >> 2); if (kv_ > tokl) p0[r] = -INFINITY; if (kv_ + 32 > tokl) p1[r] = -INFINITY; }
        } else if (MODE == 1 && j == tb - 8) {
#pragma unroll
            for (int r = 0; r < 16; ++r) { const int kv_ = kb + (r & 3) + 8 * (r >> 2); if (kv_ <= tokl) p0[r] = -INFINITY; if (kv_ + 32 <= tokl) p1[r] = -INFINITY; } } };
    auto rowsel = [&](int id) -> bool { if (id & 128) return false; if (MODE == 0) return (rowmask >> (id & 63)) & 1ull; return true; };
    FT_WAIT_BAR(3);
    _Pragma("unroll") for (int d0 = 0; d0 < 4; ++d0) ft_kload2(kf, kp0, d0);
    pA0 = FA_MFMA(kf[0], qr[0], zero16); pA1 = FA_MFMA(kf[1], qr[0], zero16); pA0 = FA_MFMA(kf[2], qr[1], pA0); pA1 = FA_MFMA(kf[3], qr[1], pA1);
    pA0 = FA_MFMA(kf[4], qr[2], pA0); pA1 = FA_MFMA(kf[5], qr[2], pA1); pA0 = FA_MFMA(kf[6], qr[3], pA0); pA1 = FA_MFMA(kf[7], qr[3], pA1);
    emask(w0, pA0, pA1);
    { const float rm = ft_rowmax(pA0, pA1); mhat = rm; const float nmh = -mhat;
#pragma unroll
      for (int r = 0; r < 16; ++r) { pA0[r] = FT_EX(pA0[r]); pA1[r] = FT_EX(pA1[r]); } }
    FT_WAIT_BAR(0);
    FT_DMA_K(w3, 0); FT_DMA_V(w1, SLOTB); FT_ROT(); FT_SHIFT();
    _Pragma("unroll") for (int d0 = 0; d0 < 4; ++d0) ft_kload2(kf, kp0 + sl_cur, d0);
    FT_WAIT_BAR(2);
#define FT_PKW(P, i) ft_cvtpk(P[i], P[i + 1])
#define FT_PAF(k) __builtin_bit_cast(bf16x8, pw##k)
#define FT_VFR(i) (bf16x8){vlo[i][0], vlo[i][1], vlo[i][2], vlo[i][3], vhi[i][0], vhi[i][1], vhi[i][2], vhi[i][3]}
#define FT_VRD(i) do { vlo[i] = ft_vtr(vp_ + (((i) >> 2) * 4096 + ((i) & 3) * 1024)); vhi[i] = ft_vtr(vp_ + (((i) >> 2) * 4096 + ((i) & 3) * 1024 + 512)); } while (0)
#define FT_KRD(G, d0) do { if (G) { ft_kload2(kf, kp0 + sl_next, d0); FT_SBAR(); } } while (0)
#define FT_GAPA(MF, a0, a1, a2, a3, W0, W1, PW) do { MF; sacc += a0; sacc += a1; sacc += a2; sacc += a3; W0; W1; FT_PIN(PW); FT_PIN(sacc); FT_SBAR(); } while (0)
#define FT_GAPB(MF, X, i) do { MF; X[i] = FT_EX(X[i]); X[i + 1] = FT_EX(X[i + 1]); X[i + 2] = FT_EX(X[i + 2]); X[i + 3] = FT_EX(X[i + 3]); FT_PIN(X); FT_SBAR(); } while (0)
#define FT_STEP(C0, C1, P0, P1, t, MASK, GK, GV, GL) do { FT_SBAR(); \
    const ft_cptr vp_ = vp0 + sl_prev; const int id_ = w0; \
    FT_VRD(0); FT_SBAR(); float sacc = P0[0] + P0[1]; \
                       FT_GAPA(C0 = FA_MFMA(kf[0], qr[0], zero16), P0[2], P0[3], P0[4], P0[5],     pw0[0] = FT_PKW(P0, 0),  pw0[1] = FT_PKW(P0, 2),  pw0); \
    FT_VRD(4); FT_SBAR(); FT_GAPA(C1 = FA_MFMA(kf[1], qr[0], zero16), P0[6], P0[7], P0[8], P0[9],     pw0[2] = FT_PKW(P0, 4),  pw0[3] = FT_PKW(P0, 6),  pw0); \
    FT_VRD(1); FT_SBAR(); FT_GAPA(C0 = FA_MFMA(kf[2], qr[1], C0),    P0[10], P0[11], P0[12], P0[13], pw1[0] = FT_PKW(P0, 8),  pw1[1] = FT_PKW(P0, 10), pw1); \
    FT_VRD(5); FT_SBAR(); FT_GAPA(C1 = FA_MFMA(kf[3], qr[1], C1),    P0[14], P0[15], P1[0], P1[1],   pw1[2] = FT_PKW(P0, 12), pw1[3] = FT_PKW(P0, 14), pw1); \
    FT_VRD(2); FT_SBAR(); FT_GAPA(C0 = FA_MFMA(kf[4], qr[2], C0),    P1[2], P1[3], P1[4], P1[5],     pw2[0] = FT_PKW(P1, 0),  pw2[1] = FT_PKW(P1, 2),  pw2); \
    FT_VRD(6); FT_SBAR(); FT_GAPA(C1 = FA_MFMA(kf[5], qr[2], C1),    P1[6], P1[7], P1[8], P1[9],     pw2[2] = FT_PKW(P1, 4),  pw2[3] = FT_PKW(P1, 6),  pw2); \
    FT_VRD(3); FT_SBAR(); FT_GAPA(C0 = FA_MFMA(kf[6], qr[3], C0),    P1[10], P1[11], P1[12], P1[13], pw3[0] = FT_PKW(P1, 8),  pw3[1] = FT_PKW(P1, 10), pw3); \
    FT_VRD(7); FT_SBAR(); FT_GAPA(C1 = FA_MFMA(kf[7], qr[3], C1),    P1[14], P1[15], 0.f, 0.f,       pw3[2] = FT_PKW(P1, 12), pw3[3] = FT_PKW(P1, 14), pw3); \
    l_reg += sacc; \
    if (GK) FT_DMA_K(w3, sl_cur); if (GV) FT_DMA_V(w1, sl_next); \
    if (MASK) emask(id_, C0, C1); \
    const bool rs_ = rowsel(id_); \
    { float rmx = ft_rowmax(C0, C1); if (!rs_) rmx = -INFINITY; const float rm = rmx - mhat; resc = false; \
      if (__builtin_expect(__any(rm > THR), 0)) { const float dl = __builtin_fmaxf(rm, 0.f); mhat += dl; \
          const float f = __builtin_amdgcn_exp2f(-dl); l_reg *= f; if (hi == 0) wsf[r32] = f; resc = true; } } \
    const float nmh = rs_ ? -mhat : -INFINITY; FT_SBAR(); \
    FT_GAPB(o[0] = FA_MFMA(FT_PAF(0), FT_VFR(0), o[0]), C0, 0);              FT_GAPB(o[1] = FA_MFMA(FT_PAF(0), FT_VFR(4), o[1]), C0, 4); \
    FT_KRD(GL, 0); FT_GAPB(o[0] = FA_MFMA(FT_PAF(1), FT_VFR(1), o[0]), C0, 8);  FT_KRD(GL, 1); FT_GAPB(o[1] = FA_MFMA(FT_PAF(1), FT_VFR(5), o[1]), C0, 12); \
    FT_KRD(GL, 2); FT_GAPB(o[0] = FA_MFMA(FT_PAF(2), FT_VFR(2), o[0]), C1, 0);  FT_KRD(GL, 3); FT_GAPB(o[1] = FA_MFMA(FT_PAF(2), FT_VFR(6), o[1]), C1, 4); \
    FT_GAPB(o[0] = FA_MFMA(FT_PAF(3), FT_VFR(3), o[0]), C1, 8);              FT_GAPB(o[1] = FA_MFMA(FT_PAF(3), FT_VFR(7), o[1]), C1, 12); \
    } while (0)
    int t = 1;
    for (; t + 5 < NT; t += 2) {
        FT_STEP(pB0, pB1, pA0, pA1, t, false, true, true, true);     FT_WAIT_BAR(2); FT_RESC(); FT_ROT(); FT_SHIFT();
        FT_STEP(pA0, pA1, pB0, pB1, t + 1, false, true, true, true); FT_WAIT_BAR(2); FT_RESC(); FT_ROT(); FT_SHIFT();
    }
#define FT_ENDW(tt) do { if ((tt) + 3 < NT) { FT_WAIT_BAR(2); } else if ((tt) + 2 < NT) { FT_WAIT_BAR(1); } else { FT_WAIT_BAR(0); } } while (0)
    for (; t + 1 < NT; t += 2) {
        FT_STEP(pB0, pB1, pA0, pA1, t, true, (t + 3 < NT), (t + 1 < NT), (t + 1 < NT));         FT_ENDW(t);     FT_RESC(); FT_ROT(); FT_SHIFT();
        FT_STEP(pA0, pA1, pB0, pB1, t + 1, true, (t + 4 < NT), (t + 2 < NT), (t + 2 < NT));     FT_ENDW(t + 1); FT_RESC(); FT_ROT(); FT_SHIFT();
    }
    FT_STEP(pB0, pB1, pA0, pA1, NT - 1, true, false, false, false); FT_RESC();
    { float sacc = pB0[0] + pB0[1];
#pragma unroll
      for (int r = 2; r < 16; ++r) sacc += pB0[r];
#pragma unroll
      for (int r = 0; r < 16; ++r) sacc += pB1[r];
      l_reg += sacc;
      pw0 = (u32x4){FT_PKW(pB0, 0), FT_PKW(pB0, 2), FT_PKW(pB0, 4), FT_PKW(pB0, 6)}; pw1 = (u32x4){FT_PKW(pB0, 8), FT_PKW(pB0, 10), FT_PKW(pB0, 12), FT_PKW(pB0, 14)};
      pw2 = (u32x4){FT_PKW(pB1, 0), FT_PKW(pB1, 2), FT_PKW(pB1, 4), FT_PKW(pB1, 6)}; pw3 = (u32x4){FT_PKW(pB1, 8), FT_PKW(pB1, 10), FT_PKW(pB1, 12), FT_PKW(pB1, 14)};
      const ft_cptr vp_ = vp0 + sl_cur; _Pragma("unroll") for (int i = 0; i < 8; ++i) FT_VRD(i);
      o[0] = FA_MFMA(FT_PAF(0), FT_VFR(0), o[0]); o[1] = FA_MFMA(FT_PAF(0), FT_VFR(4), o[1]); o[0] = FA_MFMA(FT_PAF(1), FT_VFR(1), o[0]); o[1] = FA_MFMA(FT_PAF(1), FT_VFR(5), o[1]);
      o[0] = FA_MFMA(FT_PAF(2), FT_VFR(2), o[0]); o[1] = FA_MFMA(FT_PAF(2), FT_VFR(6), o[1]); o[0] = FA_MFMA(FT_PAF(3), FT_VFR(3), o[0]); o[1] = FA_MFMA(FT_PAF(3), FT_VFR(7), o[1]); }
    l_out = l_reg;
    asm volatile("s_waitcnt lgkmcnt(0)\n\ts_barrier" ::: "memory");
#undef FT_SHIFT
#undef FT_DMA_K
#undef FT_DMA_V
#undef FT_ROT
#undef FT_EX
#undef FT_RESC
#undef FT_PKW
#undef FT_PAF
#undef FT_VFR
#undef FT_VRD
#undef FT_KRD
#undef FT_ENDW
#undef FT_GAPA
#undef FT_GAPB
#undef FT_STEP
}

constexpr int M_KSLOT = 12288, M_LK = 0, M_LV = 4 * M_KSLOT, M_LWSF = M_LV + 3 * 8192, M_LOST = M_LWSF + 8 * 512, M_LEND = M_LOST + 8 * 4096;
DEV void ft_wait_bar(int n) {
    if (n == 0) asm volatile("s_waitcnt vmcnt(0) lgkmcnt(0)\n\ts_barrier" ::: "memory");
    else if (n == 1) asm volatile("s_waitcnt vmcnt(1) lgkmcnt(0)\n\ts_barrier" ::: "memory");
    else if (n == 2) asm volatile("s_waitcnt vmcnt(2) lgkmcnt(0)\n\ts_barrier" ::: "memory");
    else if (n == 3) asm volatile("s_waitcnt vmcnt(3) lgkmcnt(0)\n\ts_barrier" ::: "memory");
    else asm volatile("s_waitcnt vmcnt(5) lgkmcnt(0)\n\ts_barrier" ::: "memory");
}
DEV void fa96_tuned(f32x16 (&o)[2], float& l_out, const bf16x8 (&qr)[6], const bf16_t* Kb, const bf16_t* Vb, int NT, int qrel, LAS unsigned char* lds, LAS float* wsf, int wid, int lane, int r32, int hi) {
    constexpr int SLOTB = 8192; constexpr float THR = 8.0f;
    const unsigned lds0 = (unsigned)(uintptr_t)lds;
    const int kc = (wid < 4) ? 2 : 1;
    const bf16_t* ksrc = Kb + (size_t)lane * 768 + wid * 8;
    const bf16_t* vsrc = Vb + (size_t)(16 * (wid & 3) + (lane >> 2)) * 512 + (wid >> 2) * 32 + (lane & 3) * 8;
    const unsigned kdst = lds0 + M_LK + wid * 1024, vdst = lds0 + M_LV + wid * 1024;
#define MT_DMA_K(t) do { const unsigned sl_ = (unsigned)(((t) & 3) * M_KSLOT); ft_glds16(ksrc + (size_t)(t) * 64 * 768, (unsigned)__builtin_amdgcn_readfirstlane(kdst + sl_)); \
        if (wid < 4) ft_glds16(ksrc + (size_t)(t) * 64 * 768 + 64, (unsigned)__builtin_amdgcn_readfirstlane(kdst + 8192 + sl_)); } while (0)
#define MT_DMA_V(t, slot) ft_glds16(vsrc + (size_t)(t) * 64 * 512, (unsigned)__builtin_amdgcn_readfirstlane(vdst + (slot)))
    const ft_cptr vp0 = (ft_cptr)lds + M_LV + ((lane >> 4) & 1) * 32 + (lane & 3) * 8 + (4 * hi + ((lane & 15) >> 2)) * 64;
    const ft_cptr kp0 = (ft_cptr)lds + M_LK + hi * 1024 + r32 * 16;
#define MT_KFR(kp, f) (*(const LAS bf16x8*)((kp) + ((f) >> 1) * 2048 + ((f) & 1) * 512))
    MT_DMA_K(0); MT_DMA_V(0, 0); MT_DMA_K(1); MT_DMA_K(2);
    float mhat = 0.f, l_reg = 0.f; o[0] = f32x16{}; o[1] = f32x16{};
    const f32x16 zero16 = f32x16{};
    bool resc = false;
    f32x16 pA0, pA1, pB0, pB1; bf16x8 kf[4]; s16x4 vlo[8], vhi[8]; u32x4 pw0, pw1, pw2, pw3;
    int sl_prev = 0, sl_cur = 0, sl_next = SLOTB;
    const int band0 = NT - 4;
#define MT_ROT() do { sl_prev = sl_cur; sl_cur = sl_next; sl_next = (sl_next == 2 * SLOTB) ? 0 : sl_next + SLOTB; } while (0)
#define MT_EX(v) __builtin_amdgcn_exp2f((v) + nmh)
#define MT_RESC() do { if (resc) { _Pragma("unroll") for (int d_ = 0; d_ < 2; ++d_) _Pragma("unroll") for (int r = 0; r < 16; ++r) o[d_][r] *= wsf[crow(r, hi)]; } } while (0)
    auto cmask = [&](int t, f32x16& p0, f32x16& p1) { const int jb = t - band0; if (jb >= 0) { const int kb = 64 * jb + 4 * hi;
#pragma unroll
            for (int r = 0; r < 16; ++r) { const int kv_ = kb + (r & 3) + 8 * (r >> 2); if (kv_ > qrel) p0[r] = -INFINITY; if (kv_ + 32 > qrel) p1[r] = -INFINITY; } } };
    ft_wait_bar(kc == 2 ? 5 : 3);
    { const ft_cptr kp = kp0;
      pA0 = zero16; pA1 = zero16;
#pragma unroll
      for (int d0 = 0; d0 < 6; ++d0) { const bf16x8 k0 = MT_KFR(kp, 2 * d0), k1 = MT_KFR(kp, 2 * d0 + 1); pA0 = FA_MFMA(k0, qr[d0], pA0); pA1 = FA_MFMA(k1, qr[d0], pA1); } }
    cmask(0, pA0, pA1);
    { const float rm = ft_rowmax(pA0, pA1); mhat = rm; const float nmh = -mhat;
#pragma unroll
      for (int r = 0; r < 16; ++r) { pA0[r] = MT_EX(pA0[r]); pA1[r] = MT_EX(pA1[r]); } }
    ft_wait_bar(0);
    MT_DMA_K(3); MT_DMA_V(1, SLOTB); MT_ROT();
    { const ft_cptr kp = kp0 + M_KSLOT;
#pragma unroll
      for (int f = 0; f < 4; ++f) kf[f] = MT_KFR(kp, f); }
    ft_wait_bar(kc + 1);
#define MT_PKW(P, i) ft_cvtpk(P[i], P[i + 1])
#define MT_PAF(k) __builtin_bit_cast(bf16x8, pw##k)
#define MT_VFR(i) (bf16x8){vlo[i][0], vlo[i][1], vlo[i][2], vlo[i][3], vhi[i][0], vhi[i][1], vhi[i][2], vhi[i][3]}
#define MT_VRD(i) do { vlo[i] = ft_vtr(vp_ + (((i) >> 2) * 4096 + ((i) & 3) * 1024)); vhi[i] = ft_vtr(vp_ + (((i) >> 2) * 4096 + ((i) & 3) * 1024 + 512)); } while (0)
#define MT_GAPA(i, C, a0, a1, a2, a3, W0, W1, PW) do { C = FA_MFMA(kf[(i) & 3], qr[(i) >> 1], ((i) < 2) ? zero16 : C); if ((i) + 4 < 12) kf[(i) & 3] = MT_KFR(kp_, (i) + 4); \
        sacc += a0; sacc += a1; sacc += a2; sacc += a3; W0; W1; FT_PIN(PW); FT_PIN(sacc); FT_SBAR(); } while (0)
#define MT_GAPA0(i, C) do { C = FA_MFMA(kf[(i) & 3], qr[(i) >> 1], C); if ((i) + 4 < 12) kf[(i) & 3] = MT_KFR(kp_, (i) + 4); FT_SBAR(); } while (0)
#define MT_GAPB(MF, X, i) do { MF; X[i] = MT_EX(X[i]); X[i + 1] = MT_EX(X[i + 1]); X[i + 2] = MT_EX(X[i + 2]); X[i + 3] = MT_EX(X[i + 3]); FT_PIN(X); FT_SBAR(); } while (0)
#define MT_STEP(C0, C1, P0, P1, t, MASK, GK, GV, GL) do { FT_SBAR(); \
    const ft_cptr vp_ = vp0 + sl_prev; const ft_cptr kp_ = kp0 + ((t) & 3) * M_KSLOT; \
    MT_VRD(0); FT_SBAR(); float sacc = P0[0] + P0[1]; \
                          MT_GAPA(0, C0, P0[2], P0[3], P0[4], P0[5],     pw0[0] = MT_PKW(P0, 0),  pw0[1] = MT_PKW(P0, 2),  pw0); \
    MT_VRD(4); FT_SBAR(); MT_GAPA(1, C1, P0[6], P0[7], P0[8], P0[9],     pw0[2] = MT_PKW(P0, 4),  pw0[3] = MT_PKW(P0, 6),  pw0); \
    MT_VRD(1); FT_SBAR(); MT_GAPA(2, C0, P0[10], P0[11], P0[12], P0[13], pw1[0] = MT_PKW(P0, 8),  pw1[1] = MT_PKW(P0, 10), pw1); \
    MT_VRD(5); FT_SBAR(); MT_GAPA(3, C1, P0[14], P0[15], P1[0], P1[1],   pw1[2] = MT_PKW(P0, 12), pw1[3] = MT_PKW(P0, 14), pw1); \
    MT_VRD(2); FT_SBAR(); MT_GAPA(4, C0, P1[2], P1[3], P1[4], P1[5],     pw2[0] = MT_PKW(P1, 0),  pw2[1] = MT_PKW(P1, 2),  pw2); \
    MT_VRD(6); FT_SBAR(); MT_GAPA(5, C1, P1[6], P1[7], P1[8], P1[9],     pw2[2] = MT_PKW(P1, 4),  pw2[3] = MT_PKW(P1, 6),  pw2); \
    MT_VRD(3); FT_SBAR(); MT_GAPA(6, C0, P1[10], P1[11], P1[12], P1[13], pw3[0] = MT_PKW(P1, 8),  pw3[1] = MT_PKW(P1, 10), pw3); \
    MT_VRD(7); FT_SBAR(); MT_GAPA(7, C1, P1[14], P1[15], 0.f, 0.f,       pw3[2] = MT_PKW(P1, 12), pw3[3] = MT_PKW(P1, 14), pw3); \
    MT_GAPA0(8, C0); MT_GAPA0(9, C1); MT_GAPA0(10, C0); MT_GAPA0(11, C1); \
    l_reg += sacc; \
    if (GK) MT_DMA_K((t) + 3); if (GV) MT_DMA_V((t) + 1, sl_next); \
    if (MASK) cmask((t), C0, C1); \
    { const float rm = ft_rowmax(C0, C1) - mhat; resc = false; \
      if (__builtin_expect(__any(rm > THR), 0)) { const float dl = __builtin_fmaxf(rm, 0.f); mhat += dl; \
          const float f = __builtin_amdgcn_exp2f(-dl); l_reg *= f; if (hi == 0) wsf[r32] = f; resc = true; } } \
    const float nmh = -mhat; FT_SBAR(); \
    MT_GAPB(o[0] = FA_MFMA(MT_PAF(0), MT_VFR(0), o[0]), C0, 0);  MT_GAPB(o[1] = FA_MFMA(MT_PAF(0), MT_VFR(4), o[1]), C0, 4); \
    MT_GAPB(o[0] = FA_MFMA(MT_PAF(1), MT_VFR(1), o[0]), C0, 8);  MT_GAPB(o[1] = FA_MFMA(MT_PAF(1), MT_VFR(5), o[1]), C0, 12); \
    MT_GAPB(o[0] = FA_MFMA(MT_PAF(2), MT_VFR(2), o[0]), C1, 0);  MT_GAPB(o[1] = FA_MFMA(MT_PAF(2), MT_VFR(6), o[1]), C1, 4); \
    MT_GAPB(o[0] = FA_MFMA(MT_PAF(3), MT_VFR(3), o[0]), C1, 8);  MT_GAPB(o[1] = FA_MFMA(MT_PAF(3), MT_VFR(7), o[1]), C1, 12); \
    if (GL) { const ft_cptr kn_ = kp0 + (((t) + 1) & 3) * M_KSLOT; _Pragma("unroll") for (int f = 0; f < 4; ++f) kf[f] = MT_KFR(kn_, f); } \
    } while (0)
#define MT_ENDW(tt) do { if ((tt) + 3 < NT) ft_wait_bar(kc + 1); else if ((tt) + 2 < NT) ft_wait_bar(1); else ft_wait_bar(0); } while (0)
    int t = 1;
    for (; t + 5 < NT; t += 2) {
        MT_STEP(pB0, pB1, pA0, pA1, t, false, true, true, true);     ft_wait_bar(kc + 1); MT_RESC(); MT_ROT();
        MT_STEP(pA0, pA1, pB0, pB1, t + 1, false, true, true, true); ft_wait_bar(kc + 1); MT_RESC(); MT_ROT();
    }
    for (; t + 1 < NT; t += 2) {
        MT_STEP(pB0, pB1, pA0, pA1, t, true, (t + 3 < NT), (t + 1 < NT), (t + 1 < NT));         MT_ENDW(t);     MT_RESC(); MT_ROT();
        MT_STEP(pA0, pA1, pB0, pB1, t + 1, true, (t + 4 < NT), (t + 2 < NT), (t + 2 < NT));     MT_ENDW(t + 1); MT_RESC(); MT_ROT();
    }
    MT_STEP(pB0, pB1, pA0, pA1, NT - 1, true, false, false, false); MT_RESC();
    { float sacc = pB0[0] + pB0[1];
#pragma unroll
      for (int r = 2; r < 16; ++r) sacc += pB0[r];
#pragma unroll
      for (int r = 0; r < 16; ++r) sacc += pB1[r];
      l_reg += sacc;
      pw0 = (u32x4){MT_PKW(pB0, 0), MT_PKW(pB0, 2), MT_PKW(pB0, 4), MT_PKW(pB0, 6)}; pw1 = (u32x4){MT_PKW(pB0, 8), MT_PKW(pB0, 10), MT_PKW(pB0, 12), MT_PKW(pB0, 14)};
      pw2 = (u32x4){MT_PKW(pB1, 0), MT_PKW(pB1, 2), MT_PKW(pB1, 4), MT_PKW(pB1, 6)}; pw3 = (u32x4){MT_PKW(pB1, 8), MT_PKW(pB1, 10), MT_PKW(pB1, 12), MT_PKW(pB1, 14)};
      const ft_cptr vp_ = vp0 + sl_cur; _Pragma("unroll") for (int i = 0; i < 8; ++i) MT_VRD(i);
      o[0] = FA_MFMA(MT_PAF(0), MT_VFR(0), o[0]); o[1] = FA_MFMA(MT_PAF(0), MT_VFR(4), o[1]); o[0] = FA_MFMA(MT_PAF(1), MT_VFR(1), o[0]); o[1] = FA_MFMA(MT_PAF(1), MT_VFR(5), o[1]);
      o[0] = FA_MFMA(MT_PAF(2), MT_VFR(2), o[0]); o[1] = FA_MFMA(MT_PAF(2), MT_VFR(6), o[1]); o[0] = FA_MFMA(MT_PAF(3), MT_VFR(3), o[0]); o[1] = FA_MFMA(MT_PAF(3), MT_VFR(7), o[1]); }
    l_out = l_reg;
    asm volatile("s_waitcnt lgkmcnt(0)\n\ts_barrier" ::: "memory");
#undef MT_DMA_K
#undef MT_DMA_V
#undef MT_KFR
#undef MT_ROT
#undef MT_EX
#undef MT_RESC
#undef MT_PKW
#undef MT_PAF
#undef MT_VFR
#undef MT_VRD
#undef MT_GAPA
#undef MT_GAPA0
#undef MT_GAPB
#undef MT_STEP
#undef MT_ENDW
}
}

DEV void mla_unit(const Params& p, LAS unsigned char* lds, int b, int h, int qb) {
    using namespace fa;
    const int tid = opaque_tid(), wid = __builtin_amdgcn_readfirstlane(tid >> 6), lane = tid & 63, r32 = lane & 31, hi = lane >> 5;
    const bf16_t* QM = (const bf16_t*)(p.ws + OFF_QM); const bf16_t* Kb = (const bf16_t*)(p.ws + OFF_KM) + (size_t)b * SEQ * 768 + h * 96;
    const bf16_t* Vb = (const bf16_t*)(p.ws + OFF_VM) + (size_t)b * SEQ * 512 + h * 64; bf16_t* OCAT = (bf16_t*)(p.ws + OFF_OCAT);
    const int q0 = qb * 256, NT = (q0 + 256) / 64;
    LAS float* wsf = (LAS float*)(lds + M_LWSF) + wid * 128;
    bf16x8 qr[6];
    { const bf16_t* qrow = QM + ((size_t)b * SEQ + q0 + wid * 32 + r32) * 768 + h * 96 + hi * 8;
#pragma unroll
      for (int d0 = 0; d0 < 6; ++d0) qr[d0] = *(const bf16x8*)(qrow + d0 * 16); }
    f32x16 o[2]; float lpart;
    fa96_tuned(o, lpart, qr, Kb, Vb, NT, wid * 32 + r32, lds, wsf, wid, lane, r32, hi);
    const float l = xhalf_sum(lpart); float rl[16]; row_to_olayout(1.0f / l, rl, wsf, r32, hi);
#pragma unroll
    for (int r = 0; r < 16; ++r) { o[0][r] *= rl[r]; o[1][r] *= rl[r]; }
    store_o_rows(o, OCAT + ((size_t)b * SEQ + q0 + wid * 32) * 1024 + h * 64, 1024, lds + M_LOST + wid * 4096, lane, r32, hi);
    __syncthreads();
}
DEV void nsa_unit(const Params& p, LAS unsigned char* lds, int b, int g, int tb) {
    using namespace fa;
    const int tid = opaque_tid(), wid = __builtin_amdgcn_readfirstlane(tid >> 6), lane = tid & 63, r32 = lane & 31, hi = lane >> 5;
    const int hl = wid >> 1, head = 4 * g + hl, q0 = 64 * tb, tokl = 32 * (wid & 1) + r32, t = q0 + tokl;
    const size_t tok = (size_t)b * SEQ + t;
    const bf16_t* PROJ = (const bf16_t*)(p.ws + OFF_PROJ); const float* GATES = (const float*)(p.ws + OFF_GATES);
    LAS float* wsf = (LAS float*)(lds + L_WSF) + wid * 128;
    LAS float* impH = (LAS float*)(lds + L_IMPH);
    const int kp0 = hi * 1024 + r32 * 16;
    const int vp0 = ((lane >> 4) & 1) * 32 + (lane & 3) * 8 + (4 * hi + ((lane & 15) >> 2)) * 64;
    bf16x8 qr[4];
    { const bf16_t* qrow = (const bf16_t*)(p.ws + OFF_NQ) + tok * 512 + head * 64 + hi * 8;
#pragma unroll
      for (int d0 = 0; d0 < 4; ++d0) qr[d0] = *(const bf16x8*)(qrow + d0 * 16); }
    if (hi == 0) { const float* gp_ = GATES + tok * 24 + head * 3; wsf[64 + r32] = gp_[0]; wsf[96 + r32] = gp_[1]; }
    const float g2reg = GATES[tok * 24 + head * 3 + 2];
    { LAS f32x4* z = (LAS f32x4*)impH + tid;
#pragma unroll
      for (int i = 0; i < 8; ++i) z[i * 512] = (f32x4){0.f, 0.f, 0.f, 0.f}; }
    KVRegs<8> kv;
    f32x16 res[2];
    const int cntq = (t >= 31) ? ((t - 31) >> 4) + 1 : 0;
    const int ntc = (4 * tb + 3 + 63) >> 6;
    const bf16_t* Kc = (const bf16_t*)(p.ws + OFF_KC) + ((size_t)b * NCMPP * 2 + g) * 64; const bf16_t* Vc = (const bf16_t*)(p.ws + OFF_VC) + ((size_t)b * NCMPP * 2 + g) * 64;
    float mc = -1e30f, lc = 0.f;
    {   KVRegs<8> kc4[4];
#pragma unroll
        for (int c = 0; c < 4; ++c) if (c < ntc) stage_load<8>(kc4[c], Kc, 128, Vc, 128, c * 64, wid, lane);

#pragma unroll
        for (int c = 0; c < 4; ++c) if (c < ntc) { *(LAS u32x4*)(lds + L_K + c * 8192 + wid * 1024 + lane * 16) = kc4[c].k0; *(LAS u32x4*)(lds + L_OST + c * 8192 + wid * 1024 + lane * 16) = kc4[c].v; } }
    __syncthreads();
#pragma unroll 1
    for (int c = 0; c < ntc; ++c) {
        f32x16 p0, p1; qk_tile<4>(lds + L_K + c * 8192, kp0, qr, p0, p1);
        const int nb = 64 * c + 4 * hi;
#pragma unroll
        for (int r = 0; r < 16; ++r) { const int n = nb + (r & 3) + 8 * (r >> 2); if (n >= cntq) p0[r] = -INFINITY; if (n + 32 >= cntq) p1[r] = -INFINITY; }
        const float newm = fmaxf(mc, rowmax32(p0, p1)); float sacc = 0.f;
#pragma unroll
        for (int r = 0; r < 16; ++r) sacc += fast_exp2(p0[r] - newm) + fast_exp2(p1[r] - newm);
        lc = lc * fast_exp2(mc - newm) + sacc; mc = newm;
    }
    lc = xhalf_sum(lc);
    const float rlc = (lc > 0.f) ? 1.0f / lc : 0.f;
    float carry = 0.f;
    f32x16 oc[2];
#pragma unroll
    for (int r = 0; r < 16; ++r) { oc[0][r] = 0.f; oc[1][r] = 0.f; }
#pragma unroll 1
    for (int c = 0; c < ntc; ++c) {
        f32x16 p0, p1; qk_tile<4>(lds + L_K + c * 8192, kp0, qr, p0, p1);
        const int nb = 64 * c + 4 * hi;
#pragma unroll
        for (int r = 0; r < 16; ++r) { const int n = nb + (r & 3) + 8 * (r >> 2);
            p0[r] = (n >= cntq) ? 0.f : fast_exp2(p0[r] - mc) * rlc; p1[r] = (n + 32 >= cntq) ? 0.f : fast_exp2(p1[r] - mc) * rlc; }
        { LAS float* ih = impH + (size_t)hl * 4096 + tokl; float b0[4], b1[4];
#pragma unroll
          for (int k = 0; k < 4; ++k) { b0[k] = __shfl_xor(p0[4 * k + 3], 32); b1[k] = __shfl_xor(p1[4 * k + 3], 32); }
#pragma unroll
          for (int k = 0; k < 4; ++k) { const int j0 = 16 * c + 2 * k + hi, j1 = j0 + 8;
              const float G0 = (p0[4 * k] + p0[4 * k + 1]) + (p0[4 * k + 2] + p0[4 * k + 3]), G1 = (p1[4 * k] + p1[4 * k + 1]) + (p1[4 * k + 2] + p1[4 * k + 3]);
              const float e0 = hi ? b0[k] : (k ? b0[k > 0 ? k - 1 : 0] : carry), e1 = hi ? b1[k] : (k ? b1[k > 0 ? k - 1 : 0] : b0[3]);
              ih[j0 * 64] = G0 + e0; ih[j1 * 64] = G1 + e1; }
          carry = b1[3]; }
        u32x4 pw[4];
#pragma unroll
        for (int k = 0; k < 2; ++k) { pw[k] = (u32x4){pk2(p0[8 * k], p0[8 * k + 1]), pk2(p0[8 * k + 2], p0[8 * k + 3]), pk2(p0[8 * k + 4], p0[8 * k + 5]), pk2(p0[8 * k + 6], p0[8 * k + 7])};
            pw[2 + k] = (u32x4){pk2(p1[8 * k], p1[8 * k + 1]), pk2(p1[8 * k + 2], p1[8 * k + 3]), pk2(p1[8 * k + 4], p1[8 * k + 5]), pk2(p1[8 * k + 6], p1[8 * k + 7])}; }
        const LAS unsigned char* vbuf = lds + L_OST + c * 8192;
#pragma unroll
        for (int dh = 0; dh < 2; ++dh)
#pragma unroll
            for (int ks = 0; ks < 4; ++ks) { const s16x4 lo = vtr(vbuf + vp0 + dh * 4096 + ks * 1024), hi4 = vtr(vbuf + vp0 + dh * 4096 + ks * 1024 + 512);
                const bf16x8 vf = (bf16x8){lo[0], lo[1], lo[2], lo[3], hi4[0], hi4[1], hi4[2], hi4[3]};
                oc[dh] = FA_MFMA(__builtin_bit_cast(bf16x8, pw[ks]), vf, oc[dh]); }
    }
    __syncthreads();
    {   const int tk = tid & 63; const int cur = tb;
        float v[8];
#pragma unroll
        for (int k = 0; k < 8; ++k) { const int j = 8 * wid + k; const LAS float* q_ = impH + j * 64 + tk;
            const float s4 = ((q_[0] + q_[4096]) + q_[2 * 4096]) + q_[3 * 4096]; const bool forced = (j == 0) || (j <= cur && j > cur - 2); v[k] = forced ? 1e30f : s4; }
#pragma unroll
        for (int k = 0; k < 8; ++k) impH[(8 * wid + k) * 64 + tk] = v[k];
        __syncthreads();
        unsigned bits = 0u; int rank[8];
#pragma unroll
        for (int k = 0; k < 8; ++k) rank[k] = 0;
        if (cur >= 16)
#pragma unroll 4
        for (int q_ = 0; q_ <= cur; ++q_) { const float vq = impH[q_ * 64 + tk];
#pragma unroll
            for (int k = 0; k < 8; ++k) rank[k] += (vq > v[k] || (vq == v[k] && q_ < 8 * wid + k)) ? 1 : 0; }
#pragma unroll
        for (int k = 0; k < 8; ++k) if (8 * wid + k <= cur && rank[k] < 16) bits |= (1u << k);
        ((LAS unsigned char*)(lds + L_MASK))[tk * 8 + wid] = (unsigned char)bits;
        __syncthreads();
    }
    LAS float* resL = impH + wid * 2048 + lane;
    { float f[16]; row_to_olayout(wsf[64 + r32], f, wsf, r32, hi);
#pragma unroll
      for (int r = 0; r < 16; ++r) { resL[r * 64] = oc[0][r] * f[r]; resL[(16 + r) * 64] = oc[1][r] * f[r]; } }
    const unsigned long long mymask = *(const LAS unsigned long long*)(lds + L_MASK + tokl * 8);
    unsigned long long um;
    { const unsigned long long mm = *(const LAS unsigned long long*)(lds + L_MASK + lane * 8); unsigned ulo = (unsigned)mm, uhi = (unsigned)(mm >> 32);
#pragma unroll
      for (int o_ = 1; o_ < 64; o_ <<= 1) { ulo |= __shfl_xor(ulo, o_); uhi |= __shfl_xor(uhi, o_); }
      um = ((unsigned long long)(unsigned)__builtin_amdgcn_readfirstlane(uhi) << 32) | (unsigned)__builtin_amdgcn_readfirstlane(ulo); }
    {   const bf16_t* Kb = (const bf16_t*)(p.ws + OFF_KSR) + (size_t)b * SEQ * 128 + g * 64; const bf16_t* Vb = (const bf16_t*)(p.ws + OFF_VSC) + (size_t)b * SEQ * 128 + g * 64;
        int nt = __builtin_popcountll(um);
        while (nt < 4 || (nt & 1)) ++nt;
        f32x16 o[2]; float lpart;
        fa64_tuned<0>(o, lpart, qr, Kb, 128, Vb, 128, um, 0, nt, mymask, tb, tokl, lds, wsf, wid, lane, r32, hi);
        const float l = xhalf_sum(lpart); float f[16]; row_to_olayout(wsf[96 + r32] / l, f, wsf, r32, hi);
#pragma unroll
        for (int r = 0; r < 16; ++r) { resL[r * 64] += o[0][r] * f[r]; resL[(16 + r) * 64] += o[1][r] * f[r]; }
    }
    {   const bf16_t* Kb = (const bf16_t*)(p.ws + OFF_KWR) + (size_t)b * SEQ * 128 + g * 64; const bf16_t* Vb = (const bf16_t*)(p.ws + OFF_VWC) + (size_t)b * SEQ * 128 + g * 64;
        const int jlast = (tb - 8 > 0) ? tb - 8 : 0; int nt = tb - jlast + 1;
        while (nt < 4 || (nt & 1)) ++nt;
        f32x16 o[2]; float lpart;
        fa64_tuned<1>(o, lpart, qr, Kb, 128, Vb, 128, 0ull, jlast, nt, 0ull, tb, tokl, lds, wsf, wid, lane, r32, hi);
        const float l = xhalf_sum(lpart); float f[16]; row_to_olayout(g2reg / l, f, wsf, r32, hi);
#pragma unroll
        for (int r = 0; r < 16; ++r) { res[0][r] = resL[r * 64] + o[0][r] * f[r]; res[1][r] = resL[(16 + r) * 64] + o[1][r] * f[r]; }
        asm volatile("s_waitcnt lgkmcnt(0)" ::: "memory");
    }
    store_o_rows(res, (bf16_t*)(p.ws + OFF_OCAT) + ((size_t)b * SEQ + q0 + 32 * (wid & 1)) * 1024 + 512 + head * 64, 1024, lds + L_OST + wid * 4096, lane, r32, hi);
    __syncthreads();
}
DEV void phase5_nsa_fa(const Params& p, LAS unsigned char* lds) {
    constexpr int NU = BATCH * 2 * 64;
    const int G = gridDim.x;
    for (int r = 0; r * G < NU; ++r) {
        const int k = r * G + ((r & 1) ? (G - 1 - (int)blockIdx.x) : (int)blockIdx.x);
        if (k >= NU) continue;
        const int tb = 63 - k / 16, bg = k % 16;
        nsa_unit(p, lds, bg >> 1, bg & 1, tb);
    }
}
DEV void phase5_mla_fa(const Params& p, LAS unsigned char* lds) {
    constexpr int NU = BATCH * 8 * 16;
    const int G = gridDim.x;
    for (int r = 0; r * G < NU; ++r) {
        const int k = r * G + ((r & 1) ? (G - 1 - (int)blockIdx.x) : (int)blockIdx.x);
        if (k >= NU) continue;
        const int qb = 15 - k / 64, bh = k % 64;
        mla_unit(p, lds, bh >> 3, bh & 7, qb);
    }
}

DEV void phase5_cmp(const Params& p, LAS unsigned char* lds) {
    const int tid = opaque_tid(), hl = tid >> 7, tl = tid & 127;
    const bf16_t* NQ = (const bf16_t*)(p.ws + OFF_NQ); const bf16_t* KC = (const bf16_t*)(p.ws + OFF_KC); const bf16_t* VC = (const bf16_t*)(p.ws + OFF_VC);
    float* OCMP = (float*)(p.ws + OFF_OCMP); unsigned long long* SELM = (unsigned long long*)(p.ws + OFF_SELM);
    LAS float* imp = (LAS float*)lds;
    constexpr int NU = BATCH * 2 * (SEQ / 128);
    for (int u = blockIdx.x; u < NU; u += gridDim.x) {
        const int tb = u % (SEQ / 128), g = (u / (SEQ / 128)) & 1, b = u / (SEQ / 128 * 2);
        const int t = tb * 128 + tl, head = g * 4 + hl; const size_t tok = (size_t)b * SEQ + t;
        float q[64];
        { const bf16_t* qr = NQ + tok * 512 + head * 64;
#pragma unroll
          for (int i = 0; i < 32; ++i) { const unsigned w = *(const unsigned*)(qr + 2 * i); q[2 * i] = bflo(w); q[2 * i + 1] = bfhi(w); } }
        for (int j = 0; j < 64; ++j) imp[(hl * 64 + j) * 128 + tl] = 0.f;
        const int cnt = (t >= 31) ? ((t - 31) / 16 + 1) : 0;
        const int tmaxw = tb * 128 + (tl | 63); const int cntw = (tmaxw >= 31) ? ((tmaxw - 31) / 16 + 1) : 0;
        const bf16_t* kb = KC + ((size_t)b * NCMPP * 2 + g) * 64; const bf16_t* vb = VC + ((size_t)b * NCMPP * 2 + g) * 64;
        float m = -INFINITY, l = 0.f;
        for (int n = 0; n < cntw; ++n) { float a = 0.f;
#pragma unroll
            for (int i = 0; i < 32; ++i) { const unsigned w = *(const unsigned*)(kb + (size_t)n * 128 + 2 * i); a += q[2 * i] * bflo(w); a += q[2 * i + 1] * bfhi(w); }
            if (n < cnt) { const float mn = fmaxf(m, a); l = l * fast_exp2(m - mn) + fast_exp2(a - mn); m = mn; } }
        const float rl = (cnt > 0) ? 1.0f / l : 0.f;
        float o[64];
#pragma unroll
        for (int d = 0; d < 64; ++d) o[d] = 0.f;
        for (int n = 0; n < cntw; ++n) { float a = 0.f;
#pragma unroll
            for (int i = 0; i < 32; ++i) { const unsigned w = *(const unsigned*)(kb + (size_t)n * 128 + 2 * i); a += q[2 * i] * bflo(w); a += q[2 * i + 1] * bfhi(w); }
            const float pr = (n < cnt) ? fast_exp2(a - m) * rl : 0.f;
#pragma unroll
            for (int i = 0; i < 32; ++i) { const unsigned w = *(const unsigned*)(vb + (size_t)n * 128 + 2 * i); o[2 * i] += pr * bflo(w); o[2 * i + 1] += pr * bfhi(w); }
            const int jj = n >> 2; imp[(hl * 64 + jj) * 128 + tl] += pr; if ((n & 3) == 3 && jj + 1 < 64) imp[(hl * 64 + jj + 1) * 128 + tl] += pr; }
        { float* orow = OCMP + tok * 512 + head * 64; const float g0 = ((const float*)(p.ws + OFF_GATES))[tok * 24 + head * 3 + 0];
#pragma unroll
          for (int i = 0; i < 16; ++i) *(f32x4*)(orow + 4 * i) = (f32x4){g0 * o[4 * i], g0 * o[4 * i + 1], g0 * o[4 * i + 2], g0 * o[4 * i + 3]}; }
        __syncthreads();
        if (tid < 128) {
            const int cur = t >> 6;
            for (int j = 0; j < 64; ++j) { const float v = ((imp[(0 * 64 + j) * 128 + tl] + imp[(1 * 64 + j) * 128 + tl]) + imp[(2 * 64 + j) * 128 + tl]) + imp[(3 * 64 + j) * 128 + tl];
                const bool forced = (j == 0) || (j <= cur && j > cur - 2);
                imp[j * 128 + tl] = forced ? 1e30f : v; }
            unsigned long long mask = 0ull;
            for (int j = 0; j <= cur; ++j) { const float vj = imp[j * 128 + tl]; int rank = 0;
                for (int k = 0; k <= cur; ++k) { const float vk = imp[k * 128 + tl]; rank += (vk > vj || (vk == vj && k < j)) ? 1 : 0; }
                if (rank < 16) mask |= (1ull << j); }
            SELM[((size_t)b * 2 + g) * SEQ + t] = mask;
        }
        __syncthreads();
    }
}

DEV void phase5_selwin(const Params& p) {
    const int tid = opaque_tid(), wid = __builtin_amdgcn_readfirstlane(tid >> 6), lane = tid & 63;
    const int gw = blockIdx.x * 8 + wid, NGW = gridDim.x * 8;
    const bf16_t* NQ = (const bf16_t*)(p.ws + OFF_NQ); const bf16_t* KSR = (const bf16_t*)(p.ws + OFF_KSR); const bf16_t* KWR = (const bf16_t*)(p.ws + OFF_KWR);
    const bf16_t* PROJ = (const bf16_t*)(p.ws + OFF_PROJ); float* OCMP = (float*)(p.ws + OFF_OCMP); const float* GATES = (const float*)(p.ws + OFF_GATES);
    const unsigned long long* SELM = (const unsigned long long*)(p.ws + OFF_SELM); bf16_t* OCAT = (bf16_t*)(p.ws + OFF_OCAT);
    constexpr int NUNIT = BATCH * 8 * (SEQ / 64);
#pragma unroll 1
    for (int uu = gw; uu < NUNIT; uu += NGW) {
        const int u = (uu & 1) ? (NUNIT - 1 - (uu >> 1)) : (uu >> 1);
        const int tb = u % (SEQ / 64), head = (u / (SEQ / 64)) & 7, b = u / (SEQ / 64 * 8), g = head >> 2;
        const int t = tb * 64 + lane; const size_t tok = (size_t)b * SEQ + t;
        float q[64];
        { const bf16_t* qr = NQ + tok * 512 + head * 64;
#pragma unroll
          for (int i = 0; i < 32; ++i) { const unsigned w = *(const unsigned*)(qr + 2 * i); q[2 * i] = bflo(w); q[2 * i + 1] = bfhi(w); } }
        const unsigned long long mask = SELM[((size_t)b * 2 + g) * SEQ + t];
        unsigned ulo = (unsigned)mask, uhi = (unsigned)(mask >> 32);
#pragma unroll
        for (int o_ = 1; o_ < 64; o_ <<= 1) { ulo |= __shfl_xor(ulo, o_); uhi |= __shfl_xor(uhi, o_); }
        const unsigned long long um = ((unsigned long long)__builtin_amdgcn_readfirstlane(uhi) << 32) | (unsigned)__builtin_amdgcn_readfirstlane(ulo);
        float* oc = OCMP + tok * 512 + head * 64;
        { float o[64];
#pragma unroll
          for (int d = 0; d < 64; ++d) o[d] = 0.f;
          float m = -INFINITY, l = 0.f;
          const bf16_t* kb = KSR + (size_t)b * SEQ * 128 + g * 64; const bf16_t* vb = PROJ + (size_t)b * SEQ * INP + C_VS + g * 64;
#pragma unroll 1
          for (int blk = 0; blk <= tb; ++blk) { if (!((um >> blk) & 1ull)) continue; const bool sel = (mask >> blk) & 1ull;
              naive_attn_range<64, 64>(q, o, m, l, blk * 64, blk * 64 + 64,
                  [&](int j, int i) -> unsigned { return *(const unsigned*)(kb + (size_t)j * 128 + 2 * i); },
                  [&](int j, int i) -> unsigned { return *(const unsigned*)(vb + (size_t)j * INP + 2 * i); },
                  [&](int j) -> bool { return sel && j <= t; }); }
          const float g1 = GATES[tok * 24 + head * 3 + 1] / l;
#pragma unroll
          for (int i = 0; i < 16; ++i) { f32x4 c4 = *(f32x4*)(oc + 4 * i); c4.x += g1 * o[4 * i]; c4.y += g1 * o[4 * i + 1]; c4.z += g1 * o[4 * i + 2]; c4.w += g1 * o[4 * i + 3]; *(f32x4*)(oc + 4 * i) = c4; } }
        { float o[64];
#pragma unroll
          for (int d = 0; d < 64; ++d) o[d] = 0.f;
          float m = -INFINITY, l = 0.f;
          const bf16_t* kb = KWR + (size_t)b * SEQ * 128 + g * 64; const bf16_t* vb = PROJ + (size_t)b * SEQ * INP + C_VW + g * 64;
          const int jlo = (tb * 64 - 511 > 0) ? tb * 64 - 511 : 0;
          naive_attn_range<64, 64>(q, o, m, l, jlo, tb * 64 + 64,
              [&](int j, int i) -> unsigned { return *(const unsigned*)(kb + (size_t)j * 128 + 2 * i); },
              [&](int j, int i) -> unsigned { return *(const unsigned*)(vb + (size_t)j * INP + 2 * i); },
              [&](int j) -> bool { return j <= t && j > t - 512; });
          const float g2 = GATES[tok * 24 + head * 3 + 2] / l; bf16_t* orow = OCAT + tok * 1024 + 512 + head * 64;
#pragma unroll
          for (int i = 0; i < 16; ++i) { const f32x4 c4 = *(const f32x4*)(oc + 4 * i); u32x2 w; w.x = pk2(c4.x + g2 * o[4 * i], c4.y + g2 * o[4 * i + 1]); w.y = pk2(c4.z + g2 * o[4 * i + 2], c4.w + g2 * o[4 * i + 3]);
              *(u32x2*)(orow + 4 * i) = w; } }
    }
}

DEV void phase7(const Params& p, LAS unsigned char* lds) {
    const int tid = opaque_tid(), wid = __builtin_amdgcn_readfirstlane(tid >> 6), lane = tid & 63;
    const float* H1 = (const float*)(p.ws + OFF_H1); unsigned char* XN = p.ws + OFF_XN; float* SXTOK = (float*)(p.ws + OFF_SXTOK);
    int* TOPI = (int*)(p.ws + OFF_TOPI); float* TOPG = (float*)(p.ws + OFF_TOPG); int* POS = (int*)(p.ws + OFF_POS); unsigned* CNT = (unsigned*)(p.ws + OFF_CNT);
    LAS float* xt = (LAS float*)lds;
    LAS float* part = (LAS float*)(lds + 16 * 1028 * 4);
    LAS unsigned* lcnt = (LAS unsigned*)(lds + 16 * 1028 * 4 + 16384);
    const int ej = lane & 15, kq = lane >> 4, k0_ = 128 * wid + 32 * kq;
    float rw0[32], rw1[32];
#pragma unroll
    for (int i = 0; i < 32; ++i) { rw0[i] = p.router_w[(size_t)(k0_ + i) * 32 + ej]; rw1[i] = p.router_w[(size_t)(k0_ + i) * 32 + 16 + ej]; }
    const f32x4* gr = (const f32x4*)p.ffn_norm + lane;
    f32x4 gg[4];
#pragma unroll
    for (int j = 0; j < 4; ++j) gg[j] = gr[64 * j];
    for (int ch = blockIdx.x; ch < NTOK / 128; ch += gridDim.x) {
        if (tid < 32) lcnt[tid] = 0u;
        f32x4 nx[2][4];
#pragma unroll
        for (int rr = 0; rr < 2; ++rr) { const f32x4* xr = (const f32x4*)(H1 + (size_t)(ch * 128 + 2 * wid + rr) * DM) + lane;
#pragma unroll
            for (int j = 0; j < 4; ++j) nx[rr][j] = xr[64 * j]; }
        __syncthreads();
#pragma unroll 1
        for (int sub = 0; sub < 8; ++sub) {
            const int tok0 = ch * 128 + sub * 16;
#pragma unroll
            for (int rr = 0; rr < 2; ++rr) { const int row = 2 * wid + rr, tok = tok0 + row;
                f32x4 v[4]; float s_ = 0.f;
#pragma unroll
                for (int j = 0; j < 4; ++j) { v[j] = nx[rr][j]; s_ += (v[j].x * v[j].x + v[j].y * v[j].y) + (v[j].z * v[j].z + v[j].w * v[j].w); }
                if (sub + 1 < 8) { const f32x4* xr = (const f32x4*)(H1 + (size_t)(tok + 16) * DM) + lane;
#pragma unroll
                    for (int j = 0; j < 4; ++j) nx[rr][j] = xr[64 * j]; }
                const float rstd = rsqrtf(wave_sum(s_) * (1.f / 1024.f) + 1e-5f);
                float amax = 0.f;
#pragma unroll
                for (int j = 0; j < 4; ++j) { v[j].x *= rstd * gg[j].x; v[j].y *= rstd * gg[j].y; v[j].z *= rstd * gg[j].z; v[j].w *= rstd * gg[j].w;
                    amax = fmaxf(fmaxf(amax, fmaxf(fabsf(v[j].x), fabsf(v[j].y))), fmaxf(fabsf(v[j].z), fabsf(v[j].w))); *(LAS f32x4*)(xt + row * 1028 + 256 * j + 4 * lane) = v[j]; }
#pragma unroll
                for (int o_ = 1; o_ < 64; o_ <<= 1) amax = fmaxf(amax, __shfl_xor(amax, o_));
                amax = fmaxf(amax, 1e-30f); const float qinv = 127.0f / amax; if (lane == 0) SXTOK[tok] = amax * (1.0f / 127.0f);
                unsigned* o4 = (unsigned*)(XN + (size_t)tok * DM) + lane;
#pragma unroll
                for (int j = 0; j < 4; ++j) { const unsigned q0 = (unsigned)__float2int_rn(v[j].x * qinv) & 255u, q1 = (unsigned)__float2int_rn(v[j].y * qinv) & 255u, q2 = (unsigned)__float2int_rn(v[j].z * qinv) & 255u, q3 = (unsigned)__float2int_rn(v[j].w * qinv) & 255u;
                    o4[64 * j] = q0 | (q1 << 8) | (q2 << 16) | (q3 << 24); } }
            __syncthreads();
            { f32x4 acc0 = (f32x4){0.f, 0.f, 0.f, 0.f}, acc1 = acc0; const LAS float* xrow = xt + ej * 1028 + k0_;
#pragma unroll
              for (int s4 = 0; s4 < 8; ++s4) { const f32x4 xv = *(const LAS f32x4*)(xrow + 4 * s4);
#pragma unroll
                  for (int i = 0; i < 4; ++i) { acc0 = __builtin_amdgcn_mfma_f32_16x16x4f32(xv[i], rw0[4 * s4 + i], acc0, 0, 0, 0); acc1 = __builtin_amdgcn_mfma_f32_16x16x4f32(xv[i], rw1[4 * s4 + i], acc1, 0, 0, 0); } }
#pragma unroll
              for (int r = 0; r < 4; ++r) { part[(wid * 16 + 4 * kq + r) * 32 + ej] = acc0[r]; part[(wid * 16 + 4 * kq + r) * 32 + 16 + ej] = acc1[r]; } }
            __syncthreads();
            { const int tk = tid >> 5, e = tid & 31, tok = tok0 + tk; float logit = p.router_b[e];
#pragma unroll
              for (int w_ = 0; w_ < 8; ++w_) logit += part[(w_ * 16 + tk) * 32 + e];
              int ti[4]; float tv[4]; float cur = logit;
#pragma unroll
              for (int r = 0; r < 4; ++r) { float bv = cur; int bi = e;
#pragma unroll
                  for (int o_ = 1; o_ < 32; o_ <<= 1) { const float ov = __shfl_xor(bv, o_); const int oi = __shfl_xor(bi, o_); if (ov > bv || (ov == bv && oi < bi)) { bv = ov; bi = oi; } }
                  ti[r] = bi; tv[r] = bv; if (e == bi) cur = -INFINITY; }
              const float e1 = __expf(tv[1] - tv[0]), e2 = __expf(tv[2] - tv[0]), e3 = __expf(tv[3] - tv[0]); const float inv = 1.0f / (1.0f + e1 + e2 + e3);
              if (e == 0) {
                  *(f32x4*)(TOPG + (size_t)tok * 4) = (f32x4){inv, e1 * inv, e2 * inv, e3 * inv};
                  int ps[4];
#pragma unroll
                  for (int r = 0; r < 4; ++r) ps[r] = (int)__hip_atomic_fetch_add(&lcnt[ti[r]], 1u, __ATOMIC_RELAXED, __HIP_MEMORY_SCOPE_WORKGROUP);
                  int* ti_o = TOPI + (size_t)tok * 4; int* ps_o = POS + (size_t)tok * 4;
#pragma unroll
                  for (int r = 0; r < 4; ++r) { ti_o[r] = ti[r]; ps_o[r] = ps[r]; }
              } }
            __syncthreads();
        }
        if (tid < 32) lcnt[32 + tid] = atomicAdd(&CNT[tid], lcnt[tid]);
        __syncthreads();
        if (tid < 128) { const int tok = ch * 128 + tid; const int* ti_o = TOPI + (size_t)tok * 4; int* ps_o = POS + (size_t)tok * 4;
#pragma unroll
            for (int r = 0; r < 4; ++r) ps_o[r] += (int)lcnt[32 + ti_o[r]]; }
        __syncthreads();
    }
}

DEV void moe_offsets(const Params& p, LAS unsigned* tab) {
    const unsigned* CNT = (const unsigned*)(p.ws + OFF_CNT);
    const int tid = opaque_tid();
    if (tid < 64) {
        const int e = tid & 31; const unsigned c = __hip_atomic_load(&CNT[e], __ATOMIC_RELAXED, __HIP_MEMORY_SCOPE_AGENT);
        const unsigned pad = ((c + 255u) >> 8) << 8; unsigned inc = pad;
#pragma unroll
        for (int o_ = 1; o_ < 32; o_ <<= 1) { const unsigned v = __shfl_up(inc, o_, 32); if (e >= o_) inc += v; }
        if (tid < 32) { tab[e] = inc - pad; tab[32 + e] = inc >> 8; if (e == 31) tab[64] = inc; }
    }
    __syncthreads();
}
typedef int i32x4_ __attribute__((ext_vector_type(4)));
DEV void phase8(const Params& p, LAS unsigned char* lds) {
    const int tid = opaque_tid(), wid = tid >> 6, lane = tid & 63;
    const int gw = blockIdx.x * 8 + wid, NGW = gridDim.x * 8;
    LAS unsigned* tab = (LAS unsigned*)lds; moe_offsets(p, tab);
    const unsigned char* XN = p.ws + OFF_XN; unsigned char* XG = p.ws + OFF_XG;
    const int* TOPI = (const int*)(p.ws + OFF_TOPI); const float* TOPG = (const float*)(p.ws + OFF_TOPG); int* POS = (int*)(p.ws + OFF_POS); float* RG = (float*)(p.ws + OFF_ROWGATE);
    const float* SXTOK = (const float*)(p.ws + OFF_SXTOK); float* SXROW = (float*)(p.ws + OFF_SXROW);
    const int q = lane >> 4, sub = lane & 15;
    for (int tok4 = gw * 4; tok4 < NTOK; tok4 += NGW * 4) {
        const int tok = tok4 + q;
        const u32x4* src = (const u32x4*)(XN + (size_t)tok * DM) + sub;
        const u32x4 a0 = src[0], a1 = src[16], a2 = src[32], a3 = src[48];
        const i32x4_ te = *(const i32x4_*)(TOPI + (size_t)tok * 4), tp = *(const i32x4_*)(POS + (size_t)tok * 4); const f32x4 tg = *(const f32x4*)(TOPG + (size_t)tok * 4); const float sx = SXTOK[tok];
        int slot[4];
#pragma unroll
        for (int r = 0; r < 4; ++r) { slot[r] = (int)tab[te[r]] + tp[r];
            u32x4* dst = (u32x4*)(XG + (size_t)slot[r] * DM) + sub; dst[0] = a0; dst[16] = a1; dst[32] = a2; dst[48] = a3;
            if (sub == 0) { RG[slot[r]] = tg[r]; SXROW[slot[r]] = sx; } }
        if (sub == 0) *(i32x4_*)(POS + (size_t)tok * 4) = (i32x4_){slot[0], slot[1], slot[2], slot[3]};
    }
}

DEV void phase11(const Params& p) {
    const int tid = opaque_tid(), wid = tid >> 6, lane = tid & 63;
    const int gw = blockIdx.x * 8 + wid, NGW = gridDim.x * 8;
    const float* H1 = (const float*)(p.ws + OFF_H1); const bf16_t* Y = (const bf16_t*)(p.ws + OFF_Y); const int* POS = (const int*)(p.ws + OFF_POS);
    f32x4 gg[2][2];
#pragma unroll
    for (int j = 0; j < 2; ++j) { gg[j][0] = *(const f32x4*)(p.final_norm + 512 * j + 8 * lane); gg[j][1] = *(const f32x4*)(p.final_norm + 512 * j + 8 * lane + 4); }
    i32x4_ slot[2];
#pragma unroll
    for (int q = 0; q < 2; ++q) { const int t0 = 2 * gw + q; slot[q] = *(const i32x4_*)(POS + (size_t)(t0 < NTOK ? t0 : 0) * 4); }
#pragma unroll 1
    for (int tok2 = gw * 2; tok2 < NTOK; tok2 += NGW * 2) {
        f32x4 v[2][2][2]; u32x4 y[2][4][2];
#pragma unroll
        for (int q = 0; q < 2; ++q) { const float* xr = H1 + (size_t)(tok2 + q) * DM + 8 * lane;
#pragma unroll
            for (int j = 0; j < 2; ++j) { v[q][j][0] = *(const f32x4*)(xr + 512 * j); v[q][j][1] = *(const f32x4*)(xr + 512 * j + 4); }
#pragma unroll
            for (int r = 0; r < 4; ++r) { const bf16_t* yr = Y + (size_t)slot[q][r] * DM + 8 * lane;
#pragma unroll
                for (int j = 0; j < 2; ++j) y[q][r][j] = *(const u32x4*)(yr + 512 * j); } }
        i32x4_ nslot[2];
#pragma unroll
        for (int q = 0; q < 2; ++q) { const int t1 = tok2 + NGW * 2 + q; nslot[q] = *(const i32x4_*)(POS + (size_t)(t1 < NTOK ? t1 : 0) * 4); }
#pragma unroll
        for (int q = 0; q < 2; ++q) {
#pragma unroll
            for (int r = 0; r < 4; ++r)
#pragma unroll
                for (int j = 0; j < 2; ++j) { const u32x4 w = y[q][r][j];
                    v[q][j][0].x += bflo(w.x); v[q][j][0].y += bfhi(w.x); v[q][j][0].z += bflo(w.y); v[q][j][0].w += bfhi(w.y);
                    v[q][j][1].x += bflo(w.z); v[q][j][1].y += bfhi(w.z); v[q][j][1].z += bflo(w.w); v[q][j][1].w += bfhi(w.w); }
            float s = 0.f;
#pragma unroll
            for (int j = 0; j < 2; ++j)
#pragma unroll
                for (int h = 0; h < 2; ++h) s += (v[q][j][h].x * v[q][j][h].x + v[q][j][h].y * v[q][j][h].y) + (v[q][j][h].z * v[q][j][h].z + v[q][j][h].w * v[q][j][h].w);
            const float rstd = rsqrtf(wave_sum(s) * (1.f / 1024.f) + 1e-5f);
            float* orow = p.out + (size_t)(tok2 + q) * DM + 8 * lane;
#pragma unroll
            for (int j = 0; j < 2; ++j)
#pragma unroll
                for (int h = 0; h < 2; ++h) *(f32x4*)(orow + 512 * j + 4 * h) = (f32x4){v[q][j][h].x * rstd * gg[j][h].x, v[q][j][h].y * rstd * gg[j][h].y, v[q][j][h].z * rstd * gg[j][h].z, v[q][j][h].w * rstd * gg[j][h].w}; }
        slot[0] = nslot[0]; slot[1] = nslot[1];
    }
}

constexpr int NPHASE = 14;
constexpr int LDS_BYTES = 163840;
template <int PH> DEV void run_phase(const Params& p, LAS unsigned char* lds) {
    using namespace pg8;
    const int G = gridDim.x, bid = blockIdx.x;
    if constexpr (PH == 0) phase0(p, lds);
    if constexpr (PH == 1) { Gemm g{1024, 0}; DenseOrder S; S.init(p.ws + OFF_U, p.ws + OFF_WINT, 1024, NTOK, INP, G, bid);
        EpiBf16 E{(bf16_t*)(p.ws + OFF_PROJ), INP}; gemm_phase(lds, g, S, E);
        const int rem = S.nwg % G;
        if (rem > 0 && rem < G) { if (bid >= rem) prep_w2_items(p, lds, (bid - rem) * 8, (G - rem) * 8); } else prep_w2_items(p, lds, bid * 8, G * 8); }
    if constexpr (PH == 2) phase2(p);
    if constexpr (PH == 3) {
        const int NC = (G >= 64) ? 32 : 0;
        if (bid < NC) { Gemm g{2048, 1}; CmpOrder S{(const char*)(p.ws + OFF_KCC), (const char*)(p.ws + OFF_VCC), (const char*)(p.ws + OFF_CW1T), bid};
            EpiCmp E{(const float*)(p.ws + OFF_CB), p.cmp_w2, p.pos, (bf16_t*)(p.ws + OFF_KC), (bf16_t*)(p.ws + OFF_VC)}; gemm_phase(lds, g, S, E); }
        else {
            { Gemm g{256, 0}; DenseOrder S; S.init(p.ws + OFF_QN, p.ws + OFF_WQUPT, 256, NTOK, 768, G - NC, bid - NC); EpiQup E{(bf16_t*)(p.ws + OFF_QM), (const float*)(p.ws + OFF_ROPEM)}; gemm_phase(lds, g, S, E); }
            { Gemm g{256, 0}; DenseOrder S; S.init(p.ws + OFF_KVN, p.ws + OFF_WKVUPT, 256, NTOK, 1024, G - NC, bid - NC); EpiKvup E{(bf16_t*)(p.ws + OFF_KM), (bf16_t*)(p.ws + OFF_VM)}; gemm_phase(lds, g, S, E); }
        }
        if (NC == 0) for (int k = bid; k < 32; k += G) { Gemm g{2048, 1}; CmpOrder S{(const char*)(p.ws + OFF_KCC), (const char*)(p.ws + OFF_VCC), (const char*)(p.ws + OFF_CW1T), k};
            EpiCmp E{(const float*)(p.ws + OFF_CB), p.cmp_w2, p.pos, (bf16_t*)(p.ws + OFF_KC), (bf16_t*)(p.ws + OFF_VC)}; gemm_phase(lds, g, S, E); }
        prep_w1_items(p, lds);
    }
    if constexpr (PH == 5) phase5_mla_fa(p, lds);
    if constexpr (PH == 6) phase5_nsa_fa(p, lds);
    if constexpr (PH == 8) { Gemm g{1024, 0}; DenseOrder S; S.init(p.ws + OFF_OCAT, p.ws + OFF_WOUTT, 1024, NTOK, 1024, G, bid);
        EpiResF32 E{p.x, (float*)(p.ws + OFF_H1), 1024}; gemm_phase(lds, g, S, E); }
    if constexpr (PH == 9) phase7(p, lds);
    if constexpr (PH == 10) phase8(p, lds);
    if constexpr (PH == 11) { LAS unsigned* tab = (LAS unsigned*)(lds + STAGE_BYTES); moe_offsets(p, tab);
        Gemm g{512, 0}; MoeOrder S; S.d.init(p.ws + OFF_XG, p.ws + OFF_W1T, 512, (int)tab[64], 2048, G, bid); S.tend = tab + 32; S.nNt = 8;
        EpiMoe1 E{(bf16_t*)(p.ws + OFF_HMID), p.moe_b1, (const float*)(p.ws + OFF_SW1), (const float*)(p.ws + OFF_SXROW)}; gemm_phase<EpiMoe1, MoeOrder, true>(lds, g, S, E); }
    if constexpr (PH == 12) { LAS unsigned* tab = (LAS unsigned*)(lds + STAGE_BYTES); moe_offsets(p, tab);
        Gemm g{1024, 0}; MoeOrder S; S.d.init(p.ws + OFF_HMID, p.ws + OFF_W2T, 1024, (int)tab[64], 1024, G, bid); S.tend = tab + 32; S.nNt = 4;
        EpiMoe2 E{(bf16_t*)(p.ws + OFF_Y), p.moe_b2, (const float*)(p.ws + OFF_ROWGATE)}; gemm_phase(lds, g, S, E); }
    if constexpr (PH == 13) phase11(p);
}

template <int PH> __global__ void __launch_bounds__(512) phase_kernel(Params p) {
    extern __shared__ __attribute__((aligned(16))) unsigned char smem[];
    run_phase<PH>(p, (LAS unsigned char*)smem);
}

#if MK_ONE_LAUNCH
__global__ void __launch_bounds__(512) mega_kernel(Params p) {
    extern __shared__ __attribute__((aligned(16))) unsigned char smem[];
    LAS unsigned char* lds = (LAS unsigned char*)smem;
    cg::grid_group grid = cg::this_grid();
    volatile LAS unsigned* st = (volatile LAS unsigned*)(lds + LDS_BYTES - 16);
    if (threadIdx.x == 0) { st[0] = 0u; st[1] = 0u; }
    __syncthreads();
    const XcdBarrier xb = xcd_barrier_post((unsigned*)(p.ws + OFF_BAR), st);
#define GSYNC() xcd_barrier(xb)
    if (p.ws == nullptr) grid.sync();
    run_phase<0>(p, lds); GSYNC();
    run_phase<1>(p, lds); GSYNC();
    run_phase<2>(p, lds); GSYNC();
    run_phase<3>(p, lds); GSYNC();
    run_phase<5>(p, lds); run_phase<6>(p, lds); GSYNC();
    run_phase<8>(p, lds); GSYNC();
    run_phase<9>(p, lds); GSYNC();
    run_phase<10>(p, lds); GSYNC();
    run_phase<11>(p, lds); GSYNC();
    run_phase<12>(p, lds); GSYNC();
    run_phase<13>(p, lds);
}
#endif

template <int PH> static void launch_phase(const Params& p, int grid, hipStream_t stream) {
    static bool attr = false;
    if (!attr) { (void)hipFuncSetAttribute((const void*)phase_kernel<PH>, hipFuncAttributeMaxDynamicSharedMemorySize, LDS_BYTES); attr = true; }
    hipLaunchKernelGGL(phase_kernel<PH>, dim3(grid), dim3(512), LDS_BYTES, stream, p);
}

extern "C" void kernel_launch(void* const* d_in, const int* in_sizes, int n_in, void* d_out, int out_size, void* d_ws, size_t ws_size, hipStream_t stream) {
    static int grid = 0;
    if (grid == 0) {
        if (n_in != 20 || out_size != NTOK * DM || ws_size < WS_END) { fprintf(stderr, "kernel_launch: unexpected shapes (n_in %d, out %d, ws %zu < %zu)\n", n_in, out_size, ws_size, (size_t)WS_END); grid = -1; return; }
        int dev = 0, cus = 0, per_cu = 0;
        (void)hipGetDevice(&dev); (void)hipDeviceGetAttribute(&cus, hipDeviceAttributeMultiprocessorCount, dev);
#if MK_ONE_LAUNCH
        (void)hipFuncSetAttribute((const void*)mega_kernel, hipFuncAttributeMaxDynamicSharedMemorySize, LDS_BYTES);
        (void)hipOccupancyMaxActiveBlocksPerMultiprocessor(&per_cu, (const void*)mega_kernel, 512, LDS_BYTES);
        if (per_cu < 1) { fprintf(stderr, "kernel_launch: occupancy query says %d blocks per CU\n", per_cu); per_cu = 1; }
#endif
        (void)hipGetLastError();
        grid = cus * 1;
        if (grid <= 0) grid = 256;
    }
    if (grid < 0) return;
    Params p; memset(&p, 0, sizeof(p));
    p.x = (const float*)d_in[0]; p.pos = (const int*)d_in[1]; p.attn_norm = (const float*)d_in[2]; p.w_in = (const float*)d_in[3]; p.q_norm = (const float*)d_in[4];
    p.w_q_up = (const float*)d_in[5]; p.kv_norm = (const float*)d_in[6]; p.w_kv_up = (const float*)d_in[7]; p.cmp_pos = (const float*)d_in[8]; p.cmp_w1 = (const float*)d_in[9];
    p.cmp_w2 = (const float*)d_in[10]; p.w_out = (const float*)d_in[11]; p.ffn_norm = (const float*)d_in[12]; p.router_w = (const float*)d_in[13]; p.router_b = (const float*)d_in[14];
    p.moe_w1 = (const float*)d_in[15]; p.moe_b1 = (const float*)d_in[16]; p.moe_w2 = (const float*)d_in[17]; p.moe_b2 = (const float*)d_in[18]; p.final_norm = (const float*)d_in[19];
    p.out = (float*)d_out; p.ws = (unsigned char*)d_ws;
#if MK_ONE_LAUNCH
    (void)hipMemsetAsync((unsigned char*)d_ws + OFF_BAR, 0, XCD_BAR_WORDS * 4, stream);
    void* args[] = {&p};
    hipError_t e = hipLaunchCooperativeKernel((const void*)mega_kernel, dim3(grid), dim3(512), args, LDS_BYTES, stream);
    if (e != hipSuccess) fprintf(stderr, "cooperative launch failed: %s (grid %d)\n", hipGetErrorString(e), grid);
#else
    launch_phase<0>(p, grid, stream); launch_phase<1>(p, grid, stream); launch_phase<2>(p, grid, stream); launch_phase<3>(p, grid, stream); launch_phase<4>(p, grid, stream);
    launch_phase<5>(p, grid, stream); launch_phase<6>(p, grid, stream); launch_phase<7>(p, grid, stream); launch_phase<8>(p, grid, stream); launch_phase<9>(p, grid, stream);
    launch_phase<10>(p, grid, stream); launch_phase<11>(p, grid, stream); launch_phase<12>(p, grid, stream); launch_phase<13>(p, grid, stream);
#endif
}
```

```cpp
#include <hip/hip_runtime.h>
#include <hip/hip_cooperative_groups.h>
#include <cstdint>
#include <cstdio>
#include <cstring>
namespace cg = cooperative_groups;

#ifndef MK_ONE_LAUNCH
#define MK_ONE_LAUNCH 1
#endif

#define LAS __attribute__((address_space(3)))
#define DEV __device__ __forceinline__
typedef unsigned short bf16_t;
typedef short bf16x8 __attribute__((ext_vector_type(8)));
typedef float f32x4 __attribute__((ext_vector_type(4)));
typedef float f32x2 __attribute__((ext_vector_type(2)));
typedef unsigned u32x4 __attribute__((ext_vector_type(4)));
typedef unsigned u32x2 __attribute__((ext_vector_type(2)));

constexpr int BATCH = 8, SEQ = 4096, NTOK = BATCH * SEQ, DM = 1024;
constexpr int INC = 1720, INP = 1792;
constexpr int C_QLAT = 0, C_KVLAT = 256, C_KPE = 384, C_QNSA = 416, C_KC = 928, C_VC = 1056, C_KS = 1184, C_VS = 1312, C_KW = 1440, C_VW = 1568, C_G = 1696;
constexpr int NEXP = 32, TOPK = 4, DFF = 1024;
constexpr int NCMP = 255, NCMPP = 256;
constexpr int MAXROWS = 139264;
constexpr float LOG2E = 1.4426950408889634f;
constexpr float MLA_QSCALE = 0.10206207261596577f * LOG2E;
constexpr float NSA_QSCALE = 0.125f * LOG2E;

constexpr size_t MiB = 1ull << 20;
constexpr size_t OFF_W1T = 0;
constexpr size_t OFF_W2T = 128 * MiB;
constexpr size_t OFF_WINT = 192 * MiB;
constexpr size_t OFF_WQUPT = 196 * MiB;
constexpr size_t OFF_WKVUPT = 197 * MiB;
constexpr size_t OFF_WOUTT = 198 * MiB;
constexpr size_t OFF_CW1T = 200 * MiB;
constexpr size_t OFF_MISC = 202 * MiB;
constexpr size_t OFF_CB = OFF_MISC + 8192;
constexpr size_t OFF_CNT = OFF_MISC + 4096;
constexpr size_t OFF_BAR = OFF_MISC + 16384;
constexpr size_t OFF_TOPI = OFF_MISC + 64 * 1024;
constexpr size_t OFF_TOPG = OFF_TOPI + (size_t)NTOK * 16;
constexpr size_t OFF_POS = OFF_TOPG + (size_t)NTOK * 16;
constexpr size_t OFF_ROWGATE = OFF_POS + (size_t)NTOK * 16;
constexpr size_t OFF_SXROW = OFF_ROWGATE + (size_t)MAXROWS * 4;
constexpr size_t OFF_SXTOK = OFF_SXROW + (size_t)MAXROWS * 4;
constexpr size_t OFF_SW1 = OFF_SXTOK + (size_t)NTOK * 4;
constexpr size_t OFF_H1 = 206 * MiB;
constexpr size_t OFF_R1 = 334 * MiB;
constexpr size_t OFF_R2 = 606 * MiB;
constexpr size_t WS_END = 878 * MiB;
constexpr size_t OFF_U = OFF_R1;
constexpr size_t OFF_QM = OFF_R1;
constexpr size_t OFF_OCAT = OFF_R1 + 64 * MiB;
constexpr size_t OFF_OCMP = OFF_R1 + 160 * MiB;
constexpr size_t OFF_KCC = OFF_R1 + 128 * MiB;
constexpr size_t OFF_VCC = OFF_R1 + 136 * MiB;
constexpr size_t OFF_VSC = OFF_R1 + 144 * MiB;
constexpr size_t OFF_VWC = OFF_R1 + 152 * MiB;
constexpr size_t OFF_SELM = OFF_R1 + 240 * MiB;
constexpr size_t OFF_KC = OFF_R1 + 241 * MiB;
constexpr size_t OFF_VC = OFF_R1 + 242 * MiB;
constexpr size_t OFF_GATES = OFF_R1 + 243 * MiB;
constexpr size_t OFF_ROPEM = OFF_R1 + 246 * MiB;
constexpr size_t OFF_KSR = OFF_R1 + 250 * MiB;
constexpr size_t OFF_KWR = OFF_R1 + 258 * MiB;
constexpr size_t OFF_PROJ = OFF_R2;
constexpr size_t OFF_NQ = OFF_R2 + 112 * MiB;
constexpr size_t OFF_QN = OFF_R2 + 144 * MiB;
constexpr size_t OFF_KVN = OFF_R2 + 160 * MiB;
constexpr size_t OFF_KM = OFF_R2 + 176 * MiB;
constexpr size_t OFF_VM = OFF_R2 + 224 * MiB;
constexpr size_t OFF_QUP = OFF_R2 + 256 * MiB;
constexpr size_t OFF_KVUP = OFF_R2 + 256 * MiB;
constexpr size_t OFF_KPE = OFF_R2 + 256 * MiB;
constexpr size_t OFF_XN = OFF_R2 + 0;
constexpr size_t OFF_XG = OFF_R1;
constexpr size_t OFF_Y = OFF_R1;
constexpr size_t OFF_HMID = OFF_R2;

struct Params {
    const float* x; const int* pos; const float* attn_norm; const float* w_in; const float* q_norm; const float* w_q_up; const float* kv_norm; const float* w_kv_up;
    const float* cmp_pos; const float* cmp_w1; const float* cmp_w2; const float* w_out; const float* ffn_norm; const float* router_w; const float* router_b;
    const float* moe_w1; const float* moe_b1; const float* moe_w2; const float* moe_b2; const float* final_norm;
    float* out; unsigned char* ws;
};

DEV float bf2f(bf16_t b) { return __uint_as_float((unsigned)b << 16); }
DEV float bflo(unsigned u) { return __uint_as_float(u << 16); }
DEV float bfhi(unsigned u) { return __uint_as_float(u & 0xffff0000u); }
DEV unsigned pk2(float lo, float hi) { unsigned r; asm volatile("v_cvt_pk_bf16_f32 %0, %1, %2" : "=v"(r) : "v"(lo), "v"(hi)); return r; }
DEV bf16_t f2bf(float f) { return (bf16_t)(pk2(f, 0.f) & 0xffffu); }
DEV float wave_sum(float v) {
#pragma unroll
    for (int o = 1; o < 64; o <<= 1) v += __shfl_xor(v, o);
    return v;
}
DEV float fast_exp2(float x) { return __builtin_amdgcn_exp2f(x); }
DEV int opaque_tid() { int t = threadIdx.x; asm volatile("" : "+v"(t)); return t; }

#define XB_TMO      128
#define XB_XCNT(j)  (256  + 64 * (j))
#define XB_XSUB(j)  (1280 + 64 * (j))
#define XB_XGEN(j)  (2304 + 64 * (j))
#define XB_TOP      3328
#define XB_TOPGEN   3392
#define XCD_BAR_WORDS 3456
#define XB_SPIN_CAP (1u << 22)
DEV unsigned xb_ld(unsigned* p) { return __hip_atomic_load(p, __ATOMIC_RELAXED, __HIP_MEMORY_SCOPE_AGENT); }
DEV unsigned xb_add(unsigned* p, unsigned v) { return __hip_atomic_fetch_add(p, v, __ATOMIC_RELAXED, __HIP_MEMORY_SCOPE_AGENT); }
DEV unsigned xb_xcc_id() { return (unsigned)__builtin_amdgcn_s_getreg((3 << 11) | 20) & 0xFu; }
#define XB_SPIN(cond, bar) do { unsigned _sp = 0; while (cond) { __builtin_amdgcn_s_sleep(1); \
    if ((++_sp & 255u) == 0u) { if (xb_ld(&(bar)[XB_TMO])) break; if (_sp > XB_SPIN_CAP) { atomicAdd(&(bar)[XB_TMO], 1u); break; } } } } while (0)
struct XcdBarrier { unsigned* bar; unsigned x; volatile LAS unsigned* st; };
DEV XcdBarrier xcd_barrier_post(unsigned* bar, volatile LAS unsigned* st) {
    XcdBarrier b; b.bar = bar; b.x = xb_xcc_id(); b.st = st;
    if (threadIdx.x == 0) (void)xb_add(&bar[XB_XCNT(b.x)], 1u);
    return b;
}
DEV void xcd_barrier_complete(unsigned* bar, unsigned x, unsigned& nloc, unsigned& nx) {
    const unsigned G = gridDim.x * gridDim.y * gridDim.z;
    unsigned sum, cnt, mine, sp = 0u;
    for (;;) {
        sum = 0u; cnt = 0u; mine = 0u;
#pragma unroll
        for (unsigned j = 0; j < 16; ++j) { const unsigned c = xb_ld(&bar[XB_XCNT(j)]); sum += c; cnt += (c > 0u) ? 1u : 0u; mine = (j == x) ? c : mine; }
        if (sum == G) break;
        __builtin_amdgcn_s_sleep(1);
        if ((++sp & 255u) == 0u) { if (xb_ld(&bar[XB_TMO])) break; if (sp > XB_SPIN_CAP) { atomicAdd(&bar[XB_TMO], 1u); break; } }
    }
    nloc = mine > 0u ? mine : 1u; nx = cnt > 0u ? cnt : 1u;
}
DEV void xcd_barrier(const XcdBarrier& b) {
    asm volatile("s_waitcnt vmcnt(0)" ::: "memory");
    __syncthreads();
    if (threadIdx.x == 0) {
        unsigned* bar = b.bar;
        __builtin_amdgcn_s_waitcnt(0);
        unsigned nloc = b.st[0], nx = b.st[1];
        if (nloc == 0u) { xcd_barrier_complete(bar, b.x, nloc, nx); b.st[0] = nloc; b.st[1] = nx; }
        const unsigned old = xb_add(&bar[XB_XSUB(b.x)], 1u);
        const unsigned gen = old / nloc;
        if (old + 1u == (gen + 1u) * nloc) {
            __builtin_amdgcn_fence(__ATOMIC_RELEASE, "agent");
            asm volatile("s_waitcnt vmcnt(0)" ::: "memory");
            const unsigned og = xb_add(&bar[XB_TOP], 1u);
            const unsigned tg = og / nx;
            if (og + 1u == (tg + 1u) * nx) xb_add(&bar[XB_TOPGEN], 1u);
            else XB_SPIN(xb_ld(&bar[XB_TOPGEN]) == tg, bar);
            __builtin_amdgcn_fence(__ATOMIC_ACQUIRE, "agent");
            xb_add(&bar[XB_XGEN(b.x)], 1u);
            asm volatile("s_waitcnt vmcnt(0)" ::: "memory");
        } else {
            XB_SPIN(xb_ld(&bar[XB_XGEN(b.x)]) == gen, bar);
            __builtin_amdgcn_fence(__ATOMIC_ACQUIRE, "agent");
            asm volatile("s_waitcnt vmcnt(0)" ::: "memory");
        }
    }
    __syncthreads();
}

namespace pg8 {
constexpr int BM = 256, BK = 64, HALF = 128, HTB = HALF * BK * 2, STAGE_BYTES = 8 * HTB, NXCD = 8, WGM = 8;
DEV int lds_byte(int r, int c) { const int st = (r >> 4) * 2 + (c >> 5), rr = r & 15, cc = c & 31, ob = rr * 64 + cc * 2; return st * 1024 + (ob ^ (((ob >> 9) & 1) << 5)); }
DEV void stage_rc(int b, int& R, int& C) { const int st = b / 1024, sb = b % 1024, swz = sb ^ (((sb >> 9) & 1) << 5); R = (st >> 1) * 16 + swz / 64; C = (st & 1) * 32 + (swz % 64) / 2; }

struct Unit { int pm, pn, e; const char* a; const char* b; };
struct Gemm { int K; int amode; };

struct DenseOrder {
    int nM, nN, nwg, G, c; const char* A; const char* Bt; size_t tstep;
    DEV void init(const void* A_, const void* Bt_, int K, int M, int N, int G_, int c_) { A = (const char*)A_; Bt = (const char*)Bt_; tstep = (size_t)BM * K * 2; nM = M / BM; nN = N / BM; nwg = nM * nN; G = G_; c = c_; }
    DEV bool next(int i, Unit& u) const {
        const long L = (long)i * G + c; if (L >= nwg) return false;
        int wgid = (int)L; { const int q = nwg / NXCD, r = nwg % NXCD, xcd = wgid % NXCD, off = wgid / NXCD; wgid = (xcd < r ? xcd * (q + 1) : r * (q + 1) + (xcd - r) * q) + off; }
        const int nig = WGM * nN, gid = wgid / nig, fm = gid * WGM, gsz = (nM - fm) < WGM ? (nM - fm) : WGM;
        u.pm = fm + ((wgid % nig) % gsz); u.pn = (wgid % nig) / gsz; u.e = 0; u.a = A + (size_t)u.pm * tstep; u.b = Bt + (size_t)u.pn * tstep; return true;
    }
};
struct MoeOrder {
    DenseOrder d; const LAS unsigned* tend;
    int nNt;
    DEV bool next(int i, Unit& u) const {
        if (!d.next(i, u)) return false;
        const int e = __builtin_popcountll(__ballot(u.pm >= (int)tend[threadIdx.x & 31]) & 0xffffffffull);
        u.e = e; u.b = d.Bt + (size_t)(e * nNt + u.pn) * d.tstep; return true;
    }
};

struct CmpOrder {
    const char* KCC; const char* VCC; const char* W; int k;
    DEV bool next(int i, Unit& u) const {
        if (i != 0 || k < 0) return false;
        const int c = k >> 4, pm = k & 15, b = pm >> 1, n0 = (pm & 1) * 128;
        u.pm = pm; u.pn = 0; u.e = c; u.a = (c == 0 ? KCC : VCC) + (size_t)(b * SEQ + 16 * n0) * 128 * 2; u.b = W + (size_t)c * 256 * 2048 * 2; return true;
    }
};

typedef int i32x4 __attribute__((ext_vector_type(4)));
template <class Epi, class Sched, bool I8 = false>
DEV void gemm_phase(LAS unsigned char* lds, const Gemm g, const Sched& S, const Epi& E) {
    const int tid = opaque_tid(), wid = __builtin_amdgcn_readfirstlane(tid >> 6), lane = tid & 63, wr = wid >> 2, wc = wid & 3, fr = lane & 15, fq = lane >> 4;
    const int K = g.K; int nt = K / BK; asm volatile("" : "+s"(nt));
    unsigned voffA[2], voffB[2];
#pragma unroll
    for (int i = 0; i < 2; ++i) { int R, C; stage_rc(tid * 16 + i * 8192, R, C); voffB[i] = (unsigned)(R * K + C) * 2u;
        voffA[i] = (g.amode == 0) ? voffB[i] : (unsigned)((R >> 1) * 16 * 128 + (R & 1) * 64 + C) * 2u; }
    const size_t kstepB = (size_t)(BK * 2), kstepA = (g.amode == 0) ? kstepB : (size_t)128 * 2;
    const size_t hstepB = (size_t)HALF * K * 2, hstepA = (g.amode == 0) ? hstepB : (size_t)64 * 16 * 128 * 2;
    const unsigned ldsw = (unsigned)wid * 1024u;
    const int aoff = lds_byte(wr * 64 + fr, fq * 8), boff = lds_byte(wc * 32 + fr, fq * 8);
#define PG8_SA(b, h) (((b) * 2 + (h)) * HTB)
#define PG8_SB(b, h) ((4 + (b) * 2 + (h)) * HTB)
#define PG8_STAGE(bufoff, gbase, voff) do { _Pragma("unroll") for (int _i = 0; _i < 2; ++_i) \
        __builtin_amdgcn_global_load_lds((const unsigned*)((const char*)(gbase) + (voff)[_i]), (LAS unsigned*)(lds + (bufoff) + ldsw + _i * 8192), 16, 0, 0); } while (0)
#define PG8_LDA(dst, b, h) do { _Pragma("unroll") for (int m = 0; m < 4; ++m) _Pragma("unroll") for (int k = 0; k < 2; ++k) dst[m][k] = *(const LAS bf16x8*)(lds + PG8_SA(b, h) + aoff + m * 2048 + k * 1024); } while (0)
#define PG8_LDB(dst, b, h) do { _Pragma("unroll") for (int n = 0; n < 2; ++n) _Pragma("unroll") for (int k = 0; k < 2; ++k) dst[n][k] = *(const LAS bf16x8*)(lds + PG8_SB(b, h) + boff + n * 2048 + k * 1024); } while (0)
#define PG8_MMA(ai, bj, At, Bt) do { __builtin_amdgcn_s_setprio(1); _Pragma("unroll") for (int m = 0; m < 4; ++m) _Pragma("unroll") for (int n = 0; n < 2; ++n) _Pragma("unroll") for (int k = 0; k < 2; ++k) { \
        if constexpr (I8) acc[ai][bj][m][n] = __builtin_bit_cast(f32x4, __builtin_amdgcn_mfma_i32_16x16x64_i8(__builtin_bit_cast(i32x4, Bt[n][k]), __builtin_bit_cast(i32x4, At[m][k]), __builtin_bit_cast(i32x4, acc[ai][bj][m][n]), 0, 0, 0)); \
        else acc[ai][bj][m][n] = __builtin_amdgcn_mfma_f32_16x16x32_bf16(Bt[n][k], At[m][k], acc[ai][bj][m][n], 0, 0, 0); } __builtin_amdgcn_s_setprio(0); } while (0)
#define PG8_WAIT_V(n) asm volatile("s_waitcnt vmcnt(" #n ")" ::: "memory")
#define PG8_WAIT_L(n) asm volatile("s_waitcnt lgkmcnt(" #n ")" ::: "memory")
#define PG8_BAR __builtin_amdgcn_s_barrier()
#define PG8_SCHED __builtin_amdgcn_sched_barrier(0)
    Unit cur, nxt; int ui = 0;
    if (!S.next(0, cur)) return;
    f32x4 acc[2][2][4][2];
#pragma unroll
    for (int a = 0; a < 2; ++a)
#pragma unroll
        for (int b = 0; b < 2; ++b)
#pragma unroll
            for (int m = 0; m < 4; ++m)
#pragma unroll
                for (int n = 0; n < 2; ++n) acc[a][b][m][n] = (f32x4){0.f, 0.f, 0.f, 0.f};
    bf16x8 At[4][2], B0[2][2], B1[2][2];
    const char* cA = cur.a; const char* cB = cur.b;
    PG8_STAGE(PG8_SB(0, 0), cB, voffB); PG8_STAGE(PG8_SB(0, 1), cB + hstepB, voffB); PG8_STAGE(PG8_SA(0, 0), cA, voffA); PG8_STAGE(PG8_SA(0, 1), cA + hstepA, voffA);
    if (wr == 1) PG8_BAR;
    PG8_WAIT_V(2); PG8_BAR;
    PG8_STAGE(PG8_SB(1, 0), cB + kstepB, voffB); PG8_STAGE(PG8_SA(1, 0), cA + kstepA, voffA); PG8_STAGE(PG8_SB(1, 1), cB + hstepB + kstepB, voffB);
    PG8_WAIT_V(6); PG8_BAR;
    for (;;) {
        const bool has_next = S.next(ui + 1, nxt);
        const char* nA = has_next ? nxt.a : cA; const char* nB = has_next ? nxt.b : cB;
#pragma unroll 1
        for (int t = 0; t < nt; t += 2) {
            const bool last = (t == nt - 2);
            const char* a1 = cA + (size_t)(t + 1) * kstepA;
            const char* a2 = last ? nA : cA + (size_t)(t + 2) * kstepA; const char* b2 = last ? nB : cB + (size_t)(t + 2) * kstepB;
            const char* a3 = a2 + kstepA; const char* b3 = b2 + kstepB;
            PG8_LDB(B0, 0, 0); PG8_LDB(B1, 0, 1); PG8_SCHED; PG8_LDA(At, 0, 0); PG8_STAGE(PG8_SA(1, 1), a1 + hstepA, voffA);
            PG8_WAIT_V(8); PG8_WAIT_L(0); PG8_BAR; PG8_MMA(0, 0, At, B0); PG8_MMA(0, 1, At, B1); PG8_BAR; PG8_SCHED;
            PG8_LDA(At, 0, 1); PG8_STAGE(PG8_SB(0, 0), b2, voffB); PG8_STAGE(PG8_SB(0, 1), b2 + hstepB, voffB); PG8_STAGE(PG8_SA(0, 0), a2, voffA);
            PG8_WAIT_V(8); PG8_WAIT_L(0); PG8_BAR; PG8_MMA(1, 0, At, B0); PG8_MMA(1, 1, At, B1); PG8_BAR; PG8_SCHED;
            PG8_LDB(B0, 1, 0); PG8_LDB(B1, 1, 1); PG8_SCHED; PG8_LDA(At, 1, 0); PG8_STAGE(PG8_SA(0, 1), a2 + hstepA, voffA);
            PG8_WAIT_V(8); PG8_WAIT_L(0); PG8_BAR; PG8_MMA(0, 0, At, B0); PG8_MMA(0, 1, At, B1); PG8_BAR; PG8_SCHED;
            PG8_LDA(At, 1, 1); PG8_STAGE(PG8_SB(1, 0), b3, voffB); PG8_STAGE(PG8_SB(1, 1), b3 + hstepB, voffB); PG8_STAGE(PG8_SA(1, 0), a3, voffA);
            PG8_WAIT_V(8); PG8_WAIT_L(0); PG8_BAR; PG8_MMA(1, 0, At, B0); PG8_MMA(1, 1, At, B1); PG8_BAR; PG8_SCHED;
        }
        if (wr == 0) PG8_BAR;
        if constexpr (!Epi::AFTER_DRAIN) E(acc, cur, wr, wc, fr, fq);
        if (!has_next) break;
#pragma unroll
        for (int a = 0; a < 2; ++a)
#pragma unroll
            for (int b = 0; b < 2; ++b)
#pragma unroll
                for (int m = 0; m < 4; ++m)
#pragma unroll
                    for (int n = 0; n < 2; ++n) acc[a][b][m][n] = (f32x4){0.f, 0.f, 0.f, 0.f};
        cur = nxt; cA = nA; cB = nB; ++ui;
        if (wr == 1) PG8_BAR;
    }
    PG8_WAIT_V(0);
    PG8_BAR;
    if constexpr (Epi::AFTER_DRAIN) E.fused(acc, cur, wr, wc, fr, fq, lds);
#undef PG8_SA
#undef PG8_SB
#undef PG8_STAGE
#undef PG8_LDA
#undef PG8_LDB
#undef PG8_MMA
#undef PG8_WAIT_V
#undef PG8_WAIT_L
#undef PG8_BAR
#undef PG8_SCHED
}
struct EpiBf16 {
    static constexpr bool AFTER_DRAIN = false;
    bf16_t* O; int ldc;
    DEV void operator()(const f32x4 (&acc)[2][2][4][2], const Unit& u, int wr, int wc, int fr, int fq) const {
#pragma unroll
        for (int ai = 0; ai < 2; ++ai)
#pragma unroll
            for (int m = 0; m < 4; ++m) { bf16_t* rowp = O + (size_t)(u.pm * BM + ai * HALF + wr * 64 + m * 16 + fr) * ldc + u.pn * BM + wc * 32 + 4 * fq;
#pragma unroll
                for (int bj = 0; bj < 2; ++bj)
#pragma unroll
                    for (int n = 0; n < 2; ++n) { const f32x4 v = acc[ai][bj][m][n]; u32x2 w; w.x = pk2(v[0], v[1]); w.y = pk2(v[2], v[3]); *(u32x2*)(rowp + bj * HALF + n * 16) = w; } }
    }
};
struct EpiResF32 {
    static constexpr bool AFTER_DRAIN = false;
    const float* base; float* out; int ldc;
    DEV void operator()(const f32x4 (&acc)[2][2][4][2], const Unit& u, int wr, int wc, int fr, int fq) const {
#pragma unroll
        for (int ai = 0; ai < 2; ++ai) { f32x4 b[4][2][2];
#pragma unroll
            for (int m = 0; m < 4; ++m) { const size_t off = (size_t)(u.pm * BM + ai * HALF + wr * 64 + m * 16 + fr) * ldc + u.pn * BM + wc * 32 + 4 * fq;
#pragma unroll
                for (int bj = 0; bj < 2; ++bj)
#pragma unroll
                    for (int n = 0; n < 2; ++n) b[m][bj][n] = *(const f32x4*)(base + off + bj * HALF + n * 16); }
#pragma unroll
            for (int m = 0; m < 4; ++m) { const size_t off = (size_t)(u.pm * BM + ai * HALF + wr * 64 + m * 16 + fr) * ldc + u.pn * BM + wc * 32 + 4 * fq;
#pragma unroll
                for (int bj = 0; bj < 2; ++bj)
#pragma unroll
                    for (int n = 0; n < 2; ++n) *(f32x4*)(out + off + bj * HALF + n * 16) = b[m][bj][n] + acc[ai][bj][m][n]; } }
    }
};
struct EpiMoe1 {
    static constexpr bool AFTER_DRAIN = false;
    bf16_t* O; const float* b1; const float* sw; const float* sx;
    DEV void operator()(const f32x4 (&acc)[2][2][4][2], const Unit& u, int wr, int wc, int fr, int fq) const {
        const float* bb = b1 + (size_t)u.e * 2048; const float* ss = sw + (size_t)u.e * 2048 + u.pn * BM;
        f32x4 ba[2], bu[2], sa[2], su[2];
#pragma unroll
        for (int n = 0; n < 2; ++n) { const int c = wc * 32 + n * 16 + 4 * fq; ba[n] = *(const f32x4*)(bb + u.pn * HALF + c); bu[n] = *(const f32x4*)(bb + 1024 + u.pn * HALF + c); sa[n] = *(const f32x4*)(ss + c); su[n] = *(const f32x4*)(ss + HALF + c); }
        float srv[2][4];
#pragma unroll
        for (int ai = 0; ai < 2; ++ai)
#pragma unroll
            for (int m = 0; m < 4; ++m) srv[ai][m] = sx[u.pm * BM + ai * HALF + wr * 64 + m * 16 + fr];
#pragma unroll
        for (int ai = 0; ai < 2; ++ai)
#pragma unroll
            for (int m = 0; m < 4; ++m) { const int row = u.pm * BM + ai * HALF + wr * 64 + m * 16 + fr; const float sr = srv[ai][m]; bf16_t* rowp = O + (size_t)row * DFF + u.pn * HALF + wc * 32 + 4 * fq;
#pragma unroll
                for (int n = 0; n < 2; ++n) { const i32x4 ia = __builtin_bit_cast(i32x4, acc[ai][0][m][n]), iu = __builtin_bit_cast(i32x4, acc[ai][1][m][n]); float r[4];
#pragma unroll
                    for (int j = 0; j < 4; ++j) { const float a = fminf((float)ia[j] * (sr * sa[n][j]) + ba[n][j], 7.0f), up = fminf(fmaxf((float)iu[j] * (sr * su[n][j]) + bu[n][j], -7.0f), 7.0f);
                        const float glu = a * __builtin_amdgcn_rcpf(1.0f + __expf(-1.702f * a)); r[j] = (up + 1.0f) * glu; }
                    u32x2 w; w.x = pk2(r[0], r[1]); w.y = pk2(r[2], r[3]); *(u32x2*)(rowp + n * 16) = w; } }
    }
};
struct EpiMoe2 {
    static constexpr bool AFTER_DRAIN = false;
    bf16_t* O; const float* b2; const float* rowgate;
    DEV void operator()(const f32x4 (&acc)[2][2][4][2], const Unit& u, int wr, int wc, int fr, int fq) const {
        const float* bb = b2 + (size_t)u.e * 1024;
        float gtv[2][4]; f32x4 bvv[2][2];
#pragma unroll
        for (int ai = 0; ai < 2; ++ai)
#pragma unroll
            for (int m = 0; m < 4; ++m) gtv[ai][m] = rowgate[u.pm * BM + ai * HALF + wr * 64 + m * 16 + fr];
#pragma unroll
        for (int bj = 0; bj < 2; ++bj)
#pragma unroll
            for (int n = 0; n < 2; ++n) bvv[bj][n] = *(const f32x4*)(bb + u.pn * BM + bj * HALF + wc * 32 + n * 16 + 4 * fq);
#pragma unroll
        for (int ai = 0; ai < 2; ++ai)
#pragma unroll
            for (int m = 0; m < 4; ++m) { const int row = u.pm * BM + ai * HALF + wr * 64 + m * 16 + fr; const float gt = gtv[ai][m]; bf16_t* rowp = O + (size_t)row * DM + u.pn * BM + wc * 32 + 4 * fq;
#pragma unroll
                for (int bj = 0; bj < 2; ++bj)
#pragma unroll
                    for (int n = 0; n < 2; ++n) { const f32x4 v = (acc[ai][bj][m][n] + bvv[bj][n]) * gt;
                        u32x2 w; w.x = pk2(v[0], v[1]); w.y = pk2(v[2], v[3]); *(u32x2*)(rowp + bj * HALF + n * 16) = w; } }
    }
};
struct EpiQup {
    static constexpr bool AFTER_DRAIN = false;
    bf16_t* O; const float* ropem;
    DEV void operator()(const f32x4 (&acc)[2][2][4][2], const Unit& u, int wr, int wc, int fr, int fq) const {
        const bool rope0 = ((u.pn * 8 + wc) % 3) == 2, rope1 = ((u.pn * 8 + 4 + wc) % 3) == 2;
        f32x4 cs[2][4], sn[2][4];
        if (rope0 || rope1) {
#pragma unroll
            for (int ai = 0; ai < 2; ++ai)
#pragma unroll
                for (int m = 0; m < 4; ++m) { const int row = u.pm * BM + ai * HALF + wr * 64 + m * 16 + fr; cs[ai][m] = *(const f32x4*)(ropem + (size_t)row * 32 + 4 * fq); sn[ai][m] = *(const f32x4*)(ropem + (size_t)row * 32 + 16 + 4 * fq); } }
#pragma unroll
        for (int bj = 0; bj < 2; ++bj) { const int g32 = u.pn * 8 + bj * 4 + wc; const bool rope = bj ? rope1 : rope0;
#pragma unroll
            for (int ai = 0; ai < 2; ++ai)
#pragma unroll
                for (int m = 0; m < 4; ++m) { const int row = u.pm * BM + ai * HALF + wr * 64 + m * 16 + fr; bf16_t* rowp = O + (size_t)row * 768 + g32 * 32 + 4 * fq;
                    f32x4 v0 = acc[ai][bj][m][0], v1 = acc[ai][bj][m][1];
                    if (rope) { const f32x4 c = cs[ai][m], s_ = sn[ai][m]; const f32x4 x1 = v0, x2 = v1; v0 = x1 * c - x2 * s_; v1 = x2 * c + x1 * s_; }
                    v0 = v0 * MLA_QSCALE; v1 = v1 * MLA_QSCALE;
                    u32x2 w; w.x = pk2(v0[0], v0[1]); w.y = pk2(v0[2], v0[3]); *(u32x2*)(rowp) = w; w.x = pk2(v1[0], v1[1]); w.y = pk2(v1[2], v1[3]); *(u32x2*)(rowp + 16) = w; } }
    }
};
struct EpiKvup {
    static constexpr bool AFTER_DRAIN = false;
    bf16_t* KM; bf16_t* VM;
    DEV void operator()(const f32x4 (&acc)[2][2][4][2], const Unit& u, int wr, int wc, int fr, int fq) const {
#pragma unroll
        for (int bj = 0; bj < 2; ++bj) { const int head = u.pn * 2 + bj;
#pragma unroll
            for (int ai = 0; ai < 2; ++ai)
#pragma unroll
                for (int m = 0; m < 4; ++m) { const int row = u.pm * BM + ai * HALF + wr * 64 + m * 16 + fr;
                    bf16_t* rowp = (wc < 2) ? KM + (size_t)row * 768 + head * 96 + wc * 32 + 4 * fq : VM + (size_t)row * 512 + head * 64 + (wc - 2) * 32 + 4 * fq;
#pragma unroll
                    for (int n = 0; n < 2; ++n) { const f32x4 v = acc[ai][bj][m][n]; u32x2 w; w.x = pk2(v[0], v[1]); w.y = pk2(v[2], v[3]); *(u32x2*)(rowp + n * 16) = w; } } }
    }
};
struct EpiCmp {
    static constexpr bool AFTER_DRAIN = true;
    const float* cb; const float* w2; const int* pos; bf16_t* KC; bf16_t* VC;
    DEV void fused(const f32x4 (&acc)[2][2][4][2], const Unit& u, int wr, int wc, int fr, int fq, LAS unsigned char* lds) const {
        const int c = u.e, tid = opaque_tid();
        LAS bf16_t* Hs = (LAS bf16_t*)lds;
        LAS float* W2s = (LAS float*)(lds + 256 * 136 * 2);
        { const f32x4* src = (const f32x4*)(w2 + (size_t)c * 128 * 64) + tid;
#pragma unroll
          for (int i = 0; i < 4; ++i) *((LAS f32x4*)W2s + tid + i * 512) = src[i * 512]; }
        f32x4 bb[2];
#pragma unroll
        for (int n = 0; n < 2; ++n) { bb[n] = *(const f32x4*)(cb + c * 128 + wc * 32 + n * 16 + 4 * fq);
#pragma unroll
            for (int part = 1; part < 8; ++part) bb[n] += *(const f32x4*)(cb + part * 256 + c * 128 + wc * 32 + n * 16 + 4 * fq); }
#pragma unroll
        for (int ai = 0; ai < 2; ++ai)
#pragma unroll
            for (int m = 0; m < 4; ++m) { const int row = ai * HALF + wr * 64 + m * 16 + fr;
#pragma unroll
                for (int n = 0; n < 2; ++n) { const f32x4 v = acc[ai][0][m][n] + bb[n]; float r[4];
#pragma unroll
                    for (int j = 0; j < 4; ++j) r[j] = v[j] / (1.0f + __expf(-v[j]));
                    u32x2 w; w.x = pk2(r[0], r[1]); w.y = pk2(r[2], r[3]); *(LAS u32x2*)(Hs + row * 136 + wc * 32 + n * 16 + 4 * fq) = w; } }
        __syncthreads();
        const int row = tid >> 1, dh = tid & 1; float o[32];
#pragma unroll
        for (int d = 0; d < 32; ++d) o[d] = 0.f;
#pragma unroll 2
        for (int h = 0; h < 128; ++h) { const float hv = bf2f(Hs[row * 136 + h]); const LAS f32x4* wrow = (const LAS f32x4*)(W2s + h * 64 + dh * 32);
#pragma unroll
            for (int q = 0; q < 8; ++q) { const f32x4 w = wrow[q]; o[4 * q] += hv * w.x; o[4 * q + 1] += hv * w.y; o[4 * q + 2] += hv * w.z; o[4 * q + 3] += hv * w.w; } }
        const int r = u.pm * BM + row, b = r >> 9, n = (r >> 1) & 255;
        if (c == 0 && dh == 0 && n < 255) { const float fpos = (float)pos[b * SEQ + 16 * n + 31];
#pragma unroll
            for (int i = 0; i < 8; ++i) { const float invf = powf(500000.0f, -(float)(2 * i) / 16.0f); float cs, sn; sincosf(fpos * invf, &sn, &cs); const float x1 = o[i], x2 = o[8 + i]; o[i] = x1 * cs - x2 * sn; o[8 + i] = x2 * cs + x1 * sn; } }
        bf16_t* dst = (c == 0 ? KC : VC) + (size_t)r * 64 + dh * 32;
#pragma unroll
        for (int q = 0; q < 4; ++q) { u32x4 w;
            if (n < 255) { w.x = pk2(o[8 * q], o[8 * q + 1]); w.y = pk2(o[8 * q + 2], o[8 * q + 3]); w.z = pk2(o[8 * q + 4], o[8 * q + 5]); w.w = pk2(o[8 * q + 6], o[8 * q + 7]); } else w = (u32x4){0u, 0u, 0u, 0u};
            *(u32x4*)(dst + 8 * q) = w; }
        __syncthreads();
    }
};
struct UpOrder {
    DenseOrder q, kv; int G, c;
    DEV bool next(int i, Unit& u) const {
        const long L = (long)i * G + c;
        if (L < q.nwg) { DenseOrder t = q; t.G = 1; t.c = 0; t.next((int)L, u); u.e = 0; return true; }
        if (L < q.nwg + kv.nwg) { DenseOrder t = kv; t.G = 1; t.c = 0; t.next((int)(L - q.nwg), u); u.e = 1; return true; }
        return false;
    }
};
struct EpiUp {
    static constexpr bool AFTER_DRAIN = false;
    EpiQup eq; EpiKvup ekv;
    DEV void operator()(const f32x4 (&acc)[2][2][4][2], const Unit& u, int wr, int wc, int fr, int fq) const { if (u.e == 0) eq(acc, u, wr, wc, fr, fq); else ekv(acc, u, wr, wc, fr, fq); }
};
}

DEV void transpose_item(const float* W, int Ksrc, int Nsrc, int k0, int n0, bf16_t* WT, int ldk, int drow0, LAS float* scr, int lane) {
    { const int kr = lane >> 3, nc = 4 * (lane & 7); f32x4 v[8];
#pragma unroll
      for (int i = 0; i < 8; ++i) { const int k = k0 + 8 * i + kr; v[i] = (k < Ksrc && n0 + nc < Nsrc) ? *(const f32x4*)(W + (size_t)k * Nsrc + n0 + nc) : (f32x4){0.f, 0.f, 0.f, 0.f}; }
#pragma unroll
      for (int i = 0; i < 8; ++i) { LAS float* d = scr + (8 * i + kr) * 33 + nc; d[0] = v[i].x; d[1] = v[i].y; d[2] = v[i].z; d[3] = v[i].w; } }
    asm volatile("s_waitcnt lgkmcnt(0)" ::: "memory");
    const int c = lane & 7;
#pragma unroll
    for (int j = 0; j < 4; ++j) { const int n = (lane >> 3) + 8 * j; const LAS float* s = scr + (8 * c) * 33 + n;
        u32x4 o; o.x = pk2(s[0 * 33], s[1 * 33]); o.y = pk2(s[2 * 33], s[3 * 33]); o.z = pk2(s[4 * 33], s[5 * 33]); o.w = pk2(s[6 * 33], s[7 * 33]);
        *(u32x4*)(WT + (size_t)(drow0 + n) * ldk + k0 + 8 * c) = o; }
    asm volatile("s_waitcnt lgkmcnt(0)" ::: "memory");
}
DEV void rms_row_to_bf16(const float* xrow, const float* g, bf16_t* orow, int lane) {
    const f32x4* xr = (const f32x4*)xrow + lane; const f32x4* gr = (const f32x4*)g + lane;
    f32x4 v[4]; float s = 0.f;
#pragma unroll
    for (int j = 0; j < 4; ++j) { v[j] = xr[64 * j]; s += (v[j].x * v[j].x + v[j].y * v[j].y) + (v[j].z * v[j].z + v[j].w * v[j].w); }
    const float rstd = rsqrtf(wave_sum(s) * (1.f / 1024.f) + 1e-5f);
    u32x2* o8 = (u32x2*)orow + lane;
#pragma unroll
    for (int j = 0; j < 4; ++j) { const f32x4 gg = gr[64 * j]; u32x2 w; w.x = pk2(v[j].x * rstd * gg.x, v[j].y * rstd * gg.y); w.y = pk2(v[j].z * rstd * gg.z, v[j].w * rstd * gg.w); o8[64 * j] = w; }
}
DEV void w1_quant_item(const float* W, unsigned char* WQ, float* SW, int n0, int drow0, LAS unsigned char* lds, int tid) {
    LAS unsigned* qs = (LAS unsigned*)lds;
    LAS float* red = (LAS float*)(lds + 32 * 1040);
    const int kg = tid >> 3, c = tid & 7, wv = tid >> 6;
    f32x4 v[4][4];
#pragma unroll
    for (int i = 0; i < 4; ++i)
#pragma unroll
        for (int q = 0; q < 4; ++q) v[i][q] = *(const f32x4*)(W + (size_t)(4 * (64 * i + kg) + q) * 2048 + n0 + 4 * c);
    float mx[4] = {0.f, 0.f, 0.f, 0.f};
#pragma unroll
    for (int i = 0; i < 4; ++i)
#pragma unroll
        for (int q = 0; q < 4; ++q) { mx[0] = fmaxf(mx[0], fabsf(v[i][q].x)); mx[1] = fmaxf(mx[1], fabsf(v[i][q].y)); mx[2] = fmaxf(mx[2], fabsf(v[i][q].z)); mx[3] = fmaxf(mx[3], fabsf(v[i][q].w)); }
#pragma unroll
    for (int j = 0; j < 4; ++j) { mx[j] = fmaxf(mx[j], __shfl_xor(mx[j], 8)); mx[j] = fmaxf(mx[j], __shfl_xor(mx[j], 16)); mx[j] = fmaxf(mx[j], __shfl_xor(mx[j], 32)); }
    if ((tid & 63) < 8) *(LAS f32x4*)(red + wv * 32 + 4 * c) = (f32x4){mx[0], mx[1], mx[2], mx[3]};
    __syncthreads();
    float inv[4];
    { f32x4 m = *(const LAS f32x4*)(red + 4 * c);
#pragma unroll
      for (int w_ = 1; w_ < 8; ++w_) { const f32x4 o = *(const LAS f32x4*)(red + w_ * 32 + 4 * c); m.x = fmaxf(m.x, o.x); m.y = fmaxf(m.y, o.y); m.z = fmaxf(m.z, o.z); m.w = fmaxf(m.w, o.w); }
      m.x = fmaxf(m.x, 1e-30f); m.y = fmaxf(m.y, 1e-30f); m.z = fmaxf(m.z, 1e-30f); m.w = fmaxf(m.w, 1e-30f);
      inv[0] = 127.0f / m.x; inv[1] = 127.0f / m.y; inv[2] = 127.0f / m.z; inv[3] = 127.0f / m.w;
      if (tid < 8) *(f32x4*)(SW + drow0 + 4 * c) = m * (1.0f / 127.0f); }
#pragma unroll
    for (int i = 0; i < 4; ++i) {
#pragma unroll
        for (int j = 0; j < 4; ++j) { unsigned x = 0u;
#pragma unroll
            for (int q = 0; q < 4; ++q) { const int b = __float2int_rn(v[i][q][j] * inv[j]); x |= ((unsigned)b & 255u) << (8 * q); }
            qs[(4 * c + j) * 260 + 64 * i + kg] = x; } }
    __syncthreads();
#pragma unroll
    for (int t_ = 0; t_ < 4; ++t_) { const int id = tid + 512 * t_, n = id >> 6, ch = id & 63;
        *(u32x4*)(WQ + (size_t)(drow0 + n) * 1024 + ch * 16) = *(const LAS u32x4*)(lds + n * 1040 + ch * 16); }
    __syncthreads();
}
DEV void prep_w1_items(const Params& p, LAS unsigned char* lds) {
    const int tid = opaque_tid();
    unsigned* ctr = (unsigned*)(p.ws + OFF_CNT) + 40; LAS int* slot = (LAS int*)(lds + 40960);
    for (;;) {
        if (tid == 0) *slot = (int)__hip_atomic_fetch_add(ctr, 1u, __ATOMIC_RELAXED, __HIP_MEMORY_SCOPE_AGENT);
        __syncthreads();
        const int it = *slot;
        __syncthreads();
        if (it >= 32 * 64) break;
        const int e = it >> 6, nb = it & 63, n0 = nb * 32;
        const int bj = n0 >> 10, rr = n0 & 1023, drow = 256 * (rr >> 7) + 128 * bj + (rr & 127);
        w1_quant_item(p.moe_w1 + (size_t)e * 1024 * 2048, p.ws + OFF_W1T + (size_t)e * 2048 * 1024, (float*)(p.ws + OFF_SW1) + (size_t)e * 2048, n0, drow, lds, tid); }
}
DEV void prep_w2_items(const Params& p, LAS unsigned char* lds, int firstw, int stridew) {
    const int tid = opaque_tid(), wid = tid >> 6, lane = tid & 63;
    LAS float* scr = (LAS float*)(lds + wid * 16384); bf16_t* W2T = (bf16_t*)(p.ws + OFF_W2T);
    for (int r = firstw + wid; r < 32 * 16 * 32; r += stridew) { const int e = r / (16 * 32), q = r % (16 * 32), kb = q / 32, nb = q % 32;
        transpose_item(p.moe_w2 + (size_t)e * 1024 * 1024, 1024, 1024, kb * 64, nb * 32, W2T + (size_t)e * 1024 * 1024, 1024, nb * 32, scr, lane); }
}
DEV void phase0(const Params& p, LAS unsigned char* lds) {
    const int tid = opaque_tid(), wid = tid >> 6, lane = tid & 63;
    LAS float* scr = (LAS float*)(lds + wid * 16384);
    const int gw = blockIdx.x * 8 + wid, NGW = gridDim.x * 8;
    bf16_t* WINT = (bf16_t*)(p.ws + OFF_WINT);
    bf16_t* WQUPT = (bf16_t*)(p.ws + OFF_WQUPT); bf16_t* WKVUPT = (bf16_t*)(p.ws + OFF_WKVUPT); bf16_t* WOUTT = (bf16_t*)(p.ws + OFF_WOUTT);
    constexpr int I_IN = 16 * 56, I_QUP = 4 * 24, I_KVUP = 4 * 32, I_OUT = 16 * 32, I_CW1 = 2 * 32 * 8, I_ROWS = NTOK;
    constexpr int NITEMS = I_IN + I_QUP + I_KVUP + I_OUT + I_CW1;
    for (int it = gw; it < NITEMS; it += NGW) {
        int r = it;
        if (r < I_IN) { const int kb = r / 56, nb = r % 56; transpose_item(p.w_in, 1024, INC, kb * 64, nb * 32, WINT, 1024, nb * 32, scr, lane); continue; } r -= I_IN;
        if (r < I_QUP) { const int kb = r / 24, nb = r % 24; transpose_item(p.w_q_up, 256, 768, kb * 64, nb * 32, WQUPT, 256, nb * 32, scr, lane); continue; } r -= I_QUP;
        if (r < I_KVUP) { const int kb = r / 32, nb = r % 32; transpose_item(p.w_kv_up, 128, 1024, kb * 64, nb * 32, WKVUPT, 256, nb * 32, scr, lane); continue; } r -= I_KVUP;
        if (r < I_OUT) { const int kb = r / 32, nb = r % 32; transpose_item(p.w_out, 1024, 1024, kb * 64, nb * 32, WOUTT, 1024, nb * 32, scr, lane); continue; } r -= I_OUT;
        if (r < I_CW1) { const int c = r / 256, q = r % 256, kb = q / 8, nb = q % 8; transpose_item(p.cmp_w1 + (size_t)c * 2048 * 128, 2048, 128, kb * 64, nb * 32, (bf16_t*)(p.ws + OFF_CW1T) + (size_t)c * 256 * 2048, 2048, nb * 32, scr, lane); continue; } r -= I_CW1;
        break;
    }
    { const f32x4* gr = (const f32x4*)p.attn_norm + lane; f32x4 gg[4];
#pragma unroll
      for (int j = 0; j < 4; ++j) gg[j] = gr[64 * j];
      for (int r0 = gw * 4; r0 < NTOK; r0 += NGW * 4) { f32x4 v[4][4];
#pragma unroll
          for (int q = 0; q < 4; ++q) { const f32x4* xr = (const f32x4*)(p.x + (size_t)(r0 + q) * DM) + lane;
#pragma unroll
              for (int j = 0; j < 4; ++j) v[q][j] = xr[64 * j]; }
#pragma unroll
          for (int q = 0; q < 4; ++q) { float s_ = 0.f;
#pragma unroll
              for (int j = 0; j < 4; ++j) s_ += (v[q][j].x * v[q][j].x + v[q][j].y * v[q][j].y) + (v[q][j].z * v[q][j].z + v[q][j].w * v[q][j].w);
              const float rstd = rsqrtf(wave_sum(s_) * (1.f / 1024.f) + 1e-5f); u32x2* o8 = (u32x2*)((bf16_t*)(p.ws + OFF_U) + (size_t)(r0 + q) * DM) + lane;
#pragma unroll
              for (int j = 0; j < 4; ++j) { u32x2 w; w.x = pk2(v[q][j].x * rstd * gg[j].x, v[q][j].y * rstd * gg[j].y); w.y = pk2(v[q][j].z * rstd * gg[j].z, v[q][j].w * rstd * gg[j].w); o8[64 * j] = w; } } } }
    float* cb = (float*)(p.ws + OFF_CB);
    for (int o8 = gw; o8 < 2048; o8 += NGW) { const int o = o8 & 255, part = o8 >> 8, c = o >> 7, h = o & 127; float s = 0.f;
#pragma unroll
        for (int q = 0; q < 4; ++q) { const int i = part * 256 + q * 64 + lane; s += p.cmp_pos[c * 2048 + i] * p.cmp_w1[((size_t)c * 2048 + i) * 128 + h]; }
        s = wave_sum(s); if (lane == 0) cb[part * 256 + o] = s; }
    if (blockIdx.x == 0 && tid < 64) ((unsigned*)(p.ws + OFF_CNT))[tid] = 0u;
}

struct P2In { u32x2 wq; unsigned wkv; unsigned kp; u32x4 wqn; u32x4 wk; u32x4 wc4; unsigned gt; int pos; };
DEV void phase2(const Params& p) {
    const int tid = opaque_tid(), wid = tid >> 6, lane = tid & 63;
    const int gw = blockIdx.x * 8 + wid, NGW = gridDim.x * 8;
    const bf16_t* PROJ = (const bf16_t*)(p.ws + OFF_PROJ);
    bf16_t* QN = (bf16_t*)(p.ws + OFF_QN); bf16_t* KVN = (bf16_t*)(p.ws + OFF_KVN); bf16_t* KM = (bf16_t*)(p.ws + OFF_KM); float* ROPEM = (float*)(p.ws + OFF_ROPEM); bf16_t* NQ = (bf16_t*)(p.ws + OFF_NQ);
    bf16_t* KSR = (bf16_t*)(p.ws + OFF_KSR); bf16_t* KWR = (bf16_t*)(p.ws + OFF_KWR); float* GATES = (float*)(p.ws + OFF_GATES);
    const float invf_m = powf(500000.0f, -(float)(2 * (lane & 15)) / 32.0f);
    const float invf_n = powf(500000.0f, -(float)(2 * (lane & 7)) / 16.0f);
    const f32x4 gq = *(const f32x4*)(p.q_norm + lane * 4); const f32x2 gkv = *(const f32x2*)(p.kv_norm + lane * 2);
    const int l16 = lane & 15, sub = lane & 7, d32 = lane & 31; const int cbase = (lane < 16) ? C_KS : C_KW;
    const int grp4 = lane >> 4; const int ccol4 = (grp4 == 0) ? C_KC : (grp4 == 1) ? C_VC : (grp4 == 2) ? C_VS : C_VW;
    bf16_t* cdst4 = (bf16_t*)(p.ws + (grp4 == 0 ? OFF_KCC : grp4 == 1 ? OFF_VCC : grp4 == 2 ? OFF_VSC : OFF_VWC));
    auto load = [&](int tok) -> P2In { const bf16_t* row = PROJ + (size_t)tok * INP; P2In in;
        in.wq = *(const u32x2*)(row + C_QLAT + lane * 4); in.wkv = *(const unsigned*)(row + C_KVLAT + lane * 2);
        in.kp = (unsigned)row[C_KPE + d32] | ((unsigned)row[C_KPE + (d32 ^ 16)] << 16);
        in.wqn = *(const u32x4*)(row + C_QNSA + lane * 8); in.wk = *(const u32x4*)(row + cbase + l16 * 8); in.wc4 = *(const u32x4*)(row + ccol4 + l16 * 8);
        in.gt = row[C_G + (lane < 24 ? lane : 23)]; in.pos = p.pos[tok]; return in; };
    P2In cur = load(gw < NTOK ? gw : 0);
#pragma unroll 1
    for (int tok = gw; tok < NTOK; tok += NGW) {
        const P2In nxt = load(tok + NGW < NTOK ? tok + NGW : tok);
        const float fpos = (float)cur.pos;
        float cm, sm, cn, sn; __sincosf(fpos * invf_m, &sm, &cm); __sincosf(fpos * invf_n, &sn, &cn);
        { const u32x2 w = cur.wq; const float a = bflo(w.x), b = bfhi(w.x), c = bflo(w.y), d = bfhi(w.y);
          const float rstd = rsqrtf(wave_sum(a * a + b * b + c * c + d * d) * (1.f / 256.f) + 1e-5f);
          u32x2 o; o.x = pk2(a * rstd * gq.x, b * rstd * gq.y); o.y = pk2(c * rstd * gq.z, d * rstd * gq.w); *(u32x2*)(QN + (size_t)tok * 256 + lane * 4) = o; }
        { const unsigned w = cur.wkv; const float a = bflo(w), b = bfhi(w);
          const float rstd = rsqrtf(wave_sum(a * a + b * b) * (1.f / 128.f) + 1e-5f);
          *(unsigned*)(KVN + (size_t)tok * 256 + lane * 2) = pk2(a * rstd * gkv.x, b * rstd * gkv.y); *(unsigned*)(KVN + (size_t)tok * 256 + 128 + lane * 2) = 0u; }
        { const float xs_ = bflo(cur.kp), xo = bfhi(cur.kp); const float val = (d32 < 16) ? xs_ * cm - xo * sm : xs_ * cm + xo * sm;
          const int hh = lane >> 3, part = lane & 7; const float a0 = __shfl(val, 4 * part), a1 = __shfl(val, 4 * part + 1), a2 = __shfl(val, 4 * part + 2), a3 = __shfl(val, 4 * part + 3);
          u32x2 w; w.x = pk2(a0, a1); w.y = pk2(a2, a3); *(u32x2*)(KM + (size_t)tok * 768 + hh * 96 + 64 + 4 * part) = w;
          if (lane < 16) { ROPEM[(size_t)tok * 32 + lane] = cm; ROPEM[(size_t)tok * 32 + 16 + lane] = sm; } }
        { const u32x4 w = cur.wqn; float v[8] = {bflo(w.x), bfhi(w.x), bflo(w.y), bfhi(w.y), bflo(w.z), bfhi(w.z), bflo(w.w), bfhi(w.w)};
#pragma unroll
          for (int i = 0; i < 8; ++i) { const float other = __shfl_xor(v[i], 1); const float c = __shfl(cn, i), s = __shfl(sn, i);
              if (sub == 0) v[i] = v[i] * c - other * s; else if (sub == 1) v[i] = v[i] * c + other * s; }
          u32x4 o; o.x = pk2(v[0] * NSA_QSCALE, v[1] * NSA_QSCALE); o.y = pk2(v[2] * NSA_QSCALE, v[3] * NSA_QSCALE); o.z = pk2(v[4] * NSA_QSCALE, v[5] * NSA_QSCALE); o.w = pk2(v[6] * NSA_QSCALE, v[7] * NSA_QSCALE);
          *(u32x4*)(NQ + (size_t)tok * 512 + lane * 8) = o; }
        { const u32x4 w = cur.wk;
          float v[8] = {bflo(w.x), bfhi(w.x), bflo(w.y), bfhi(w.y), bflo(w.z), bfhi(w.z), bflo(w.w), bfhi(w.w)};
#pragma unroll
          for (int i = 0; i < 8; ++i) { const float other = __shfl_xor(v[i], 1); const float c = __shfl(cn, i), s = __shfl(sn, i);
              if (sub == 0) v[i] = v[i] * c - other * s; else if (sub == 1) v[i] = v[i] * c + other * s; }
          if (lane < 32) { u32x4 o; o.x = pk2(v[0], v[1]); o.y = pk2(v[2], v[3]); o.z = pk2(v[4], v[5]); o.w = pk2(v[6], v[7]);
              *(u32x4*)(((lane < 16) ? KSR : KWR) + (size_t)tok * 128 + l16 * 8) = o; } }
        *(u32x4*)(cdst4 + (size_t)tok * 128 + l16 * 8) = cur.wc4;
        if (lane < 24) GATES[(size_t)tok * 24 + lane] = __builtin_amdgcn_rcpf(1.0f + __expf(-bflo(cur.gt)));
        cur = nxt;
    }
}

DEV void phase4(const Params& p, LAS unsigned char* lds) {
    const int tid = opaque_tid();
    if (blockIdx.x < BATCH * 2 && tid < 128) { const int bb = blockIdx.x >> 1, c_ = blockIdx.x & 1; ((bf16_t*)(p.ws + (c_ == 0 ? OFF_KC : OFF_VC)))[((size_t)(bb * NCMPP + 255) * 2) * 64 + tid] = 0; }
    const bf16_t* PROJ = (const bf16_t*)(p.ws + OFF_PROJ); const float* cb = (const float*)(p.ws + OFF_CB);
    LAS float* hid = (LAS float*)lds;
    const int sub = tid >> 7, h = tid & 127;
    constexpr int NU = 2 * BATCH * NCMP * 2;
    for (int u0 = blockIdx.x * 4; u0 < NU; u0 += gridDim.x * 4) {
        const int u = u0 + sub; const bool act = u < NU;
        int c = 0, b = 0, n = 0, g = 0;
        if (act) { c = u / (BATCH * NCMP * 2); int r = u % (BATCH * NCMP * 2); b = r / (NCMP * 2); r %= (NCMP * 2); n = r >> 1; g = r & 1; }
        float acc = 0.f;
        if (act) {
            const bf16_t* src = PROJ + (size_t)(b * SEQ + n * 16) * INP + (c == 0 ? C_KC : C_VC) + g * 64;
            const float* w1 = p.cmp_w1 + (size_t)c * 2048 * 128 + h;
            for (int l = 0; l < 32; ++l) { const bf16_t* sr = src + (size_t)l * INP;
#pragma unroll 8
                for (int d = 0; d < 64; d += 2) { const unsigned w = *(const unsigned*)(sr + d); acc += bflo(w) * w1[(size_t)(l * 64 + d) * 128] + bfhi(w) * w1[(size_t)(l * 64 + d + 1) * 128]; } }
            acc += cb[c * 128 + h];
            acc = acc / (1.0f + __expf(-acc));
        }
        hid[sub * 128 + h] = acc;
        __syncthreads();
        if (act && h < 64) {
            const float* w2 = p.cmp_w2 + (size_t)c * 128 * 64 + h; float o = 0.f;
            for (int k = 0; k < 128; ++k) o += hid[sub * 128 + k] * w2[k * 64];
            LAS float* ob = (LAS float*)(lds + 4096) + sub * 64; ob[h] = o;
            asm volatile("s_waitcnt lgkmcnt(0)" ::: "memory");
            if (c == 0 && h < 16) { const int i = h & 7; const float fpos = (float)p.pos[b * SEQ + 16 * n + 31]; const float invf = powf(500000.0f, -(float)(2 * i) / 16.0f);
                float cs, sn; sincosf(fpos * invf, &sn, &cs); const float x1 = ob[i], x2 = ob[8 + i]; o = (h < 8) ? (x1 * cs - x2 * sn) : (x2 * cs + x1 * sn); }
            ((bf16_t*)(p.ws + (c == 0 ? OFF_KC : OFF_VC)))[((size_t)(b * NCMPP + n) * 2 + g) * 64 + h] = f2bf(o);
        }
        __syncthreads();
    }
}

template <int DQK, int DV, class KF, class VF, class MF>
DEV void naive_attn_range(const float (&q)[DQK], float (&o)[DV], float& m, float& l, int jlo, int jhi, KF kf, VF vf, MF valid) {
#pragma unroll 1
    for (int j0 = jlo; j0 < jhi; j0 += 2) {
        const int ja = __builtin_amdgcn_readfirstlane(j0), jb = __builtin_amdgcn_readfirstlane((j0 + 1 < jhi) ? j0 + 1 : j0);
        float s0 = 0.f, s1 = 0.f;
#pragma unroll
        for (int i = 0; i < DQK / 2; ++i) { const unsigned w = kf(ja, i); s0 += q[2 * i] * bflo(w); s0 += q[2 * i + 1] * bfhi(w); }
#pragma unroll
        for (int i = 0; i < DQK / 2; ++i) { const unsigned w = kf(jb, i); s1 += q[2 * i] * bflo(w); s1 += q[2 * i + 1] * bfhi(w); }
        if (!valid(ja)) s0 = -INFINITY;
        if (!(j0 + 1 < jhi && valid(jb))) s1 = -INFINITY;
        const float mn = fmaxf(m, fmaxf(s0, s1));
        const bool live = mn != -INFINITY;
        const float alpha = live ? fast_exp2(m - mn) : 1.f, p0 = live ? fast_exp2(s0 - mn) : 0.f, p1 = live ? fast_exp2(s1 - mn) : 0.f;
        l = l * alpha + p0 + p1; m = mn;
#pragma unroll
        for (int i = 0; i < DV / 2; ++i) { const unsigned w0 = vf(ja, i), w1 = vf(jb, i);
            o[2 * i] = o[2 * i] * alpha + p0 * bflo(w0) + p1 * bflo(w1); o[2 * i + 1] = o[2 * i + 1] * alpha + p0 * bfhi(w0) + p1 * bfhi(w1); }
    }
}

DEV void phase3b(const Params& p) {
    const bf16_t* QUP = (const bf16_t*)(p.ws + OFF_QUP); const bf16_t* KVUP = (const bf16_t*)(p.ws + OFF_KVUP); const bf16_t* KPE = (const bf16_t*)(p.ws + OFF_KPE);
    bf16_t* QM = (bf16_t*)(p.ws + OFF_QM); bf16_t* KM = (bf16_t*)(p.ws + OFF_KM);
    for (int id = blockIdx.x * 512 + opaque_tid(); id < NTOK * 8; id += gridDim.x * 512) {
        const int tok = id >> 3, h = id & 7;
        const u32x4* qs = (const u32x4*)(QUP + (size_t)tok * 768 + h * 96); u32x4* qd = (u32x4*)(QM + (size_t)tok * 768 + h * 96);
        const u32x4* ks = (const u32x4*)(KVUP + (size_t)tok * 1024 + h * 128); u32x4* kd = (u32x4*)(KM + (size_t)tok * 768 + h * 96);
#pragma unroll 1
        for (int c = 0; c < 8; ++c) { const u32x4 w = qs[c]; u32x4 o;
            o.x = pk2(bflo(w.x) * MLA_QSCALE, bfhi(w.x) * MLA_QSCALE); o.y = pk2(bflo(w.y) * MLA_QSCALE, bfhi(w.y) * MLA_QSCALE);
            o.z = pk2(bflo(w.z) * MLA_QSCALE, bfhi(w.z) * MLA_QSCALE); o.w = pk2(bflo(w.w) * MLA_QSCALE, bfhi(w.w) * MLA_QSCALE); qd[c] = o; kd[c] = ks[c]; }
        const u32x4* pe = (const u32x4*)(KPE + (size_t)tok * 32);
#pragma unroll 1
        for (int c = 0; c < 4; ++c) kd[8 + c] = pe[c];
        const float fpos = (float)p.pos[tok]; const bf16_t* qr = QUP + (size_t)tok * 768 + h * 96 + 64; bf16_t* qo = QM + (size_t)tok * 768 + h * 96 + 64;
#pragma unroll 1
        for (int i = 0; i < 16; ++i) { const float invf = powf(500000.0f, -(float)(2 * i) / 32.0f); float c, sn; sincosf(fpos * invf, &sn, &c);
            const float x1 = bf2f(qr[i]), x2 = bf2f(qr[16 + i]); qo[i] = f2bf((x1 * c - x2 * sn) * MLA_QSCALE); qo[16 + i] = f2bf((x2 * c + x1 * sn) * MLA_QSCALE); }
    }
}

DEV void phase5_mla(const Params& p) {
    const int tid = opaque_tid(), wid = __builtin_amdgcn_readfirstlane(tid >> 6), lane = tid & 63;
    const int gw = blockIdx.x * 8 + wid, NGW = gridDim.x * 8;
    const bf16_t* QM = (const bf16_t*)(p.ws + OFF_QM); const bf16_t* KM = (const bf16_t*)(p.ws + OFF_KM); const bf16_t* KVUP = (const bf16_t*)(p.ws + OFF_KVUP);
    bf16_t* OCAT = (bf16_t*)(p.ws + OFF_OCAT);
    constexpr int NUNIT = BATCH * 8 * (SEQ / 64);
#pragma unroll 1
    for (int uu = gw; uu < NUNIT; uu += NGW) {
        const int u = (uu & 1) ? (NUNIT - 1 - (uu >> 1)) : (uu >> 1);
        const int tb = u % (SEQ / 64), h = (u / (SEQ / 64)) & 7, b = u / (SEQ / 64 * 8);
        const int t = tb * 64 + lane; const size_t tok = (size_t)b * SEQ + t;
        unsigned qp[48];
        { const bf16_t* qr = QM + tok * 768 + h * 96;
#pragma unroll
          for (int i = 0; i < 48; ++i) qp[i] = *(const unsigned*)(qr + 2 * i); }
        float o[64];
#pragma unroll
        for (int d = 0; d < 64; ++d) o[d] = 0.f;
        float m = -INFINITY, l = 0.f;
        const bf16_t* kb = KM + (size_t)b * SEQ * 768 + h * 96; const bf16_t* vb = KVUP + (size_t)b * SEQ * 1024 + h * 128 + 64;
        const int jhi = tb * 64 + 64;
#pragma unroll 1
        for (int j0 = 0; j0 < jhi; ++j0) {
            const int j = __builtin_amdgcn_readfirstlane(j0);
            const unsigned* kr = (const unsigned*)(kb + (size_t)j * 768); const unsigned* vr = (const unsigned*)(vb + (size_t)j * 1024);
            float s0 = 0.f;
#pragma unroll
            for (int i = 0; i < 48; ++i) { const unsigned w = kr[i]; s0 += bflo(qp[i]) * bflo(w); s0 += bfhi(qp[i]) * bfhi(w); }
            if (j > t) s0 = -INFINITY;
            const float mn = fmaxf(m, s0);
            const float alpha = fast_exp2(m - mn), p0 = fast_exp2(s0 - mn);
            l = l * alpha + p0; m = mn;
#pragma unroll
            for (int i = 0; i < 32; ++i) { const unsigned w0 = vr[i]; o[2 * i] = o[2 * i] * alpha + p0 * bflo(w0); o[2 * i + 1] = o[2 * i + 1] * alpha + p0 * bfhi(w0); }
        }
        const float rl = 1.0f / l;
        bf16_t* orow = OCAT + tok * 1024 + h * 64;
#pragma unroll
        for (int i = 0; i < 32; ++i) *(unsigned*)(orow + 2 * i) = pk2(o[2 * i] * rl, o[2 * i + 1] * rl);
    }
}

namespace fa {
typedef float f32x16 __attribute__((ext_vector_type(16)));
typedef short s16x4 __attribute__((ext_vector_type(4)));
constexpr int KSLOT = 12288, VSLOT = 8192;
constexpr int L_K = 0, L_V = 2 * KSLOT, L_WSF = L_V + 3 * VSLOT, L_OST = L_WSF + 8 * 512, L_MASK = L_OST + 8 * 4096, L_SEQ = L_MASK + 512, L_VAL = L_MASK + 1024, L_IMPH = L_VAL + 0;
constexpr int L_END = L_IMPH + 65536;
#define FA_MFMA(a, b, c) __builtin_amdgcn_mfma_f32_32x32x16_bf16(a, b, c, 0, 0, 0)
DEV int crow(int r, int hi) { return (r & 3) + 8 * (r >> 2) + 4 * hi; }
DEV s16x4 vtr(const LAS unsigned char* p) { return __builtin_bit_cast(s16x4, __builtin_amdgcn_ds_read_tr16_b64_v4i16((LAS s16x4*)p)); }
DEV float xhalf_max(float m) { auto rr = __builtin_amdgcn_permlane32_swap(__float_as_uint(m), __float_as_uint(m), false, false); return fmaxf(__uint_as_float(rr[0]), __uint_as_float(rr[1])); }
DEV float xhalf_sum(float m) { auto rr = __builtin_amdgcn_permlane32_swap(__float_as_uint(m), __float_as_uint(m), false, false); return __uint_as_float(rr[0]) + __uint_as_float(rr[1]); }

template <int NCH> struct KVRegs { u32x4 k0, k1, v; };
template <int NCH> DEV void stage_load(KVRegs<NCH>& r, const bf16_t* Kb, int kpitch, const bf16_t* Vb, int vpitch, int key0, int wid, int lane) {
    r.k0 = *(const u32x4*)(Kb + (size_t)(key0 + lane) * kpitch + wid * 8);
    if (NCH > 8 && wid < NCH - 8) r.k1 = *(const u32x4*)(Kb + (size_t)(key0 + lane) * kpitch + (8 + wid) * 8);
    r.v = *(const u32x4*)(Vb + (size_t)(key0 + 16 * (wid & 3) + (lane >> 2)) * vpitch + (wid >> 2) * 32 + (lane & 3) * 8);
}
template <int NCH> DEV void stage_write(const KVRegs<NCH>& r, LAS unsigned char* lds, int buf, int wid, int lane) {
    *(LAS u32x4*)(lds + L_K + buf * KSLOT + wid * 1024 + lane * 16) = r.k0;
    if (NCH > 8 && wid < NCH - 8) *(LAS u32x4*)(lds + L_K + buf * KSLOT + (8 + wid) * 1024 + lane * 16) = r.k1;
    *(LAS u32x4*)(lds + L_V + buf * VSLOT + wid * 1024 + lane * 16) = r.v;
}
template <int ND0> DEV void qk_tile(const LAS unsigned char* kbuf, int kp0, const bf16x8 (&qr)[ND0], f32x16& p0, f32x16& p1) {
#pragma unroll
    for (int r = 0; r < 16; ++r) { p0[r] = 0.f; p1[r] = 0.f; }
#pragma unroll
    for (int d0 = 0; d0 < ND0; ++d0) { const bf16x8 k0 = *(const LAS bf16x8*)(kbuf + kp0 + d0 * 2048), k1 = *(const LAS bf16x8*)(kbuf + kp0 + d0 * 2048 + 512);
        p0 = FA_MFMA(k0, qr[d0], p0); p1 = FA_MFMA(k1, qr[d0], p1); }
}
DEV float rowmax32(const f32x16& p0, const f32x16& p1) {
    float a = fmaxf(p0[0], p1[0]);
#pragma unroll
    for (int r = 1; r < 16; ++r) a = fmaxf(a, fmaxf(p0[r], p1[r]));
    return xhalf_max(a);
}
struct SmState { float mhat, l; f32x16 o[2]; };
DEV void sm_init(SmState& st) { st.mhat = -1e30f; st.l = 0.f;
#pragma unroll
    for (int r = 0; r < 16; ++r) { st.o[0][r] = 0.f; st.o[1][r] = 0.f; } }
DEV void sm_pv_tile(SmState& st, f32x16& p0, f32x16& p1, const LAS unsigned char* vbuf, int vp0, LAS float* wsf, int r32, int hi) {
    const float rm = rowmax32(p0, p1);
    const float newm = fmaxf(st.mhat, rm);
    if (__any(newm - st.mhat > 8.0f)) {
        const float f = fast_exp2(st.mhat - newm); st.mhat = newm; st.l *= f;
        if (hi == 0) wsf[r32] = f;
        asm volatile("s_waitcnt lgkmcnt(0)" ::: "memory");
#pragma unroll
        for (int r = 0; r < 16; ++r) { const float fr = wsf[crow(r, hi)]; st.o[0][r] *= fr; st.o[1][r] *= fr; }
        asm volatile("s_waitcnt lgkmcnt(0)" ::: "memory");
    }
    const float nm = -st.mhat; float sacc = 0.f;
#pragma unroll
    for (int r = 0; r < 16; ++r) { p0[r] = fast_exp2(p0[r] + nm); p1[r] = fast_exp2(p1[r] + nm); sacc += p0[r] + p1[r]; }
    st.l += sacc;
    u32x4 pw[4];
#pragma unroll
    for (int k = 0; k < 2; ++k) { pw[k] = (u32x4){pk2(p0[8 * k], p0[8 * k + 1]), pk2(p0[8 * k + 2], p0[8 * k + 3]), pk2(p0[8 * k + 4], p0[8 * k + 5]), pk2(p0[8 * k + 6], p0[8 * k + 7])};
        pw[2 + k] = (u32x4){pk2(p1[8 * k], p1[8 * k + 1]), pk2(p1[8 * k + 2], p1[8 * k + 3]), pk2(p1[8 * k + 4], p1[8 * k + 5]), pk2(p1[8 * k + 6], p1[8 * k + 7])}; }
#pragma unroll
    for (int dh = 0; dh < 2; ++dh)
#pragma unroll
        for (int ks = 0; ks < 4; ++ks) { const s16x4 lo = vtr(vbuf + vp0 + dh * 4096 + ks * 1024), hi4 = vtr(vbuf + vp0 + dh * 4096 + ks * 1024 + 512);
            const bf16x8 vf = (bf16x8){lo[0], lo[1], lo[2], lo[3], hi4[0], hi4[1], hi4[2], hi4[3]};
            st.o[dh] = FA_MFMA(__builtin_bit_cast(bf16x8, pw[ks]), vf, st.o[dh]); }
}
#define FA_MX3(a, b, c) __builtin_fmaxf(__builtin_fmaxf((a), (b)), (c))
template <int ND0> DEV void qk_tile_rel(const LAS unsigned char* kbuf, int kp0, const bf16x8 (&qr)[ND0], const f32x16& mC, f32x16& p0, f32x16& p1) {
    p0 = mC; p1 = mC;
#pragma unroll
    for (int d0 = 0; d0 < ND0; ++d0) { const bf16x8 k0 = *(const LAS bf16x8*)(kbuf + kp0 + d0 * 2048), k1 = *(const LAS bf16x8*)(kbuf + kp0 + d0 * 2048 + 512);
        p0 = FA_MFMA(k0, qr[d0], p0); p1 = FA_MFMA(k1, qr[d0], p1); }
}
DEV void sm_decide(SmState& st, f32x16& mC, f32x16& p0, f32x16& p1, bool firsttile, LAS float* wsf, int r32, int hi) {
    float a = FA_MX3(p0[0], p1[0], p0[1]), b = FA_MX3(p1[1], p0[2], p1[2]);
#pragma unroll
    for (int r = 3; r < 15; r += 2) { a = FA_MX3(a, p0[r], p1[r]); b = FA_MX3(b, p0[r + 1], p1[r + 1]); }
    a = FA_MX3(a, p0[15], p1[15]);
    const float rm = xhalf_max(fmaxf(a, b));
    if (firsttile) { const float m0 = (rm > -1e30f) ? rm : 0.f; st.mhat = m0;
#pragma unroll
        for (int r = 0; r < 16; ++r) { p0[r] -= m0; p1[r] -= m0; mC[r] = -m0; }
    } else if (__any(rm > 8.0f)) {
        const float dl = fmaxf(rm, 0.f); const float f = fast_exp2(-dl); st.mhat += dl; st.l *= f;
        if (hi == 0) wsf[r32] = f;
        asm volatile("s_waitcnt lgkmcnt(0)" ::: "memory");
#pragma unroll
        for (int r = 0; r < 16; ++r) { const float fr = wsf[crow(r, hi)]; st.o[0][r] *= fr; st.o[1][r] *= fr; p0[r] -= dl; p1[r] -= dl; mC[r] = -st.mhat; }
        asm volatile("s_waitcnt lgkmcnt(0)" ::: "memory");
    }
}
DEV void sm_exp_pv(SmState& st, f32x16& p0, f32x16& p1, const LAS unsigned char* vbuf, int vp0) {
    float s0 = 0.f, s1 = 0.f;
#pragma unroll
    for (int r = 0; r < 16; ++r) { p0[r] = fast_exp2(p0[r]); p1[r] = fast_exp2(p1[r]); s0 += p0[r]; s1 += p1[r]; }
    st.l += s0 + s1;
    u32x4 pw[4];
#pragma unroll
    for (int k = 0; k < 2; ++k) { pw[k] = (u32x4){pk2(p0[8 * k], p0[8 * k + 1]), pk2(p0[8 * k + 2], p0[8 * k + 3]), pk2(p0[8 * k + 4], p0[8 * k + 5]), pk2(p0[8 * k + 6], p0[8 * k + 7])};
        pw[2 + k] = (u32x4){pk2(p1[8 * k], p1[8 * k + 1]), pk2(p1[8 * k + 2], p1[8 * k + 3]), pk2(p1[8 * k + 4], p1[8 * k + 5]), pk2(p1[8 * k + 6], p1[8 * k + 7])}; }
#pragma unroll
    for (int dh = 0; dh < 2; ++dh)
#pragma unroll
        for (int ks = 0; ks < 4; ++ks) { const s16x4 lo = vtr(vbuf + vp0 + dh * 4096 + ks * 1024), hi4 = vtr(vbuf + vp0 + dh * 4096 + ks * 1024 + 512);
            const bf16x8 vf = (bf16x8){lo[0], lo[1], lo[2], lo[3], hi4[0], hi4[1], hi4[2], hi4[3]};
            st.o[dh] = FA_MFMA(__builtin_bit_cast(bf16x8, pw[ks]), vf, st.o[dh]); }
}
DEV void row_to_olayout(float fq, float (&out)[16], LAS float* wsf, int r32, int hi) {
    if (hi == 0) wsf[32 + r32] = fq;
    asm volatile("s_waitcnt lgkmcnt(0)" ::: "memory");
#pragma unroll
    for (int r = 0; r < 16; ++r) out[r] = wsf[32 + crow(r, hi)];
    asm volatile("s_waitcnt lgkmcnt(0)" ::: "memory");
}
DEV void store_o_rows(const f32x16 (&o)[2], bf16_t* dst, size_t pitch, LAS unsigned char* ost, int lane, int r32, int hi) {
    LAS bf16_t* stg = (LAS bf16_t*)ost;
#pragma unroll
    for (int r = 0; r < 16; ++r) { const int orow = crow(r, hi);
#pragma unroll
        for (int d0 = 0; d0 < 2; ++d0) stg[orow * 64 + d0 * 32 + r32] = f2bf(o[d0][r]); }
    asm volatile("s_waitcnt lgkmcnt(0)" ::: "memory");
#pragma unroll
    for (int i = 0; i < 4; ++i) { const int row = i * 8 + (lane >> 3), ch = lane & 7; *(u32x4*)(dst + (size_t)row * pitch + ch * 8) = *(const LAS u32x4*)(stg + row * 64 + ch * 8); }
    asm volatile("s_waitcnt lgkmcnt(0)" ::: "memory");
}

#define FT_SBAR() __builtin_amdgcn_sched_barrier(0)
#define FT_PIN(x) asm volatile("" : "+v"(x))
#define FT_WAIT_BAR(N) asm volatile("s_waitcnt vmcnt(" #N ") lgkmcnt(0)\n\ts_barrier" ::: "memory")
DEV unsigned ft_cvtpk(float lo, float hi) { unsigned r; asm("v_cvt_pk_bf16_f32 %0, %1, %2" : "=v"(r) : "v"(lo), "v"(hi)); return r; }
DEV void ft_glds16(const void* g, unsigned lds_base) { unsigned sv; asm volatile("s_mov_b32 %0, m0\n\ts_mov_b32 m0, %2\n\ts_nop 0\n\tglobal_load_lds_dwordx4 %1, off\n\ts_mov_b32 m0, %0" : "=&s"(sv) : "v"(g), "s"(lds_base) : "memory"); }
typedef LAS const char* ft_cptr;
DEV void ft_kload2(bf16x8* kf, ft_cptr kp, int d0) { kf[2 * d0] = *(const LAS bf16x8*)(kp + d0 * 2048); kf[2 * d0 + 1] = *(const LAS bf16x8*)(kp + d0 * 2048 + 512); }
DEV s16x4 ft_vtr(ft_cptr p) { return __builtin_bit_cast(s16x4, __builtin_amdgcn_ds_read_tr16_b64_v4i16((LAS s16x4*)p)); }
DEV float ft_rowmax(const f32x16& p0, const f32x16& p1) {
    float a = FA_MX3(p0[0], p0[1], p1[0]), b = FA_MX3(p0[2], p0[3], p1[1]); a = FA_MX3(a, p1[2], p1[3]);
#pragma unroll
    for (int r = 4; r < 16; r += 4) { a = FA_MX3(a, p0[r], p0[r + 1]); b = FA_MX3(b, p0[r + 2], p0[r + 3]); a = FA_MX3(a, p1[r], p1[r + 1]); b = FA_MX3(b, p1[r + 2], p1[r + 3]); }
    return xhalf_max(__builtin_fmaxf(a, b)); }
template <int MODE>
DEV void fa64_tuned(f32x16 (&o)[2], float& l_out, const bf16x8 (&qr)[4], const bf16_t* Kb, int kpitch, const bf16_t* Vb, int vpitch, unsigned long long um, int jlast, int NT,
                    unsigned long long rowmask, int tb, int tokl, LAS unsigned char* lds, LAS float* wsf, int wid, int lane, int r32, int hi) {
    constexpr int SLOTB = 8192; constexpr float THR = 8.0f;
    const unsigned lds0 = (unsigned)(uintptr_t)lds;
    const bf16_t* ksrc = Kb + (size_t)lane * kpitch + wid * 8;
    const bf16_t* vsrc = Vb + (size_t)(16 * (wid & 3) + (lane >> 2)) * vpitch + (wid >> 2) * 32 + (lane & 3) * 8;
    const unsigned kdst = lds0 + L_K + wid * 1024, vdst = lds0 + L_V + wid * 1024;
    unsigned long long rem_ = um; int jn_ = tb;
    auto gen = [&]() -> int { if (MODE == 0) { if (rem_ == 0ull) return 128; const int j = (int)__builtin_ctzll(rem_); rem_ &= rem_ - 1ull; return j; } else { if (jn_ < jlast) return 128; return jn_--; } };
    int w0 = gen(), w1 = gen(), w2 = gen(), w3 = gen();
#define FT_SHIFT() do { w0 = w1; w1 = w2; w2 = w3; w3 = gen(); } while (0)
#define FT_DMA_K(id, slot) ft_glds16(ksrc + (size_t)(((id) & 63) * 64) * kpitch, (unsigned)__builtin_amdgcn_readfirstlane(kdst + (slot)))
#define FT_DMA_V(id, slot) ft_glds16(vsrc + (size_t)(((id) & 63) * 64) * vpitch, (unsigned)__builtin_amdgcn_readfirstlane(vdst + (slot)))
    const ft_cptr vp0 = (ft_cptr)lds + L_V + ((lane >> 4) & 1) * 32 + (lane & 3) * 8 + (4 * hi + ((lane & 15) >> 2)) * 64;
    const ft_cptr kp0 = (ft_cptr)lds + L_K + hi * 1024 + r32 * 16;
    FT_DMA_K(w0, 0); FT_DMA_V(w0, 0); FT_DMA_K(w1, SLOTB); FT_DMA_K(w2, 2 * SLOTB);
    float mhat = 0.f, l_reg = 0.f; o[0] = f32x16{}; o[1] = f32x16{};
    const f32x16 zero16 = f32x16{};
    bool resc = false;
    f32x16 pA0, pA1, pB0, pB1; bf16x8 kf[8]; s16x4 vlo[8], vhi[8]; u32x4 pw0, pw1, pw2, pw3;
    int sl_prev = 0, sl_cur = 0, sl_next = SLOTB;
#define FT_ROT() do { sl_prev = sl_cur; sl_cur = sl_next; sl_next = (sl_next == 2 * SLOTB) ? 0 : sl_next + SLOTB; } while (0)
#define FT_EX(v) __builtin_amdgcn_exp2f((v) + nmh)
#define FT_RESC() do { if (resc) { _Pragma("unroll") for (int d_ = 0; d_ < 2; ++d_) _Pragma("unroll") for (int r = 0; r < 16; ++r) o[d_][r] *= wsf[crow(r, hi)]; } } while (0)
    auto emask = [&](int id, f32x16& p0, f32x16& p1) {
        const int j = id & 63, kb = 4 * hi;
        if (j == tb) {
#pragma unroll
            for (int r = 0; r < 16; ++r) { const int kv_ = kb + (r & 3) + 8 * (r >> 2); if (kv_ > tokl) p0[r] = -INFINITY; if (kv_ + 32 > tokl) p1[r] = -INFINITY; }
        } else if (MODE == 1 && j == tb - 8) {
#pragma unroll
            for (int r = 0; r < 16; ++r) { const int kv_ = kb + (r & 3) + 8 * (r >> 2); if (kv_ <= tokl) p0[r] = -INFINITY; if (kv_ + 32 <= tokl) p1[r] = -INFINITY; } } };
    auto rowsel = [&](int id) -> bool { if (id & 128) return false; if (MODE == 0) return (rowmask >> (id & 63)) & 1ull; return true; };
    FT_WAIT_BAR(3);
    _Pragma("unroll") for (int d0 = 0; d0 < 4; ++d0) ft_kload2(kf, kp0, d0);
    pA0 = FA_MFMA(kf[0], qr[0], zero16); pA1 = FA_MFMA(kf[1], qr[0], zero16); pA0 = FA_MFMA(kf[2], qr[1], pA0); pA1 = FA_MFMA(kf[3], qr[1], pA1);
    pA0 = FA_MFMA(kf[4], qr[2], pA0); pA1 = FA_MFMA(kf[5], qr[2], pA1); pA0 = FA_MFMA(kf[6], qr[3], pA0); pA1 = FA_MFMA(kf[7], qr[3], pA1);
    emask(w0, pA0, pA1);
    { const float rm = ft_rowmax(pA0, pA1); mhat = rm; const float nmh = -mhat;
#pragma unroll
      for (int r = 0; r < 16; ++r) { pA0[r] = FT_EX(pA0[r]); pA1[r] = FT_EX(pA1[r]); } }
    FT_WAIT_BAR(0);
    FT_DMA_K(w3, 0); FT_DMA_V(w1, SLOTB); FT_ROT(); FT_SHIFT();
    _Pragma("unroll") for (int d0 = 0; d0 < 4; ++d0) ft_kload2(kf, kp0 + sl_cur, d0);
    FT_WAIT_BAR(2);
#define FT_PKW(P, i) ft_cvtpk(P[i], P[i + 1])
#define FT_PAF(k) __builtin_bit_cast(bf16x8, pw##k)
#define FT_VFR(i) (bf16x8){vlo[i][0], vlo[i][1], vlo[i][2], vlo[i][3], vhi[i][0], vhi[i][1], vhi[i][2], vhi[i][3]}
#define FT_VRD(i) do { vlo[i] = ft_vtr(vp_ + (((i) >> 2) * 4096 + ((i) & 3) * 1024)); vhi[i] = ft_vtr(vp_ + (((i) >> 2) * 4096 + ((i) & 3) * 1024 + 512)); } while (0)
#define FT_KRD(G, d0) do { if (G) { ft_kload2(kf, kp0 + sl_next, d0); FT_SBAR(); } } while (0)
#define FT_GAPA(MF, a0, a1, a2, a3, W0, W1, PW) do { MF; sacc += a0; sacc += a1; sacc += a2; sacc += a3; W0; W1; FT_PIN(PW); FT_PIN(sacc); FT_SBAR(); } while (0)
#define FT_GAPB(MF, X, i) do { MF; X[i] = FT_EX(X[i]); X[i + 1] = FT_EX(X[i + 1]); X[i + 2] = FT_EX(X[i + 2]); X[i + 3] = FT_EX(X[i + 3]); FT_PIN(X); FT_SBAR(); } while (0)
#define FT_STEP(C0, C1, P0, P1, t, MASK, GK, GV, GL) do { FT_SBAR(); \
    const ft_cptr vp_ = vp0 + sl_prev; const int id_ = w0; \
    FT_VRD(0); FT_SBAR(); float sacc = P0[0] + P0[1]; \
                       FT_GAPA(C0 = FA_MFMA(kf[0], qr[0], zero16), P0[2], P0[3], P0[4], P0[5],     pw0[0] = FT_PKW(P0, 0),  pw0[1] = FT_PKW(P0, 2),  pw0); \
    FT_VRD(4); FT_SBAR(); FT_GAPA(C1 = FA_MFMA(kf[1], qr[0], zero16), P0[6], P0[7], P0[8], P0[9],     pw0[2] = FT_PKW(P0, 4),  pw0[3] = FT_PKW(P0, 6),  pw0); \
    FT_VRD(1); FT_SBAR(); FT_GAPA(C0 = FA_MFMA(kf[2], qr[1], C0),    P0[10], P0[11], P0[12], P0[13], pw1[0] = FT_PKW(P0, 8),  pw1[1] = FT_PKW(P0, 10), pw1); \
    FT_VRD(5); FT_SBAR(); FT_GAPA(C1 = FA_MFMA(kf[3], qr[1], C1),    P0[14], P0[15], P1[0], P1[1],   pw1[2] = FT_PKW(P0, 12), pw1[3] = FT_PKW(P0, 14), pw1); \
    FT_VRD(2); FT_SBAR(); FT_GAPA(C0 = FA_MFMA(kf[4], qr[2], C0),    P1[2], P1[3], P1[4], P1[5],     pw2[0] = FT_PKW(P1, 0),  pw2[1] = FT_PKW(P1, 2),  pw2); \
    FT_VRD(6); FT_SBAR(); FT_GAPA(C1 = FA_MFMA(kf[5], qr[2], C1),    P1[6], P1[7], P1[8], P1[9],     pw2[2] = FT_PKW(P1, 4),  pw2[3] = FT_PKW(P1, 6),  pw2); \
    FT_VRD(3); FT_SBAR(); FT_GAPA(C0 = FA_MFMA(kf[6], qr[3], C0),    P1[10], P1[11], P1[12], P1[13], pw3[0] = FT_PKW(P1, 8),  pw3[1] = FT_PKW(P1, 10), pw3); \
    FT_VRD(7); FT_SBAR(); FT_GAPA(C1 = FA_MFMA(kf[7], qr[3], C1),    P1[14], P1[15], 0.f, 0.f,       pw3[2] = FT_PKW(P1, 12), pw3[3] = FT_PKW(P1, 14), pw3); \
    l_reg += sacc; \
    if (GK) FT_DMA_K(w3, sl_cur); if (GV) FT_DMA_V(w1, sl_next); \
    if (MASK) emask(id_, C0, C1); \
    const bool rs_ = rowsel(id_); \
    { float rmx = ft_rowmax(C0, C1); if (!rs_) rmx = -INFINITY; const float rm = rmx - mhat; resc = false; \
      if (__builtin_expect(__any(rm > THR), 0)) { const float dl = __builtin_fmaxf(rm, 0.f); mhat += dl; \
          const float f = __builtin_amdgcn_exp2f(-dl); l_reg *= f; if (hi == 0) wsf[r32] = f; resc = true; } } \
    const float nmh = rs_ ? -mhat : -INFINITY; FT_SBAR(); \
    FT_GAPB(o[0] = FA_MFMA(FT_PAF(0), FT_VFR(0), o[0]), C0, 0);              FT_GAPB(o[1] = FA_MFMA(FT_PAF(0), FT_VFR(4), o[1]), C0, 4); \
    FT_KRD(GL, 0); FT_GAPB(o[0] = FA_MFMA(FT_PAF(1), FT_VFR(1), o[0]), C0, 8);  FT_KRD(GL, 1); FT_GAPB(o[1] = FA_MFMA(FT_PAF(1), FT_VFR(5), o[1]), C0, 12); \
    FT_KRD(GL, 2); FT_GAPB(o[0] = FA_MFMA(FT_PAF(2), FT_VFR(2), o[0]), C1, 0);  FT_KRD(GL, 3); FT_GAPB(o[1] = FA_MFMA(FT_PAF(2), FT_VFR(6), o[1]), C1, 4); \
    FT_GAPB(o[0] = FA_MFMA(FT_PAF(3), FT_VFR(3), o[0]), C1, 8);              FT_GAPB(o[1] = FA_MFMA(FT_PAF(3), FT_VFR(7), o[1]), C1, 12); \
    } while (0)
    int t = 1;
    for (; t + 5 < NT; t += 2) {
        FT_STEP(pB0, pB1, pA0, pA1, t, false, true, true, true);     FT_WAIT_BAR(2); FT_RESC(); FT_ROT(); FT_SHIFT();
        FT_STEP(pA0, pA1, pB0, pB1, t + 1, false, true, true, true); FT_WAIT_BAR(2); FT_RESC(); FT_ROT(); FT_SHIFT();
    }
#define FT_ENDW(tt) do { if ((tt) + 3 < NT) { FT_WAIT_BAR(2); } else if ((tt) + 2 < NT) { FT_WAIT_BAR(1); } else { FT_WAIT_BAR(0); } } while (0)
    for (; t + 1 < NT; t += 2) {
        FT_STEP(pB0, pB1, pA0, pA1, t, true, (t + 3 < NT), (t + 1 < NT), (t + 1 < NT));         FT_ENDW(t);     FT_RESC(); FT_ROT(); FT_SHIFT();
        FT_STEP(pA0, pA1, pB0, pB1, t + 1, true, (t + 4 < NT), (t + 2 < NT), (t + 2 < NT));     FT_ENDW(t + 1); FT_RESC(); FT_ROT(); FT_SHIFT();
    }
    FT_STEP(pB0, pB1, pA0, pA1, NT - 1, true, false, false, false); FT_RESC();
    { float sacc = pB0[0] + pB0[1];
#pragma unroll
      for (int r = 2; r < 16; ++r) sacc += pB0[r];
#pragma unroll
      for (int r = 0; r < 16; ++r) sacc += pB1[r];
      l_reg += sacc;
      pw0 = (u32x4){FT_PKW(pB0, 0), FT_PKW(pB0, 2), FT_PKW(pB0, 4), FT_PKW(pB0, 6)}; pw1 = (u32x4){FT_PKW(pB0, 8), FT_PKW(pB0, 10), FT_PKW(pB0, 12), FT_PKW(pB0, 14)};
      pw2 = (u32x4){FT_PKW(pB1, 0), FT_PKW(pB1, 2), FT_PKW(pB1, 4), FT_PKW(pB1, 6)}; pw3 = (u32x4){FT_PKW(pB1, 8), FT_PKW(pB1, 10), FT_PKW(pB1, 12), FT_PKW(pB1, 14)};
      const ft_cptr vp_ = vp0 + sl_cur; _Pragma("unroll") for (int i = 0; i < 8; ++i) FT_VRD(i);
      o[0] = FA_MFMA(FT_PAF(0), FT_VFR(0), o[0]); o[1] = FA_MFMA(FT_PAF(0), FT_VFR(4), o[1]); o[0] = FA_MFMA(FT_PAF(1), FT_VFR(1), o[0]); o[1] = FA_MFMA(FT_PAF(1), FT_VFR(5), o[1]);
      o[0] = FA_MFMA(FT_PAF(2), FT_VFR(2), o[0]); o[1] = FA_MFMA(FT_PAF(2), FT_VFR(6), o[1]); o[0] = FA_MFMA(FT_PAF(3), FT_VFR(3), o[0]); o[1] = FA_MFMA(FT_PAF(3), FT_VFR(7), o[1]); }
    l_out = l_reg;
    asm volatile("s_waitcnt lgkmcnt(0)\n\ts_barrier" ::: "memory");
#undef FT_SHIFT
#undef FT_DMA_K
#undef FT_DMA_V
#undef FT_ROT
#undef FT_EX
#undef FT_RESC
#undef FT_PKW
#undef FT_PAF
#undef FT_VFR
#undef FT_VRD
#undef FT_KRD
#undef FT_ENDW
#undef FT_GAPA
#undef FT_GAPB
#undef FT_STEP
}

constexpr int M_KSLOT = 12288, M_LK = 0, M_LV = 4 * M_KSLOT, M_LWSF = M_LV + 3 * 8192, M_LOST = M_LWSF + 8 * 512, M_LEND = M_LOST + 8 * 4096;
DEV void ft_wait_bar(int n) {
    if (n == 0) asm volatile("s_waitcnt vmcnt(0) lgkmcnt(0)\n\ts_barrier" ::: "memory");
    else if (n == 1) asm volatile("s_waitcnt vmcnt(1) lgkmcnt(0)\n\ts_barrier" ::: "memory");
    else if (n == 2) asm volatile("s_waitcnt vmcnt(2) lgkmcnt(0)\n\ts_barrier" ::: "memory");
    else if (n == 3) asm volatile("s_waitcnt vmcnt(3) lgkmcnt(0)\n\ts_barrier" ::: "memory");
    else asm volatile("s_waitcnt vmcnt(5) lgkmcnt(0)\n\ts_barrier" ::: "memory");
}
DEV void fa96_tuned(f32x16 (&o)[2], float& l_out, const bf16x8 (&qr)[6], const bf16_t* Kb, const bf16_t* Vb, int NT, int qrel, LAS unsigned char* lds, LAS float* wsf, int wid, int lane, int r32, int hi) {
    constexpr int SLOTB = 8192; constexpr float THR = 8.0f;
    const unsigned lds0 = (unsigned)(uintptr_t)lds;
    const int kc = (wid < 4) ? 2 : 1;
    const bf16_t* ksrc = Kb + (size_t)lane * 768 + wid * 8;
    const bf16_t* vsrc = Vb + (size_t)(16 * (wid & 3) + (lane >> 2)) * 512 + (wid >> 2) * 32 + (lane & 3) * 8;
    const unsigned kdst = lds0 + M_LK + wid * 1024, vdst = lds0 + M_LV + wid * 1024;
#define MT_DMA_K(t) do { const unsigned sl_ = (unsigned)(((t) & 3) * M_KSLOT); ft_glds16(ksrc + (size_t)(t) * 64 * 768, (unsigned)__builtin_amdgcn_readfirstlane(kdst + sl_)); \
        if (wid < 4) ft_glds16(ksrc + (size_t)(t) * 64 * 768 + 64, (unsigned)__builtin_amdgcn_readfirstlane(kdst + 8192 + sl_)); } while (0)
#define MT_DMA_V(t, slot) ft_glds16(vsrc + (size_t)(t) * 64 * 512, (unsigned)__builtin_amdgcn_readfirstlane(vdst + (slot)))
    const ft_cptr vp0 = (ft_cptr)lds + M_LV + ((lane >> 4) & 1) * 32 + (lane & 3) * 8 + (4 * hi + ((lane & 15) >> 2)) * 64;
    const ft_cptr kp0 = (ft_cptr)lds + M_LK + hi * 1024 + r32 * 16;
#define MT_KFR(kp, f) (*(const LAS bf16x8*)((kp) + ((f) >> 1) * 2048 + ((f) & 1) * 512))
    MT_DMA_K(0); MT_DMA_V(0, 0); MT_DMA_K(1); MT_DMA_K(2);
    float mhat = 0.f, l_reg = 0.f; o[0] = f32x16{}; o[1] = f32x16{};
    const f32x16 zero16 = f32x16{};
    bool resc = false;
    f32x16 pA0, pA1, pB0, pB1; bf16x8 kf[4]; s16x4 vlo[8], vhi[8]; u32x4 pw0, pw1, pw2, pw3;
    int sl_prev = 0, sl_cur = 0, sl_next = SLOTB;
    const int band0 = NT - 4;
#define MT_ROT() do { sl_prev = sl_cur; sl_cur = sl_next; sl_next = (sl_next == 2 * SLOTB) ? 0 : sl_next + SLOTB; } while (0)
#define MT_EX(v) __builtin_amdgcn_exp2f((v) + nmh)
#define MT_RESC() do { if (resc) { _Pragma("unroll") for (int d_ = 0; d_ < 2; ++d_) _Pragma("unroll") for (int r = 0; r < 16; ++r) o[d_][r] *= wsf[crow(r, hi)]; } } while (0)
    auto cmask = [&](int t, f32x16& p0, f32x16& p1) { const int jb = t - band0; if (jb >= 0) { const int kb = 64 * jb + 4 * hi;
#pragma unroll
            for (int r = 0; r < 16; ++r) { const int kv_ = kb + (r & 3) + 8 * (r >> 2); if (kv_ > qrel) p0[r] = -INFINITY; if (kv_ + 32 > qrel) p1[r] = -INFINITY; } } };
    ft_wait_bar(kc == 2 ? 5 : 3);
    { const ft_cptr kp = kp0;
      pA0 = zero16; pA1 = zero16;
#pragma unroll
      for (int d0 = 0; d0 < 6; ++d0) { const bf16x8 k0 = MT_KFR(kp, 2 * d0), k1 = MT_KFR(kp, 2 * d0 + 1); pA0 = FA_MFMA(k0, qr[d0], pA0); pA1 = FA_MFMA(k1, qr[d0], pA1); } }
    cmask(0, pA0, pA1);
    { const float rm = ft_rowmax(pA0, pA1); mhat = rm; const float nmh = -mhat;
#pragma unroll
      for (int r = 0; r < 16; ++r) { pA0[r] = MT_EX(pA0[r]); pA1[r] = MT_EX(pA1[r]); } }
    ft_wait_bar(0);
    MT_DMA_K(3); MT_DMA_V(1, SLOTB); MT_ROT();
    { const ft_cptr kp = kp0 + M_KSLOT;
#pragma unroll
      for (int f = 0; f < 4; ++f) kf[f] = MT_KFR(kp, f); }
    ft_wait_bar(kc + 1);
#define MT_PKW(P, i) ft_cvtpk(P[i], P[i + 1])
#define MT_PAF(k) __builtin_bit_cast(bf16x8, pw##k)
#define MT_VFR(i) (bf16x8){vlo[i][0], vlo[i][1], vlo[i][2], vlo[i][3], vhi[i][0], vhi[i][1], vhi[i][2], vhi[i][3]}
#define MT_VRD(i) do { vlo[i] = ft_vtr(vp_ + (((i) >> 2) * 4096 + ((i) & 3) * 1024)); vhi[i] = ft_vtr(vp_ + (((i) >> 2) * 4096 + ((i) & 3) * 1024 + 512)); } while (0)
#define MT_GAPA(i, C, a0, a1, a2, a3, W0, W1, PW) do { C = FA_MFMA(kf[(i) & 3], qr[(i) >> 1], ((i) < 2) ? zero16 : C); if ((i) + 4 < 12) kf[(i) & 3] = MT_KFR(kp_, (i) + 4); \
        sacc += a0; sacc += a1; sacc += a2; sacc += a3; W0; W1; FT_PIN(PW); FT_PIN(sacc); FT_SBAR(); } while (0)
#define MT_GAPA0(i, C) do { C = FA_MFMA(kf[(i) & 3], qr[(i) >> 1], C); if ((i) + 4 < 12) kf[(i) & 3] = MT_KFR(kp_, (i) + 4); FT_SBAR(); } while (0)
#define MT_GAPB(MF, X, i) do { MF; X[i] = MT_EX(X[i]); X[i + 1] = MT_EX(X[i + 1]); X[i + 2] = MT_EX(X[i + 2]); X[i + 3] = MT_EX(X[i + 3]); FT_PIN(X); FT_SBAR(); } while (0)
#define MT_STEP(C0, C1, P0, P1, t, MASK, GK, GV, GL) do { FT_SBAR(); \
    const ft_cptr vp_ = vp0 + sl_prev; const ft_cptr kp_ = kp0 + ((t) & 3) * M_KSLOT; \
    MT_VRD(0); FT_SBAR(); float sacc = P0[0] + P0[1]; \
                          MT_GAPA(0, C0, P0[2], P0[3], P0[4], P0[5],     pw0[0] = MT_PKW(P0, 0),  pw0[1] = MT_PKW(P0, 2),  pw0); \
    MT_VRD(4); FT_SBAR(); MT_GAPA(1, C1, P0[6], P0[7], P0[8], P0[9],     pw0[2] = MT_PKW(P0, 4),  pw0[3] = MT_PKW(P0, 6),  pw0); \
    MT_VRD(1); FT_SBAR(); MT_GAPA(2, C0, P0[10], P0[11], P0[12], P0[13], pw1[0] = MT_PKW(P0, 8),  pw1[1] = MT_PKW(P0, 10), pw1); \
    MT_VRD(5); FT_SBAR(); MT_GAPA(3, C1, P0[14], P0[15], P1[0], P1[1],   pw1[2] = MT_PKW(P0, 12), pw1[3] = MT_PKW(P0, 14), pw1); \
    MT_VRD(2); FT_SBAR(); MT_GAPA(4, C0, P1[2], P1[3], P1[4], P1[5],     pw2[0] = MT_PKW(P1, 0),  pw2[1] = MT_PKW(P1, 2),  pw2); \
    MT_VRD(6); FT_SBAR(); MT_GAPA(5, C1, P1[6], P1[7], P1[8], P1[9],     pw2[2] = MT_PKW(P1, 4),  pw2[3] = MT_PKW(P1, 6),  pw2); \
    MT_VRD(3); FT_SBAR(); MT_GAPA(6, C0, P1[10], P1[11], P1[12], P1[13], pw3[0] = MT_PKW(P1, 8),  pw3[1] = MT_PKW(P1, 10), pw3); \
    MT_VRD(7); FT_SBAR(); MT_GAPA(7, C1, P1[14], P1[15], 0.f, 0.f,       pw3[2] = MT_PKW(P1, 12), pw3[3] = MT_PKW(P1, 14), pw3); \
    MT_GAPA0(8, C0); MT_GAPA0(9, C1); MT_GAPA0(10, C0); MT_GAPA0(11, C1); \
    l_reg += sacc; \
    if (GK) MT_DMA_K((t) + 3); if (GV) MT_DMA_V((t) + 1, sl_next); \
    if (MASK) cmask((t), C0, C1); \
    { const float rm = ft_rowmax(C0, C1) - mhat; resc = false; \
      if (__builtin_expect(__any(rm > THR), 0)) { const float dl = __builtin_fmaxf(rm, 0.f); mhat += dl; \
          const float f = __builtin_amdgcn_exp2f(-dl); l_reg *= f; if (hi == 0) wsf[r32] = f; resc = true; } } \
    const float nmh = -mhat; FT_SBAR(); \
    MT_GAPB(o[0] = FA_MFMA(MT_PAF(0), MT_VFR(0), o[0]), C0, 0);  MT_GAPB(o[1] = FA_MFMA(MT_PAF(0), MT_VFR(4), o[1]), C0, 4); \
    MT_GAPB(o[0] = FA_MFMA(MT_PAF(1), MT_VFR(1), o[0]), C0, 8);  MT_GAPB(o[1] = FA_MFMA(MT_PAF(1), MT_VFR(5), o[1]), C0, 12); \
    MT_GAPB(o[0] = FA_MFMA(MT_PAF(2), MT_VFR(2), o[0]), C1, 0);  MT_GAPB(o[1] = FA_MFMA(MT_PAF(2), MT_VFR(6), o[1]), C1, 4); \
    MT_GAPB(o[0] = FA_MFMA(MT_PAF(3), MT_VFR(3), o[0]), C1, 8);  MT_GAPB(o[1] = FA_MFMA(MT_PAF(3), MT_VFR(7), o[1]), C1, 12); \
    if (GL) { const ft_cptr kn_ = kp0 + (((t) + 1) & 3) * M_KSLOT; _Pragma("unroll") for (int f = 0; f < 4; ++f) kf[f] = MT_KFR(kn_, f); } \
    } while (0)
#define MT_ENDW(tt) do { if ((tt) + 3 < NT) ft_wait_bar(kc + 1); else if ((tt) + 2 < NT) ft_wait_bar(1); else ft_wait_bar(0); } while (0)
    int t = 1;
    for (; t + 5 < NT; t += 2) {
        MT_STEP(pB0, pB1, pA0, pA1, t, false, true, true, true);     ft_wait_bar(kc + 1); MT_RESC(); MT_ROT();
        MT_STEP(pA0, pA1, pB0, pB1, t + 1, false, true, true, true); ft_wait_bar(kc + 1); MT_RESC(); MT_ROT();
    }
    for (; t + 1 < NT; t += 2) {
        MT_STEP(pB0, pB1, pA0, pA1, t, true, (t + 3 < NT), (t + 1 < NT), (t + 1 < NT));         MT_ENDW(t);     MT_RESC(); MT_ROT();
        MT_STEP(pA0, pA1, pB0, pB1, t + 1, true, (t + 4 < NT), (t + 2 < NT), (t + 2 < NT));     MT_ENDW(t + 1); MT_RESC(); MT_ROT();
    }
    MT_STEP(pB0, pB1, pA0, pA1, NT - 1, true, false, false, false); MT_RESC();
    { float sacc = pB0[0] + pB0[1];
#pragma unroll
      for (int r = 2; r < 16; ++r) sacc += pB0[r];
#pragma unroll
      for (int r = 0; r < 16; ++r) sacc += pB1[r];
      l_reg += sacc;
      pw0 = (u32x4){MT_PKW(pB0, 0), MT_PKW(pB0, 2), MT_PKW(pB0, 4), MT_PKW(pB0, 6)}; pw1 = (u32x4){MT_PKW(pB0, 8), MT_PKW(pB0, 10), MT_PKW(pB0, 12), MT_PKW(pB0, 14)};
      pw2 = (u32x4){MT_PKW(pB1, 0), MT_PKW(pB1, 2), MT_PKW(pB1, 4), MT_PKW(pB1, 6)}; pw3 = (u32x4){MT_PKW(pB1, 8), MT_PKW(pB1, 10), MT_PKW(pB1, 12), MT_PKW(pB1, 14)};
      const ft_cptr vp_ = vp0 + sl_cur; _Pragma("unroll") for (int i = 0; i < 8; ++i) MT_VRD(i);
      o[0] = FA_MFMA(MT_PAF(0), MT_VFR(0), o[0]); o[1] = FA_MFMA(MT_PAF(0), MT_VFR(4), o[1]); o[0] = FA_MFMA(MT_PAF(1), MT_VFR(1), o[0]); o[1] = FA_MFMA(MT_PAF(1), MT_VFR(5), o[1]);
      o[0] = FA_MFMA(MT_PAF(2), MT_VFR(2), o[0]); o[1] = FA_MFMA(MT_PAF(2), MT_VFR(6), o[1]); o[0] = FA_MFMA(MT_PAF(3), MT_VFR(3), o[0]); o[1] = FA_MFMA(MT_PAF(3), MT_VFR(7), o[1]); }
    l_out = l_reg;
    asm volatile("s_waitcnt lgkmcnt(0)\n\ts_barrier" ::: "memory");
#undef MT_DMA_K
#undef MT_DMA_V
#undef MT_KFR
#undef MT_ROT
#undef MT_EX
#undef MT_RESC
#undef MT_PKW
#undef MT_PAF
#undef MT_VFR
#undef MT_VRD
#undef MT_GAPA
#undef MT_GAPA0
#undef MT_GAPB
#undef MT_STEP
#undef MT_ENDW
}
}

DEV void mla_unit(const Params& p, LAS unsigned char* lds, int b, int h, int qb) {
    using namespace fa;
    const int tid = opaque_tid(), wid = __builtin_amdgcn_readfirstlane(tid >> 6), lane = tid & 63, r32 = lane & 31, hi = lane >> 5;
    const bf16_t* QM = (const bf16_t*)(p.ws + OFF_QM); const bf16_t* Kb = (const bf16_t*)(p.ws + OFF_KM) + (size_t)b * SEQ * 768 + h * 96;
    const bf16_t* Vb = (const bf16_t*)(p.ws + OFF_VM) + (size_t)b * SEQ * 512 + h * 64; bf16_t* OCAT = (bf16_t*)(p.ws + OFF_OCAT);
    const int q0 = qb * 256, NT = (q0 + 256) / 64;
    LAS float* wsf = (LAS float*)(lds + M_LWSF) + wid * 128;
    bf16x8 qr[6];
    { const bf16_t* qrow = QM + ((size_t)b * SEQ + q0 + wid * 32 + r32) * 768 + h * 96 + hi * 8;
#pragma unroll
      for (int d0 = 0; d0 < 6; ++d0) qr[d0] = *(const bf16x8*)(qrow + d0 * 16); }
    f32x16 o[2]; float lpart;
    fa96_tuned(o, lpart, qr, Kb, Vb, NT, wid * 32 + r32, lds, wsf, wid, lane, r32, hi);
    const float l = xhalf_sum(lpart); float rl[16]; row_to_olayout(1.0f / l, rl, wsf, r32, hi);
#pragma unroll
    for (int r = 0; r < 16; ++r) { o[0][r] *= rl[r]; o[1][r] *= rl[r]; }
    store_o_rows(o, OCAT + ((size_t)b * SEQ + q0 + wid * 32) * 1024 + h * 64, 1024, lds + M_LOST + wid * 4096, lane, r32, hi);
    __syncthreads();
}
DEV void nsa_unit(const Params& p, LAS unsigned char* lds, int b, int g, int tb) {
    using namespace fa;
    const int tid = opaque_tid(), wid = __builtin_amdgcn_readfirstlane(tid >> 6), lane = tid & 63, r32 = lane & 31, hi = lane >> 5;
    const int hl = wid >> 1, head = 4 * g + hl, q0 = 64 * tb, tokl = 32 * (wid & 1) + r32, t = q0 + tokl;
    const size_t tok = (size_t)b * SEQ + t;
    const bf16_t* PROJ = (const bf16_t*)(p.ws + OFF_PROJ); const float* GATES = (const float*)(p.ws + OFF_GATES);
    LAS float* wsf = (LAS float*)(lds + L_WSF) + wid * 128;
    LAS float* impH = (LAS float*)(lds + L_IMPH);
    const int kp0 = hi * 1024 + r32 * 16;
    const int vp0 = ((lane >> 4) & 1) * 32 + (lane & 3) * 8 + (4 * hi + ((lane & 15) >> 2)) * 64;
    bf16x8 qr[4];
    { const bf16_t* qrow = (const bf16_t*)(p.ws + OFF_NQ) + tok * 512 + head * 64 + hi * 8;
#pragma unroll
      for (int d0 = 0; d0 < 4; ++d0) qr[d0] = *(const bf16x8*)(qrow + d0 * 16); }
    if (hi == 0) { const float* gp_ = GATES + tok * 24 + head * 3; wsf[64 + r32] = gp_[0]; wsf[96 + r32] = gp_[1]; }
    const float g2reg = GATES[tok * 24 + head * 3 + 2];
    { LAS f32x4* z = (LAS f32x4*)impH + tid;
#pragma unroll
      for (int i = 0; i < 8; ++i) z[i * 512] = (f32x4){0.f, 0.f, 0.f, 0.f}; }
    KVRegs<8> kv;
    f32x16 res[2];
    const int cntq = (t >= 31) ? ((t - 31) >> 4) + 1 : 0;
    const int ntc = (4 * tb + 3 + 63) >> 6;
    const bf16_t* Kc = (const bf16_t*)(p.ws + OFF_KC) + ((size_t)b * NCMPP * 2 + g) * 64; const bf16_t* Vc = (const bf16_t*)(p.ws + OFF_VC) + ((size_t)b * NCMPP * 2 + g) * 64;
    float mc = -1e30f, lc = 0.f;
    {   KVRegs<8> kc4[4];
#pragma unroll
        for (int c = 0; c < 4; ++c) if (c < ntc) stage_load<8>(kc4[c], Kc, 128, Vc, 128, c * 64, wid, lane);

#pragma unroll
        for (int c = 0; c < 4; ++c) if (c < ntc) { *(LAS u32x4*)(lds + L_K + c * 8192 + wid * 1024 + lane * 16) = kc4[c].k0; *(LAS u32x4*)(lds + L_OST + c * 8192 + wid * 1024 + lane * 16) = kc4[c].v; } }
    __syncthreads();
#pragma unroll 1
    for (int c = 0; c < ntc; ++c) {
        f32x16 p0, p1; qk_tile<4>(lds + L_K + c * 8192, kp0, qr, p0, p1);
        const int nb = 64 * c + 4 * hi;
#pragma unroll
        for (int r = 0; r < 16; ++r) { const int n = nb + (r & 3) + 8 * (r >> 2); if (n >= cntq) p0[r] = -INFINITY; if (n + 32 >= cntq) p1[r] = -INFINITY; }
        const float newm = fmaxf(mc, rowmax32(p0, p1)); float sacc = 0.f;
#pragma unroll
        for (int r = 0; r < 16; ++r) sacc += fast_exp2(p0[r] - newm) + fast_exp2(p1[r] - newm);
        lc = lc * fast_exp2(mc - newm) + sacc; mc = newm;
    }
    lc = xhalf_sum(lc);
    const float rlc = (lc > 0.f) ? 1.0f / lc : 0.f;
    float carry = 0.f;
    f32x16 oc[2];
#pragma unroll
    for (int r = 0; r < 16; ++r) { oc[0][r] = 0.f; oc[1][r] = 0.f; }
#pragma unroll 1
    for (int c = 0; c < ntc; ++c) {
        f32x16 p0, p1; qk_tile<4>(lds + L_K + c * 8192, kp0, qr, p0, p1);
        const int nb = 64 * c + 4 * hi;
#pragma unroll
        for (int r = 0; r < 16; ++r) { const int n = nb + (r & 3) + 8 * (r >> 2);
            p0[r] = (n >= cntq) ? 0.f : fast_exp2(p0[r] - mc) * rlc; p1[r] = (n + 32 >= cntq) ? 0.f : fast_exp2(p1[r] - mc) * rlc; }
        { LAS float* ih = impH + (size_t)hl * 4096 + tokl; float b0[4], b1[4];
#pragma unroll
          for (int k = 0; k < 4; ++k) { b0[k] = __shfl_xor(p0[4 * k + 3], 32); b1[k] = __shfl_xor(p1[4 * k + 3], 32); }
#pragma unroll
          for (int k = 0; k < 4; ++k) { const int j0 = 16 * c + 2 * k + hi, j1 = j0 + 8;
              const float G0 = (p0[4 * k] + p0[4 * k + 1]) + (p0[4 * k + 2] + p0[4 * k + 3]), G1 = (p1[4 * k] + p1[4 * k + 1]) + (p1[4 * k + 2] + p1[4 * k + 3]);
              const float e0 = hi ? b0[k] : (k ? b0[k > 0 ? k - 1 : 0] : carry), e1 = hi ? b1[k] : (k ? b1[k > 0 ? k - 1 : 0] : b0[3]);
              ih[j0 * 64] = G0 + e0; ih[j1 * 64] = G1 + e1; }
          carry = b1[3]; }
        u32x4 pw[4];
#pragma unroll
        for (int k = 0; k < 2; ++k) { pw[k] = (u32x4){pk2(p0[8 * k], p0[8 * k + 1]), pk2(p0[8 * k + 2], p0[8 * k + 3]), pk2(p0[8 * k + 4], p0[8 * k + 5]), pk2(p0[8 * k + 6], p0[8 * k + 7])};
            pw[2 + k] = (u32x4){pk2(p1[8 * k], p1[8 * k + 1]), pk2(p1[8 * k + 2], p1[8 * k + 3]), pk2(p1[8 * k + 4], p1[8 * k + 5]), pk2(p1[8 * k + 6], p1[8 * k + 7])}; }
        const LAS unsigned char* vbuf = lds + L_OST + c * 8192;
#pragma unroll
        for (int dh = 0; dh < 2; ++dh)
#pragma unroll
            for (int ks = 0; ks < 4; ++ks) { const s16x4 lo = vtr(vbuf + vp0 + dh * 4096 + ks * 1024), hi4 = vtr(vbuf + vp0 + dh * 4096 + ks * 1024 + 512);
                const bf16x8 vf = (bf16x8){lo[0], lo[1], lo[2], lo[3], hi4[0], hi4[1], hi4[2], hi4[3]};
                oc[dh] = FA_MFMA(__builtin_bit_cast(bf16x8, pw[ks]), vf, oc[dh]); }
    }
    __syncthreads();
    {   const int tk = tid & 63; const int cur = tb;
        float v[8];
#pragma unroll
        for (int k = 0; k < 8; ++k) { const int j = 8 * wid + k; const LAS float* q_ = impH + j * 64 + tk;
            const float s4 = ((q_[0] + q_[4096]) + q_[2 * 4096]) + q_[3 * 4096]; const bool forced = (j == 0) || (j <= cur && j > cur - 2); v[k] = forced ? 1e30f : s4; }
#pragma unroll
        for (int k = 0; k < 8; ++k) impH[(8 * wid + k) * 64 + tk] = v[k];
        __syncthreads();
        unsigned bits = 0u; int rank[8];
#pragma unroll
        for (int k = 0; k < 8; ++k) rank[k] = 0;
        if (cur >= 16)
#pragma unroll 4
        for (int q_ = 0; q_ <= cur; ++q_) { const float vq = impH[q_ * 64 + tk];
#pragma unroll
            for (int k = 0; k < 8; ++k) rank[k] += (vq > v[k] || (vq == v[k] && q_ < 8 * wid + k)) ? 1 : 0; }
#pragma unroll
        for (int k = 0; k < 8; ++k) if (8 * wid + k <= cur && rank[k] < 16) bits |= (1u << k);
        ((LAS unsigned char*)(lds + L_MASK))[tk * 8 + wid] = (unsigned char)bits;
        __syncthreads();
    }
    LAS float* resL = impH + wid * 2048 + lane;
    { float f[16]; row_to_olayout(wsf[64 + r32], f, wsf, r32, hi);
#pragma unroll
      for (int r = 0; r < 16; ++r) { resL[r * 64] = oc[0][r] * f[r]; resL[(16 + r) * 64] = oc[1][r] * f[r]; } }
    const unsigned long long mymask = *(const LAS unsigned long long*)(lds + L_MASK + tokl * 8);
    unsigned long long um;
    { const unsigned long long mm = *(const LAS unsigned long long*)(lds + L_MASK + lane * 8); unsigned ulo = (unsigned)mm, uhi = (unsigned)(mm >> 32);
#pragma unroll
      for (int o_ = 1; o_ < 64; o_ <<= 1) { ulo |= __shfl_xor(ulo, o_); uhi |= __shfl_xor(uhi, o_); }
      um = ((unsigned long long)(unsigned)__builtin_amdgcn_readfirstlane(uhi) << 32) | (unsigned)__builtin_amdgcn_readfirstlane(ulo); }
    {   const bf16_t* Kb = (const bf16_t*)(p.ws + OFF_KSR) + (size_t)b * SEQ * 128 + g * 64; const bf16_t* Vb = (const bf16_t*)(p.ws + OFF_VSC) + (size_t)b * SEQ * 128 + g * 64;
        int nt = __builtin_popcountll(um);
        while (nt < 4 || (nt & 1)) ++nt;
        f32x16 o[2]; float lpart;
        fa64_tuned<0>(o, lpart, qr, Kb, 128, Vb, 128, um, 0, nt, mymask, tb, tokl, lds, wsf, wid, lane, r32, hi);
        const float l = xhalf_sum(lpart); float f[16]; row_to_olayout(wsf[96 + r32] / l, f, wsf, r32, hi);
#pragma unroll
        for (int r = 0; r < 16; ++r) { resL[r * 64] += o[0][r] * f[r]; resL[(16 + r) * 64] += o[1][r] * f[r]; }
    }
    {   const bf16_t* Kb = (const bf16_t*)(p.ws + OFF_KWR) + (size_t)b * SEQ * 128 + g * 64; const bf16_t* Vb = (const bf16_t*)(p.ws + OFF_VWC) + (size_t)b * SEQ * 128 + g * 64;
        const int jlast = (tb - 8 > 0) ? tb - 8 : 0; int nt = tb - jlast + 1;
        while (nt < 4 || (nt & 1)) ++nt;
        f32x16 o[2]; float lpart;
        fa64_tuned<1>(o, lpart, qr, Kb, 128, Vb, 128, 0ull, jlast, nt, 0ull, tb, tokl, lds, wsf, wid, lane, r32, hi);
        const float l = xhalf_sum(lpart); float f[16]; row_to_olayout(g2reg / l, f, wsf, r32, hi);
#pragma unroll
        for (int r = 0; r < 16; ++r) { res[0][r] = resL[r * 64] + o[0][r] * f[r]; res[1][r] = resL[(16 + r) * 64] + o[1][r] * f[r]; }
        asm volatile("s_waitcnt lgkmcnt(0)" ::: "memory");
    }
    store_o_rows(res, (bf16_t*)(p.ws + OFF_OCAT) + ((size_t)b * SEQ + q0 + 32 * (wid & 1)) * 1024 + 512 + head * 64, 1024, lds + L_OST + wid * 4096, lane, r32, hi);
    __syncthreads();
}
DEV void phase5_nsa_fa(const Params& p, LAS unsigned char* lds) {
    constexpr int NU = BATCH * 2 * 64;
    const int G = gridDim.x;
    for (int r = 0; r * G < NU; ++r) {
        const int k = r * G + ((r & 1) ? (G - 1 - (int)blockIdx.x) : (int)blockIdx.x);
        if (k >= NU) continue;
        const int tb = 63 - k / 16, bg = k % 16;
        nsa_unit(p, lds, bg >> 1, bg & 1, tb);
    }
}
DEV void phase5_mla_fa(const Params& p, LAS unsigned char* lds) {
    constexpr int NU = BATCH * 8 * 16;
    const int G = gridDim.x;
    for (int r = 0; r * G < NU; ++r) {
        const int k = r * G + ((r & 1) ? (G - 1 - (int)blockIdx.x) : (int)blockIdx.x);
        if (k >= NU) continue;
        const int qb = 15 - k / 64, bh = k % 64;
        mla_unit(p, lds, bh >> 3, bh & 7, qb);
    }
}

DEV void phase5_cmp(const Params& p, LAS unsigned char* lds) {
    const int tid = opaque_tid(), hl = tid >> 7, tl = tid & 127;
    const bf16_t* NQ = (const bf16_t*)(p.ws + OFF_NQ); const bf16_t* KC = (const bf16_t*)(p.ws + OFF_KC); const bf16_t* VC = (const bf16_t*)(p.ws + OFF_VC);
    float* OCMP = (float*)(p.ws + OFF_OCMP); unsigned long long* SELM = (unsigned long long*)(p.ws + OFF_SELM);
    LAS float* imp = (LAS float*)lds;
    constexpr int NU = BATCH * 2 * (SEQ / 128);
    for (int u = blockIdx.x; u < NU; u += gridDim.x) {
        const int tb = u % (SEQ / 128), g = (u / (SEQ / 128)) & 1, b = u / (SEQ / 128 * 2);
        const int t = tb * 128 + tl, head = g * 4 + hl; const size_t tok = (size_t)b * SEQ + t;
        float q[64];
        { const bf16_t* qr = NQ + tok * 512 + head * 64;
#pragma unroll
          for (int i = 0; i < 32; ++i) { const unsigned w = *(const unsigned*)(qr + 2 * i); q[2 * i] = bflo(w); q[2 * i + 1] = bfhi(w); } }
        for (int j = 0; j < 64; ++j) imp[(hl * 64 + j) * 128 + tl] = 0.f;
        const int cnt = (t >= 31) ? ((t - 31) / 16 + 1) : 0;
        const int tmaxw = tb * 128 + (tl | 63); const int cntw = (tmaxw >= 31) ? ((tmaxw - 31) / 16 + 1) : 0;
        const bf16_t* kb = KC + ((size_t)b * NCMPP * 2 + g) * 64; const bf16_t* vb = VC + ((size_t)b * NCMPP * 2 + g) * 64;
        float m = -INFINITY, l = 0.f;
        for (int n = 0; n < cntw; ++n) { float a = 0.f;
#pragma unroll
            for (int i = 0; i < 32; ++i) { const unsigned w = *(const unsigned*)(kb + (size_t)n * 128 + 2 * i); a += q[2 * i] * bflo(w); a += q[2 * i + 1] * bfhi(w); }
            if (n < cnt) { const float mn = fmaxf(m, a); l = l * fast_exp2(m - mn) + fast_exp2(a - mn); m = mn; } }
        const float rl = (cnt > 0) ? 1.0f / l : 0.f;
        float o[64];
#pragma unroll
        for (int d = 0; d < 64; ++d) o[d] = 0.f;
        for (int n = 0; n < cntw; ++n) { float a = 0.f;
#pragma unroll
            for (int i = 0; i < 32; ++i) { const unsigned w = *(const unsigned*)(kb + (size_t)n * 128 + 2 * i); a += q[2 * i] * bflo(w); a += q[2 * i + 1] * bfhi(w); }
            const float pr = (n < cnt) ? fast_exp2(a - m) * rl : 0.f;
#pragma unroll
            for (int i = 0; i < 32; ++i) { const unsigned w = *(const unsigned*)(vb + (size_t)n * 128 + 2 * i); o[2 * i] += pr * bflo(w); o[2 * i + 1] += pr * bfhi(w); }
            const int jj = n >> 2; imp[(hl * 64 + jj) * 128 + tl] += pr; if ((n & 3) == 3 && jj + 1 < 64) imp[(hl * 64 + jj + 1) * 128 + tl] += pr; }
        { float* orow = OCMP + tok * 512 + head * 64; const float g0 = ((const float*)(p.ws + OFF_GATES))[tok * 24 + head * 3 + 0];
#pragma unroll
          for (int i = 0; i < 16; ++i) *(f32x4*)(orow + 4 * i) = (f32x4){g0 * o[4 * i], g0 * o[4 * i + 1], g0 * o[4 * i + 2], g0 * o[4 * i + 3]}; }
        __syncthreads();
        if (tid < 128) {
            const int cur = t >> 6;
            for (int j = 0; j < 64; ++j) { const float v = ((imp[(0 * 64 + j) * 128 + tl] + imp[(1 * 64 + j) * 128 + tl]) + imp[(2 * 64 + j) * 128 + tl]) + imp[(3 * 64 + j) * 128 + tl];
                const bool forced = (j == 0) || (j <= cur && j > cur - 2);
                imp[j * 128 + tl] = forced ? 1e30f : v; }
            unsigned long long mask = 0ull;
            for (int j = 0; j <= cur; ++j) { const float vj = imp[j * 128 + tl]; int rank = 0;
                for (int k = 0; k <= cur; ++k) { const float vk = imp[k * 128 + tl]; rank += (vk > vj || (vk == vj && k < j)) ? 1 : 0; }
                if (rank < 16) mask |= (1ull << j); }
            SELM[((size_t)b * 2 + g) * SEQ + t] = mask;
        }
        __syncthreads();
    }
}

DEV void phase5_selwin(const Params& p) {
    const int tid = opaque_tid(), wid = __builtin_amdgcn_readfirstlane(tid >> 6), lane = tid & 63;
    const int gw = blockIdx.x * 8 + wid, NGW = gridDim.x * 8;
    const bf16_t* NQ = (const bf16_t*)(p.ws + OFF_NQ); const bf16_t* KSR = (const bf16_t*)(p.ws + OFF_KSR); const bf16_t* KWR = (const bf16_t*)(p.ws + OFF_KWR);
    const bf16_t* PROJ = (const bf16_t*)(p.ws + OFF_PROJ); float* OCMP = (float*)(p.ws + OFF_OCMP); const float* GATES = (const float*)(p.ws + OFF_GATES);
    const unsigned long long* SELM = (const unsigned long long*)(p.ws + OFF_SELM); bf16_t* OCAT = (bf16_t*)(p.ws + OFF_OCAT);
    constexpr int NUNIT = BATCH * 8 * (SEQ / 64);
#pragma unroll 1
    for (int uu = gw; uu < NUNIT; uu += NGW) {
        const int u = (uu & 1) ? (NUNIT - 1 - (uu >> 1)) : (uu >> 1);
        const int tb = u % (SEQ / 64), head = (u / (SEQ / 64)) & 7, b = u / (SEQ / 64 * 8), g = head >> 2;
        const int t = tb * 64 + lane; const size_t tok = (size_t)b * SEQ + t;
        float q[64];
        { const bf16_t* qr = NQ + tok * 512 + head * 64;
#pragma unroll
          for (int i = 0; i < 32; ++i) { const unsigned w = *(const unsigned*)(qr + 2 * i); q[2 * i] = bflo(w); q[2 * i + 1] = bfhi(w); } }
        const unsigned long long mask = SELM[((size_t)b * 2 + g) * SEQ + t];
        unsigned ulo = (unsigned)mask, uhi = (unsigned)(mask >> 32);
#pragma unroll
        for (int o_ = 1; o_ < 64; o_ <<= 1) { ulo |= __shfl_xor(ulo, o_); uhi |= __shfl_xor(uhi, o_); }
        const unsigned long long um = ((unsigned long long)__builtin_amdgcn_readfirstlane(uhi) << 32) | (unsigned)__builtin_amdgcn_readfirstlane(ulo);
        float* oc = OCMP + tok * 512 + head * 64;
        { float o[64];
#pragma unroll
          for (int d = 0; d < 64; ++d) o[d] = 0.f;
          float m = -INFINITY, l = 0.f;
          const bf16_t* kb = KSR + (size_t)b * SEQ * 128 + g * 64; const bf16_t* vb = PROJ + (size_t)b * SEQ * INP + C_VS + g * 64;
#pragma unroll 1
          for (int blk = 0; blk <= tb; ++blk) { if (!((um >> blk) & 1ull)) continue; const bool sel = (mask >> blk) & 1ull;
              naive_attn_range<64, 64>(q, o, m, l, blk * 64, blk * 64 + 64,
                  [&](int j, int i) -> unsigned { return *(const unsigned*)(kb + (size_t)j * 128 + 2 * i); },
                  [&](int j, int i) -> unsigned { return *(const unsigned*)(vb + (size_t)j * INP + 2 * i); },
                  [&](int j) -> bool { return sel && j <= t; }); }
          const float g1 = GATES[tok * 24 + head * 3 + 1] / l;
#pragma unroll
          for (int i = 0; i < 16; ++i) { f32x4 c4 = *(f32x4*)(oc + 4 * i); c4.x += g1 * o[4 * i]; c4.y += g1 * o[4 * i + 1]; c4.z += g1 * o[4 * i + 2]; c4.w += g1 * o[4 * i + 3]; *(f32x4*)(oc + 4 * i) = c4; } }
        { float o[64];
#pragma unroll
          for (int d = 0; d < 64; ++d) o[d] = 0.f;
          float m = -INFINITY, l = 0.f;
          const bf16_t* kb = KWR + (size_t)b * SEQ * 128 + g * 64; const bf16_t* vb = PROJ + (size_t)b * SEQ * INP + C_VW + g * 64;
          const int jlo = (tb * 64 - 511 > 0) ? tb * 64 - 511 : 0;
          naive_attn_range<64, 64>(q, o, m, l, jlo, tb * 64 + 64,
              [&](int j, int i) -> unsigned { return *(const unsigned*)(kb + (size_t)j * 128 + 2 * i); },
              [&](int j, int i) -> unsigned { return *(const unsigned*)(vb + (size_t)j * INP + 2 * i); },
              [&](int j) -> bool { return j <= t && j > t - 512; });
          const float g2 = GATES[tok * 24 + head * 3 + 2] / l; bf16_t* orow = OCAT + tok * 1024 + 512 + head * 64;
#pragma unroll
          for (int i = 0; i < 16; ++i) { const f32x4 c4 = *(const f32x4*)(oc + 4 * i); u32x2 w; w.x = pk2(c4.x + g2 * o[4 * i], c4.y + g2 * o[4 * i + 1]); w.y = pk2(c4.z + g2 * o[4 * i + 2], c4.w + g2 * o[4 * i + 3]);
              *(u32x2*)(orow + 4 * i) = w; } }
    }
}

DEV void phase7(const Params& p, LAS unsigned char* lds) {
    const int tid = opaque_tid(), wid = __builtin_amdgcn_readfirstlane(tid >> 6), lane = tid & 63;
    const float* H1 = (const float*)(p.ws + OFF_H1); unsigned char* XN = p.ws + OFF_XN; float* SXTOK = (float*)(p.ws + OFF_SXTOK);
    int* TOPI = (int*)(p.ws + OFF_TOPI); float* TOPG = (float*)(p.ws + OFF_TOPG); int* POS = (int*)(p.ws + OFF_POS); unsigned* CNT = (unsigned*)(p.ws + OFF_CNT);
    LAS float* xt = (LAS float*)lds;
    LAS float* part = (LAS float*)(lds + 16 * 1028 * 4);
    LAS unsigned* lcnt = (LAS unsigned*)(lds + 16 * 1028 * 4 + 16384);
    const int ej = lane & 15, kq = lane >> 4, k0_ = 128 * wid + 32 * kq;
    float rw0[32], rw1[32];
#pragma unroll
    for (int i = 0; i < 32; ++i) { rw0[i] = p.router_w[(size_t)(k0_ + i) * 32 + ej]; rw1[i] = p.router_w[(size_t)(k0_ + i) * 32 + 16 + ej]; }
    const f32x4* gr = (const f32x4*)p.ffn_norm + lane;
    f32x4 gg[4];
#pragma unroll
    for (int j = 0; j < 4; ++j) gg[j] = gr[64 * j];
    for (int ch = blockIdx.x; ch < NTOK / 128; ch += gridDim.x) {
        if (tid < 32) lcnt[tid] = 0u;
        f32x4 nx[2][4];
#pragma unroll
        for (int rr = 0; rr < 2; ++rr) { const f32x4* xr = (const f32x4*)(H1 + (size_t)(ch * 128 + 2 * wid + rr) * DM) + lane;
#pragma unroll
            for (int j = 0; j < 4; ++j) nx[rr][j] = xr[64 * j]; }
        __syncthreads();
#pragma unroll 1
        for (int sub = 0; sub < 8; ++sub) {
            const int tok0 = ch * 128 + sub * 16;
#pragma unroll
            for (int rr = 0; rr < 2; ++rr) { const int row = 2 * wid + rr, tok = tok0 + row;
                f32x4 v[4]; float s_ = 0.f;
#pragma unroll
                for (int j = 0; j < 4; ++j) { v[j] = nx[rr][j]; s_ += (v[j].x * v[j].x + v[j].y * v[j].y) + (v[j].z * v[j].z + v[j].w * v[j].w); }
                if (sub + 1 < 8) { const f32x4* xr = (const f32x4*)(H1 + (size_t)(tok + 16) * DM) + lane;
#pragma unroll
                    for (int j = 0; j < 4; ++j) nx[rr][j] = xr[64 * j]; }
                const float rstd = rsqrtf(wave_sum(s_) * (1.f / 1024.f) + 1e-5f);
                float amax = 0.f;
#pragma unroll
                for (int j = 0; j < 4; ++j) { v[j].x *= rstd * gg[j].x; v[j].y *= rstd * gg[j].y; v[j].z *= rstd * gg[j].z; v[j].w *= rstd * gg[j].w;
                    amax = fmaxf(fmaxf(amax, fmaxf(fabsf(v[j].x), fabsf(v[j].y))), fmaxf(fabsf(v[j].z), fabsf(v[j].w))); *(LAS f32x4*)(xt + row * 1028 + 256 * j + 4 * lane) = v[j]; }
#pragma unroll
                for (int o_ = 1; o_ < 64; o_ <<= 1) amax = fmaxf(amax, __shfl_xor(amax, o_));
                amax = fmaxf(amax, 1e-30f); const float qinv = 127.0f / amax; if (lane == 0) SXTOK[tok] = amax * (1.0f / 127.0f);
                unsigned* o4 = (unsigned*)(XN + (size_t)tok * DM) + lane;
#pragma unroll
                for (int j = 0; j < 4; ++j) { const unsigned q0 = (unsigned)__float2int_rn(v[j].x * qinv) & 255u, q1 = (unsigned)__float2int_rn(v[j].y * qinv) & 255u, q2 = (unsigned)__float2int_rn(v[j].z * qinv) & 255u, q3 = (unsigned)__float2int_rn(v[j].w * qinv) & 255u;
                    o4[64 * j] = q0 | (q1 << 8) | (q2 << 16) | (q3 << 24); } }
            __syncthreads();
            { f32x4 acc0 = (f32x4){0.f, 0.f, 0.f, 0.f}, acc1 = acc0; const LAS float* xrow = xt + ej * 1028 + k0_;
#pragma unroll
              for (int s4 = 0; s4 < 8; ++s4) { const f32x4 xv = *(const LAS f32x4*)(xrow + 4 * s4);
#pragma unroll
                  for (int i = 0; i < 4; ++i) { acc0 = __builtin_amdgcn_mfma_f32_16x16x4f32(xv[i], rw0[4 * s4 + i], acc0, 0, 0, 0); acc1 = __builtin_amdgcn_mfma_f32_16x16x4f32(xv[i], rw1[4 * s4 + i], acc1, 0, 0, 0); } }
#pragma unroll
              for (int r = 0; r < 4; ++r) { part[(wid * 16 + 4 * kq + r) * 32 + ej] = acc0[r]; part[(wid * 16 + 4 * kq + r) * 32 + 16 + ej] = acc1[r]; } }
            __syncthreads();
            { const int tk = tid >> 5, e = tid & 31, tok = tok0 + tk; float logit = p.router_b[e];
#pragma unroll
              for (int w_ = 0; w_ < 8; ++w_) logit += part[(w_ * 16 + tk) * 32 + e];
              int ti[4]; float tv[4]; float cur = logit;
#pragma unroll
              for (int r = 0; r < 4; ++r) { float bv = cur; int bi = e;
#pragma unroll
                  for (int o_ = 1; o_ < 32; o_ <<= 1) { const float ov = __shfl_xor(bv, o_); const int oi = __shfl_xor(bi, o_); if (ov > bv || (ov == bv && oi < bi)) { bv = ov; bi = oi; } }
                  ti[r] = bi; tv[r] = bv; if (e == bi) cur = -INFINITY; }
              const float e1 = __expf(tv[1] - tv[0]), e2 = __expf(tv[2] - tv[0]), e3 = __expf(tv[3] - tv[0]); const float inv = 1.0f / (1.0f + e1 + e2 + e3);
              if (e == 0) {
                  *(f32x4*)(TOPG + (size_t)tok * 4) = (f32x4){inv, e1 * inv, e2 * inv, e3 * inv};
                  int ps[4];
#pragma unroll
                  for (int r = 0; r < 4; ++r) ps[r] = (int)__hip_atomic_fetch_add(&lcnt[ti[r]], 1u, __ATOMIC_RELAXED, __HIP_MEMORY_SCOPE_WORKGROUP);
                  int* ti_o = TOPI + (size_t)tok * 4; int* ps_o = POS + (size_t)tok * 4;
#pragma unroll
                  for (int r = 0; r < 4; ++r) { ti_o[r] = ti[r]; ps_o[r] = ps[r]; }
              } }
            __syncthreads();
        }
        if (tid < 32) lcnt[32 + tid] = atomicAdd(&CNT[tid], lcnt[tid]);
        __syncthreads();
        if (tid < 128) { const int tok = ch * 128 + tid; const int* ti_o = TOPI + (size_t)tok * 4; int* ps_o = POS + (size_t)tok * 4;
#pragma unroll
            for (int r = 0; r < 4; ++r) ps_o[r] += (int)lcnt[32 + ti_o[r]]; }
        __syncthreads();
    }
}

DEV void moe_offsets(const Params& p, LAS unsigned* tab) {
    const unsigned* CNT = (const unsigned*)(p.ws + OFF_CNT);
    const int tid = opaque_tid();
    if (tid < 64) {
        const int e = tid & 31; const unsigned c = __hip_atomic_load(&CNT[e], __ATOMIC_RELAXED, __HIP_MEMORY_SCOPE_AGENT);
        const unsigned pad = ((c + 255u) >> 8) << 8; unsigned inc = pad;
#pragma unroll
        for (int o_ = 1; o_ < 32; o_ <<= 1) { const unsigned v = __shfl_up(inc, o_, 32); if (e >= o_) inc += v; }
        if (tid < 32) { tab[e] = inc - pad; tab[32 + e] = inc >> 8; if (e == 31) tab[64] = inc; }
    }
    __syncthreads();
}
typedef int i32x4_ __attribute__((ext_vector_type(4)));
DEV void phase8(const Params& p, LAS unsigned char* lds) {
    const int tid = opaque_tid(), wid = tid >> 6, lane = tid & 63;
    const int gw = blockIdx.x * 8 + wid, NGW = gridDim.x * 8;
    LAS unsigned* tab = (LAS unsigned*)lds; moe_offsets(p, tab);
    const unsigned char* XN = p.ws + OFF_XN; unsigned char* XG = p.ws + OFF_XG;
    const int* TOPI = (const int*)(p.ws + OFF_TOPI); const float* TOPG = (const float*)(p.ws + OFF_TOPG); int* POS = (int*)(p.ws + OFF_POS); float* RG = (float*)(p.ws + OFF_ROWGATE);
    const float* SXTOK = (const float*)(p.ws + OFF_SXTOK); float* SXROW = (float*)(p.ws + OFF_SXROW);
    const int q = lane >> 4, sub = lane & 15;
    for (int tok4 = gw * 4; tok4 < NTOK; tok4 += NGW * 4) {
        const int tok = tok4 + q;
        const u32x4* src = (const u32x4*)(XN + (size_t)tok * DM) + sub;
        const u32x4 a0 = src[0], a1 = src[16], a2 = src[32], a3 = src[48];
        const i32x4_ te = *(const i32x4_*)(TOPI + (size_t)tok * 4), tp = *(const i32x4_*)(POS + (size_t)tok * 4); const f32x4 tg = *(const f32x4*)(TOPG + (size_t)tok * 4); const float sx = SXTOK[tok];
        int slot[4];
#pragma unroll
        for (int r = 0; r < 4; ++r) { slot[r] = (int)tab[te[r]] + tp[r];
            u32x4* dst = (u32x4*)(XG + (size_t)slot[r] * DM) + sub; dst[0] = a0; dst[16] = a1; dst[32] = a2; dst[48] = a3;
            if (sub == 0) { RG[slot[r]] = tg[r]; SXROW[slot[r]] = sx; } }
        if (sub == 0) *(i32x4_*)(POS + (size_t)tok * 4) = (i32x4_){slot[0], slot[1], slot[2], slot[3]};
    }
}

DEV void phase11(const Params& p) {
    const int tid = opaque_tid(), wid = tid >> 6, lane = tid & 63;
    const int gw = blockIdx.x * 8 + wid, NGW = gridDim.x * 8;
    const float* H1 = (const float*)(p.ws + OFF_H1); const bf16_t* Y = (const bf16_t*)(p.ws + OFF_Y); const int* POS = (const int*)(p.ws + OFF_POS);
    const f32x4* gr = (const f32x4*)p.final_norm + lane; f32x4 gg[4];
#pragma unroll
    for (int j = 0; j < 4; ++j) gg[j] = gr[64 * j];
    i32x4_ slot[2];
#pragma unroll
    for (int q = 0; q < 2; ++q) { const int t0 = 2 * gw + q; slot[q] = *(const i32x4_*)(POS + (size_t)(t0 < NTOK ? t0 : 0) * 4); }
#pragma unroll 1
    for (int tok2 = gw * 2; tok2 < NTOK; tok2 += NGW * 2) {
        f32x4 v[2][4]; u32x2 y[2][4][4];
#pragma unroll
        for (int q = 0; q < 2; ++q) { const f32x4* xr = (const f32x4*)(H1 + (size_t)(tok2 + q) * DM) + lane;
#pragma unroll
            for (int j = 0; j < 4; ++j) v[q][j] = xr[64 * j];
#pragma unroll
            for (int r = 0; r < 4; ++r) { const u32x2* yr = (const u32x2*)(Y + (size_t)slot[q][r] * DM) + lane;
#pragma unroll
                for (int j = 0; j < 4; ++j) y[q][r][j] = yr[64 * j]; } }
        i32x4_ nslot[2];
#pragma unroll
        for (int q = 0; q < 2; ++q) { const int t1 = tok2 + NGW * 2 + q; nslot[q] = *(const i32x4_*)(POS + (size_t)(t1 < NTOK ? t1 : 0) * 4); }
#pragma unroll
        for (int q = 0; q < 2; ++q) {
#pragma unroll
            for (int r = 0; r < 4; ++r)
#pragma unroll
                for (int j = 0; j < 4; ++j) { const u32x2 w = y[q][r][j]; v[q][j].x += bflo(w.x); v[q][j].y += bfhi(w.x); v[q][j].z += bflo(w.y); v[q][j].w += bfhi(w.y); }
            float s = 0.f;
#pragma unroll
            for (int j = 0; j < 4; ++j) s += (v[q][j].x * v[q][j].x + v[q][j].y * v[q][j].y) + (v[q][j].z * v[q][j].z + v[q][j].w * v[q][j].w);
            const float rstd = rsqrtf(wave_sum(s) * (1.f / 1024.f) + 1e-5f);
            f32x4* orow = (f32x4*)(p.out + (size_t)(tok2 + q) * DM) + lane;
#pragma unroll
            for (int j = 0; j < 4; ++j) orow[64 * j] = (f32x4){v[q][j].x * rstd * gg[j].x, v[q][j].y * rstd * gg[j].y, v[q][j].z * rstd * gg[j].z, v[q][j].w * rstd * gg[j].w}; }
        slot[0] = nslot[0]; slot[1] = nslot[1];
    }
}

constexpr int NPHASE = 14;
constexpr int LDS_BYTES = 163840;
template <int PH> DEV void run_phase(const Params& p, LAS unsigned char* lds) {
    using namespace pg8;
    const int G = gridDim.x, bid = blockIdx.x;
    if constexpr (PH == 0) phase0(p, lds);
    if constexpr (PH == 1) { Gemm g{1024, 0}; DenseOrder S; S.init(p.ws + OFF_U, p.ws + OFF_WINT, 1024, NTOK, INP, G, bid);
        EpiBf16 E{(bf16_t*)(p.ws + OFF_PROJ), INP}; gemm_phase(lds, g, S, E);
        const int rem = S.nwg % G;
        if (rem > 0 && rem < G) { if (bid >= rem) prep_w2_items(p, lds, (bid - rem) * 8, (G - rem) * 8); } else prep_w2_items(p, lds, bid * 8, G * 8); }
    if constexpr (PH == 2) phase2(p);
    if constexpr (PH == 3) {
        const int NC = (G >= 64) ? 32 : 0;
        if (bid < NC) { Gemm g{2048, 1}; CmpOrder S{(const char*)(p.ws + OFF_KCC), (const char*)(p.ws + OFF_VCC), (const char*)(p.ws + OFF_CW1T), bid};
            EpiCmp E{(const float*)(p.ws + OFF_CB), p.cmp_w2, p.pos, (bf16_t*)(p.ws + OFF_KC), (bf16_t*)(p.ws + OFF_VC)}; gemm_phase(lds, g, S, E); }
        else {
            { Gemm g{256, 0}; UpOrder S; S.q.init(p.ws + OFF_QN, p.ws + OFF_WQUPT, 256, NTOK, 768, 1, 0); S.kv.init(p.ws + OFF_KVN, p.ws + OFF_WKVUPT, 256, NTOK, 1024, 1, 0); S.G = G - NC; S.c = bid - NC;
              EpiUp E{EpiQup{(bf16_t*)(p.ws + OFF_QM), (const float*)(p.ws + OFF_ROPEM)}, EpiKvup{(bf16_t*)(p.ws + OFF_KM), (bf16_t*)(p.ws + OFF_VM)}}; gemm_phase(lds, g, S, E); }
        }
        if (NC == 0) for (int k = bid; k < 32; k += G) { Gemm g{2048, 1}; CmpOrder S{(const char*)(p.ws + OFF_KCC), (const char*)(p.ws + OFF_VCC), (const char*)(p.ws + OFF_CW1T), k};
            EpiCmp E{(const float*)(p.ws + OFF_CB), p.cmp_w2, p.pos, (bf16_t*)(p.ws + OFF_KC), (bf16_t*)(p.ws + OFF_VC)}; gemm_phase(lds, g, S, E); }
        prep_w1_items(p, lds);
    }
    if constexpr (PH == 5) phase5_mla_fa(p, lds);
    if constexpr (PH == 6) phase5_nsa_fa(p, lds);
    if constexpr (PH == 8) { Gemm g{1024, 0}; DenseOrder S; S.init(p.ws + OFF_OCAT, p.ws + OFF_WOUTT, 1024, NTOK, 1024, G, bid);
        EpiResF32 E{p.x, (float*)(p.ws + OFF_H1), 1024}; gemm_phase(lds, g, S, E); }
    if constexpr (PH == 9) phase7(p, lds);
    if constexpr (PH == 10) phase8(p, lds);
    if constexpr (PH == 11) { LAS unsigned* tab = (LAS unsigned*)(lds + STAGE_BYTES); moe_offsets(p, tab);
        Gemm g{512, 0}; MoeOrder S; S.d.init(p.ws + OFF_XG, p.ws + OFF_W1T, 512, (int)tab[64], 2048, G, bid); S.tend = tab + 32; S.nNt = 8;
        EpiMoe1 E{(bf16_t*)(p.ws + OFF_HMID), p.moe_b1, (const float*)(p.ws + OFF_SW1), (const float*)(p.ws + OFF_SXROW)}; gemm_phase<EpiMoe1, MoeOrder, true>(lds, g, S, E); }
    if constexpr (PH == 12) { LAS unsigned* tab = (LAS unsigned*)(lds + STAGE_BYTES); moe_offsets(p, tab);
        Gemm g{1024, 0}; MoeOrder S; S.d.init(p.ws + OFF_HMID, p.ws + OFF_W2T, 1024, (int)tab[64], 1024, G, bid); S.tend = tab + 32; S.nNt = 4;
        EpiMoe2 E{(bf16_t*)(p.ws + OFF_Y), p.moe_b2, (const float*)(p.ws + OFF_ROWGATE)}; gemm_phase(lds, g, S, E); }
    if constexpr (PH == 13) phase11(p);
}

template <int PH> __global__ void __launch_bounds__(512) phase_kernel(Params p) {
    extern __shared__ __attribute__((aligned(16))) unsigned char smem[];
    run_phase<PH>(p, (LAS unsigned char*)smem);
}

#if MK_ONE_LAUNCH
__global__ void __launch_bounds__(512) mega_kernel(Params p) {
    extern __shared__ __attribute__((aligned(16))) unsigned char smem[];
    LAS unsigned char* lds = (LAS unsigned char*)smem;
    cg::grid_group grid = cg::this_grid();
    volatile LAS unsigned* st = (volatile LAS unsigned*)(lds + LDS_BYTES - 16);
    if (threadIdx.x == 0) { st[0] = 0u; st[1] = 0u; }
    __syncthreads();
    const XcdBarrier xb = xcd_barrier_post((unsigned*)(p.ws + OFF_BAR), st);
#define GSYNC() xcd_barrier(xb)
    if (p.ws == nullptr) grid.sync();
    run_phase<0>(p, lds); GSYNC();
    run_phase<1>(p, lds); GSYNC();
    run_phase<2>(p, lds); GSYNC();
    run_phase<3>(p, lds); GSYNC();
    run_phase<5>(p, lds); run_phase<6>(p, lds); GSYNC();
    run_phase<8>(p, lds); GSYNC();
    run_phase<9>(p, lds); GSYNC();
    run_phase<10>(p, lds); GSYNC();
    run_phase<11>(p, lds); GSYNC();
    run_phase<12>(p, lds); GSYNC();
    run_phase<13>(p, lds);
}
#endif

template <int PH> static void launch_phase(const Params& p, int grid, hipStream_t stream) {
    static bool attr = false;
    if (!attr) { (void)hipFuncSetAttribute((const void*)phase_kernel<PH>, hipFuncAttributeMaxDynamicSharedMemorySize, LDS_BYTES); attr = true; }
    hipLaunchKernelGGL(phase_kernel<PH>, dim3(grid), dim3(512), LDS_BYTES, stream, p);
}

extern "C" void kernel_launch(void* const* d_in, const int* in_sizes, int n_in, void* d_out, int out_size, void* d_ws, size_t ws_size, hipStream_t stream) {
    static int grid = 0;
    if (grid == 0) {
        if (n_in != 20 || out_size != NTOK * DM || ws_size < WS_END) { fprintf(stderr, "kernel_launch: unexpected shapes (n_in %d, out %d, ws %zu < %zu)\n", n_in, out_size, ws_size, (size_t)WS_END); grid = -1; return; }
        int dev = 0, cus = 0, per_cu = 0;
        (void)hipGetDevice(&dev); (void)hipDeviceGetAttribute(&cus, hipDeviceAttributeMultiprocessorCount, dev);
#if MK_ONE_LAUNCH
        (void)hipFuncSetAttribute((const void*)mega_kernel, hipFuncAttributeMaxDynamicSharedMemorySize, LDS_BYTES);
        (void)hipOccupancyMaxActiveBlocksPerMultiprocessor(&per_cu, (const void*)mega_kernel, 512, LDS_BYTES);
        if (per_cu < 1) { fprintf(stderr, "kernel_launch: occupancy query says %d blocks per CU\n", per_cu); per_cu = 1; }
#endif
        (void)hipGetLastError();
        grid = cus * 1;
        if (grid <= 0) grid = 256;
    }
    if (grid < 0) return;
    Params p; memset(&p, 0, sizeof(p));
    p.x = (const float*)d_in[0]; p.pos = (const int*)d_in[1]; p.attn_norm = (const float*)d_in[2]; p.w_in = (const float*)d_in[3]; p.q_norm = (const float*)d_in[4];
    p.w_q_up = (const float*)d_in[5]; p.kv_norm = (const float*)d_in[6]; p.w_kv_up = (const float*)d_in[7]; p.cmp_pos = (const float*)d_in[8]; p.cmp_w1 = (const float*)d_in[9];
    p.cmp_w2 = (const float*)d_in[10]; p.w_out = (const float*)d_in[11]; p.ffn_norm = (const float*)d_in[12]; p.router_w = (const float*)d_in[13]; p.router_b = (const float*)d_in[14];
    p.moe_w1 = (const float*)d_in[15]; p.moe_b1 = (const float*)d_in[16]; p.moe_w2 = (const float*)d_in[17]; p.moe_b2 = (const float*)d_in[18]; p.final_norm = (const float*)d_in[19];
    p.out = (float*)d_out; p.ws = (unsigned char*)d_ws;
#if MK_ONE_LAUNCH
    (void)hipMemsetAsync((unsigned char*)d_ws + OFF_BAR, 0, XCD_BAR_WORDS * 4, stream);
    void* args[] = {&p};
    hipError_t e = hipLaunchCooperativeKernel((const void*)mega_kernel, dim3(grid), dim3(512), args, LDS_BYTES, stream);
    if (e != hipSuccess) fprintf(stderr, "cooperative launch failed: %s (grid %d)\n", hipGetErrorString(e), grid);
#else
    launch_phase<0>(p, grid, stream); launch_phase<1>(p, grid, stream); launch_phase<2>(p, grid, stream); launch_phase<3>(p, grid, stream); launch_phase<4>(p, grid, stream);
    launch_phase<5>(p, grid, stream); launch_phase<6>(p, grid, stream); launch_phase<7>(p, grid, stream); launch_phase<8>(p, grid, stream); launch_phase<9>(p, grid, stream);
    launch_phase<10>(p, grid, stream); launch_phase<11>(p, grid, stream); launch_phase<12>(p, grid, stream); launch_phase<13>(p, grid, stream);
#endif
}
```

```cpp
#include <hip/hip_runtime.h>
#include <hip/hip_cooperative_groups.h>
#include <cstdint>
#include <cstdio>
#include <cstring>
namespace cg = cooperative_groups;

#ifndef MK_ONE_LAUNCH
#define MK_ONE_LAUNCH 1
#endif

#define LAS __attribute__((address_space(3)))
#define DEV __device__ __forceinline__
typedef unsigned short bf16_t;
typedef short bf16x8 __attribute__((ext_vector_type(8)));
typedef float f32x4 __attribute__((ext_vector_type(4)));
typedef float f32x2 __attribute__((ext_vector_type(2)));
typedef unsigned u32x4 __attribute__((ext_vector_type(4)));
typedef unsigned u32x2 __attribute__((ext_vector_type(2)));

constexpr int BATCH = 8, SEQ = 4096, NTOK = BATCH * SEQ, DM = 1024;
constexpr int INC = 1720, INP = 1792;
constexpr int C_QLAT = 0, C_KVLAT = 256, C_KPE = 384, C_QNSA = 416, C_KC = 928, C_VC = 1056, C_KS = 1184, C_VS = 1312, C_KW = 1440, C_VW = 1568, C_G = 1696;
constexpr int NEXP = 32, TOPK = 4, DFF = 1024;
constexpr int NCMP = 255, NCMPP = 256;
constexpr int MAXROWS = 139264;
constexpr float LOG2E = 1.4426950408889634f;
constexpr float MLA_QSCALE = 0.10206207261596577f * LOG2E;
constexpr float NSA_QSCALE = 0.125f * LOG2E;

constexpr size_t MiB = 1ull << 20;
constexpr size_t OFF_W1T = 0;
constexpr size_t OFF_W2T = 128 * MiB;
constexpr size_t OFF_WINT = 192 * MiB;
constexpr size_t OFF_WQUPT = 196 * MiB;
constexpr size_t OFF_WKVUPT = 197 * MiB;
constexpr size_t OFF_WOUTT = 198 * MiB;
constexpr size_t OFF_CW1T = 200 * MiB;
constexpr size_t OFF_MISC = 202 * MiB;
constexpr size_t OFF_CB = OFF_MISC + 8192;
constexpr size_t OFF_CNT = OFF_MISC + 4096;
constexpr size_t OFF_BAR = OFF_MISC + 16384;
constexpr size_t OFF_TOPI = OFF_MISC + 64 * 1024;
constexpr size_t OFF_TOPG = OFF_TOPI + (size_t)NTOK * 16;
constexpr size_t OFF_POS = OFF_TOPG + (size_t)NTOK * 16;
constexpr size_t OFF_ROWGATE = OFF_POS + (size_t)NTOK * 16;
constexpr size_t OFF_SXROW = OFF_ROWGATE + (size_t)MAXROWS * 4;
constexpr size_t OFF_SXTOK = OFF_SXROW + (size_t)MAXROWS * 4;
constexpr size_t OFF_ROWTOK = OFF_SXTOK + (size_t)NTOK * 4;
constexpr size_t OFF_SW1 = OFF_ROWTOK + (size_t)MAXROWS * 4;
constexpr size_t OFF_H1 = 206 * MiB;
constexpr size_t OFF_R1 = 334 * MiB;
constexpr size_t OFF_R2 = 606 * MiB;
constexpr size_t WS_END = 878 * MiB;
constexpr size_t OFF_U = OFF_R1;
constexpr size_t OFF_QM = OFF_R1;
constexpr size_t OFF_OCAT = OFF_R1 + 64 * MiB;
constexpr size_t OFF_OCMP = OFF_R1 + 160 * MiB;
constexpr size_t OFF_KCC = OFF_R1 + 128 * MiB;
constexpr size_t OFF_VCC = OFF_R1 + 136 * MiB;
constexpr size_t OFF_VSC = OFF_R1 + 144 * MiB;
constexpr size_t OFF_VWC = OFF_R1 + 152 * MiB;
constexpr size_t OFF_SELM = OFF_R1 + 240 * MiB;
constexpr size_t OFF_KC = OFF_R1 + 241 * MiB;
constexpr size_t OFF_VC = OFF_R1 + 242 * MiB;
constexpr size_t OFF_GATES = OFF_R1 + 243 * MiB;
constexpr size_t OFF_ROPEM = OFF_R1 + 246 * MiB;
constexpr size_t OFF_KSR = OFF_R1 + 250 * MiB;
constexpr size_t OFF_KWR = OFF_R1 + 258 * MiB;
constexpr size_t OFF_PROJ = OFF_R2;
constexpr size_t OFF_NQ = OFF_R2 + 112 * MiB;
constexpr size_t OFF_QN = OFF_R2 + 144 * MiB;
constexpr size_t OFF_KVN = OFF_R2 + 160 * MiB;
constexpr size_t OFF_KM = OFF_R2 + 176 * MiB;
constexpr size_t OFF_VM = OFF_R2 + 224 * MiB;
constexpr size_t OFF_QUP = OFF_R2 + 256 * MiB;
constexpr size_t OFF_KVUP = OFF_R2 + 256 * MiB;
constexpr size_t OFF_KPE = OFF_R2 + 256 * MiB;
constexpr size_t OFF_XN = OFF_R1 + 0;
constexpr size_t OFF_XG = OFF_R1;
constexpr size_t OFF_Y = OFF_R1;
constexpr size_t OFF_HMID = OFF_R2;

struct Params {
    const float* x; const int* pos; const float* attn_norm; const float* w_in; const float* q_norm; const float* w_q_up; const float* kv_norm; const float* w_kv_up;
    const float* cmp_pos; const float* cmp_w1; const float* cmp_w2; const float* w_out; const float* ffn_norm; const float* router_w; const float* router_b;
    const float* moe_w1; const float* moe_b1; const float* moe_w2; const float* moe_b2; const float* final_norm;
    float* out; unsigned char* ws;
};

DEV float bf2f(bf16_t b) { return __uint_as_float((unsigned)b << 16); }
DEV float bflo(unsigned u) { return __uint_as_float(u << 16); }
DEV float bfhi(unsigned u) { return __uint_as_float(u & 0xffff0000u); }
DEV unsigned pk2(float lo, float hi) { unsigned r; asm volatile("v_cvt_pk_bf16_f32 %0, %1, %2" : "=v"(r) : "v"(lo), "v"(hi)); return r; }
DEV bf16_t f2bf(float f) { return (bf16_t)(pk2(f, 0.f) & 0xffffu); }
DEV float wave_sum(float v) {
#pragma unroll
    for (int o = 1; o < 64; o <<= 1) v += __shfl_xor(v, o);
    return v;
}
DEV float fast_exp2(float x) { return __builtin_amdgcn_exp2f(x); }
DEV int opaque_tid() { int t = threadIdx.x; asm volatile("" : "+v"(t)); return t; }

#define XB_TMO      128
#define XB_XCNT(j)  (256  + 64 * (j))
#define XB_XSUB(j)  (1280 + 64 * (j))
#define XB_XGEN(j)  (2304 + 64 * (j))
#define XB_TOP      3328
#define XB_TOPGEN   3392
#define XCD_BAR_WORDS 3456
#define XB_SPIN_CAP (1u << 22)
DEV unsigned xb_ld(unsigned* p) { return __hip_atomic_load(p, __ATOMIC_RELAXED, __HIP_MEMORY_SCOPE_AGENT); }
DEV unsigned xb_add(unsigned* p, unsigned v) { return __hip_atomic_fetch_add(p, v, __ATOMIC_RELAXED, __HIP_MEMORY_SCOPE_AGENT); }
DEV unsigned xb_xcc_id() { return (unsigned)__builtin_amdgcn_s_getreg((3 << 11) | 20) & 0xFu; }
#define XB_SPIN(cond, bar) do { unsigned _sp = 0; while (cond) { __builtin_amdgcn_s_sleep(1); \
    if ((++_sp & 255u) == 0u) { if (xb_ld(&(bar)[XB_TMO])) break; if (_sp > XB_SPIN_CAP) { atomicAdd(&(bar)[XB_TMO], 1u); break; } } } } while (0)
struct XcdBarrier { unsigned* bar; unsigned x; volatile LAS unsigned* st; };
DEV XcdBarrier xcd_barrier_post(unsigned* bar, volatile LAS unsigned* st) {
    XcdBarrier b; b.bar = bar; b.x = xb_xcc_id(); b.st = st;
    if (threadIdx.x == 0) (void)xb_add(&bar[XB_XCNT(b.x)], 1u);
    return b;
}
DEV void xcd_barrier_complete(unsigned* bar, unsigned x, unsigned& nloc, unsigned& nx) {
    const unsigned G = gridDim.x * gridDim.y * gridDim.z;
    unsigned sum, cnt, mine, sp = 0u;
    for (;;) {
        sum = 0u; cnt = 0u; mine = 0u;
#pragma unroll
        for (unsigned j = 0; j < 16; ++j) { const unsigned c = xb_ld(&bar[XB_XCNT(j)]); sum += c; cnt += (c > 0u) ? 1u : 0u; mine = (j == x) ? c : mine; }
        if (sum == G) break;
        __builtin_amdgcn_s_sleep(1);
        if ((++sp & 255u) == 0u) { if (xb_ld(&bar[XB_TMO])) break; if (sp > XB_SPIN_CAP) { atomicAdd(&bar[XB_TMO], 1u); break; } }
    }
    nloc = mine > 0u ? mine : 1u; nx = cnt > 0u ? cnt : 1u;
}
DEV void xcd_barrier(const XcdBarrier& b) {
    asm volatile("s_waitcnt vmcnt(0)" ::: "memory");
    __syncthreads();
    if (threadIdx.x == 0) {
        unsigned* bar = b.bar;
        __builtin_amdgcn_s_waitcnt(0);
        unsigned nloc = b.st[0], nx = b.st[1];
        if (nloc == 0u) { xcd_barrier_complete(bar, b.x, nloc, nx); b.st[0] = nloc; b.st[1] = nx; }
        const unsigned old = xb_add(&bar[XB_XSUB(b.x)], 1u);
        const unsigned gen = old / nloc;
        if (old + 1u == (gen + 1u) * nloc) {
            __builtin_amdgcn_fence(__ATOMIC_RELEASE, "agent");
            asm volatile("s_waitcnt vmcnt(0)" ::: "memory");
            const unsigned og = xb_add(&bar[XB_TOP], 1u);
            const unsigned tg = og / nx;
            if (og + 1u == (tg + 1u) * nx) xb_add(&bar[XB_TOPGEN], 1u);
            else XB_SPIN(xb_ld(&bar[XB_TOPGEN]) == tg, bar);
            __builtin_amdgcn_fence(__ATOMIC_ACQUIRE, "agent");
            xb_add(&bar[XB_XGEN(b.x)], 1u);
            asm volatile("s_waitcnt vmcnt(0)" ::: "memory");
        } else {
            XB_SPIN(xb_ld(&bar[XB_XGEN(b.x)]) == gen, bar);
            __builtin_amdgcn_fence(__ATOMIC_ACQUIRE, "agent");
            asm volatile("s_waitcnt vmcnt(0)" ::: "memory");
        }
    }
    __syncthreads();
}

namespace pg8 {
constexpr int BM = 256, BK = 64, HALF = 128, HTB = HALF * BK * 2, STAGE_BYTES = 8 * HTB, NXCD = 8, WGM = 8;
DEV int lds_byte(int r, int c) { const int st = (r >> 4) * 2 + (c >> 5), rr = r & 15, cc = c & 31, ob = rr * 64 + cc * 2; return st * 1024 + (ob ^ (((ob >> 9) & 1) << 5)); }
DEV void stage_rc(int b, int& R, int& C) { const int st = b / 1024, sb = b % 1024, swz = sb ^ (((sb >> 9) & 1) << 5); R = (st >> 1) * 16 + swz / 64; C = (st & 1) * 32 + (swz % 64) / 2; }

struct Unit { int pm, pn, e; const char* a; const char* b; };
struct Gemm { int K; int amode; const LAS int* rt = nullptr; };

struct DenseOrder {
    int nM, nN, nwg, G, c; const char* A; const char* Bt; size_t tstep;
    DEV void init(const void* A_, const void* Bt_, int K, int M, int N, int G_, int c_) { A = (const char*)A_; Bt = (const char*)Bt_; tstep = (size_t)BM * K * 2; nM = M / BM; nN = N / BM; nwg = nM * nN; G = G_; c = c_; }
    DEV bool next(int i, Unit& u) const {
        const long L = (long)i * G + c; if (L >= nwg) return false;
        int wgid = (int)L; { const int q = nwg / NXCD, r = nwg % NXCD, xcd = wgid % NXCD, off = wgid / NXCD; wgid = (xcd < r ? xcd * (q + 1) : r * (q + 1) + (xcd - r) * q) + off; }
        const int nig = WGM * nN, gid = wgid / nig, fm = gid * WGM, gsz = (nM - fm) < WGM ? (nM - fm) : WGM;
        u.pm = fm + ((wgid % nig) % gsz); u.pn = (wgid % nig) / gsz; u.e = 0; u.a = A + (size_t)u.pm * tstep; u.b = Bt + (size_t)u.pn * tstep; return true;
    }
};
struct MoeOrder {
    DenseOrder d; const LAS unsigned* tend;
    int nNt;
    bool gatherA = false;
    DEV bool next(int i, Unit& u) const {
        if (!d.next(i, u)) return false;
        const int e = __builtin_popcountll(__ballot(u.pm >= (int)tend[threadIdx.x & 31]) & 0xffffffffull);
        u.e = e; u.b = d.Bt + (size_t)(e * nNt + u.pn) * d.tstep; if (gatherA) u.a = d.A; return true;
    }
};

struct CmpOrder {
    const char* KCC; const char* VCC; const char* W; int k;
    DEV bool next(int i, Unit& u) const {
        if (i != 0 || k < 0) return false;
        const int c = k >> 4, pm = k & 15, b = pm >> 1, n0 = (pm & 1) * 128;
        u.pm = pm; u.pn = 0; u.e = c; u.a = (c == 0 ? KCC : VCC) + (size_t)(b * SEQ + 16 * n0) * 128 * 2; u.b = W + (size_t)c * 256 * 2048 * 2; return true;
    }
};

typedef int i32x4 __attribute__((ext_vector_type(4)));
template <class Epi, class Sched, bool I8 = false>
DEV void gemm_phase(LAS unsigned char* lds, const Gemm g, const Sched& S, const Epi& E) {
    const int tid = opaque_tid(), wid = __builtin_amdgcn_readfirstlane(tid >> 6), lane = tid & 63, wr = wid >> 2, wc = wid & 3, fr = lane & 15, fq = lane >> 4;
    const int K = g.K; int nt = K / BK; asm volatile("" : "+s"(nt));
    unsigned voffA[2], voffB[2];
#pragma unroll
    for (int i = 0; i < 2; ++i) { int R, C; stage_rc(tid * 16 + i * 8192, R, C); voffB[i] = (unsigned)(R * K + C) * 2u;
        voffA[i] = (g.amode == 1) ? (unsigned)((R >> 1) * 16 * 128 + (R & 1) * 64 + C) * 2u : voffB[i]; }
    const size_t kstepB = (size_t)(BK * 2), kstepA = (g.amode == 1) ? (size_t)128 * 2 : kstepB;
    const size_t hstepB = (size_t)HALF * K * 2, hstepA = (g.amode == 0) ? hstepB : (g.amode == 1) ? (size_t)64 * 16 * 128 * 2 : (size_t)0;
    int RA[2], CA[2];
#pragma unroll
    for (int i = 0; i < 2; ++i) stage_rc(tid * 16 + i * 8192, RA[i], CA[i]);
    unsigned gc[2][2], gn[2][2];
    auto gload = [&](int ui_, unsigned (&o_)[2][2]) {
#pragma unroll
        for (int h = 0; h < 2; ++h)
#pragma unroll
            for (int i = 0; i < 2; ++i) o_[h][i] = (unsigned)g.rt[ui_ * 256 + h * HALF + RA[i]] * (unsigned)(K * 2) + (unsigned)(CA[i] * 2); };
    const unsigned ldsw = (unsigned)wid * 1024u;
    const int aoff = lds_byte(wr * 64 + fr, fq * 8), boff = lds_byte(wc * 32 + fr, fq * 8);
#define PG8_SA(b, h) (((b) * 2 + (h)) * HTB)
#define PG8_SB(b, h) ((4 + (b) * 2 + (h)) * HTB)
#define PG8_STAGE(bufoff, gbase, voff) do { _Pragma("unroll") for (int _i = 0; _i < 2; ++_i) \
        __builtin_amdgcn_global_load_lds((const unsigned*)((const char*)(gbase) + (voff)[_i]), (LAS unsigned*)(lds + (bufoff) + ldsw + _i * 8192), 16, 0, 0); } while (0)
#define PG8_VA(h, nx) ((g.amode == 2) ? ((nx) ? gn[h] : gc[h]) : voffA)
#define PG8_LDA(dst, b, h) do { _Pragma("unroll") for (int m = 0; m < 4; ++m) _Pragma("unroll") for (int k = 0; k < 2; ++k) dst[m][k] = *(const LAS bf16x8*)(lds + PG8_SA(b, h) + aoff + m * 2048 + k * 1024); } while (0)
#define PG8_LDB(dst, b, h) do { _Pragma("unroll") for (int n = 0; n < 2; ++n) _Pragma("unroll") for (int k = 0; k < 2; ++k) dst[n][k] = *(const LAS bf16x8*)(lds + PG8_SB(b, h) + boff + n * 2048 + k * 1024); } while (0)
#define PG8_MMA(ai, bj, At, Bt) do { __builtin_amdgcn_s_setprio(1); _Pragma("unroll") for (int m = 0; m < 4; ++m) _Pragma("unroll") for (int n = 0; n < 2; ++n) _Pragma("unroll") for (int k = 0; k < 2; ++k) { \
        if constexpr (I8) acc[ai][bj][m][n] = __builtin_bit_cast(f32x4, __builtin_amdgcn_mfma_i32_16x16x64_i8(__builtin_bit_cast(i32x4, Bt[n][k]), __builtin_bit_cast(i32x4, At[m][k]), __builtin_bit_cast(i32x4, acc[ai][bj][m][n]), 0, 0, 0)); \
        else acc[ai][bj][m][n] = __builtin_amdgcn_mfma_f32_16x16x32_bf16(Bt[n][k], At[m][k], acc[ai][bj][m][n], 0, 0, 0); } __builtin_amdgcn_s_setprio(0); } while (0)
#define PG8_WAIT_V(n) asm volatile("s_waitcnt vmcnt(" #n ")" ::: "memory")
#define PG8_WAIT_L(n) asm volatile("s_waitcnt lgkmcnt(" #n ")" ::: "memory")
#define PG8_BAR __builtin_amdgcn_s_barrier()
#define PG8_SCHED __builtin_amdgcn_sched_barrier(0)
    Unit cur, nxt; int ui = 0;
    if (!S.next(0, cur)) return;
    f32x4 acc[2][2][4][2];
#pragma unroll
    for (int a = 0; a < 2; ++a)
#pragma unroll
        for (int b = 0; b < 2; ++b)
#pragma unroll
            for (int m = 0; m < 4; ++m)
#pragma unroll
                for (int n = 0; n < 2; ++n) acc[a][b][m][n] = (f32x4){0.f, 0.f, 0.f, 0.f};
    bf16x8 At[4][2], B0[2][2], B1[2][2];
    const char* cA = cur.a; const char* cB = cur.b;
    if (g.amode == 2) { gload(0, gc); asm volatile("s_waitcnt lgkmcnt(0)" ::: "memory"); }
    PG8_STAGE(PG8_SB(0, 0), cB, voffB); PG8_STAGE(PG8_SB(0, 1), cB + hstepB, voffB); PG8_STAGE(PG8_SA(0, 0), cA, PG8_VA(0, false)); PG8_STAGE(PG8_SA(0, 1), cA + hstepA, PG8_VA(1, false));
    if (wr == 1) PG8_BAR;
    PG8_WAIT_V(2); PG8_BAR;
    PG8_STAGE(PG8_SB(1, 0), cB + kstepB, voffB); PG8_STAGE(PG8_SA(1, 0), cA + kstepA, PG8_VA(0, false)); PG8_STAGE(PG8_SB(1, 1), cB + hstepB + kstepB, voffB);
    PG8_WAIT_V(6); PG8_BAR;
    for (;;) {
        const bool has_next = S.next(ui + 1, nxt);
        if (g.amode == 2) { if (has_next) gload(ui + 1, gn); else { gn[0][0] = gc[0][0]; gn[0][1] = gc[0][1]; gn[1][0] = gc[1][0]; gn[1][1] = gc[1][1]; } }
        const char* nA = has_next ? nxt.a : cA; const char* nB = has_next ? nxt.b : cB;
#pragma unroll 1
        for (int t = 0; t < nt; t += 2) {
            const bool last = (t == nt - 2);
            const char* a1 = cA + (size_t)(t + 1) * kstepA;
            const char* a2 = last ? nA : cA + (size_t)(t + 2) * kstepA; const char* b2 = last ? nB : cB + (size_t)(t + 2) * kstepB;
            const char* a3 = a2 + kstepA; const char* b3 = b2 + kstepB;
            PG8_LDB(B0, 0, 0); PG8_LDB(B1, 0, 1); PG8_SCHED; PG8_LDA(At, 0, 0); PG8_STAGE(PG8_SA(1, 1), a1 + hstepA, PG8_VA(1, false));
            PG8_WAIT_V(8); PG8_WAIT_L(0); PG8_BAR; PG8_MMA(0, 0, At, B0); PG8_MMA(0, 1, At, B1); PG8_BAR; PG8_SCHED;
            PG8_LDA(At, 0, 1); PG8_STAGE(PG8_SB(0, 0), b2, voffB); PG8_STAGE(PG8_SB(0, 1), b2 + hstepB, voffB); PG8_STAGE(PG8_SA(0, 0), a2, PG8_VA(0, last));
            PG8_WAIT_V(8); PG8_WAIT_L(0); PG8_BAR; PG8_MMA(1, 0, At, B0); PG8_MMA(1, 1, At, B1); PG8_BAR; PG8_SCHED;
            PG8_LDB(B0, 1, 0); PG8_LDB(B1, 1, 1); PG8_SCHED; PG8_LDA(At, 1, 0); PG8_STAGE(PG8_SA(0, 1), a2 + hstepA, PG8_VA(1, last));
            PG8_WAIT_V(8); PG8_WAIT_L(0); PG8_BAR; PG8_MMA(0, 0, At, B0); PG8_MMA(0, 1, At, B1); PG8_BAR; PG8_SCHED;
            PG8_LDA(At, 1, 1); PG8_STAGE(PG8_SB(1, 0), b3, voffB); PG8_STAGE(PG8_SB(1, 1), b3 + hstepB, voffB); PG8_STAGE(PG8_SA(1, 0), a3, PG8_VA(0, last));
            PG8_WAIT_V(8); PG8_WAIT_L(0); PG8_BAR; PG8_MMA(1, 0, At, B0); PG8_MMA(1, 1, At, B1); PG8_BAR; PG8_SCHED;
        }
        if (wr == 0) PG8_BAR;
        if constexpr (!Epi::AFTER_DRAIN) E(acc, cur, wr, wc, fr, fq);
        if (!has_next) break;
#pragma unroll
        for (int a = 0; a < 2; ++a)
#pragma unroll
            for (int b = 0; b < 2; ++b)
#pragma unroll
                for (int m = 0; m < 4; ++m)
#pragma unroll
                    for (int n = 0; n < 2; ++n) acc[a][b][m][n] = (f32x4){0.f, 0.f, 0.f, 0.f};
        cur = nxt; cA = nA; cB = nB; ++ui;
        if (g.amode == 2) { gc[0][0] = gn[0][0]; gc[0][1] = gn[0][1]; gc[1][0] = gn[1][0]; gc[1][1] = gn[1][1]; }
        if (wr == 1) PG8_BAR;
    }
    PG8_WAIT_V(0);
    PG8_BAR;
    if constexpr (Epi::AFTER_DRAIN) E.fused(acc, cur, wr, wc, fr, fq, lds);
#undef PG8_SA
#undef PG8_SB
#undef PG8_STAGE
#undef PG8_VA
#undef PG8_LDA
#undef PG8_LDB
#undef PG8_MMA
#undef PG8_WAIT_V
#undef PG8_WAIT_L
#undef PG8_BAR
#undef PG8_SCHED
}
struct EpiBf16 {
    static constexpr bool AFTER_DRAIN = false;
    bf16_t* O; int ldc;
    DEV void operator()(const f32x4 (&acc)[2][2][4][2], const Unit& u, int wr, int wc, int fr, int fq) const {
#pragma unroll
        for (int ai = 0; ai < 2; ++ai)
#pragma unroll
            for (int m = 0; m < 4; ++m) { bf16_t* rowp = O + (size_t)(u.pm * BM + ai * HALF + wr * 64 + m * 16 + fr) * ldc + u.pn * BM + wc * 32 + 4 * fq;
#pragma unroll
                for (int bj = 0; bj < 2; ++bj)
#pragma unroll
                    for (int n = 0; n < 2; ++n) { const f32x4 v = acc[ai][bj][m][n]; u32x2 w; w.x = pk2(v[0], v[1]); w.y = pk2(v[2], v[3]); *(u32x2*)(rowp + bj * HALF + n * 16) = w; } }
    }
};
struct EpiResF32 {
    static constexpr bool AFTER_DRAIN = false;
    const float* base; float* out; int ldc;
    DEV void operator()(const f32x4 (&acc)[2][2][4][2], const Unit& u, int wr, int wc, int fr, int fq) const {
#pragma unroll
        for (int ai = 0; ai < 2; ++ai) { f32x4 b[4][2][2];
#pragma unroll
            for (int m = 0; m < 4; ++m) { const size_t off = (size_t)(u.pm * BM + ai * HALF + wr * 64 + m * 16 + fr) * ldc + u.pn * BM + wc * 32 + 4 * fq;
#pragma unroll
                for (int bj = 0; bj < 2; ++bj)
#pragma unroll
                    for (int n = 0; n < 2; ++n) b[m][bj][n] = *(const f32x4*)(base + off + bj * HALF + n * 16); }
#pragma unroll
            for (int m = 0; m < 4; ++m) { const size_t off = (size_t)(u.pm * BM + ai * HALF + wr * 64 + m * 16 + fr) * ldc + u.pn * BM + wc * 32 + 4 * fq;
#pragma unroll
                for (int bj = 0; bj < 2; ++bj)
#pragma unroll
                    for (int n = 0; n < 2; ++n) *(f32x4*)(out + off + bj * HALF + n * 16) = b[m][bj][n] + acc[ai][bj][m][n]; } }
    }
};
struct EpiMoe1 {
    static constexpr bool AFTER_DRAIN = false;
    bf16_t* O; const float* b1; const float* sw; const float* sx;
    DEV void operator()(const f32x4 (&acc)[2][2][4][2], const Unit& u, int wr, int wc, int fr, int fq) const {
        const float* bb = b1 + (size_t)u.e * 2048; const float* ss = sw + (size_t)u.e * 2048 + u.pn * BM;
        f32x4 ba[2], bu[2], sa[2], su[2];
#pragma unroll
        for (int n = 0; n < 2; ++n) { const int c = wc * 32 + n * 16 + 4 * fq; ba[n] = *(const f32x4*)(bb + u.pn * HALF + c); bu[n] = *(const f32x4*)(bb + 1024 + u.pn * HALF + c); sa[n] = *(const f32x4*)(ss + c); su[n] = *(const f32x4*)(ss + HALF + c); }
        float srv[2][4];
#pragma unroll
        for (int ai = 0; ai < 2; ++ai)
#pragma unroll
            for (int m = 0; m < 4; ++m) srv[ai][m] = sx[u.pm * BM + ai * HALF + wr * 64 + m * 16 + fr];
#pragma unroll
        for (int ai = 0; ai < 2; ++ai)
#pragma unroll
            for (int m = 0; m < 4; ++m) { const int row = u.pm * BM + ai * HALF + wr * 64 + m * 16 + fr; const float sr = srv[ai][m]; bf16_t* rowp = O + (size_t)row * DFF + u.pn * HALF + wc * 32 + 4 * fq;
#pragma unroll
                for (int n = 0; n < 2; ++n) { const i32x4 ia = __builtin_bit_cast(i32x4, acc[ai][0][m][n]), iu = __builtin_bit_cast(i32x4, acc[ai][1][m][n]); float r[4];
#pragma unroll
                    for (int j = 0; j < 4; ++j) { const float a = fminf((float)ia[j] * (sr * sa[n][j]) + ba[n][j], 7.0f), up = fminf(fmaxf((float)iu[j] * (sr * su[n][j]) + bu[n][j], -7.0f), 7.0f);
                        const float glu = a * __builtin_amdgcn_rcpf(1.0f + __expf(-1.702f * a)); r[j] = (up + 1.0f) * glu; }
                    u32x2 w; w.x = pk2(r[0], r[1]); w.y = pk2(r[2], r[3]); *(u32x2*)(rowp + n * 16) = w; } }
    }
};
struct EpiMoe2 {
    static constexpr bool AFTER_DRAIN = false;
    bf16_t* O; const float* b2; const float* rowgate;
    DEV void operator()(const f32x4 (&acc)[2][2][4][2], const Unit& u, int wr, int wc, int fr, int fq) const {
        const float* bb = b2 + (size_t)u.e * 1024;
        float gtv[2][4]; f32x4 bvv[2][2];
#pragma unroll
        for (int ai = 0; ai < 2; ++ai)
#pragma unroll
            for (int m = 0; m < 4; ++m) gtv[ai][m] = rowgate[u.pm * BM + ai * HALF + wr * 64 + m * 16 + fr];
#pragma unroll
        for (int bj = 0; bj < 2; ++bj)
#pragma unroll
            for (int n = 0; n < 2; ++n) bvv[bj][n] = *(const f32x4*)(bb + u.pn * BM + bj * HALF + wc * 32 + n * 16 + 4 * fq);
#pragma unroll
        for (int ai = 0; ai < 2; ++ai)
#pragma unroll
            for (int m = 0; m < 4; ++m) { const int row = u.pm * BM + ai * HALF + wr * 64 + m * 16 + fr; const float gt = gtv[ai][m]; bf16_t* rowp = O + (size_t)row * DM + u.pn * BM + wc * 32 + 4 * fq;
#pragma unroll
                for (int bj = 0; bj < 2; ++bj)
#pragma unroll
                    for (int n = 0; n < 2; ++n) { const f32x4 v = (acc[ai][bj][m][n] + bvv[bj][n]) * gt;
                        u32x2 w; w.x = pk2(v[0], v[1]); w.y = pk2(v[2], v[3]); *(u32x2*)(rowp + bj * HALF + n * 16) = w; } }
    }
};
struct EpiQup {
    static constexpr bool AFTER_DRAIN = false;
    bf16_t* O; const float* ropem;
    DEV void operator()(const f32x4 (&acc)[2][2][4][2], const Unit& u, int wr, int wc, int fr, int fq) const {
        const bool rope0 = ((u.pn * 8 + wc) % 3) == 2, rope1 = ((u.pn * 8 + 4 + wc) % 3) == 2;
        f32x4 cs[2][4], sn[2][4];
        if (rope0 || rope1) {
#pragma unroll
            for (int ai = 0; ai < 2; ++ai)
#pragma unroll
                for (int m = 0; m < 4; ++m) { const int row = u.pm * BM + ai * HALF + wr * 64 + m * 16 + fr; cs[ai][m] = *(const f32x4*)(ropem + (size_t)row * 32 + 4 * fq); sn[ai][m] = *(const f32x4*)(ropem + (size_t)row * 32 + 16 + 4 * fq); } }
#pragma unroll
        for (int bj = 0; bj < 2; ++bj) { const int g32 = u.pn * 8 + bj * 4 + wc; const bool rope = bj ? rope1 : rope0;
#pragma unroll
            for (int ai = 0; ai < 2; ++ai)
#pragma unroll
                for (int m = 0; m < 4; ++m) { const int row = u.pm * BM + ai * HALF + wr * 64 + m * 16 + fr; bf16_t* rowp = O + (size_t)row * 768 + g32 * 32 + 4 * fq;
                    f32x4 v0 = acc[ai][bj][m][0], v1 = acc[ai][bj][m][1];
                    if (rope) { const f32x4 c = cs[ai][m], s_ = sn[ai][m]; const f32x4 x1 = v0, x2 = v1; v0 = x1 * c - x2 * s_; v1 = x2 * c + x1 * s_; }
                    v0 = v0 * MLA_QSCALE; v1 = v1 * MLA_QSCALE;
                    u32x2 w; w.x = pk2(v0[0], v0[1]); w.y = pk2(v0[2], v0[3]); *(u32x2*)(rowp) = w; w.x = pk2(v1[0], v1[1]); w.y = pk2(v1[2], v1[3]); *(u32x2*)(rowp + 16) = w; } }
    }
};
struct EpiKvup {
    static constexpr bool AFTER_DRAIN = false;
    bf16_t* KM; bf16_t* VM;
    DEV void operator()(const f32x4 (&acc)[2][2][4][2], const Unit& u, int wr, int wc, int fr, int fq) const {
#pragma unroll
        for (int bj = 0; bj < 2; ++bj) { const int head = u.pn * 2 + bj;
#pragma unroll
            for (int ai = 0; ai < 2; ++ai)
#pragma unroll
                for (int m = 0; m < 4; ++m) { const int row = u.pm * BM + ai * HALF + wr * 64 + m * 16 + fr;
                    bf16_t* rowp = (wc < 2) ? KM + (size_t)row * 768 + head * 96 + wc * 32 + 4 * fq : VM + (size_t)row * 512 + head * 64 + (wc - 2) * 32 + 4 * fq;
#pragma unroll
                    for (int n = 0; n < 2; ++n) { const f32x4 v = acc[ai][bj][m][n]; u32x2 w; w.x = pk2(v[0], v[1]); w.y = pk2(v[2], v[3]); *(u32x2*)(rowp + n * 16) = w; } } }
    }
};
struct EpiCmp {
    static constexpr bool AFTER_DRAIN = true;
    const float* cb; const float* w2; const int* pos; bf16_t* KC; bf16_t* VC;
    DEV void fused(const f32x4 (&acc)[2][2][4][2], const Unit& u, int wr, int wc, int fr, int fq, LAS unsigned char* lds) const {
        const int c = u.e, tid = opaque_tid();
        LAS bf16_t* Hs = (LAS bf16_t*)lds;
        LAS float* W2s = (LAS float*)(lds + 256 * 136 * 2);
        { const f32x4* src = (const f32x4*)(w2 + (size_t)c * 128 * 64) + tid;
#pragma unroll
          for (int i = 0; i < 4; ++i) *((LAS f32x4*)W2s + tid + i * 512) = src[i * 512]; }
        f32x4 bb[2];
#pragma unroll
        for (int n = 0; n < 2; ++n) { bb[n] = *(const f32x4*)(cb + c * 128 + wc * 32 + n * 16 + 4 * fq);
#pragma unroll
            for (int part = 1; part < 8; ++part) bb[n] += *(const f32x4*)(cb + part * 256 + c * 128 + wc * 32 + n * 16 + 4 * fq); }
#pragma unroll
        for (int ai = 0; ai < 2; ++ai)
#pragma unroll
            for (int m = 0; m < 4; ++m) { const int row = ai * HALF + wr * 64 + m * 16 + fr;
#pragma unroll
                for (int n = 0; n < 2; ++n) { const f32x4 v = acc[ai][0][m][n] + bb[n]; float r[4];
#pragma unroll
                    for (int j = 0; j < 4; ++j) r[j] = v[j] / (1.0f + __expf(-v[j]));
                    u32x2 w; w.x = pk2(r[0], r[1]); w.y = pk2(r[2], r[3]); *(LAS u32x2*)(Hs + row * 136 + wc * 32 + n * 16 + 4 * fq) = w; } }
        __syncthreads();
        const int row = tid >> 1, dh = tid & 1; float o[32];
#pragma unroll
        for (int d = 0; d < 32; ++d) o[d] = 0.f;
#pragma unroll 2
        for (int h = 0; h < 128; ++h) { const float hv = bf2f(Hs[row * 136 + h]); const LAS f32x4* wrow = (const LAS f32x4*)(W2s + h * 64 + dh * 32);
#pragma unroll
            for (int q = 0; q < 8; ++q) { const f32x4 w = wrow[q]; o[4 * q] += hv * w.x; o[4 * q + 1] += hv * w.y; o[4 * q + 2] += hv * w.z; o[4 * q + 3] += hv * w.w; } }
        const int r = u.pm * BM + row, b = r >> 9, n = (r >> 1) & 255;
        if (c == 0 && dh == 0 && n < 255) { const float fpos = (float)pos[b * SEQ + 16 * n + 31];
#pragma unroll
            for (int i = 0; i < 8; ++i) { const float invf = powf(500000.0f, -(float)(2 * i) / 16.0f); float cs, sn; sincosf(fpos * invf, &sn, &cs); const float x1 = o[i], x2 = o[8 + i]; o[i] = x1 * cs - x2 * sn; o[8 + i] = x2 * cs + x1 * sn; } }
        bf16_t* dst = (c == 0 ? KC : VC) + (size_t)r * 64 + dh * 32;
#pragma unroll
        for (int q = 0; q < 4; ++q) { u32x4 w;
            if (n < 255) { w.x = pk2(o[8 * q], o[8 * q + 1]); w.y = pk2(o[8 * q + 2], o[8 * q + 3]); w.z = pk2(o[8 * q + 4], o[8 * q + 5]); w.w = pk2(o[8 * q + 6], o[8 * q + 7]); } else w = (u32x4){0u, 0u, 0u, 0u};
            *(u32x4*)(dst + 8 * q) = w; }
        __syncthreads();
    }
};
struct UpOrder {
    DenseOrder q, kv; int G, c;
    DEV bool next(int i, Unit& u) const {
        const long L = (long)i * G + c;
        if (L < q.nwg) { DenseOrder t = q; t.G = 1; t.c = 0; t.next((int)L, u); u.e = 0; return true; }
        if (L < q.nwg + kv.nwg) { DenseOrder t = kv; t.G = 1; t.c = 0; t.next((int)(L - q.nwg), u); u.e = 1; return true; }
        return false;
    }
};
struct EpiUp {
    static constexpr bool AFTER_DRAIN = false;
    EpiQup eq; EpiKvup ekv;
    DEV void operator()(const f32x4 (&acc)[2][2][4][2], const Unit& u, int wr, int wc, int fr, int fq) const { if (u.e == 0) eq(acc, u, wr, wc, fr, fq); else ekv(acc, u, wr, wc, fr, fq); }
};
}

DEV void transpose_item(const float* W, int Ksrc, int Nsrc, int k0, int n0, bf16_t* WT, int ldk, int drow0, LAS float* scr, int lane) {
    { const int kr = lane >> 3, nc = 4 * (lane & 7); f32x4 v[8];
#pragma unroll
      for (int i = 0; i < 8; ++i) { const int k = k0 + 8 * i + kr; v[i] = (k < Ksrc && n0 + nc < Nsrc) ? *(const f32x4*)(W + (size_t)k * Nsrc + n0 + nc) : (f32x4){0.f, 0.f, 0.f, 0.f}; }
#pragma unroll
      for (int i = 0; i < 8; ++i) { LAS float* d = scr + (8 * i + kr) * 33 + nc; d[0] = v[i].x; d[1] = v[i].y; d[2] = v[i].z; d[3] = v[i].w; } }
    asm volatile("s_waitcnt lgkmcnt(0)" ::: "memory");
    const int c = lane & 7;
#pragma unroll
    for (int j = 0; j < 4; ++j) { const int n = (lane >> 3) + 8 * j; const LAS float* s = scr + (8 * c) * 33 + n;
        u32x4 o; o.x = pk2(s[0 * 33], s[1 * 33]); o.y = pk2(s[2 * 33], s[3 * 33]); o.z = pk2(s[4 * 33], s[5 * 33]); o.w = pk2(s[6 * 33], s[7 * 33]);
        *(u32x4*)(WT + (size_t)(drow0 + n) * ldk + k0 + 8 * c) = o; }
    asm volatile("s_waitcnt lgkmcnt(0)" ::: "memory");
}
DEV void rms_row_to_bf16(const float* xrow, const float* g, bf16_t* orow, int lane) {
    const f32x4* xr = (const f32x4*)xrow + lane; const f32x4* gr = (const f32x4*)g + lane;
    f32x4 v[4]; float s = 0.f;
#pragma unroll
    for (int j = 0; j < 4; ++j) { v[j] = xr[64 * j]; s += (v[j].x * v[j].x + v[j].y * v[j].y) + (v[j].z * v[j].z + v[j].w * v[j].w); }
    const float rstd = rsqrtf(wave_sum(s) * (1.f / 1024.f) + 1e-5f);
    u32x2* o8 = (u32x2*)orow + lane;
#pragma unroll
    for (int j = 0; j < 4; ++j) { const f32x4 gg = gr[64 * j]; u32x2 w; w.x = pk2(v[j].x * rstd * gg.x, v[j].y * rstd * gg.y); w.y = pk2(v[j].z * rstd * gg.z, v[j].w * rstd * gg.w); o8[64 * j] = w; }
}
DEV void w1_quant_item(const float* W, unsigned char* WQ, float* SW, int n0, int drow0, LAS unsigned char* lds, int tid) {
    LAS unsigned* qs = (LAS unsigned*)lds;
    LAS float* red = (LAS float*)(lds + 32 * 1040);
    const int kg = tid >> 3, c = tid & 7, wv = tid >> 6;
    f32x4 v[4][4];
#pragma unroll
    for (int i = 0; i < 4; ++i)
#pragma unroll
        for (int q = 0; q < 4; ++q) v[i][q] = *(const f32x4*)(W + (size_t)(4 * (64 * i + kg) + q) * 2048 + n0 + 4 * c);
    float mx[4] = {0.f, 0.f, 0.f, 0.f};
#pragma unroll
    for (int i = 0; i < 4; ++i)
#pragma unroll
        for (int q = 0; q < 4; ++q) { mx[0] = fmaxf(mx[0], fabsf(v[i][q].x)); mx[1] = fmaxf(mx[1], fabsf(v[i][q].y)); mx[2] = fmaxf(mx[2], fabsf(v[i][q].z)); mx[3] = fmaxf(mx[3], fabsf(v[i][q].w)); }
#pragma unroll
    for (int j = 0; j < 4; ++j) { mx[j] = fmaxf(mx[j], __shfl_xor(mx[j], 8)); mx[j] = fmaxf(mx[j], __shfl_xor(mx[j], 16)); mx[j] = fmaxf(mx[j], __shfl_xor(mx[j], 32)); }
    if ((tid & 63) < 8) *(LAS f32x4*)(red + wv * 32 + 4 * c) = (f32x4){mx[0], mx[1], mx[2], mx[3]};
    __syncthreads();
    float inv[4];
    { f32x4 m = *(const LAS f32x4*)(red + 4 * c);
#pragma unroll
      for (int w_ = 1; w_ < 8; ++w_) { const f32x4 o = *(const LAS f32x4*)(red + w_ * 32 + 4 * c); m.x = fmaxf(m.x, o.x); m.y = fmaxf(m.y, o.y); m.z = fmaxf(m.z, o.z); m.w = fmaxf(m.w, o.w); }
      m.x = fmaxf(m.x, 1e-30f); m.y = fmaxf(m.y, 1e-30f); m.z = fmaxf(m.z, 1e-30f); m.w = fmaxf(m.w, 1e-30f);
      inv[0] = 127.0f / m.x; inv[1] = 127.0f / m.y; inv[2] = 127.0f / m.z; inv[3] = 127.0f / m.w;
      if (tid < 8) *(f32x4*)(SW + drow0 + 4 * c) = m * (1.0f / 127.0f); }
#pragma unroll
    for (int i = 0; i < 4; ++i) {
#pragma unroll
        for (int j = 0; j < 4; ++j) { unsigned x = 0u;
#pragma unroll
            for (int q = 0; q < 4; ++q) { const int b = __float2int_rn(v[i][q][j] * inv[j]); x |= ((unsigned)b & 255u) << (8 * q); }
            qs[(4 * c + j) * 260 + 64 * i + kg] = x; } }
    __syncthreads();
#pragma unroll
    for (int t_ = 0; t_ < 4; ++t_) { const int id = tid + 512 * t_, n = id >> 6, ch = id & 63;
        *(u32x4*)(WQ + (size_t)(drow0 + n) * 1024 + ch * 16) = *(const LAS u32x4*)(lds + n * 1040 + ch * 16); }
    __syncthreads();
}
DEV void prep_w1_items(const Params& p, LAS unsigned char* lds) {
    const int tid = opaque_tid();
    unsigned* ctr = (unsigned*)(p.ws + OFF_CNT) + 40; LAS int* slot = (LAS int*)(lds + 40960);
    for (;;) {
        if (tid == 0) *slot = (int)__hip_atomic_fetch_add(ctr, 1u, __ATOMIC_RELAXED, __HIP_MEMORY_SCOPE_AGENT);
        __syncthreads();
        const int it = *slot;
        __syncthreads();
        if (it >= 32 * 64) break;
        const int e = it >> 6, nb = it & 63, n0 = nb * 32;
        const int bj = n0 >> 10, rr = n0 & 1023, drow = 256 * (rr >> 7) + 128 * bj + (rr & 127);
        w1_quant_item(p.moe_w1 + (size_t)e * 1024 * 2048, p.ws + OFF_W1T + (size_t)e * 2048 * 1024, (float*)(p.ws + OFF_SW1) + (size_t)e * 2048, n0, drow, lds, tid); }
}
DEV void prep_w2_items(const Params& p, LAS unsigned char* lds, int firstw, int stridew) {
    const int tid = opaque_tid(), wid = tid >> 6, lane = tid & 63;
    LAS float* scr = (LAS float*)(lds + wid * 16384); bf16_t* W2T = (bf16_t*)(p.ws + OFF_W2T);
    for (int r = firstw + wid; r < 32 * 16 * 32; r += stridew) { const int e = r / (16 * 32), q = r % (16 * 32), kb = q / 32, nb = q % 32;
        transpose_item(p.moe_w2 + (size_t)e * 1024 * 1024, 1024, 1024, kb * 64, nb * 32, W2T + (size_t)e * 1024 * 1024, 1024, nb * 32, scr, lane); }
}
DEV void phase0(const Params& p, LAS unsigned char* lds) {
    const int tid = opaque_tid(), wid = tid >> 6, lane = tid & 63;
    LAS float* scr = (LAS float*)(lds + wid * 16384);
    const int gw = blockIdx.x * 8 + wid, NGW = gridDim.x * 8;
    bf16_t* WINT = (bf16_t*)(p.ws + OFF_WINT);
    bf16_t* WQUPT = (bf16_t*)(p.ws + OFF_WQUPT); bf16_t* WKVUPT = (bf16_t*)(p.ws + OFF_WKVUPT); bf16_t* WOUTT = (bf16_t*)(p.ws + OFF_WOUTT);
    constexpr int I_IN = 16 * 56, I_QUP = 4 * 24, I_KVUP = 4 * 32, I_OUT = 16 * 32, I_CW1 = 2 * 32 * 8, I_ROWS = NTOK;
    constexpr int NITEMS = I_IN + I_QUP + I_KVUP + I_OUT + I_CW1;
    for (int it = gw; it < NITEMS; it += NGW) {
        int r = it;
        if (r < I_IN) { const int kb = r / 56, nb = r % 56; transpose_item(p.w_in, 1024, INC, kb * 64, nb * 32, WINT, 1024, nb * 32, scr, lane); continue; } r -= I_IN;
        if (r < I_QUP) { const int kb = r / 24, nb = r % 24; transpose_item(p.w_q_up, 256, 768, kb * 64, nb * 32, WQUPT, 256, nb * 32, scr, lane); continue; } r -= I_QUP;
        if (r < I_KVUP) { const int kb = r / 32, nb = r % 32; transpose_item(p.w_kv_up, 128, 1024, kb * 64, nb * 32, WKVUPT, 256, nb * 32, scr, lane); continue; } r -= I_KVUP;
        if (r < I_OUT) { const int kb = r / 32, nb = r % 32; transpose_item(p.w_out, 1024, 1024, kb * 64, nb * 32, WOUTT, 1024, nb * 32, scr, lane); continue; } r -= I_OUT;
        if (r < I_CW1) { const int c = r / 256, q = r % 256, kb = q / 8, nb = q % 8; transpose_item(p.cmp_w1 + (size_t)c * 2048 * 128, 2048, 128, kb * 64, nb * 32, (bf16_t*)(p.ws + OFF_CW1T) + (size_t)c * 256 * 2048, 2048, nb * 32, scr, lane); continue; } r -= I_CW1;
        break;
    }
    { const f32x4* gr = (const f32x4*)p.attn_norm + lane; f32x4 gg[4];
#pragma unroll
      for (int j = 0; j < 4; ++j) gg[j] = gr[64 * j];
      for (int r0 = gw * 4; r0 < NTOK; r0 += NGW * 4) { f32x4 v[4][4];
#pragma unroll
          for (int q = 0; q < 4; ++q) { const f32x4* xr = (const f32x4*)(p.x + (size_t)(r0 + q) * DM) + lane;
#pragma unroll
              for (int j = 0; j < 4; ++j) v[q][j] = xr[64 * j]; }
#pragma unroll
          for (int q = 0; q < 4; ++q) { float s_ = 0.f;
#pragma unroll
              for (int j = 0; j < 4; ++j) s_ += (v[q][j].x * v[q][j].x + v[q][j].y * v[q][j].y) + (v[q][j].z * v[q][j].z + v[q][j].w * v[q][j].w);
              const float rstd = rsqrtf(wave_sum(s_) * (1.f / 1024.f) + 1e-5f); u32x2* o8 = (u32x2*)((bf16_t*)(p.ws + OFF_U) + (size_t)(r0 + q) * DM) + lane;
#pragma unroll
              for (int j = 0; j < 4; ++j) { u32x2 w; w.x = pk2(v[q][j].x * rstd * gg[j].x, v[q][j].y * rstd * gg[j].y); w.y = pk2(v[q][j].z * rstd * gg[j].z, v[q][j].w * rstd * gg[j].w); o8[64 * j] = w; } } } }
    float* cb = (float*)(p.ws + OFF_CB);
    for (int o8 = gw; o8 < 2048; o8 += NGW) { const int o = o8 & 255, part = o8 >> 8, c = o >> 7, h = o & 127; float s = 0.f;
#pragma unroll
        for (int q = 0; q < 4; ++q) { const int i = part * 256 + q * 64 + lane; s += p.cmp_pos[c * 2048 + i] * p.cmp_w1[((size_t)c * 2048 + i) * 128 + h]; }
        s = wave_sum(s); if (lane == 0) cb[part * 256 + o] = s; }
    if (blockIdx.x == 0 && tid < 64) ((unsigned*)(p.ws + OFF_CNT))[tid] = 0u;
}

struct P2In { u32x2 wq; unsigned wkv; unsigned kp; u32x4 wqn; u32x4 wk; u32x4 wc4; unsigned gt; int pos; };
DEV void phase2(const Params& p) {
    const int tid = opaque_tid(), wid = tid >> 6, lane = tid & 63;
    const int gw = blockIdx.x * 8 + wid, NGW = gridDim.x * 8;
    const bf16_t* PROJ = (const bf16_t*)(p.ws + OFF_PROJ);
    bf16_t* QN = (bf16_t*)(p.ws + OFF_QN); bf16_t* KVN = (bf16_t*)(p.ws + OFF_KVN); bf16_t* KM = (bf16_t*)(p.ws + OFF_KM); float* ROPEM = (float*)(p.ws + OFF_ROPEM); bf16_t* NQ = (bf16_t*)(p.ws + OFF_NQ);
    bf16_t* KSR = (bf16_t*)(p.ws + OFF_KSR); bf16_t* KWR = (bf16_t*)(p.ws + OFF_KWR); float* GATES = (float*)(p.ws + OFF_GATES);
    const float invf_m = powf(500000.0f, -(float)(2 * (lane & 15)) / 32.0f);
    const float invf_n = powf(500000.0f, -(float)(2 * (lane & 7)) / 16.0f);
    const f32x4 gq = *(const f32x4*)(p.q_norm + lane * 4); const f32x2 gkv = *(const f32x2*)(p.kv_norm + lane * 2);
    const int l16 = lane & 15, sub = lane & 7, d32 = lane & 31; const int cbase = (lane < 16) ? C_KS : C_KW;
    const int grp4 = lane >> 4; const int ccol4 = (grp4 == 0) ? C_KC : (grp4 == 1) ? C_VC : (grp4 == 2) ? C_VS : C_VW;
    bf16_t* cdst4 = (bf16_t*)(p.ws + (grp4 == 0 ? OFF_KCC : grp4 == 1 ? OFF_VCC : grp4 == 2 ? OFF_VSC : OFF_VWC));
    auto load = [&](int tok) -> P2In { const bf16_t* row = PROJ + (size_t)tok * INP; P2In in;
        in.wq = *(const u32x2*)(row + C_QLAT + lane * 4); in.wkv = *(const unsigned*)(row + C_KVLAT + lane * 2);
        in.kp = (unsigned)row[C_KPE + d32] | ((unsigned)row[C_KPE + (d32 ^ 16)] << 16);
        in.wqn = *(const u32x4*)(row + C_QNSA + lane * 8); in.wk = *(const u32x4*)(row + cbase + l16 * 8); in.wc4 = *(const u32x4*)(row + ccol4 + l16 * 8);
        in.gt = row[C_G + (lane < 24 ? lane : 23)]; in.pos = p.pos[tok]; return in; };
    P2In cur = load(gw < NTOK ? gw : 0);
#pragma unroll 1
    for (int tok = gw; tok < NTOK; tok += NGW) {
        const P2In nxt = load(tok + NGW < NTOK ? tok + NGW : tok);
        const float fpos = (float)cur.pos;
        float cm, sm, cn, sn; __sincosf(fpos * invf_m, &sm, &cm); __sincosf(fpos * invf_n, &sn, &cn);
        { const u32x2 w = cur.wq; const float a = bflo(w.x), b = bfhi(w.x), c = bflo(w.y), d = bfhi(w.y);
          const float rstd = rsqrtf(wave_sum(a * a + b * b + c * c + d * d) * (1.f / 256.f) + 1e-5f);
          u32x2 o; o.x = pk2(a * rstd * gq.x, b * rstd * gq.y); o.y = pk2(c * rstd * gq.z, d * rstd * gq.w); *(u32x2*)(QN + (size_t)tok * 256 + lane * 4) = o; }
        { const unsigned w = cur.wkv; const float a = bflo(w), b = bfhi(w);
          const float rstd = rsqrtf(wave_sum(a * a + b * b) * (1.f / 128.f) + 1e-5f);
          *(unsigned*)(KVN + (size_t)tok * 256 + lane * 2) = pk2(a * rstd * gkv.x, b * rstd * gkv.y); *(unsigned*)(KVN + (size_t)tok * 256 + 128 + lane * 2) = 0u; }
        { const float xs_ = bflo(cur.kp), xo = bfhi(cur.kp); const float val = (d32 < 16) ? xs_ * cm - xo * sm : xs_ * cm + xo * sm;
          const int hh = lane >> 3, part = lane & 7; const float a0 = __shfl(val, 4 * part), a1 = __shfl(val, 4 * part + 1), a2 = __shfl(val, 4 * part + 2), a3 = __shfl(val, 4 * part + 3);
          u32x2 w; w.x = pk2(a0, a1); w.y = pk2(a2, a3); *(u32x2*)(KM + (size_t)tok * 768 + hh * 96 + 64 + 4 * part) = w;
          if (lane < 16) { ROPEM[(size_t)tok * 32 + lane] = cm; ROPEM[(size_t)tok * 32 + 16 + lane] = sm; } }
        { const u32x4 w = cur.wqn; float v[8] = {bflo(w.x), bfhi(w.x), bflo(w.y), bfhi(w.y), bflo(w.z), bfhi(w.z), bflo(w.w), bfhi(w.w)};
#pragma unroll
          for (int i = 0; i < 8; ++i) { const float other = __shfl_xor(v[i], 1); const float c = __shfl(cn, i), s = __shfl(sn, i);
              if (sub == 0) v[i] = v[i] * c - other * s; else if (sub == 1) v[i] = v[i] * c + other * s; }
          u32x4 o; o.x = pk2(v[0] * NSA_QSCALE, v[1] * NSA_QSCALE); o.y = pk2(v[2] * NSA_QSCALE, v[3] * NSA_QSCALE); o.z = pk2(v[4] * NSA_QSCALE, v[5] * NSA_QSCALE); o.w = pk2(v[6] * NSA_QSCALE, v[7] * NSA_QSCALE);
          *(u32x4*)(NQ + (size_t)tok * 512 + lane * 8) = o; }
        { const u32x4 w = cur.wk;
          float v[8] = {bflo(w.x), bfhi(w.x), bflo(w.y), bfhi(w.y), bflo(w.z), bfhi(w.z), bflo(w.w), bfhi(w.w)};
#pragma unroll
          for (int i = 0; i < 8; ++i) { const float other = __shfl_xor(v[i], 1); const float c = __shfl(cn, i), s = __shfl(sn, i);
              if (sub == 0) v[i] = v[i] * c - other * s; else if (sub == 1) v[i] = v[i] * c + other * s; }
          if (lane < 32) { u32x4 o; o.x = pk2(v[0], v[1]); o.y = pk2(v[2], v[3]); o.z = pk2(v[4], v[5]); o.w = pk2(v[6], v[7]);
              *(u32x4*)(((lane < 16) ? KSR : KWR) + (size_t)tok * 128 + l16 * 8) = o; } }
        *(u32x4*)(cdst4 + (size_t)tok * 128 + l16 * 8) = cur.wc4;
        if (lane < 24) GATES[(size_t)tok * 24 + lane] = __builtin_amdgcn_rcpf(1.0f + __expf(-bflo(cur.gt)));
        cur = nxt;
    }
}

DEV void phase4(const Params& p, LAS unsigned char* lds) {
    const int tid = opaque_tid();
    if (blockIdx.x < BATCH * 2 && tid < 128) { const int bb = blockIdx.x >> 1, c_ = blockIdx.x & 1; ((bf16_t*)(p.ws + (c_ == 0 ? OFF_KC : OFF_VC)))[((size_t)(bb * NCMPP + 255) * 2) * 64 + tid] = 0; }
    const bf16_t* PROJ = (const bf16_t*)(p.ws + OFF_PROJ); const float* cb = (const float*)(p.ws + OFF_CB);
    LAS float* hid = (LAS float*)lds;
    const int sub = tid >> 7, h = tid & 127;
    constexpr int NU = 2 * BATCH * NCMP * 2;
    for (int u0 = blockIdx.x * 4; u0 < NU; u0 += gridDim.x * 4) {
        const int u = u0 + sub; const bool act = u < NU;
        int c = 0, b = 0, n = 0, g = 0;
        if (act) { c = u / (BATCH * NCMP * 2); int r = u % (BATCH * NCMP * 2); b = r / (NCMP * 2); r %= (NCMP * 2); n = r >> 1; g = r & 1; }
        float acc = 0.f;
        if (act) {
            const bf16_t* src = PROJ + (size_t)(b * SEQ + n * 16) * INP + (c == 0 ? C_KC : C_VC) + g * 64;
            const float* w1 = p.cmp_w1 + (size_t)c * 2048 * 128 + h;
            for (int l = 0; l < 32; ++l) { const bf16_t* sr = src + (size_t)l * INP;
#pragma unroll 8
                for (int d = 0; d < 64; d += 2) { const unsigned w = *(const unsigned*)(sr + d); acc += bflo(w) * w1[(size_t)(l * 64 + d) * 128] + bfhi(w) * w1[(size_t)(l * 64 + d + 1) * 128]; } }
            acc += cb[c * 128 + h];
            acc = acc / (1.0f + __expf(-acc));
        }
        hid[sub * 128 + h] = acc;
        __syncthreads();
        if (act && h < 64) {
            const float* w2 = p.cmp_w2 + (size_t)c * 128 * 64 + h; float o = 0.f;
            for (int k = 0; k < 128; ++k) o += hid[sub * 128 + k] * w2[k * 64];
            LAS float* ob = (LAS float*)(lds + 4096) + sub * 64; ob[h] = o;
            asm volatile("s_waitcnt lgkmcnt(0)" ::: "memory");
            if (c == 0 && h < 16) { const int i = h & 7; const float fpos = (float)p.pos[b * SEQ + 16 * n + 31]; const float invf = powf(500000.0f, -(float)(2 * i) / 16.0f);
                float cs, sn; sincosf(fpos * invf, &sn, &cs); const float x1 = ob[i], x2 = ob[8 + i]; o = (h < 8) ? (x1 * cs - x2 * sn) : (x2 * cs + x1 * sn); }
            ((bf16_t*)(p.ws + (c == 0 ? OFF_KC : OFF_VC)))[((size_t)(b * NCMPP + n) * 2 + g) * 64 + h] = f2bf(o);
        }
        __syncthreads();
    }
}

template <int DQK, int DV, class KF, class VF, class MF>
DEV void naive_attn_range(const float (&q)[DQK], float (&o)[DV], float& m, float& l, int jlo, int jhi, KF kf, VF vf, MF valid) {
#pragma unroll 1
    for (int j0 = jlo; j0 < jhi; j0 += 2) {
        const int ja = __builtin_amdgcn_readfirstlane(j0), jb = __builtin_amdgcn_readfirstlane((j0 + 1 < jhi) ? j0 + 1 : j0);
        float s0 = 0.f, s1 = 0.f;
#pragma unroll
        for (int i = 0; i < DQK / 2; ++i) { const unsigned w = kf(ja, i); s0 += q[2 * i] * bflo(w); s0 += q[2 * i + 1] * bfhi(w); }
#pragma unroll
        for (int i = 0; i < DQK / 2; ++i) { const unsigned w = kf(jb, i); s1 += q[2 * i] * bflo(w); s1 += q[2 * i + 1] * bfhi(w); }
        if (!valid(ja)) s0 = -INFINITY;
        if (!(j0 + 1 < jhi && valid(jb))) s1 = -INFINITY;
        const float mn = fmaxf(m, fmaxf(s0, s1));
        const bool live = mn != -INFINITY;
        const float alpha = live ? fast_exp2(m - mn) : 1.f, p0 = live ? fast_exp2(s0 - mn) : 0.f, p1 = live ? fast_exp2(s1 - mn) : 0.f;
        l = l * alpha + p0 + p1; m = mn;
#pragma unroll
        for (int i = 0; i < DV / 2; ++i) { const unsigned w0 = vf(ja, i), w1 = vf(jb, i);
            o[2 * i] = o[2 * i] * alpha + p0 * bflo(w0) + p1 * bflo(w1); o[2 * i + 1] = o[2 * i + 1] * alpha + p0 * bfhi(w0) + p1 * bfhi(w1); }
    }
}

DEV void phase3b(const Params& p) {
    const bf16_t* QUP = (const bf16_t*)(p.ws + OFF_QUP); const bf16_t* KVUP = (const bf16_t*)(p.ws + OFF_KVUP); const bf16_t* KPE = (const bf16_t*)(p.ws + OFF_KPE);
    bf16_t* QM = (bf16_t*)(p.ws + OFF_QM); bf16_t* KM = (bf16_t*)(p.ws + OFF_KM);
    for (int id = blockIdx.x * 512 + opaque_tid(); id < NTOK * 8; id += gridDim.x * 512) {
        const int tok = id >> 3, h = id & 7;
        const u32x4* qs = (const u32x4*)(QUP + (size_t)tok * 768 + h * 96); u32x4* qd = (u32x4*)(QM + (size_t)tok * 768 + h * 96);
        const u32x4* ks = (const u32x4*)(KVUP + (size_t)tok * 1024 + h * 128); u32x4* kd = (u32x4*)(KM + (size_t)tok * 768 + h * 96);
#pragma unroll 1
        for (int c = 0; c < 8; ++c) { const u32x4 w = qs[c]; u32x4 o;
            o.x = pk2(bflo(w.x) * MLA_QSCALE, bfhi(w.x) * MLA_QSCALE); o.y = pk2(bflo(w.y) * MLA_QSCALE, bfhi(w.y) * MLA_QSCALE);
            o.z = pk2(bflo(w.z) * MLA_QSCALE, bfhi(w.z) * MLA_QSCALE); o.w = pk2(bflo(w.w) * MLA_QSCALE, bfhi(w.w) * MLA_QSCALE); qd[c] = o; kd[c] = ks[c]; }
        const u32x4* pe = (const u32x4*)(KPE + (size_t)tok * 32);
#pragma unroll 1
        for (int c = 0; c < 4; ++c) kd[8 + c] = pe[c];
        const float fpos = (float)p.pos[tok]; const bf16_t* qr = QUP + (size_t)tok * 768 + h * 96 + 64; bf16_t* qo = QM + (size_t)tok * 768 + h * 96 + 64;
#pragma unroll 1
        for (int i = 0; i < 16; ++i) { const float invf = powf(500000.0f, -(float)(2 * i) / 32.0f); float c, sn; sincosf(fpos * invf, &sn, &c);
            const float x1 = bf2f(qr[i]), x2 = bf2f(qr[16 + i]); qo[i] = f2bf((x1 * c - x2 * sn) * MLA_QSCALE); qo[16 + i] = f2bf((x2 * c + x1 * sn) * MLA_QSCALE); }
    }
}

DEV void phase5_mla(const Params& p) {
    const int tid = opaque_tid(), wid = __builtin_amdgcn_readfirstlane(tid >> 6), lane = tid & 63;
    const int gw = blockIdx.x * 8 + wid, NGW = gridDim.x * 8;
    const bf16_t* QM = (const bf16_t*)(p.ws + OFF_QM); const bf16_t* KM = (const bf16_t*)(p.ws + OFF_KM); const bf16_t* KVUP = (const bf16_t*)(p.ws + OFF_KVUP);
    bf16_t* OCAT = (bf16_t*)(p.ws + OFF_OCAT);
    constexpr int NUNIT = BATCH * 8 * (SEQ / 64);
#pragma unroll 1
    for (int uu = gw; uu < NUNIT; uu += NGW) {
        const int u = (uu & 1) ? (NUNIT - 1 - (uu >> 1)) : (uu >> 1);
        const int tb = u % (SEQ / 64), h = (u / (SEQ / 64)) & 7, b = u / (SEQ / 64 * 8);
        const int t = tb * 64 + lane; const size_t tok = (size_t)b * SEQ + t;
        unsigned qp[48];
        { const bf16_t* qr = QM + tok * 768 + h * 96;
#pragma unroll
          for (int i = 0; i < 48; ++i) qp[i] = *(const unsigned*)(qr + 2 * i); }
        float o[64];
#pragma unroll
        for (int d = 0; d < 64; ++d) o[d] = 0.f;
        float m = -INFINITY, l = 0.f;
        const bf16_t* kb = KM + (size_t)b * SEQ * 768 + h * 96; const bf16_t* vb = KVUP + (size_t)b * SEQ * 1024 + h * 128 + 64;
        const int jhi = tb * 64 + 64;
#pragma unroll 1
        for (int j0 = 0; j0 < jhi; ++j0) {
            const int j = __builtin_amdgcn_readfirstlane(j0);
            const unsigned* kr = (const unsigned*)(kb + (size_t)j * 768); const unsigned* vr = (const unsigned*)(vb + (size_t)j * 1024);
            float s0 = 0.f;
#pragma unroll
            for (int i = 0; i < 48; ++i) { const unsigned w = kr[i]; s0 += bflo(qp[i]) * bflo(w); s0 += bfhi(qp[i]) * bfhi(w); }
            if (j > t) s0 = -INFINITY;
            const float mn = fmaxf(m, s0);
            const float alpha = fast_exp2(m - mn), p0 = fast_exp2(s0 - mn);
            l = l * alpha + p0; m = mn;
#pragma unroll
            for (int i = 0; i < 32; ++i) { const unsigned w0 = vr[i]; o[2 * i] = o[2 * i] * alpha + p0 * bflo(w0); o[2 * i + 1] = o[2 * i + 1] * alpha + p0 * bfhi(w0); }
        }
        const float rl = 1.0f / l;
        bf16_t* orow = OCAT + tok * 1024 + h * 64;
#pragma unroll
        for (int i = 0; i < 32; ++i) *(unsigned*)(orow + 2 * i) = pk2(o[2 * i] * rl, o[2 * i + 1] * rl);
    }
}

namespace fa {
typedef float f32x16 __attribute__((ext_vector_type(16)));
typedef short s16x4 __attribute__((ext_vector_type(4)));
constexpr int KSLOT = 12288, VSLOT = 8192;
constexpr int L_K = 0, L_V = 2 * KSLOT, L_WSF = L_V + 3 * VSLOT, L_OST = L_WSF + 8 * 512, L_MASK = L_OST + 8 * 4096, L_SEQ = L_MASK + 512, L_VAL = L_MASK + 1024, L_IMPH = L_VAL + 0;
constexpr int L_END = L_IMPH + 65536;
#define FA_MFMA(a, b, c) __builtin_amdgcn_mfma_f32_32x32x16_bf16(a, b, c, 0, 0, 0)
DEV int crow(int r, int hi) { return (r & 3) + 8 * (r >> 2) + 4 * hi; }
DEV s16x4 vtr(const LAS unsigned char* p) { return __builtin_bit_cast(s16x4, __builtin_amdgcn_ds_read_tr16_b64_v4i16((LAS s16x4*)p)); }
DEV float xhalf_max(float m) { auto rr = __builtin_amdgcn_permlane32_swap(__float_as_uint(m), __float_as_uint(m), false, false); return fmaxf(__uint_as_float(rr[0]), __uint_as_float(rr[1])); }
DEV float xhalf_sum(float m) { auto rr = __builtin_amdgcn_permlane32_swap(__float_as_uint(m), __float_as_uint(m), false, false); return __uint_as_float(rr[0]) + __uint_as_float(rr[1]); }

template <int NCH> struct KVRegs { u32x4 k0, k1, v; };
template <int NCH> DEV void stage_load(KVRegs<NCH>& r, const bf16_t* Kb, int kpitch, const bf16_t* Vb, int vpitch, int key0, int wid, int lane) {
    r.k0 = *(const u32x4*)(Kb + (size_t)(key0 + lane) * kpitch + wid * 8);
    if (NCH > 8 && wid < NCH - 8) r.k1 = *(const u32x4*)(Kb + (size_t)(key0 + lane) * kpitch + (8 + wid) * 8);
    r.v = *(const u32x4*)(Vb + (size_t)(key0 + 16 * (wid & 3) + (lane >> 2)) * vpitch + (wid >> 2) * 32 + (lane & 3) * 8);
}
template <int NCH> DEV void stage_write(const KVRegs<NCH>& r, LAS unsigned char* lds, int buf, int wid, int lane) {
    *(LAS u32x4*)(lds + L_K + buf * KSLOT + wid * 1024 + lane * 16) = r.k0;
    if (NCH > 8 && wid < NCH - 8) *(LAS u32x4*)(lds + L_K + buf * KSLOT + (8 + wid) * 1024 + lane * 16) = r.k1;
    *(LAS u32x4*)(lds + L_V + buf * VSLOT + wid * 1024 + lane * 16) = r.v;
}
template <int ND0> DEV void qk_tile(const LAS unsigned char* kbuf, int kp0, const bf16x8 (&qr)[ND0], f32x16& p0, f32x16& p1) {
#pragma unroll
    for (int r = 0; r < 16; ++r) { p0[r] = 0.f; p1[r] = 0.f; }
#pragma unroll
    for (int d0 = 0; d0 < ND0; ++d0) { const bf16x8 k0 = *(const LAS bf16x8*)(kbuf + kp0 + d0 * 2048), k1 = *(const LAS bf16x8*)(kbuf + kp0 + d0 * 2048 + 512);
        p0 = FA_MFMA(k0, qr[d0], p0); p1 = FA_MFMA(k1, qr[d0], p1); }
}
DEV float rowmax32(const f32x16& p0, const f32x16& p1) {
    float a = fmaxf(p0[0], p1[0]);
#pragma unroll
    for (int r = 1; r < 16; ++r) a = fmaxf(a, fmaxf(p0[r], p1[r]));
    return xhalf_max(a);
}
struct SmState { float mhat, l; f32x16 o[2]; };
DEV void sm_init(SmState& st) { st.mhat = -1e30f; st.l = 0.f;
#pragma unroll
    for (int r = 0; r < 16; ++r) { st.o[0][r] = 0.f; st.o[1][r] = 0.f; } }
DEV void sm_pv_tile(SmState& st, f32x16& p0, f32x16& p1, const LAS unsigned char* vbuf, int vp0, LAS float* wsf, int r32, int hi) {
    const float rm = rowmax32(p0, p1);
    const float newm = fmaxf(st.mhat, rm);
    if (__any(newm - st.mhat > 8.0f)) {
        const float f = fast_exp2(st.mhat - newm); st.mhat = newm; st.l *= f;
        if (hi == 0) wsf[r32] = f;
        asm volatile("s_waitcnt lgkmcnt(0)" ::: "memory");
#pragma unroll
        for (int r = 0; r < 16; ++r) { const float fr = wsf[crow(r, hi)]; st.o[0][r] *= fr; st.o[1][r] *= fr; }
        asm volatile("s_waitcnt lgkmcnt(0)" ::: "memory");
    }
    const float nm = -st.mhat; float sacc = 0.f;
#pragma unroll
    for (int r = 0; r < 16; ++r) { p0[r] = fast_exp2(p0[r] + nm); p1[r] = fast_exp2(p1[r] + nm); sacc += p0[r] + p1[r]; }
    st.l += sacc;
    u32x4 pw[4];
#pragma unroll
    for (int k = 0; k < 2; ++k) { pw[k] = (u32x4){pk2(p0[8 * k], p0[8 * k + 1]), pk2(p0[8 * k + 2], p0[8 * k + 3]), pk2(p0[8 * k + 4], p0[8 * k + 5]), pk2(p0[8 * k + 6], p0[8 * k + 7])};
        pw[2 + k] = (u32x4){pk2(p1[8 * k], p1[8 * k + 1]), pk2(p1[8 * k + 2], p1[8 * k + 3]), pk2(p1[8 * k + 4], p1[8 * k + 5]), pk2(p1[8 * k + 6], p1[8 * k + 7])}; }
#pragma unroll
    for (int dh = 0; dh < 2; ++dh)
#pragma unroll
        for (int ks = 0; ks < 4; ++ks) { const s16x4 lo = vtr(vbuf + vp0 + dh * 4096 + ks * 1024), hi4 = vtr(vbuf + vp0 + dh * 4096 + ks * 1024 + 512);
            const bf16x8 vf = (bf16x8){lo[0], lo[1], lo[2], lo[3], hi4[0], hi4[1], hi4[2], hi4[3]};
            st.o[dh] = FA_MFMA(__builtin_bit_cast(bf16x8, pw[ks]), vf, st.o[dh]); }
}
#define FA_MX3(a, b, c) __builtin_fmaxf(__builtin_fmaxf((a), (b)), (c))
template <int ND0> DEV void qk_tile_rel(const LAS unsigned char* kbuf, int kp0, const bf16x8 (&qr)[ND0], const f32x16& mC, f32x16& p0, f32x16& p1) {
    p0 = mC; p1 = mC;
#pragma unroll
    for (int d0 = 0; d0 < ND0; ++d0) { const bf16x8 k0 = *(const LAS bf16x8*)(kbuf + kp0 + d0 * 2048), k1 = *(const LAS bf16x8*)(kbuf + kp0 + d0 * 2048 + 512);
        p0 = FA_MFMA(k0, qr[d0], p0); p1 = FA_MFMA(k1, qr[d0], p1); }
}
DEV void sm_decide(SmState& st, f32x16& mC, f32x16& p0, f32x16& p1, bool firsttile, LAS float* wsf, int r32, int hi) {
    float a = FA_MX3(p0[0], p1[0], p0[1]), b = FA_MX3(p1[1], p0[2], p1[2]);
#pragma unroll
    for (int r = 3; r < 15; r += 2) { a = FA_MX3(a, p0[r], p1[r]); b = FA_MX3(b, p0[r + 1], p1[r + 1]); }
    a = FA_MX3(a, p0[15], p1[15]);
    const float rm = xhalf_max(fmaxf(a, b));
    if (firsttile) { const float m0 = (rm > -1e30f) ? rm : 0.f; st.mhat = m0;
#pragma unroll
        for (int r = 0; r < 16; ++r) { p0[r] -= m0; p1[r] -= m0; mC[r] = -m0; }
    } else if (__any(rm > 8.0f)) {
        const float dl = fmaxf(rm, 0.f); const float f = fast_exp2(-dl); st.mhat += dl; st.l *= f;
        if (hi == 0) wsf[r32] = f;
        asm volatile("s_waitcnt lgkmcnt(0)" ::: "memory");
#pragma unroll
        for (int r = 0; r < 16; ++r) { const float fr = wsf[crow(r, hi)]; st.o[0][r] *= fr; st.o[1][r] *= fr; p0[r] -= dl; p1[r] -= dl; mC[r] = -st.mhat; }
        asm volatile("s_waitcnt lgkmcnt(0)" ::: "memory");
    }
}
DEV void sm_exp_pv(SmState& st, f32x16& p0, f32x16& p1, const LAS unsigned char* vbuf, int vp0) {
    float s0 = 0.f, s1 = 0.f;
#pragma unroll
    for (int r = 0; r < 16; ++r) { p0[r] = fast_exp2(p0[r]); p1[r] = fast_exp2(p1[r]); s0 += p0[r]; s1 += p1[r]; }
    st.l += s0 + s1;
    u32x4 pw[4];
#pragma unroll
    for (int k = 0; k < 2; ++k) { pw[k] = (u32x4){pk2(p0[8 * k], p0[8 * k + 1]), pk2(p0[8 * k + 2], p0[8 * k + 3]), pk2(p0[8 * k + 4], p0[8 * k + 5]), pk2(p0[8 * k + 6], p0[8 * k + 7])};
        pw[2 + k] = (u32x4){pk2(p1[8 * k], p1[8 * k + 1]), pk2(p1[8 * k + 2], p1[8 * k + 3]), pk2(p1[8 * k + 4], p1[8 * k + 5]), pk2(p1[8 * k + 6], p1[8 * k + 7])}; }
#pragma unroll
    for (int dh = 0; dh < 2; ++dh)
#pragma unroll
        for (int ks = 0; ks < 4; ++ks) { const s16x4 lo = vtr(vbuf + vp0 + dh * 4096 + ks * 1024), hi4 = vtr(vbuf + vp0 + dh * 4096 + ks * 1024 + 512);
            const bf16x8 vf = (bf16x8){lo[0], lo[1], lo[2], lo[3], hi4[0], hi4[1], hi4[2], hi4[3]};
            st.o[dh] = FA_MFMA(__builtin_bit_cast(bf16x8, pw[ks]), vf, st.o[dh]); }
}
DEV void row_to_olayout(float fq, float (&out)[16], LAS float* wsf, int r32, int hi) {
    if (hi == 0) wsf[32 + r32] = fq;
    asm volatile("s_waitcnt lgkmcnt(0)" ::: "memory");
#pragma unroll
    for (int r = 0; r < 16; ++r) out[r] = wsf[32 + crow(r, hi)];
    asm volatile("s_waitcnt lgkmcnt(0)" ::: "memory");
}
DEV void store_o_rows(const f32x16 (&o)[2], bf16_t* dst, size_t pitch, LAS unsigned char* ost, int lane, int r32, int hi) {
    LAS bf16_t* stg = (LAS bf16_t*)ost;
#pragma unroll
    for (int r = 0; r < 16; ++r) { const int orow = crow(r, hi);
#pragma unroll
        for (int d0 = 0; d0 < 2; ++d0) stg[orow * 64 + d0 * 32 + r32] = f2bf(o[d0][r]); }
    asm volatile("s_waitcnt lgkmcnt(0)" ::: "memory");
#pragma unroll
    for (int i = 0; i < 4; ++i) { const int row = i * 8 + (lane >> 3), ch = lane & 7; *(u32x4*)(dst + (size_t)row * pitch + ch * 8) = *(const LAS u32x4*)(stg + row * 64 + ch * 8); }
    asm volatile("s_waitcnt lgkmcnt(0)" ::: "memory");
}

#define FT_SBAR() __builtin_amdgcn_sched_barrier(0)
#define FT_PIN(x) asm volatile("" : "+v"(x))
#define FT_WAIT_BAR(N) asm volatile("s_waitcnt vmcnt(" #N ") lgkmcnt(0)\n\ts_barrier" ::: "memory")
DEV unsigned ft_cvtpk(float lo, float hi) { unsigned r; asm("v_cvt_pk_bf16_f32 %0, %1, %2" : "=v"(r) : "v"(lo), "v"(hi)); return r; }
DEV void ft_glds16(const void* g, unsigned lds_base) { unsigned sv; asm volatile("s_mov_b32 %0, m0\n\ts_mov_b32 m0, %2\n\ts_nop 0\n\tglobal_load_lds_dwordx4 %1, off\n\ts_mov_b32 m0, %0" : "=&s"(sv) : "v"(g), "s"(lds_base) : "memory"); }
typedef LAS const char* ft_cptr;
DEV void ft_kload2(bf16x8* kf, ft_cptr kp, int d0) { kf[2 * d0] = *(const LAS bf16x8*)(kp + d0 * 2048); kf[2 * d0 + 1] = *(const LAS bf16x8*)(kp + d0 * 2048 + 512); }
DEV s16x4 ft_vtr(ft_cptr p) { return __builtin_bit_cast(s16x4, __builtin_amdgcn_ds_read_tr16_b64_v4i16((LAS s16x4*)p)); }
DEV float ft_rowmax(const f32x16& p0, const f32x16& p1) {
    float a = FA_MX3(p0[0], p0[1], p1[0]), b = FA_MX3(p0[2], p0[3], p1[1]); a = FA_MX3(a, p1[2], p1[3]);
#pragma unroll
    for (int r = 4; r < 16; r += 4) { a = FA_MX3(a, p0[r], p0[r + 1]); b = FA_MX3(b, p0[r + 2], p0[r + 3]); a = FA_MX3(a, p1[r], p1[r + 1]); b = FA_MX3(b, p1[r + 2], p1[r + 3]); }
    return xhalf_max(__builtin_fmaxf(a, b)); }
template <int MODE>
DEV void fa64_tuned(f32x16 (&o)[2], float& l_out, const bf16x8 (&qr)[4], const bf16_t* Kb, int kpitch, const bf16_t* Vb, int vpitch, unsigned long long um, int jlast, int NT,
                    unsigned long long rowmask, int tb, int tokl, LAS unsigned char* lds, LAS float* wsf, int wid, int lane, int r32, int hi) {
    constexpr int SLOTB = 8192; constexpr float THR = 8.0f;
    const unsigned lds0 = (unsigned)(uintptr_t)lds;
    const bf16_t* ksrc = Kb + (size_t)lane * kpitch + wid * 8;
    const bf16_t* vsrc = Vb + (size_t)(16 * (wid & 3) + (lane >> 2)) * vpitch + (wid >> 2) * 32 + (lane & 3) * 8;
    const unsigned kdst = lds0 + L_K + wid * 1024, vdst = lds0 + L_V + wid * 1024;
    unsigned long long rem_ = um; int jn_ = tb;
    auto gen = [&]() -> int { if (MODE == 0) { if (rem_ == 0ull) return 128; const int j = (int)__builtin_ctzll(rem_); rem_ &= rem_ - 1ull; return j; } else { if (jn_ < jlast) return 128; return jn_--; } };
    int w0 = gen(), w1 = gen(), w2 = gen(), w3 = gen();
#define FT_SHIFT() do { w0 = w1; w1 = w2; w2 = w3; w3 = gen(); } while (0)
#define FT_DMA_K(id, slot) ft_glds16(ksrc + (size_t)(((id) & 63) * 64) * kpitch, (unsigned)__builtin_amdgcn_readfirstlane(kdst + (slot)))
#define FT_DMA_V(id, slot) ft_glds16(vsrc + (size_t)(((id) & 63) * 64) * vpitch, (unsigned)__builtin_amdgcn_readfirstlane(vdst + (slot)))
    const ft_cptr vp0 = (ft_cptr)lds + L_V + ((lane >> 4) & 1) * 32 + (lane & 3) * 8 + (4 * hi + ((lane & 15) >> 2)) * 64;
    const ft_cptr kp0 = (ft_cptr)lds + L_K + hi * 1024 + r32 * 16;
    FT_DMA_K(w0, 0); FT_DMA_V(w0, 0); FT_DMA_K(w1, SLOTB); FT_DMA_K(w2, 2 * SLOTB);
    float mhat = 0.f, l_reg = 0.f; o[0] = f32x16{}; o[1] = f32x16{};
    const f32x16 zero16 = f32x16{};
    bool resc = false;
    f32x16 pA0, pA1, pB0, pB1; bf16x8 kf[8]; s16x4 vlo[8], vhi[8]; u32x4 pw0, pw1, pw2, pw3;
    int sl_prev = 0, sl_cur = 0, sl_next = SLOTB;
#define FT_ROT() do { sl_prev = sl_cur; sl_cur = sl_next; sl_next = (sl_next == 2 * SLOTB) ? 0 : sl_next + SLOTB; } while (0)
#define FT_EX(v) __builtin_amdgcn_exp2f((v) + nmh)
#define FT_RESC() do { if (resc) { _Pragma("unroll") for (int d_ = 0; d_ < 2; ++d_) _Pragma("unroll") for (int r = 0; r < 16; ++r) o[d_][r] *= wsf[crow(r, hi)]; } } while (0)
    auto emask = [&](int id, f32x16& p0, f32x16& p1) {
        const int j = id & 63, kb = 4 * hi;
        if (j == tb) {
#pragma unroll
            for (int r = 0; r < 16; ++r) { const int kv_ = kb + (r & 3) + 8 * (r >> 2); if (kv_ > tokl) p0[r] = -INFINITY; if (kv_ + 32 > tokl) p1[r] = -INFINITY; }
        } else if (MODE == 1 && j == tb - 8) {
#pragma unroll
            for (int r = 0; r < 16; ++r) { const int kv_ = kb + (r & 3) + 8 * (r >> 2); if (kv_ <= tokl) p0[r] = -INFINITY; if (kv_ + 32 <= tokl) p1[r] = -INFINITY; } } };
    auto rowsel = [&](int id) -> bool { if (id & 128) return false; if (MODE == 0) return (rowmask >> (id & 63)) & 1ull; return true; };
    FT_WAIT_BAR(3);
    _Pragma("unroll") for (int d0 = 0; d0 < 4; ++d0) ft_kload2(kf, kp0, d0);
    pA0 = FA_MFMA(kf[0], qr[0], zero16); pA1 = FA_MFMA(kf[1], qr[0], zero16); pA0 = FA_MFMA(kf[2], qr[1], pA0); pA1 = FA_MFMA(kf[3], qr[1], pA1);
    pA0 = FA_MFMA(kf[4], qr[2], pA0); pA1 = FA_MFMA(kf[5], qr[2], pA1); pA0 = FA_MFMA(kf[6], qr[3], pA0); pA1 = FA_MFMA(kf[7], qr[3], pA1);
    emask(w0, pA0, pA1);
    { const float rm = ft_rowmax(pA0, pA1); mhat = rm; const float nmh = -mhat;
#pragma unroll
      for (int r = 0; r < 16; ++r) { pA0[r] = FT_EX(pA0[r]); pA1[r] = FT_EX(pA1[r]); } }
    FT_WAIT_BAR(0);
    FT_DMA_K(w3, 0); FT_DMA_V(w1, SLOTB); FT_ROT(); FT_SHIFT();
    _Pragma("unroll") for (int d0 = 0; d0 < 4; ++d0) ft_kload2(kf, kp0 + sl_cur, d0);
    FT_WAIT_BAR(2);
#define FT_PKW(P, i) ft_cvtpk(P[i], P[i + 1])
#define FT_PAF(k) __builtin_bit_cast(bf16x8, pw##k)
#define FT_VFR(i) (bf16x8){vlo[i][0], vlo[i][1], vlo[i][2], vlo[i][3], vhi[i][0], vhi[i][1], vhi[i][2], vhi[i][3]}
#define FT_VRD(i) do { vlo[i] = ft_vtr(vp_ + (((i) >> 2) * 4096 + ((i) & 3) * 1024)); vhi[i] = ft_vtr(vp_ + (((i) >> 2) * 4096 + ((i) & 3) * 1024 + 512)); } while (0)
#define FT_KRD(G, d0) do { if (G) { ft_kload2(kf, kp0 + sl_next, d0); FT_SBAR(); } } while (0)
#define FT_GAPA(MF, a0, a1, a2, a3, W0, W1, PW) do { MF; sacc += a0; sacc += a1; sacc += a2; sacc += a3; W0; W1; FT_PIN(PW); FT_PIN(sacc); FT_SBAR(); } while (0)
#define FT_GAPB(MF, X, i) do { MF; X[i] = FT_EX(X[i]); X[i + 1] = FT_EX(X[i + 1]); X[i + 2] = FT_EX(X[i + 2]); X[i + 3] = FT_EX(X[i + 3]); FT_PIN(X); FT_SBAR(); } while (0)
#define FT_STEP(C0, C1, P0, P1, t, MASK, GK, GV, GL) do { FT_SBAR(); \
    const ft_cptr vp_ = vp0 + sl_prev; const int id_ = w0; \
    FT_VRD(0); FT_SBAR(); float sacc = P0[0] + P0[1]; \
                       FT_GAPA(C0 = FA_MFMA(kf[0], qr[0], zero16), P0[2], P0[3], P0[4], P0[5],     pw0[0] = FT_PKW(P0, 0),  pw0[1] = FT_PKW(P0, 2),  pw0); \
    FT_VRD(4); FT_SBAR(); FT_GAPA(C1 = FA_MFMA(kf[1], qr[0], zero16), P0[6], P0[7], P0[8], P0[9],     pw0[2] = FT_PKW(P0, 4),  pw0[3] = FT_PKW(P0, 6),  pw0); \
    FT_VRD(1); FT_SBAR(); FT_GAPA(C0 = FA_MFMA(kf[2], qr[1], C0),    P0[10], P0[11], P0[12], P0[13], pw1[0] = FT_PKW(P0, 8),  pw1[1] = FT_PKW(P0, 10), pw1); \
    FT_VRD(5); FT_SBAR(); FT_GAPA(C1 = FA_MFMA(kf[3], qr[1], C1),    P0[14], P0[15], P1[0], P1[1],   pw1[2] = FT_PKW(P0, 12), pw1[3] = FT_PKW(P0, 14), pw1); \
    FT_VRD(2); FT_SBAR(); FT_GAPA(C0 = FA_MFMA(kf[4], qr[2], C0),    P1[2], P1[3], P1[4], P1[5],     pw2[0] = FT_PKW(P1, 0),  pw2[1] = FT_PKW(P1, 2),  pw2); \
    FT_VRD(6); FT_SBAR(); FT_GAPA(C1 = FA_MFMA(kf[5], qr[2], C1),    P1[6], P1[7], P1[8], P1[9],     pw2[2] = FT_PKW(P1, 4),  pw2[3] = FT_PKW(P1, 6),  pw2); \
    FT_VRD(3); FT_SBAR(); FT_GAPA(C0 = FA_MFMA(kf[6], qr[3], C0),    P1[10], P1[11], P1[12], P1[13], pw3[0] = FT_PKW(P1, 8),  pw3[1] = FT_PKW(P1, 10), pw3); \
    FT_VRD(7); FT_SBAR(); FT_GAPA(C1 = FA_MFMA(kf[7], qr[3], C1),    P1[14], P1[15], 0.f, 0.f,       pw3[2] = FT_PKW(P1, 12), pw3[3] = FT_PKW(P1, 14), pw3); \
    l_reg += sacc; \
    if (GK) FT_DMA_K(w3, sl_cur); if (GV) FT_DMA_V(w1, sl_next); \
    if (MASK) emask(id_, C0, C1); \
    const bool rs_ = rowsel(id_); \
    { float rmx = ft_rowmax(C0, C1); if (!rs_) rmx = -INFINITY; const float rm = rmx - mhat; resc = false; \
      if (__builtin_expect(__any(rm > THR), 0)) { const float dl = __builtin_fmaxf(rm, 0.f); mhat += dl; \
          const float f = __builtin_amdgcn_exp2f(-dl); l_reg *= f; if (hi == 0) wsf[r32] = f; resc = true; } } \
    const float nmh = rs_ ? -mhat : -INFINITY; FT_SBAR(); \
    FT_GAPB(o[0] = FA_MFMA(FT_PAF(0), FT_VFR(0), o[0]), C0, 0);              FT_GAPB(o[1] = FA_MFMA(FT_PAF(0), FT_VFR(4), o[1]), C0, 4); \
    FT_KRD(GL, 0); FT_GAPB(o[0] = FA_MFMA(FT_PAF(1), FT_VFR(1), o[0]), C0, 8);  FT_KRD(GL, 1); FT_GAPB(o[1] = FA_MFMA(FT_PAF(1), FT_VFR(5), o[1]), C0, 12); \
    FT_KRD(GL, 2); FT_GAPB(o[0] = FA_MFMA(FT_PAF(2), FT_VFR(2), o[0]), C1, 0);  FT_KRD(GL, 3); FT_GAPB(o[1] = FA_MFMA(FT_PAF(2), FT_VFR(6), o[1]), C1, 4); \
    FT_GAPB(o[0] = FA_MFMA(FT_PAF(3), FT_VFR(3), o[0]), C1, 8);              FT_GAPB(o[1] = FA_MFMA(FT_PAF(3), FT_VFR(7), o[1]), C1, 12); \
    } while (0)
    int t = 1;
    for (; t + 5 < NT; t += 2) {
        FT_STEP(pB0, pB1, pA0, pA1, t, false, true, true, true);     FT_WAIT_BAR(2); FT_RESC(); FT_ROT(); FT_SHIFT();
        FT_STEP(pA0, pA1, pB0, pB1, t + 1, false, true, true, true); FT_WAIT_BAR(2); FT_RESC(); FT_ROT(); FT_SHIFT();
    }
#define FT_ENDW(tt) do { if ((tt) + 3 < NT) { FT_WAIT_BAR(2); } else if ((tt) + 2 < NT) { FT_WAIT_BAR(1); } else { FT_WAIT_BAR(0); } } while (0)
    for (; t + 1 < NT; t += 2) {
        FT_STEP(pB0, pB1, pA0, pA1, t, true, (t + 3 < NT), (t + 1 < NT), (t + 1 < NT));         FT_ENDW(t);     FT_RESC(); FT_ROT(); FT_SHIFT();
        FT_STEP(pA0, pA1, pB0, pB1, t + 1, true, (t + 4 < NT), (t + 2 < NT), (t + 2 < NT));     FT_ENDW(t + 1); FT_RESC(); FT_ROT(); FT_SHIFT();
    }
    FT_STEP(pB0, pB1, pA0, pA1, NT - 1, true, false, false, false); FT_RESC();
    { float sacc = pB0[0] + pB0[1];
#pragma unroll
      for (int r = 2; r < 16; ++r) sacc += pB0[r];
#pragma unroll
      for (int r = 0; r < 16; ++r) sacc += pB1[r];
      l_reg += sacc;
      pw0 = (u32x4){FT_PKW(pB0, 0), FT_PKW(pB0, 2), FT_PKW(pB0, 4), FT_PKW(pB0, 6)}; pw1 = (u32x4){FT_PKW(pB0, 8), FT_PKW(pB0, 10), FT_PKW(pB0, 12), FT_PKW(pB0, 14)};
      pw2 = (u32x4){FT_PKW(pB1, 0), FT_PKW(pB1, 2), FT_PKW(pB1, 4), FT_PKW(pB1, 6)}; pw3 = (u32x4){FT_PKW(pB1, 8), FT_PKW(pB1, 10), FT_PKW(pB1, 12), FT_PKW(pB1, 14)};
      const ft_cptr vp_ = vp0 + sl_cur; _Pragma("unroll") for (int i = 0; i < 8; ++i) FT_VRD(i);
      o[0] = FA_MFMA(FT_PAF(0), FT_VFR(0), o[0]); o[1] = FA_MFMA(FT_PAF(0), FT_VFR(4), o[1]); o[0] = FA_MFMA(FT_PAF(1), FT_VFR(1), o[0]); o[1] = FA_MFMA(FT_PAF(1), FT_VFR(5), o[1]);
      o[0] = FA_MFMA(FT_PAF(2), FT_VFR(2), o[0]); o[1] = FA_MFMA(FT_PAF(2), FT_VFR(6), o[1]); o[0] = FA_MFMA(FT_PAF(3), FT_VFR(3), o[0]); o[1] = FA_MFMA(FT_PAF(3), FT_VFR(7), o[1]); }
    l_out = l_reg;
    asm volatile("s_waitcnt lgkmcnt(0)\n\ts_barrier" ::: "memory");
#undef FT_SHIFT
#undef FT_DMA_K
#undef FT_DMA_V
#undef FT_ROT
#undef FT_EX
#undef FT_RESC
#undef FT_PKW
#undef FT_PAF
#undef FT_VFR
#undef FT_VRD
#undef FT_KRD
#undef FT_ENDW
#undef FT_GAPA
#undef FT_GAPB
#undef FT_STEP
}

constexpr int M_KSLOT = 12288, M_LK = 0, M_LV = 4 * M_KSLOT, M_LWSF = M_LV + 3 * 8192, M_LOST = M_LWSF + 8 * 512, M_LEND = M_LOST + 8 * 4096;
DEV void ft_wait_bar(int n) {
    if (n == 0) asm volatile("s_waitcnt vmcnt(0) lgkmcnt(0)\n\ts_barrier" ::: "memory");
    else if (n == 1) asm volatile("s_waitcnt vmcnt(1) lgkmcnt(0)\n\ts_barrier" ::: "memory");
    else if (n == 2) asm volatile("s_waitcnt vmcnt(2) lgkmcnt(0)\n\ts_barrier" ::: "memory");
    else if (n == 3) asm volatile("s_waitcnt vmcnt(3) lgkmcnt(0)\n\ts_barrier" ::: "memory");
    else asm volatile("s_waitcnt vmcnt(5) lgkmcnt(0)\n\ts_barrier" ::: "memory");
}
DEV void fa96_tuned(f32x16 (&o)[2], float& l_out, const bf16x8 (&qr)[6], const bf16_t* Kb, const bf16_t* Vb, int NT, int qrel, LAS unsigned char* lds, LAS float* wsf, int wid, int lane, int r32, int hi) {
    constexpr int SLOTB = 8192; constexpr float THR = 8.0f;
    const unsigned lds0 = (unsigned)(uintptr_t)lds;
    const int kc = (wid < 4) ? 2 : 1;
    const bf16_t* ksrc = Kb + (size_t)lane * 768 + wid * 8;
    const bf16_t* vsrc = Vb + (size_t)(16 * (wid & 3) + (lane >> 2)) * 512 + (wid >> 2) * 32 + (lane & 3) * 8;
    const unsigned kdst = lds0 + M_LK + wid * 1024, vdst = lds0 + M_LV + wid * 1024;
#define MT_DMA_K(t) do { const unsigned sl_ = (unsigned)(((t) & 3) * M_KSLOT); ft_glds16(ksrc + (size_t)(t) * 64 * 768, (unsigned)__builtin_amdgcn_readfirstlane(kdst + sl_)); \
        if (wid < 4) ft_glds16(ksrc + (size_t)(t) * 64 * 768 + 64, (unsigned)__builtin_amdgcn_readfirstlane(kdst + 8192 + sl_)); } while (0)
#define MT_DMA_V(t, slot) ft_glds16(vsrc + (size_t)(t) * 64 * 512, (unsigned)__builtin_amdgcn_readfirstlane(vdst + (slot)))
    const ft_cptr vp0 = (ft_cptr)lds + M_LV + ((lane >> 4) & 1) * 32 + (lane & 3) * 8 + (4 * hi + ((lane & 15) >> 2)) * 64;
    const ft_cptr kp0 = (ft_cptr)lds + M_LK + hi * 1024 + r32 * 16;
#define MT_KFR(kp, f) (*(const LAS bf16x8*)((kp) + ((f) >> 1) * 2048 + ((f) & 1) * 512))
    MT_DMA_K(0); MT_DMA_V(0, 0); MT_DMA_K(1); MT_DMA_K(2);
    float mhat = 0.f, l_reg = 0.f; o[0] = f32x16{}; o[1] = f32x16{};
    const f32x16 zero16 = f32x16{};
    bool resc = false;
    f32x16 pA0, pA1, pB0, pB1; bf16x8 kf[4]; s16x4 vlo[8], vhi[8]; u32x4 pw0, pw1, pw2, pw3;
    int sl_prev = 0, sl_cur = 0, sl_next = SLOTB;
    const int band0 = NT - 4;
#define MT_ROT() do { sl_prev = sl_cur; sl_cur = sl_next; sl_next = (sl_next == 2 * SLOTB) ? 0 : sl_next + SLOTB; } while (0)
#define MT_EX(v) __builtin_amdgcn_exp2f((v) + nmh)
#define MT_RESC() do { if (resc) { _Pragma("unroll") for (int d_ = 0; d_ < 2; ++d_) _Pragma("unroll") for (int r = 0; r < 16; ++r) o[d_][r] *= wsf[crow(r, hi)]; } } while (0)
    auto cmask = [&](int t, f32x16& p0, f32x16& p1) { const int jb = t - band0; if (jb >= 0) { const int kb = 64 * jb + 4 * hi;
#pragma unroll
            for (int r = 0; r < 16; ++r) { const int kv_ = kb + (r & 3) + 8 * (r >> 2); if (kv_ > qrel) p0[r] = -INFINITY; if (kv_ + 32 > qrel) p1[r] = -INFINITY; } } };
    ft_wait_bar(kc == 2 ? 5 : 3);
    { const ft_cptr kp = kp0;
      pA0 = zero16; pA1 = zero16;
#pragma unroll
      for (int d0 = 0; d0 < 6; ++d0) { const bf16x8 k0 = MT_KFR(kp, 2 * d0), k1 = MT_KFR(kp, 2 * d0 + 1); pA0 = FA_MFMA(k0, qr[d0], pA0); pA1 = FA_MFMA(k1, qr[d0], pA1); } }
    cmask(0, pA0, pA1);
    { const float rm = ft_rowmax(pA0, pA1); mhat = rm; const float nmh = -mhat;
#pragma unroll
      for (int r = 0; r < 16; ++r) { pA0[r] = MT_EX(pA0[r]); pA1[r] = MT_EX(pA1[r]); } }
    ft_wait_bar(0);
    MT_DMA_K(3); MT_DMA_V(1, SLOTB); MT_ROT();
    { const ft_cptr kp = kp0 + M_KSLOT;
#pragma unroll
      for (int f = 0; f < 4; ++f) kf[f] = MT_KFR(kp, f); }
    ft_wait_bar(kc + 1);
#define MT_PKW(P, i) ft_cvtpk(P[i], P[i + 1])
#define MT_PAF(k) __builtin_bit_cast(bf16x8, pw##k)
#define MT_VFR(i) (bf16x8){vlo[i][0], vlo[i][1], vlo[i][2], vlo[i][3], vhi[i][0], vhi[i][1], vhi[i][2], vhi[i][3]}
#define MT_VRD(i) do { vlo[i] = ft_vtr(vp_ + (((i) >> 2) * 4096 + ((i) & 3) * 1024)); vhi[i] = ft_vtr(vp_ + (((i) >> 2) * 4096 + ((i) & 3) * 1024 + 512)); } while (0)
#define MT_GAPA(i, C, a0, a1, a2, a3, W0, W1, PW) do { C = FA_MFMA(kf[(i) & 3], qr[(i) >> 1], ((i) < 2) ? zero16 : C); if ((i) + 4 < 12) kf[(i) & 3] = MT_KFR(kp_, (i) + 4); \
        sacc += a0; sacc += a1; sacc += a2; sacc += a3; W0; W1; FT_PIN(PW); FT_PIN(sacc); FT_SBAR(); } while (0)
#define MT_GAPA0(i, C) do { C = FA_MFMA(kf[(i) & 3], qr[(i) >> 1], C); if ((i) + 4 < 12) kf[(i) & 3] = MT_KFR(kp_, (i) + 4); FT_SBAR(); } while (0)
#define MT_GAPB(MF, X, i) do { MF; X[i] = MT_EX(X[i]); X[i + 1] = MT_EX(X[i + 1]); X[i + 2] = MT_EX(X[i + 2]); X[i + 3] = MT_EX(X[i + 3]); FT_PIN(X); FT_SBAR(); } while (0)
#define MT_STEP(C0, C1, P0, P1, t, MASK, GK, GV, GL) do { FT_SBAR(); \
    const ft_cptr vp_ = vp0 + sl_prev; const ft_cptr kp_ = kp0 + ((t) & 3) * M_KSLOT; \
    MT_VRD(0); FT_SBAR(); float sacc = P0[0] + P0[1]; \
                          MT_GAPA(0, C0, P0[2], P0[3], P0[4], P0[5],     pw0[0] = MT_PKW(P0, 0),  pw0[1] = MT_PKW(P0, 2),  pw0); \
    MT_VRD(4); FT_SBAR(); MT_GAPA(1, C1, P0[6], P0[7], P0[8], P0[9],     pw0[2] = MT_PKW(P0, 4),  pw0[3] = MT_PKW(P0, 6),  pw0); \
    MT_VRD(1); FT_SBAR(); MT_GAPA(2, C0, P0[10], P0[11], P0[12], P0[13], pw1[0] = MT_PKW(P0, 8),  pw1[1] = MT_PKW(P0, 10), pw1); \
    MT_VRD(5); FT_SBAR(); MT_GAPA(3, C1, P0[14], P0[15], P1[0], P1[1],   pw1[2] = MT_PKW(P0, 12), pw1[3] = MT_PKW(P0, 14), pw1); \
    MT_VRD(2); FT_SBAR(); MT_GAPA(4, C0, P1[2], P1[3], P1[4], P1[5],     pw2[0] = MT_PKW(P1, 0),  pw2[1] = MT_PKW(P1, 2),  pw2); \
    MT_VRD(6); FT_SBAR(); MT_GAPA(5, C1, P1[6], P1[7], P1[8], P1[9],     pw2[2] = MT_PKW(P1, 4),  pw2[3] = MT_PKW(P1, 6),  pw2); \
    MT_VRD(3); FT_SBAR(); MT_GAPA(6, C0, P1[10], P1[11], P1[12], P1[13], pw3[0] = MT_PKW(P1, 8),  pw3[1] = MT_PKW(P1, 10), pw3); \
    MT_VRD(7); FT_SBAR(); MT_GAPA(7, C1, P1[14], P1[15], 0.f, 0.f,       pw3[2] = MT_PKW(P1, 12), pw3[3] = MT_PKW(P1, 14), pw3); \
    MT_GAPA0(8, C0); MT_GAPA0(9, C1); MT_GAPA0(10, C0); MT_GAPA0(11, C1); \
    l_reg += sacc; \
    if (GK) MT_DMA_K((t) + 3); if (GV) MT_DMA_V((t) + 1, sl_next); \
    if (MASK) cmask((t), C0, C1); \
    { const float rm = ft_rowmax(C0, C1) - mhat; resc = false; \
      if (__builtin_expect(__any(rm > THR), 0)) { const float dl = __builtin_fmaxf(rm, 0.f); mhat += dl; \
          const float f = __builtin_amdgcn_exp2f(-dl); l_reg *= f; if (hi == 0) wsf[r32] = f; resc = true; } } \
    const float nmh = -mhat; FT_SBAR(); \
    MT_GAPB(o[0] = FA_MFMA(MT_PAF(0), MT_VFR(0), o[0]), C0, 0);  MT_GAPB(o[1] = FA_MFMA(MT_PAF(0), MT_VFR(4), o[1]), C0, 4); \
    MT_GAPB(o[0] = FA_MFMA(MT_PAF(1), MT_VFR(1), o[0]), C0, 8);  MT_GAPB(o[1] = FA_MFMA(MT_PAF(1), MT_VFR(5), o[1]), C0, 12); \
    MT_GAPB(o[0] = FA_MFMA(MT_PAF(2), MT_VFR(2), o[0]), C1, 0);  MT_GAPB(o[1] = FA_MFMA(MT_PAF(2), MT_VFR(6), o[1]), C1, 4); \
    MT_GAPB(o[0] = FA_MFMA(MT_PAF(3), MT_VFR(3), o[0]), C1, 8);  MT_GAPB(o[1] = FA_MFMA(MT_PAF(3), MT_VFR(7), o[1]), C1, 12); \
    if (GL) { const ft_cptr kn_ = kp0 + (((t) + 1) & 3) * M_KSLOT; _Pragma("unroll") for (int f = 0; f < 4; ++f) kf[f] = MT_KFR(kn_, f); } \
    } while (0)
#define MT_ENDW(tt) do { if ((tt) + 3 < NT) ft_wait_bar(kc + 1); else if ((tt) + 2 < NT) ft_wait_bar(1); else ft_wait_bar(0); } while (0)
    int t = 1;
    for (; t + 5 < NT; t += 2) {
        MT_STEP(pB0, pB1, pA0, pA1, t, false, true, true, true);     ft_wait_bar(kc + 1); MT_RESC(); MT_ROT();
        MT_STEP(pA0, pA1, pB0, pB1, t + 1, false, true, true, true); ft_wait_bar(kc + 1); MT_RESC(); MT_ROT();
    }
    for (; t + 1 < NT; t += 2) {
        MT_STEP(pB0, pB1, pA0, pA1, t, true, (t + 3 < NT), (t + 1 < NT), (t + 1 < NT));         MT_ENDW(t);     MT_RESC(); MT_ROT();
        MT_STEP(pA0, pA1, pB0, pB1, t + 1, true, (t + 4 < NT), (t + 2 < NT), (t + 2 < NT));     MT_ENDW(t + 1); MT_RESC(); MT_ROT();
    }
    MT_STEP(pB0, pB1, pA0, pA1, NT - 1, true, false, false, false); MT_RESC();
    { float sacc = pB0[0] + pB0[1];
#pragma unroll
      for (int r = 2; r < 16; ++r) sacc += pB0[r];
#pragma unroll
      for (int r = 0; r < 16; ++r) sacc += pB1[r];
      l_reg += sacc;
      pw0 = (u32x4){MT_PKW(pB0, 0), MT_PKW(pB0, 2), MT_PKW(pB0, 4), MT_PKW(pB0, 6)}; pw1 = (u32x4){MT_PKW(pB0, 8), MT_PKW(pB0, 10), MT_PKW(pB0, 12), MT_PKW(pB0, 14)};
      pw2 = (u32x4){MT_PKW(pB1, 0), MT_PKW(pB1, 2), MT_PKW(pB1, 4), MT_PKW(pB1, 6)}; pw3 = (u32x4){MT_PKW(pB1, 8), MT_PKW(pB1, 10), MT_PKW(pB1, 12), MT_PKW(pB1, 14)};
      const ft_cptr vp_ = vp0 + sl_cur; _Pragma("unroll") for (int i = 0; i < 8; ++i) MT_VRD(i);
      o[0] = FA_MFMA(MT_PAF(0), MT_VFR(0), o[0]); o[1] = FA_MFMA(MT_PAF(0), MT_VFR(4), o[1]); o[0] = FA_MFMA(MT_PAF(1), MT_VFR(1), o[0]); o[1] = FA_MFMA(MT_PAF(1), MT_VFR(5), o[1]);
      o[0] = FA_MFMA(MT_PAF(2), MT_VFR(2), o[0]); o[1] = FA_MFMA(MT_PAF(2), MT_VFR(6), o[1]); o[0] = FA_MFMA(MT_PAF(3), MT_VFR(3), o[0]); o[1] = FA_MFMA(MT_PAF(3), MT_VFR(7), o[1]); }
    l_out = l_reg;
    asm volatile("s_waitcnt lgkmcnt(0)\n\ts_barrier" ::: "memory");
#undef MT_DMA_K
#undef MT_DMA_V
#undef MT_KFR
#undef MT_ROT
#undef MT_EX
#undef MT_RESC
#undef MT_PKW
#undef MT_PAF
#undef MT_VFR
#undef MT_VRD
#undef MT_GAPA
#undef MT_GAPA0
#undef MT_GAPB
#undef MT_STEP
#undef MT_ENDW
}
}

DEV void mla_unit(const Params& p, LAS unsigned char* lds, int b, int h, int qb) {
    using namespace fa;
    const int tid = opaque_tid(), wid = __builtin_amdgcn_readfirstlane(tid >> 6), lane = tid & 63, r32 = lane & 31, hi = lane >> 5;
    const bf16_t* QM = (const bf16_t*)(p.ws + OFF_QM); const bf16_t* Kb = (const bf16_t*)(p.ws + OFF_KM) + (size_t)b * SEQ * 768 + h * 96;
    const bf16_t* Vb = (const bf16_t*)(p.ws + OFF_VM) + (size_t)b * SEQ * 512 + h * 64; bf16_t* OCAT = (bf16_t*)(p.ws + OFF_OCAT);
    const int q0 = qb * 256, NT = (q0 + 256) / 64;
    LAS float* wsf = (LAS float*)(lds + M_LWSF) + wid * 128;
    bf16x8 qr[6];
    { const bf16_t* qrow = QM + ((size_t)b * SEQ + q0 + wid * 32 + r32) * 768 + h * 96 + hi * 8;
#pragma unroll
      for (int d0 = 0; d0 < 6; ++d0) qr[d0] = *(const bf16x8*)(qrow + d0 * 16); }
    f32x16 o[2]; float lpart;
    fa96_tuned(o, lpart, qr, Kb, Vb, NT, wid * 32 + r32, lds, wsf, wid, lane, r32, hi);
    const float l = xhalf_sum(lpart); float rl[16]; row_to_olayout(1.0f / l, rl, wsf, r32, hi);
#pragma unroll
    for (int r = 0; r < 16; ++r) { o[0][r] *= rl[r]; o[1][r] *= rl[r]; }
    store_o_rows(o, OCAT + ((size_t)b * SEQ + q0 + wid * 32) * 1024 + h * 64, 1024, lds + M_LOST + wid * 4096, lane, r32, hi);
    __syncthreads();
}
DEV void nsa_unit(const Params& p, LAS unsigned char* lds, int b, int g, int tb) {
    using namespace fa;
    const int tid = opaque_tid(), wid = __builtin_amdgcn_readfirstlane(tid >> 6), lane = tid & 63, r32 = lane & 31, hi = lane >> 5;
    const int hl = wid >> 1, head = 4 * g + hl, q0 = 64 * tb, tokl = 32 * (wid & 1) + r32, t = q0 + tokl;
    const size_t tok = (size_t)b * SEQ + t;
    const bf16_t* PROJ = (const bf16_t*)(p.ws + OFF_PROJ); const float* GATES = (const float*)(p.ws + OFF_GATES);
    LAS float* wsf = (LAS float*)(lds + L_WSF) + wid * 128;
    LAS float* impH = (LAS float*)(lds + L_IMPH);
    const int kp0 = hi * 1024 + r32 * 16;
    const int vp0 = ((lane >> 4) & 1) * 32 + (lane & 3) * 8 + (4 * hi + ((lane & 15) >> 2)) * 64;
    bf16x8 qr[4];
    { const bf16_t* qrow = (const bf16_t*)(p.ws + OFF_NQ) + tok * 512 + head * 64 + hi * 8;
#pragma unroll
      for (int d0 = 0; d0 < 4; ++d0) qr[d0] = *(const bf16x8*)(qrow + d0 * 16); }
    if (hi == 0) { const float* gp_ = GATES + tok * 24 + head * 3; wsf[64 + r32] = gp_[0]; wsf[96 + r32] = gp_[1]; }
    const float g2reg = GATES[tok * 24 + head * 3 + 2];
    { LAS f32x4* z = (LAS f32x4*)impH + tid;
#pragma unroll
      for (int i = 0; i < 8; ++i) z[i * 512] = (f32x4){0.f, 0.f, 0.f, 0.f}; }
    KVRegs<8> kv;
    f32x16 res[2];
    const int cntq = (t >= 31) ? ((t - 31) >> 4) + 1 : 0;
    const int ntc = (4 * tb + 3 + 63) >> 6;
    const bf16_t* Kc = (const bf16_t*)(p.ws + OFF_KC) + ((size_t)b * NCMPP * 2 + g) * 64; const bf16_t* Vc = (const bf16_t*)(p.ws + OFF_VC) + ((size_t)b * NCMPP * 2 + g) * 64;
    float mc = -1e30f, lc = 0.f;
    {   KVRegs<8> kc4[4];
#pragma unroll
        for (int c = 0; c < 4; ++c) if (c < ntc) stage_load<8>(kc4[c], Kc, 128, Vc, 128, c * 64, wid, lane);

#pragma unroll
        for (int c = 0; c < 4; ++c) if (c < ntc) { *(LAS u32x4*)(lds + L_K + c * 8192 + wid * 1024 + lane * 16) = kc4[c].k0; *(LAS u32x4*)(lds + L_OST + c * 8192 + wid * 1024 + lane * 16) = kc4[c].v; } }
    __syncthreads();
#pragma unroll 1
    for (int c = 0; c < ntc; ++c) {
        f32x16 p0, p1; qk_tile<4>(lds + L_K + c * 8192, kp0, qr, p0, p1);
        const int nb = 64 * c + 4 * hi;
#pragma unroll
        for (int r = 0; r < 16; ++r) { const int n = nb + (r & 3) + 8 * (r >> 2); if (n >= cntq) p0[r] = -INFINITY; if (n + 32 >= cntq) p1[r] = -INFINITY; }
        const float newm = fmaxf(mc, rowmax32(p0, p1)); float sacc = 0.f;
#pragma unroll
        for (int r = 0; r < 16; ++r) sacc += fast_exp2(p0[r] - newm) + fast_exp2(p1[r] - newm);
        lc = lc * fast_exp2(mc - newm) + sacc; mc = newm;
    }
    lc = xhalf_sum(lc);
    const float rlc = (lc > 0.f) ? 1.0f / lc : 0.f;
    float carry = 0.f;
    f32x16 oc[2];
#pragma unroll
    for (int r = 0; r < 16; ++r) { oc[0][r] = 0.f; oc[1][r] = 0.f; }
#pragma unroll 1
    for (int c = 0; c < ntc; ++c) {
        f32x16 p0, p1; qk_tile<4>(lds + L_K + c * 8192, kp0, qr, p0, p1);
        const int nb = 64 * c + 4 * hi;
#pragma unroll
        for (int r = 0; r < 16; ++r) { const int n = nb + (r & 3) + 8 * (r >> 2);
            p0[r] = (n >= cntq) ? 0.f : fast_exp2(p0[r] - mc) * rlc; p1[r] = (n + 32 >= cntq) ? 0.f : fast_exp2(p1[r] - mc) * rlc; }
        { LAS float* ih = impH + (size_t)hl * 4096 + tokl; float b0[4], b1[4];
#pragma unroll
          for (int k = 0; k < 4; ++k) { b0[k] = __shfl_xor(p0[4 * k + 3], 32); b1[k] = __shfl_xor(p1[4 * k + 3], 32); }
#pragma unroll
          for (int k = 0; k < 4; ++k) { const int j0 = 16 * c + 2 * k + hi, j1 = j0 + 8;
              const float G0 = (p0[4 * k] + p0[4 * k + 1]) + (p0[4 * k + 2] + p0[4 * k + 3]), G1 = (p1[4 * k] + p1[4 * k + 1]) + (p1[4 * k + 2] + p1[4 * k + 3]);
              const float e0 = hi ? b0[k] : (k ? b0[k > 0 ? k - 1 : 0] : carry), e1 = hi ? b1[k] : (k ? b1[k > 0 ? k - 1 : 0] : b0[3]);
              ih[j0 * 64] = G0 + e0; ih[j1 * 64] = G1 + e1; }
          carry = b1[3]; }
        u32x4 pw[4];
#pragma unroll
        for (int k = 0; k < 2; ++k) { pw[k] = (u32x4){pk2(p0[8 * k], p0[8 * k + 1]), pk2(p0[8 * k + 2], p0[8 * k + 3]), pk2(p0[8 * k + 4], p0[8 * k + 5]), pk2(p0[8 * k + 6], p0[8 * k + 7])};
            pw[2 + k] = (u32x4){pk2(p1[8 * k], p1[8 * k + 1]), pk2(p1[8 * k + 2], p1[8 * k + 3]), pk2(p1[8 * k + 4], p1[8 * k + 5]), pk2(p1[8 * k + 6], p1[8 * k + 7])}; }
        const LAS unsigned char* vbuf = lds + L_OST + c * 8192;
#pragma unroll
        for (int dh = 0; dh < 2; ++dh)
#pragma unroll
            for (int ks = 0; ks < 4; ++ks) { const s16x4 lo = vtr(vbuf + vp0 + dh * 4096 + ks * 1024), hi4 = vtr(vbuf + vp0 + dh * 4096 + ks * 1024 + 512);
                const bf16x8 vf = (bf16x8){lo[0], lo[1], lo[2], lo[3], hi4[0], hi4[1], hi4[2], hi4[3]};
                oc[dh] = FA_MFMA(__builtin_bit_cast(bf16x8, pw[ks]), vf, oc[dh]); }
    }
    __syncthreads();
    {   const int tk = tid & 63; const int cur = tb;
        float v[8];
#pragma unroll
        for (int k = 0; k < 8; ++k) { const int j = 8 * wid + k; const LAS float* q_ = impH + j * 64 + tk;
            const float s4 = ((q_[0] + q_[4096]) + q_[2 * 4096]) + q_[3 * 4096]; const bool forced = (j == 0) || (j <= cur && j > cur - 2); v[k] = forced ? 1e30f : s4; }
#pragma unroll
        for (int k = 0; k < 8; ++k) impH[(8 * wid + k) * 64 + tk] = v[k];
        __syncthreads();
        unsigned bits = 0u; int rank[8];
#pragma unroll
        for (int k = 0; k < 8; ++k) rank[k] = 0;
        if (cur >= 16)
#pragma unroll 4
        for (int q_ = 0; q_ <= cur; ++q_) { const float vq = impH[q_ * 64 + tk];
#pragma unroll
            for (int k = 0; k < 8; ++k) rank[k] += (vq > v[k] || (vq == v[k] && q_ < 8 * wid + k)) ? 1 : 0; }
#pragma unroll
        for (int k = 0; k < 8; ++k) if (8 * wid + k <= cur && rank[k] < 16) bits |= (1u << k);
        ((LAS unsigned char*)(lds + L_MASK))[tk * 8 + wid] = (unsigned char)bits;
        __syncthreads();
    }
    LAS float* resL = impH + wid * 2048 + lane;
    { float f[16]; row_to_olayout(wsf[64 + r32], f, wsf, r32, hi);
#pragma unroll
      for (int r = 0; r < 16; ++r) { resL[r * 64] = oc[0][r] * f[r]; resL[(16 + r) * 64] = oc[1][r] * f[r]; } }
    const unsigned long long mymask = *(const LAS unsigned long long*)(lds + L_MASK + tokl * 8);
    unsigned long long um;
    { const unsigned long long mm = *(const LAS unsigned long long*)(lds + L_MASK + lane * 8); unsigned ulo = (unsigned)mm, uhi = (unsigned)(mm >> 32);
#pragma unroll
      for (int o_ = 1; o_ < 64; o_ <<= 1) { ulo |= __shfl_xor(ulo, o_); uhi |= __shfl_xor(uhi, o_); }
      um = ((unsigned long long)(unsigned)__builtin_amdgcn_readfirstlane(uhi) << 32) | (unsigned)__builtin_amdgcn_readfirstlane(ulo); }
    {   const bf16_t* Kb = (const bf16_t*)(p.ws + OFF_KSR) + (size_t)b * SEQ * 128 + g * 64; const bf16_t* Vb = (const bf16_t*)(p.ws + OFF_VSC) + (size_t)b * SEQ * 128 + g * 64;
        int nt = __builtin_popcountll(um);
        while (nt < 4 || (nt & 1)) ++nt;
        f32x16 o[2]; float lpart;
        fa64_tuned<0>(o, lpart, qr, Kb, 128, Vb, 128, um, 0, nt, mymask, tb, tokl, lds, wsf, wid, lane, r32, hi);
        const float l = xhalf_sum(lpart); float f[16]; row_to_olayout(wsf[96 + r32] / l, f, wsf, r32, hi);
#pragma unroll
        for (int r = 0; r < 16; ++r) { resL[r * 64] += o[0][r] * f[r]; resL[(16 + r) * 64] += o[1][r] * f[r]; }
    }
    {   const bf16_t* Kb = (const bf16_t*)(p.ws + OFF_KWR) + (size_t)b * SEQ * 128 + g * 64; const bf16_t* Vb = (const bf16_t*)(p.ws + OFF_VWC) + (size_t)b * SEQ * 128 + g * 64;
        const int jlast = (tb - 8 > 0) ? tb - 8 : 0; int nt = tb - jlast + 1;
        while (nt < 4 || (nt & 1)) ++nt;
        f32x16 o[2]; float lpart;
        fa64_tuned<1>(o, lpart, qr, Kb, 128, Vb, 128, 0ull, jlast, nt, 0ull, tb, tokl, lds, wsf, wid, lane, r32, hi);
        const float l = xhalf_sum(lpart); float f[16]; row_to_olayout(g2reg / l, f, wsf, r32, hi);
#pragma unroll
        for (int r = 0; r < 16; ++r) { res[0][r] = resL[r * 64] + o[0][r] * f[r]; res[1][r] = resL[(16 + r) * 64] + o[1][r] * f[r]; }
        asm volatile("s_waitcnt lgkmcnt(0)" ::: "memory");
    }
    store_o_rows(res, (bf16_t*)(p.ws + OFF_OCAT) + ((size_t)b * SEQ + q0 + 32 * (wid & 1)) * 1024 + 512 + head * 64, 1024, lds + L_OST + wid * 4096, lane, r32, hi);
    __syncthreads();
}
DEV void phase5_nsa_fa(const Params& p, LAS unsigned char* lds) {
    constexpr int NU = BATCH * 2 * 64;
    const int G = gridDim.x;
    for (int r = 0; r * G < NU; ++r) {
        const int k = r * G + ((r & 1) ? (G - 1 - (int)blockIdx.x) : (int)blockIdx.x);
        if (k >= NU) continue;
        const int tb = 63 - k / 16, bg = k % 16;
        nsa_unit(p, lds, bg >> 1, bg & 1, tb);
    }
}
DEV void phase5_mla_fa(const Params& p, LAS unsigned char* lds) {
    constexpr int NU = BATCH * 8 * 16;
    const int G = gridDim.x;
    for (int r = 0; r * G < NU; ++r) {
        const int k = r * G + ((r & 1) ? (G - 1 - (int)blockIdx.x) : (int)blockIdx.x);
        if (k >= NU) continue;
        const int qb = 15 - k / 64, bh = k % 64;
        mla_unit(p, lds, bh >> 3, bh & 7, qb);
    }
}

DEV void phase5_cmp(const Params& p, LAS unsigned char* lds) {
    const int tid = opaque_tid(), hl = tid >> 7, tl = tid & 127;
    const bf16_t* NQ = (const bf16_t*)(p.ws + OFF_NQ); const bf16_t* KC = (const bf16_t*)(p.ws + OFF_KC); const bf16_t* VC = (const bf16_t*)(p.ws + OFF_VC);
    float* OCMP = (float*)(p.ws + OFF_OCMP); unsigned long long* SELM = (unsigned long long*)(p.ws + OFF_SELM);
    LAS float* imp = (LAS float*)lds;
    constexpr int NU = BATCH * 2 * (SEQ / 128);
    for (int u = blockIdx.x; u < NU; u += gridDim.x) {
        const int tb = u % (SEQ / 128), g = (u / (SEQ / 128)) & 1, b = u / (SEQ / 128 * 2);
        const int t = tb * 128 + tl, head = g * 4 + hl; const size_t tok = (size_t)b * SEQ + t;
        float q[64];
        { const bf16_t* qr = NQ + tok * 512 + head * 64;
#pragma unroll
          for (int i = 0; i < 32; ++i) { const unsigned w = *(const unsigned*)(qr + 2 * i); q[2 * i] = bflo(w); q[2 * i + 1] = bfhi(w); } }
        for (int j = 0; j < 64; ++j) imp[(hl * 64 + j) * 128 + tl] = 0.f;
        const int cnt = (t >= 31) ? ((t - 31) / 16 + 1) : 0;
        const int tmaxw = tb * 128 + (tl | 63); const int cntw = (tmaxw >= 31) ? ((tmaxw - 31) / 16 + 1) : 0;
        const bf16_t* kb = KC + ((size_t)b * NCMPP * 2 + g) * 64; const bf16_t* vb = VC + ((size_t)b * NCMPP * 2 + g) * 64;
        float m = -INFINITY, l = 0.f;
        for (int n = 0; n < cntw; ++n) { float a = 0.f;
#pragma unroll
            for (int i = 0; i < 32; ++i) { const unsigned w = *(const unsigned*)(kb + (size_t)n * 128 + 2 * i); a += q[2 * i] * bflo(w); a += q[2 * i + 1] * bfhi(w); }
            if (n < cnt) { const float mn = fmaxf(m, a); l = l * fast_exp2(m - mn) + fast_exp2(a - mn); m = mn; } }
        const float rl = (cnt > 0) ? 1.0f / l : 0.f;
        float o[64];
#pragma unroll
        for (int d = 0; d < 64; ++d) o[d] = 0.f;
        for (int n = 0; n < cntw; ++n) { float a = 0.f;
#pragma unroll
            for (int i = 0; i < 32; ++i) { const unsigned w = *(const unsigned*)(kb + (size_t)n * 128 + 2 * i); a += q[2 * i] * bflo(w); a += q[2 * i + 1] * bfhi(w); }
            const float pr = (n < cnt) ? fast_exp2(a - m) * rl : 0.f;
#pragma unroll
            for (int i = 0; i < 32; ++i) { const unsigned w = *(const unsigned*)(vb + (size_t)n * 128 + 2 * i); o[2 * i] += pr * bflo(w); o[2 * i + 1] += pr * bfhi(w); }
            const int jj = n >> 2; imp[(hl * 64 + jj) * 128 + tl] += pr; if ((n & 3) == 3 && jj + 1 < 64) imp[(hl * 64 + jj + 1) * 128 + tl] += pr; }
        { float* orow = OCMP + tok * 512 + head * 64; const float g0 = ((const float*)(p.ws + OFF_GATES))[tok * 24 + head * 3 + 0];
#pragma unroll
          for (int i = 0; i < 16; ++i) *(f32x4*)(orow + 4 * i) = (f32x4){g0 * o[4 * i], g0 * o[4 * i + 1], g0 * o[4 * i + 2], g0 * o[4 * i + 3]}; }
        __syncthreads();
        if (tid < 128) {
            const int cur = t >> 6;
            for (int j = 0; j < 64; ++j) { const float v = ((imp[(0 * 64 + j) * 128 + tl] + imp[(1 * 64 + j) * 128 + tl]) + imp[(2 * 64 + j) * 128 + tl]) + imp[(3 * 64 + j) * 128 + tl];
                const bool forced = (j == 0) || (j <= cur && j > cur - 2);
                imp[j * 128 + tl] = forced ? 1e30f : v; }
            unsigned long long mask = 0ull;
            for (int j = 0; j <= cur; ++j) { const float vj = imp[j * 128 + tl]; int rank = 0;
                for (int k = 0; k <= cur; ++k) { const float vk = imp[k * 128 + tl]; rank += (vk > vj || (vk == vj && k < j)) ? 1 : 0; }
                if (rank < 16) mask |= (1ull << j); }
            SELM[((size_t)b * 2 + g) * SEQ + t] = mask;
        }
        __syncthreads();
    }
}

DEV void phase5_selwin(const Params& p) {
    const int tid = opaque_tid(), wid = __builtin_amdgcn_readfirstlane(tid >> 6), lane = tid & 63;
    const int gw = blockIdx.x * 8 + wid, NGW = gridDim.x * 8;
    const bf16_t* NQ = (const bf16_t*)(p.ws + OFF_NQ); const bf16_t* KSR = (const bf16_t*)(p.ws + OFF_KSR); const bf16_t* KWR = (const bf16_t*)(p.ws + OFF_KWR);
    const bf16_t* PROJ = (const bf16_t*)(p.ws + OFF_PROJ); float* OCMP = (float*)(p.ws + OFF_OCMP); const float* GATES = (const float*)(p.ws + OFF_GATES);
    const unsigned long long* SELM = (const unsigned long long*)(p.ws + OFF_SELM); bf16_t* OCAT = (bf16_t*)(p.ws + OFF_OCAT);
    constexpr int NUNIT = BATCH * 8 * (SEQ / 64);
#pragma unroll 1
    for (int uu = gw; uu < NUNIT; uu += NGW) {
        const int u = (uu & 1) ? (NUNIT - 1 - (uu >> 1)) : (uu >> 1);
        const int tb = u % (SEQ / 64), head = (u / (SEQ / 64)) & 7, b = u / (SEQ / 64 * 8), g = head >> 2;
        const int t = tb * 64 + lane; const size_t tok = (size_t)b * SEQ + t;
        float q[64];
        { const bf16_t* qr = NQ + tok * 512 + head * 64;
#pragma unroll
          for (int i = 0; i < 32; ++i) { const unsigned w = *(const unsigned*)(qr + 2 * i); q[2 * i] = bflo(w); q[2 * i + 1] = bfhi(w); } }
        const unsigned long long mask = SELM[((size_t)b * 2 + g) * SEQ + t];
        unsigned ulo = (unsigned)mask, uhi = (unsigned)(mask >> 32);
#pragma unroll
        for (int o_ = 1; o_ < 64; o_ <<= 1) { ulo |= __shfl_xor(ulo, o_); uhi |= __shfl_xor(uhi, o_); }
        const unsigned long long um = ((unsigned long long)__builtin_amdgcn_readfirstlane(uhi) << 32) | (unsigned)__builtin_amdgcn_readfirstlane(ulo);
        float* oc = OCMP + tok * 512 + head * 64;
        { float o[64];
#pragma unroll
          for (int d = 0; d < 64; ++d) o[d] = 0.f;
          float m = -INFINITY, l = 0.f;
          const bf16_t* kb = KSR + (size_t)b * SEQ * 128 + g * 64; const bf16_t* vb = PROJ + (size_t)b * SEQ * INP + C_VS + g * 64;
#pragma unroll 1
          for (int blk = 0; blk <= tb; ++blk) { if (!((um >> blk) & 1ull)) continue; const bool sel = (mask >> blk) & 1ull;
              naive_attn_range<64, 64>(q, o, m, l, blk * 64, blk * 64 + 64,
                  [&](int j, int i) -> unsigned { return *(const unsigned*)(kb + (size_t)j * 128 + 2 * i); },
                  [&](int j, int i) -> unsigned { return *(const unsigned*)(vb + (size_t)j * INP + 2 * i); },
                  [&](int j) -> bool { return sel && j <= t; }); }
          const float g1 = GATES[tok * 24 + head * 3 + 1] / l;
#pragma unroll
          for (int i = 0; i < 16; ++i) { f32x4 c4 = *(f32x4*)(oc + 4 * i); c4.x += g1 * o[4 * i]; c4.y += g1 * o[4 * i + 1]; c4.z += g1 * o[4 * i + 2]; c4.w += g1 * o[4 * i + 3]; *(f32x4*)(oc + 4 * i) = c4; } }
        { float o[64];
#pragma unroll
          for (int d = 0; d < 64; ++d) o[d] = 0.f;
          float m = -INFINITY, l = 0.f;
          const bf16_t* kb = KWR + (size_t)b * SEQ * 128 + g * 64; const bf16_t* vb = PROJ + (size_t)b * SEQ * INP + C_VW + g * 64;
          const int jlo = (tb * 64 - 511 > 0) ? tb * 64 - 511 : 0;
          naive_attn_range<64, 64>(q, o, m, l, jlo, tb * 64 + 64,
              [&](int j, int i) -> unsigned { return *(const unsigned*)(kb + (size_t)j * 128 + 2 * i); },
              [&](int j, int i) -> unsigned { return *(const unsigned*)(vb + (size_t)j * INP + 2 * i); },
              [&](int j) -> bool { return j <= t && j > t - 512; });
          const float g2 = GATES[tok * 24 + head * 3 + 2] / l; bf16_t* orow = OCAT + tok * 1024 + 512 + head * 64;
#pragma unroll
          for (int i = 0; i < 16; ++i) { const f32x4 c4 = *(const f32x4*)(oc + 4 * i); u32x2 w; w.x = pk2(c4.x + g2 * o[4 * i], c4.y + g2 * o[4 * i + 1]); w.y = pk2(c4.z + g2 * o[4 * i + 2], c4.w + g2 * o[4 * i + 3]);
              *(u32x2*)(orow + 4 * i) = w; } }
    }
}

DEV void phase7(const Params& p, LAS unsigned char* lds) {
    const int tid = opaque_tid(), wid = __builtin_amdgcn_readfirstlane(tid >> 6), lane = tid & 63;
    const float* H1 = (const float*)(p.ws + OFF_H1); unsigned char* XN = p.ws + OFF_XN; float* SXTOK = (float*)(p.ws + OFF_SXTOK);
    int* TOPI = (int*)(p.ws + OFF_TOPI); float* TOPG = (float*)(p.ws + OFF_TOPG); int* POS = (int*)(p.ws + OFF_POS); unsigned* CNT = (unsigned*)(p.ws + OFF_CNT);
    LAS float* xt = (LAS float*)lds;
    LAS float* part = (LAS float*)(lds + 16 * 1028 * 4);
    LAS unsigned* lcnt = (LAS unsigned*)(lds + 16 * 1028 * 4 + 16384);
    const int ej = lane & 15, kq = lane >> 4, k0_ = 128 * wid + 32 * kq;
    float rw0[32], rw1[32];
#pragma unroll
    for (int i = 0; i < 32; ++i) { rw0[i] = p.router_w[(size_t)(k0_ + i) * 32 + ej]; rw1[i] = p.router_w[(size_t)(k0_ + i) * 32 + 16 + ej]; }
    const f32x4* gr = (const f32x4*)p.ffn_norm + lane;
    f32x4 gg[4];
#pragma unroll
    for (int j = 0; j < 4; ++j) gg[j] = gr[64 * j];
    for (int ch = blockIdx.x; ch < NTOK / 128; ch += gridDim.x) {
        if (tid < 32) lcnt[tid] = 0u;
        f32x4 nx[2][4];
#pragma unroll
        for (int rr = 0; rr < 2; ++rr) { const f32x4* xr = (const f32x4*)(H1 + (size_t)(ch * 128 + 2 * wid + rr) * DM) + lane;
#pragma unroll
            for (int j = 0; j < 4; ++j) nx[rr][j] = xr[64 * j]; }
        __syncthreads();
#pragma unroll 1
        for (int sub = 0; sub < 8; ++sub) {
            const int tok0 = ch * 128 + sub * 16;
#pragma unroll
            for (int rr = 0; rr < 2; ++rr) { const int row = 2 * wid + rr, tok = tok0 + row;
                f32x4 v[4]; float s_ = 0.f;
#pragma unroll
                for (int j = 0; j < 4; ++j) { v[j] = nx[rr][j]; s_ += (v[j].x * v[j].x + v[j].y * v[j].y) + (v[j].z * v[j].z + v[j].w * v[j].w); }
                if (sub + 1 < 8) { const f32x4* xr = (const f32x4*)(H1 + (size_t)(tok + 16) * DM) + lane;
#pragma unroll
                    for (int j = 0; j < 4; ++j) nx[rr][j] = xr[64 * j]; }
                const float rstd = rsqrtf(wave_sum(s_) * (1.f / 1024.f) + 1e-5f);
                float amax = 0.f;
#pragma unroll
                for (int j = 0; j < 4; ++j) { v[j].x *= rstd * gg[j].x; v[j].y *= rstd * gg[j].y; v[j].z *= rstd * gg[j].z; v[j].w *= rstd * gg[j].w;
                    amax = fmaxf(fmaxf(amax, fmaxf(fabsf(v[j].x), fabsf(v[j].y))), fmaxf(fabsf(v[j].z), fabsf(v[j].w))); *(LAS f32x4*)(xt + row * 1028 + 256 * j + 4 * lane) = v[j]; }
#pragma unroll
                for (int o_ = 1; o_ < 64; o_ <<= 1) amax = fmaxf(amax, __shfl_xor(amax, o_));
                amax = fmaxf(amax, 1e-30f); const float qinv = 127.0f / amax; if (lane == 0) SXTOK[tok] = amax * (1.0f / 127.0f);
                unsigned* o4 = (unsigned*)(XN + (size_t)tok * DM) + lane;
#pragma unroll
                for (int j = 0; j < 4; ++j) { const unsigned q0 = (unsigned)__float2int_rn(v[j].x * qinv) & 255u, q1 = (unsigned)__float2int_rn(v[j].y * qinv) & 255u, q2 = (unsigned)__float2int_rn(v[j].z * qinv) & 255u, q3 = (unsigned)__float2int_rn(v[j].w * qinv) & 255u;
                    o4[64 * j] = q0 | (q1 << 8) | (q2 << 16) | (q3 << 24); } }
            __syncthreads();
            { f32x4 acc0 = (f32x4){0.f, 0.f, 0.f, 0.f}, acc1 = acc0; const LAS float* xrow = xt + ej * 1028 + k0_;
#pragma unroll
              for (int s4 = 0; s4 < 8; ++s4) { const f32x4 xv = *(const LAS f32x4*)(xrow + 4 * s4);
#pragma unroll
                  for (int i = 0; i < 4; ++i) { acc0 = __builtin_amdgcn_mfma_f32_16x16x4f32(xv[i], rw0[4 * s4 + i], acc0, 0, 0, 0); acc1 = __builtin_amdgcn_mfma_f32_16x16x4f32(xv[i], rw1[4 * s4 + i], acc1, 0, 0, 0); } }
#pragma unroll
              for (int r = 0; r < 4; ++r) { part[(wid * 16 + 4 * kq + r) * 32 + ej] = acc0[r]; part[(wid * 16 + 4 * kq + r) * 32 + 16 + ej] = acc1[r]; } }
            __syncthreads();
            { const int tk = tid >> 5, e = tid & 31, tok = tok0 + tk; float logit = p.router_b[e];
#pragma unroll
              for (int w_ = 0; w_ < 8; ++w_) logit += part[(w_ * 16 + tk) * 32 + e];
              int ti[4]; float tv[4]; float cur = logit;
#pragma unroll
              for (int r = 0; r < 4; ++r) { float bv = cur; int bi = e;
#pragma unroll
                  for (int o_ = 1; o_ < 32; o_ <<= 1) { const float ov = __shfl_xor(bv, o_); const int oi = __shfl_xor(bi, o_); if (ov > bv || (ov == bv && oi < bi)) { bv = ov; bi = oi; } }
                  ti[r] = bi; tv[r] = bv; if (e == bi) cur = -INFINITY; }
              const float e1 = __expf(tv[1] - tv[0]), e2 = __expf(tv[2] - tv[0]), e3 = __expf(tv[3] - tv[0]); const float inv = 1.0f / (1.0f + e1 + e2 + e3);
              if (e == 0) {
                  *(f32x4*)(TOPG + (size_t)tok * 4) = (f32x4){inv, e1 * inv, e2 * inv, e3 * inv};
                  int ps[4];
#pragma unroll
                  for (int r = 0; r < 4; ++r) ps[r] = (int)__hip_atomic_fetch_add(&lcnt[ti[r]], 1u, __ATOMIC_RELAXED, __HIP_MEMORY_SCOPE_WORKGROUP);
                  int* ti_o = TOPI + (size_t)tok * 4; int* ps_o = POS + (size_t)tok * 4;
#pragma unroll
                  for (int r = 0; r < 4; ++r) { ti_o[r] = ti[r]; ps_o[r] = ps[r]; }
              } }
            __syncthreads();
        }
        if (tid < 32) lcnt[32 + tid] = atomicAdd(&CNT[tid], lcnt[tid]);
        __syncthreads();
        if (tid < 128) { const int tok = ch * 128 + tid; const int* ti_o = TOPI + (size_t)tok * 4; int* ps_o = POS + (size_t)tok * 4;
#pragma unroll
            for (int r = 0; r < 4; ++r) ps_o[r] += (int)lcnt[32 + ti_o[r]]; }
        __syncthreads();
    }
}

DEV void moe_offsets(const Params& p, LAS unsigned* tab) {
    const unsigned* CNT = (const unsigned*)(p.ws + OFF_CNT);
    const int tid = opaque_tid();
    if (tid < 64) {
        const int e = tid & 31; const unsigned c = __hip_atomic_load(&CNT[e], __ATOMIC_RELAXED, __HIP_MEMORY_SCOPE_AGENT);
        const unsigned pad = ((c + 255u) >> 8) << 8; unsigned inc = pad;
#pragma unroll
        for (int o_ = 1; o_ < 32; o_ <<= 1) { const unsigned v = __shfl_up(inc, o_, 32); if (e >= o_) inc += v; }
        if (tid < 32) { tab[e] = inc - pad; tab[32 + e] = inc >> 8; if (e == 31) tab[64] = inc; }
    }
    __syncthreads();
}
typedef int i32x4_ __attribute__((ext_vector_type(4)));
DEV void phase8(const Params& p, LAS unsigned char* lds) {
    const int tid = opaque_tid();
    LAS unsigned* tab = (LAS unsigned*)lds; moe_offsets(p, tab);
    const int* TOPI = (const int*)(p.ws + OFF_TOPI); const float* TOPG = (const float*)(p.ws + OFF_TOPG); int* POS = (int*)(p.ws + OFF_POS); float* RG = (float*)(p.ws + OFF_ROWGATE);
    const float* SXTOK = (const float*)(p.ws + OFF_SXTOK); float* SXROW = (float*)(p.ws + OFF_SXROW); int* ROWTOK = (int*)(p.ws + OFF_ROWTOK); const unsigned* CNT = (const unsigned*)(p.ws + OFF_CNT);
    for (int id = blockIdx.x * 512 + tid; id < NTOK * 4; id += gridDim.x * 512) { const int tok = id >> 2;
        const int e = TOPI[id]; const int slot = (int)tab[e] + POS[id];
        ROWTOK[slot] = tok; RG[slot] = TOPG[id]; SXROW[slot] = SXTOK[tok]; POS[id] = slot; }
    if (blockIdx.x < NEXP) { const int e = blockIdx.x; const int beg = (int)tab[e] + (int)__hip_atomic_load(&CNT[e], __ATOMIC_RELAXED, __HIP_MEMORY_SCOPE_AGENT), end = (int)tab[32 + e] * 256;
        for (int s_ = beg + tid; s_ < end; s_ += 512) ROWTOK[s_] = 0; }
}

DEV void phase11(const Params& p) {
    const int tid = opaque_tid(), wid = tid >> 6, lane = tid & 63;
    const int gw = blockIdx.x * 8 + wid, NGW = gridDim.x * 8;
    const float* H1 = (const float*)(p.ws + OFF_H1); const bf16_t* Y = (const bf16_t*)(p.ws + OFF_Y); const int* POS = (const int*)(p.ws + OFF_POS);
    const f32x4* gr = (const f32x4*)p.final_norm + lane; f32x4 gg[4];
#pragma unroll
    for (int j = 0; j < 4; ++j) gg[j] = gr[64 * j];
    i32x4_ slot[2];
#pragma unroll
    for (int q = 0; q < 2; ++q) { const int t0 = 2 * gw + q; slot[q] = *(const i32x4_*)(POS + (size_t)(t0 < NTOK ? t0 : 0) * 4); }
#pragma unroll 1
    for (int tok2 = gw * 2; tok2 < NTOK; tok2 += NGW * 2) {
        f32x4 v[2][4]; u32x2 y[2][4][4];
#pragma unroll
        for (int q = 0; q < 2; ++q) { const f32x4* xr = (const f32x4*)(H1 + (size_t)(tok2 + q) * DM) + lane;
#pragma unroll
            for (int j = 0; j < 4; ++j) v[q][j] = xr[64 * j];
#pragma unroll
            for (int r = 0; r < 4; ++r) { const u32x2* yr = (const u32x2*)(Y + (size_t)slot[q][r] * DM) + lane;
#pragma unroll
                for (int j = 0; j < 4; ++j) y[q][r][j] = yr[64 * j]; } }
        i32x4_ nslot[2];
#pragma unroll
        for (int q = 0; q < 2; ++q) { const int t1 = tok2 + NGW * 2 + q; nslot[q] = *(const i32x4_*)(POS + (size_t)(t1 < NTOK ? t1 : 0) * 4); }
#pragma unroll
        for (int q = 0; q < 2; ++q) {
#pragma unroll
            for (int r = 0; r < 4; ++r)
#pragma unroll
                for (int j = 0; j < 4; ++j) { const u32x2 w = y[q][r][j]; v[q][j].x += bflo(w.x); v[q][j].y += bfhi(w.x); v[q][j].z += bflo(w.y); v[q][j].w += bfhi(w.y); }
            float s = 0.f;
#pragma unroll
            for (int j = 0; j < 4; ++j) s += (v[q][j].x * v[q][j].x + v[q][j].y * v[q][j].y) + (v[q][j].z * v[q][j].z + v[q][j].w * v[q][j].w);
            const float rstd = rsqrtf(wave_sum(s) * (1.f / 1024.f) + 1e-5f);
            f32x4* orow = (f32x4*)(p.out + (size_t)(tok2 + q) * DM) + lane;
#pragma unroll
            for (int j = 0; j < 4; ++j) orow[64 * j] = (f32x4){v[q][j].x * rstd * gg[j].x, v[q][j].y * rstd * gg[j].y, v[q][j].z * rstd * gg[j].z, v[q][j].w * rstd * gg[j].w}; }
        slot[0] = nslot[0]; slot[1] = nslot[1];
    }
}

constexpr int NPHASE = 14;
constexpr int LDS_BYTES = 163840;
template <int PH> DEV void run_phase(const Params& p, LAS unsigned char* lds) {
    using namespace pg8;
    const int G = gridDim.x, bid = blockIdx.x;
    if constexpr (PH == 0) phase0(p, lds);
    if constexpr (PH == 1) { Gemm g{1024, 0}; DenseOrder S; S.init(p.ws + OFF_U, p.ws + OFF_WINT, 1024, NTOK, INP, G, bid);
        EpiBf16 E{(bf16_t*)(p.ws + OFF_PROJ), INP}; gemm_phase(lds, g, S, E);
        const int rem = S.nwg % G;
        if (rem > 0 && rem < G) { if (bid >= rem) prep_w2_items(p, lds, (bid - rem) * 8, (G - rem) * 8); } else prep_w2_items(p, lds, bid * 8, G * 8); }
    if constexpr (PH == 2) phase2(p);
    if constexpr (PH == 3) {
        const int NC = (G >= 64) ? 32 : 0;
        if (bid < NC) { Gemm g{2048, 1}; CmpOrder S{(const char*)(p.ws + OFF_KCC), (const char*)(p.ws + OFF_VCC), (const char*)(p.ws + OFF_CW1T), bid};
            EpiCmp E{(const float*)(p.ws + OFF_CB), p.cmp_w2, p.pos, (bf16_t*)(p.ws + OFF_KC), (bf16_t*)(p.ws + OFF_VC)}; gemm_phase(lds, g, S, E); }
        else {
            { Gemm g{256, 0}; UpOrder S; S.q.init(p.ws + OFF_QN, p.ws + OFF_WQUPT, 256, NTOK, 768, 1, 0); S.kv.init(p.ws + OFF_KVN, p.ws + OFF_WKVUPT, 256, NTOK, 1024, 1, 0); S.G = G - NC; S.c = bid - NC;
              EpiUp E{EpiQup{(bf16_t*)(p.ws + OFF_QM), (const float*)(p.ws + OFF_ROPEM)}, EpiKvup{(bf16_t*)(p.ws + OFF_KM), (bf16_t*)(p.ws + OFF_VM)}}; gemm_phase(lds, g, S, E); }
        }
        if (NC == 0) for (int k = bid; k < 32; k += G) { Gemm g{2048, 1}; CmpOrder S{(const char*)(p.ws + OFF_KCC), (const char*)(p.ws + OFF_VCC), (const char*)(p.ws + OFF_CW1T), k};
            EpiCmp E{(const float*)(p.ws + OFF_CB), p.cmp_w2, p.pos, (bf16_t*)(p.ws + OFF_KC), (bf16_t*)(p.ws + OFF_VC)}; gemm_phase(lds, g, S, E); }
        prep_w1_items(p, lds);
    }
    if constexpr (PH == 5) phase5_mla_fa(p, lds);
    if constexpr (PH == 6) phase5_nsa_fa(p, lds);
    if constexpr (PH == 8) { Gemm g{1024, 0}; DenseOrder S; S.init(p.ws + OFF_OCAT, p.ws + OFF_WOUTT, 1024, NTOK, 1024, G, bid);
        EpiResF32 E{p.x, (float*)(p.ws + OFF_H1), 1024}; gemm_phase(lds, g, S, E); }
    if constexpr (PH == 9) phase7(p, lds);
    if constexpr (PH == 10) phase8(p, lds);
    if constexpr (PH == 11) { LAS unsigned* tab = (LAS unsigned*)(lds + STAGE_BYTES); moe_offsets(p, tab);
        MoeOrder S; S.d.init(p.ws + OFF_XN, p.ws + OFF_W1T, 512, (int)tab[64], 2048, G, bid); S.tend = tab + 32; S.nNt = 8; S.gatherA = true;
        LAS int* rt = (LAS int*)(lds + STAGE_BYTES + 2048);
        { const int* ROWTOK = (const int*)(p.ws + OFF_ROWTOK); const int tid_ = opaque_tid(); Unit u_;
          for (int i = 0; S.next(i, u_); ++i) if (tid_ < 256) rt[i * 256 + tid_] = ROWTOK[u_.pm * 256 + tid_];
          __syncthreads(); }
        Gemm g{512, 2, rt};
        EpiMoe1 E{(bf16_t*)(p.ws + OFF_HMID), p.moe_b1, (const float*)(p.ws + OFF_SW1), (const float*)(p.ws + OFF_SXROW)}; gemm_phase<EpiMoe1, MoeOrder, true>(lds, g, S, E); }
    if constexpr (PH == 12) { LAS unsigned* tab = (LAS unsigned*)(lds + STAGE_BYTES); moe_offsets(p, tab);
        Gemm g{1024, 0}; MoeOrder S; S.d.init(p.ws + OFF_HMID, p.ws + OFF_W2T, 1024, (int)tab[64], 1024, G, bid); S.tend = tab + 32; S.nNt = 4;
        EpiMoe2 E{(bf16_t*)(p.ws + OFF_Y), p.moe_b2, (const float*)(p.ws + OFF_ROWGATE)}; gemm_phase(lds, g, S, E); }
    if constexpr (PH == 13) phase11(p);
}

template <int PH> __global__ void __launch_bounds__(512) phase_kernel(Params p) {
    extern __shared__ __attribute__((aligned(16))) unsigned char smem[];
    run_phase<PH>(p, (LAS unsigned char*)smem);
}

#if MK_ONE_LAUNCH
__global__ void __launch_bounds__(512) mega_kernel(Params p) {
    extern __shared__ __attribute__((aligned(16))) unsigned char smem[];
    LAS unsigned char* lds = (LAS unsigned char*)smem;
    cg::grid_group grid = cg::this_grid();
    volatile LAS unsigned* st = (volatile LAS unsigned*)(lds + LDS_BYTES - 16);
    if (threadIdx.x == 0) { st[0] = 0u; st[1] = 0u; }
    __syncthreads();
    const XcdBarrier xb = xcd_barrier_post((unsigned*)(p.ws + OFF_BAR), st);
#define GSYNC() xcd_barrier(xb)
    if (p.ws == nullptr) grid.sync();
    run_phase<0>(p, lds); GSYNC();
    run_phase<1>(p, lds); GSYNC();
    run_phase<2>(p, lds); GSYNC();
    run_phase<3>(p, lds); GSYNC();
    run_phase<5>(p, lds); run_phase<6>(p, lds); GSYNC();
    run_phase<8>(p, lds); GSYNC();
    run_phase<9>(p, lds); GSYNC();
    run_phase<10>(p, lds); GSYNC();
    run_phase<11>(p, lds); GSYNC();
    run_phase<12>(p, lds); GSYNC();
    run_phase<13>(p, lds);
}
#endif

template <int PH> static void launch_phase(const Params& p, int grid, hipStream_t stream) {
    static bool attr = false;
    if (!attr) { (void)hipFuncSetAttribute((const void*)phase_kernel<PH>, hipFuncAttributeMaxDynamicSharedMemorySize, LDS_BYTES); attr = true; }
    hipLaunchKernelGGL(phase_kernel<PH>, dim3(grid), dim3(512), LDS_BYTES, stream, p);
}

extern "C" void kernel_launch(void* const* d_in, const int* in_sizes, int n_in, void* d_out, int out_size, void* d_ws, size_t ws_size, hipStream_t stream) {
    static int grid = 0;
    if (grid == 0) {
        if (n_in != 20 || out_size != NTOK * DM || ws_size < WS_END) { fprintf(stderr, "kernel_launch: unexpected shapes (n_in %d, out %d, ws %zu < %zu)\n", n_in, out_size, ws_size, (size_t)WS_END); grid = -1; return; }
        int dev = 0, cus = 0, per_cu = 0;
        (void)hipGetDevice(&dev); (void)hipDeviceGetAttribute(&cus, hipDeviceAttributeMultiprocessorCount, dev);
#if MK_ONE_LAUNCH
        (void)hipFuncSetAttribute((const void*)mega_kernel, hipFuncAttributeMaxDynamicSharedMemorySize, LDS_BYTES);
        (void)hipOccupancyMaxActiveBlocksPerMultiprocessor(&per_cu, (const void*)mega_kernel, 512, LDS_BYTES);
        if (per_cu < 1) { fprintf(stderr, "kernel_launch: occupancy query says %d blocks per CU\n", per_cu); per_cu = 1; }
#endif
        (void)hipGetLastError();
        grid = cus * 1;
        if (grid <= 0) grid = 256;
    }
    if (grid < 0) return;
    Params p; memset(&p, 0, sizeof(p));
    p.x = (const float*)d_in[0]; p.pos = (const int*)d_in[1]; p.attn_norm = (const float*)d_in[2]; p.w_in = (const float*)d_in[3]; p.q_norm = (const float*)d_in[4];
    p.w_q_up = (const float*)d_in[5]; p.kv_norm = (const float*)d_in[6]; p.w_kv_up = (const float*)d_in[7]; p.cmp_pos = (const float*)d_in[8]; p.cmp_w1 = (const float*)d_in[9];
    p.cmp_w2 = (const float*)d_in[10]; p.w_out = (const float*)d_in[11]; p.ffn_norm = (const float*)d_in[12]; p.router_w = (const float*)d_in[13]; p.router_b = (const float*)d_in[14];
    p.moe_w1 = (const float*)d_in[15]; p.moe_b1 = (const float*)d_in[16]; p.moe_w2 = (const float*)d_in[17]; p.moe_b2 = (const float*)d_in[18]; p.final_norm = (const float*)d_in[19];
    p.out = (float*)d_out; p.ws = (unsigned char*)d_ws;
#if MK_ONE_LAUNCH
    (void)hipMemsetAsync((unsigned char*)d_ws + OFF_BAR, 0, XCD_BAR_WORDS * 4, stream);
    void* args[] = {&p};
    hipError_t e = hipLaunchCooperativeKernel((const void*)mega_kernel, dim3(grid), dim3(512), args, LDS_BYTES, stream);
    if (e != hipSuccess) fprintf(stderr, "cooperative launch failed: %s (grid %d)\n", hipGetErrorString(e), grid);
#else
    launch_phase<0>(p, grid, stream); launch_phase<1>(p, grid, stream); launch_phase<2>(p, grid, stream); launch_phase<3>(p, grid, stream); launch_phase<4>(p, grid, stream);
    launch_phase<5>(p, grid, stream); launch_phase<6>(p, grid, stream); launch_phase<7>(p, grid, stream); launch_phase<8>(p, grid, stream); launch_phase<9>(p, grid, stream);
    launch_phase<10>(p, grid, stream); launch_phase<11>(p, grid, stream); launch_phase<12>(p, grid, stream); launch_phase<13>(p, grid, stream);
#endif
}
```

```cpp
#include <hip/hip_runtime.h>
#include <hip/hip_cooperative_groups.h>
#include <cstdint>
#include <cstdio>
#include <cstring>
namespace cg = cooperative_groups;

#ifndef MK_ONE_LAUNCH
#define MK_ONE_LAUNCH 1
#endif

#define LAS __attribute__((address_space(3)))
#define DEV __device__ __forceinline__
typedef unsigned short bf16_t;
typedef short bf16x8 __attribute__((ext_vector_type(8)));
typedef float f32x4 __attribute__((ext_vector_type(4)));
typedef float f32x2 __attribute__((ext_vector_type(2)));
typedef unsigned u32x4 __attribute__((ext_vector_type(4)));
typedef unsigned u32x2 __attribute__((ext_vector_type(2)));

constexpr int BATCH = 8, SEQ = 4096, NTOK = BATCH * SEQ, DM = 1024;
constexpr int INC = 1720, INP = 1792;
constexpr int C_QLAT = 0, C_KVLAT = 256, C_KPE = 384, C_QNSA = 416, C_KC = 928, C_VC = 1056, C_KS = 1184, C_VS = 1312, C_KW = 1440, C_VW = 1568, C_G = 1696;
constexpr int NEXP = 32, TOPK = 4, DFF = 1024;
constexpr int NCMP = 255, NCMPP = 256;
constexpr int MAXROWS = 139264;
constexpr float LOG2E = 1.4426950408889634f;
constexpr float MLA_QSCALE = 0.10206207261596577f * LOG2E;
constexpr float NSA_QSCALE = 0.125f * LOG2E;

constexpr size_t MiB = 1ull << 20;
constexpr size_t OFF_W1T = 0;
constexpr size_t OFF_W2T = 128 * MiB;
constexpr size_t OFF_WINT = 192 * MiB;
constexpr size_t OFF_WQUPT = 196 * MiB;
constexpr size_t OFF_WKVUPT = 197 * MiB;
constexpr size_t OFF_WOUTT = 198 * MiB;
constexpr size_t OFF_CW1T = 200 * MiB;
constexpr size_t OFF_MISC = 202 * MiB;
constexpr size_t OFF_CB = OFF_MISC + 8192;
constexpr size_t OFF_CNT = OFF_MISC + 4096;
constexpr size_t OFF_BAR = OFF_MISC + 16384;
constexpr size_t OFF_TOPI = OFF_MISC + 64 * 1024;
constexpr size_t OFF_TOPG = OFF_TOPI + (size_t)NTOK * 16;
constexpr size_t OFF_POS = OFF_TOPG + (size_t)NTOK * 16;
constexpr size_t OFF_ROWGATE = OFF_POS + (size_t)NTOK * 16;
constexpr size_t OFF_SXROW = OFF_ROWGATE + (size_t)MAXROWS * 4;
constexpr size_t OFF_SXTOK = OFF_SXROW + (size_t)MAXROWS * 4;
constexpr size_t OFF_ROWTOK = OFF_SXTOK + (size_t)NTOK * 4;
constexpr size_t OFF_SW1 = OFF_ROWTOK + (size_t)MAXROWS * 4;
constexpr size_t OFF_H1 = 206 * MiB;
constexpr size_t OFF_R1 = 334 * MiB;
constexpr size_t OFF_R2 = 606 * MiB;
constexpr size_t WS_END = 878 * MiB;
constexpr size_t OFF_U = OFF_R1;
constexpr size_t OFF_QM = OFF_R1;
constexpr size_t OFF_OCAT = OFF_R1 + 64 * MiB;
constexpr size_t OFF_OCMP = OFF_R1 + 160 * MiB;
constexpr size_t OFF_KCC = OFF_R1 + 128 * MiB;
constexpr size_t OFF_VCC = OFF_R1 + 136 * MiB;
constexpr size_t OFF_VSC = OFF_R1 + 144 * MiB;
constexpr size_t OFF_VWC = OFF_R1 + 152 * MiB;
constexpr size_t OFF_SELM = OFF_R1 + 240 * MiB;
constexpr size_t OFF_KC = OFF_R1 + 241 * MiB;
constexpr size_t OFF_VC = OFF_R1 + 242 * MiB;
constexpr size_t OFF_GATES = OFF_R1 + 243 * MiB;
constexpr size_t OFF_ROPEM = OFF_R1 + 246 * MiB;
constexpr size_t OFF_KSR = OFF_R1 + 250 * MiB;
constexpr size_t OFF_KWR = OFF_R1 + 258 * MiB;
constexpr size_t OFF_PROJ = OFF_R2;
constexpr size_t OFF_NQ = OFF_R2 + 112 * MiB;
constexpr size_t OFF_QN = OFF_R2 + 144 * MiB;
constexpr size_t OFF_KVN = OFF_R2 + 160 * MiB;
constexpr size_t OFF_KM = OFF_R2 + 176 * MiB;
constexpr size_t OFF_VM = OFF_R2 + 224 * MiB;
constexpr size_t OFF_QUP = OFF_R2 + 256 * MiB;
constexpr size_t OFF_KVUP = OFF_R2 + 256 * MiB;
constexpr size_t OFF_KPE = OFF_R2 + 256 * MiB;
constexpr size_t OFF_XN = OFF_R1 + 0;
constexpr size_t OFF_XG = OFF_R1;
constexpr size_t OFF_Y = OFF_R1;
constexpr size_t OFF_HMID = OFF_R2;

struct Params {
    const float* x; const int* pos; const float* attn_norm; const float* w_in; const float* q_norm; const float* w_q_up; const float* kv_norm; const float* w_kv_up;
    const float* cmp_pos; const float* cmp_w1; const float* cmp_w2; const float* w_out; const float* ffn_norm; const float* router_w; const float* router_b;
    const float* moe_w1; const float* moe_b1; const float* moe_w2; const float* moe_b2; const float* final_norm;
    float* out; unsigned char* ws;
};

DEV float bf2f(bf16_t b) { return __uint_as_float((unsigned)b << 16); }
DEV float bflo(unsigned u) { return __uint_as_float(u << 16); }
DEV float bfhi(unsigned u) { return __uint_as_float(u & 0xffff0000u); }
DEV unsigned pk2(float lo, float hi) { unsigned r; asm volatile("v_cvt_pk_bf16_f32 %0, %1, %2" : "=v"(r) : "v"(lo), "v"(hi)); return r; }
DEV bf16_t f2bf(float f) { return (bf16_t)(pk2(f, 0.f) & 0xffffu); }
DEV float wave_sum(float v) {
#pragma unroll
    for (int o = 1; o < 64; o <<= 1) v += __shfl_xor(v, o);
    return v;
}
DEV float fast_exp2(float x) { return __builtin_amdgcn_exp2f(x); }
DEV int opaque_tid() { int t = threadIdx.x; asm volatile("" : "+v"(t)); return t; }

#define XB_TMO      128
#define XB_XCNT(j)  (256  + 64 * (j))
#define XB_XSUB(j)  (1280 + 64 * (j))
#define XB_XGEN(j)  (2304 + 64 * (j))
#define XB_TOP      3328
#define XB_TOPGEN   3392
#define XCD_BAR_WORDS 3456
#define XB_SPIN_CAP (1u << 22)
DEV unsigned xb_ld(unsigned* p) { return __hip_atomic_load(p, __ATOMIC_RELAXED, __HIP_MEMORY_SCOPE_AGENT); }
DEV unsigned xb_add(unsigned* p, unsigned v) { return __hip_atomic_fetch_add(p, v, __ATOMIC_RELAXED, __HIP_MEMORY_SCOPE_AGENT); }
DEV unsigned xb_xcc_id() { return (unsigned)__builtin_amdgcn_s_getreg((3 << 11) | 20) & 0xFu; }
#define XB_SPIN(cond, bar) do { unsigned _sp = 0; while (cond) { __builtin_amdgcn_s_sleep(1); \
    if ((++_sp & 255u) == 0u) { if (xb_ld(&(bar)[XB_TMO])) break; if (_sp > XB_SPIN_CAP) { atomicAdd(&(bar)[XB_TMO], 1u); break; } } } } while (0)
struct XcdBarrier { unsigned* bar; unsigned x; volatile LAS unsigned* st; };
DEV XcdBarrier xcd_barrier_post(unsigned* bar, volatile LAS unsigned* st) {
    XcdBarrier b; b.bar = bar; b.x = xb_xcc_id(); b.st = st;
    if (threadIdx.x == 0) (void)xb_add(&bar[XB_XCNT(b.x)], 1u);
    return b;
}
DEV void xcd_barrier_complete(unsigned* bar, unsigned x, unsigned& nloc, unsigned& nx) {
    const unsigned G = gridDim.x * gridDim.y * gridDim.z;
    unsigned sum, cnt, mine, sp = 0u;
    for (;;) {
        sum = 0u; cnt = 0u; mine = 0u;
#pragma unroll
        for (unsigned j = 0; j < 16; ++j) { const unsigned c = xb_ld(&bar[XB_XCNT(j)]); sum += c; cnt += (c > 0u) ? 1u : 0u; mine = (j == x) ? c : mine; }
        if (sum == G) break;
        __builtin_amdgcn_s_sleep(1);
        if ((++sp & 255u) == 0u) { if (xb_ld(&bar[XB_TMO])) break; if (sp > XB_SPIN_CAP) { atomicAdd(&bar[XB_TMO], 1u); break; } }
    }
    nloc = mine > 0u ? mine : 1u; nx = cnt > 0u ? cnt : 1u;
}
DEV void xcd_barrier(const XcdBarrier& b) {
    asm volatile("s_waitcnt vmcnt(0)" ::: "memory");
    __syncthreads();
    if (threadIdx.x == 0) {
        unsigned* bar = b.bar;
        __builtin_amdgcn_s_waitcnt(0);
        unsigned nloc = b.st[0], nx = b.st[1];
        if (nloc == 0u) { xcd_barrier_complete(bar, b.x, nloc, nx); b.st[0] = nloc; b.st[1] = nx; }
        const unsigned old = xb_add(&bar[XB_XSUB(b.x)], 1u);
        const unsigned gen = old / nloc;
        if (old + 1u == (gen + 1u) * nloc) {
            __builtin_amdgcn_fence(__ATOMIC_RELEASE, "agent");
            asm volatile("s_waitcnt vmcnt(0)" ::: "memory");
            const unsigned og = xb_add(&bar[XB_TOP], 1u);
            const unsigned tg = og / nx;
            if (og + 1u == (tg + 1u) * nx) xb_add(&bar[XB_TOPGEN], 1u);
            else XB_SPIN(xb_ld(&bar[XB_TOPGEN]) == tg, bar);
            __builtin_amdgcn_fence(__ATOMIC_ACQUIRE, "agent");
            xb_add(&bar[XB_XGEN(b.x)], 1u);
            asm volatile("s_waitcnt vmcnt(0)" ::: "memory");
        } else {
            XB_SPIN(xb_ld(&bar[XB_XGEN(b.x)]) == gen, bar);
            __builtin_amdgcn_fence(__ATOMIC_ACQUIRE, "agent");
            asm volatile("s_waitcnt vmcnt(0)" ::: "memory");
        }
    }
    __syncthreads();
}

namespace pg8 {
constexpr int BM = 256, BK = 64, HALF = 128, HTB = HALF * BK * 2, STAGE_BYTES = 8 * HTB, NXCD = 8, WGM = 8;
DEV int lds_byte(int r, int c) { const int st = (r >> 4) * 2 + (c >> 5), rr = r & 15, cc = c & 31, ob = rr * 64 + cc * 2; return st * 1024 + (ob ^ (((ob >> 9) & 1) << 5)); }
DEV void stage_rc(int b, int& R, int& C) { const int st = b / 1024, sb = b % 1024, swz = sb ^ (((sb >> 9) & 1) << 5); R = (st >> 1) * 16 + swz / 64; C = (st & 1) * 32 + (swz % 64) / 2; }

struct Unit { int pm, pn, e; const char* a; const char* b; };
struct Gemm { int K; int amode; const LAS int* rt = nullptr; };

struct DenseOrder {
    int nM, nN, nwg, G, c; const char* A; const char* Bt; size_t tstep;
    DEV void init(const void* A_, const void* Bt_, int K, int M, int N, int G_, int c_) { A = (const char*)A_; Bt = (const char*)Bt_; tstep = (size_t)BM * K * 2; nM = M / BM; nN = N / BM; nwg = nM * nN; G = G_; c = c_; }
    DEV bool next(int i, Unit& u) const {
        const long L = (long)i * G + c; if (L >= nwg) return false;
        int wgid = (int)L; { const int q = nwg / NXCD, r = nwg % NXCD, xcd = wgid % NXCD, off = wgid / NXCD; wgid = (xcd < r ? xcd * (q + 1) : r * (q + 1) + (xcd - r) * q) + off; }
        const int nig = WGM * nN, gid = wgid / nig, fm = gid * WGM, gsz = (nM - fm) < WGM ? (nM - fm) : WGM;
        u.pm = fm + ((wgid % nig) % gsz); u.pn = (wgid % nig) / gsz; u.e = 0; u.a = A + (size_t)u.pm * tstep; u.b = Bt + (size_t)u.pn * tstep; return true;
    }
};
struct MoeOrder {
    DenseOrder d; const LAS unsigned* tend;
    int nNt;
    bool gatherA = false;
    DEV bool next(int i, Unit& u) const {
        if (!d.next(i, u)) return false;
        const int e = __builtin_popcountll(__ballot(u.pm >= (int)tend[threadIdx.x & 31]) & 0xffffffffull);
        u.e = e; u.b = d.Bt + (size_t)(e * nNt + u.pn) * d.tstep; if (gatherA) u.a = d.A; return true;
    }
};

struct CmpOrder {
    const char* KCC; const char* VCC; const char* W; int k;
    DEV bool next(int i, Unit& u) const {
        if (i != 0 || k < 0) return false;
        const int c = k >> 4, pm = k & 15, b = pm >> 1, n0 = (pm & 1) * 128;
        u.pm = pm; u.pn = 0; u.e = c; u.a = (c == 0 ? KCC : VCC) + (size_t)(b * SEQ + 16 * n0) * 128 * 2; u.b = W + (size_t)c * 256 * 2048 * 2; return true;
    }
};

typedef int i32x4 __attribute__((ext_vector_type(4)));
template <class Epi, class Sched, bool I8 = false>
DEV void gemm_phase(LAS unsigned char* lds, const Gemm g, const Sched& S, const Epi& E) {
    const int tid = opaque_tid(), wid = __builtin_amdgcn_readfirstlane(tid >> 6), lane = tid & 63, wr = wid >> 2, wc = wid & 3, fr = lane & 15, fq = lane >> 4;
    const int K = g.K; int nt = K / BK; asm volatile("" : "+s"(nt));
    unsigned voffA[2], voffB[2];
#pragma unroll
    for (int i = 0; i < 2; ++i) { int R, C; stage_rc(tid * 16 + i * 8192, R, C); voffB[i] = (unsigned)(R * K + C) * 2u;
        voffA[i] = (g.amode == 1) ? (unsigned)((R >> 1) * 16 * 128 + (R & 1) * 64 + C) * 2u : voffB[i]; }
    const size_t kstepB = (size_t)(BK * 2), kstepA = (g.amode == 1) ? (size_t)128 * 2 : kstepB;
    const size_t hstepB = (size_t)HALF * K * 2, hstepA = (g.amode == 0) ? hstepB : (g.amode == 1) ? (size_t)64 * 16 * 128 * 2 : (size_t)0;
    int RA[2], CA[2];
#pragma unroll
    for (int i = 0; i < 2; ++i) stage_rc(tid * 16 + i * 8192, RA[i], CA[i]);
    unsigned gc[2][2], gn[2][2];
    auto gload = [&](int ui_, unsigned (&o_)[2][2]) {
#pragma unroll
        for (int h = 0; h < 2; ++h)
#pragma unroll
            for (int i = 0; i < 2; ++i) o_[h][i] = (unsigned)g.rt[ui_ * 256 + h * HALF + RA[i]] * (unsigned)(K * 2) + (unsigned)(CA[i] * 2); };
    const unsigned ldsw = (unsigned)wid * 1024u;
    const int aoff = lds_byte(wr * 64 + fr, fq * 8), boff = lds_byte(wc * 32 + fr, fq * 8);
#define PG8_SA(b, h) (((b) * 2 + (h)) * HTB)
#define PG8_SB(b, h) ((4 + (b) * 2 + (h)) * HTB)
#define PG8_STAGE(bufoff, gbase, voff) do { _Pragma("unroll") for (int _i = 0; _i < 2; ++_i) \
        __builtin_amdgcn_global_load_lds((const unsigned*)((const char*)(gbase) + (voff)[_i]), (LAS unsigned*)(lds + (bufoff) + ldsw + _i * 8192), 16, 0, 0); } while (0)
#define PG8_VA(h, nx) ((g.amode == 2) ? ((nx) ? gn[h] : gc[h]) : voffA)
#define PG8_LDA(dst, b, h) do { _Pragma("unroll") for (int m = 0; m < 4; ++m) _Pragma("unroll") for (int k = 0; k < 2; ++k) dst[m][k] = *(const LAS bf16x8*)(lds + PG8_SA(b, h) + aoff + m * 2048 + k * 1024); } while (0)
#define PG8_LDB(dst, b, h) do { _Pragma("unroll") for (int n = 0; n < 2; ++n) _Pragma("unroll") for (int k = 0; k < 2; ++k) dst[n][k] = *(const LAS bf16x8*)(lds + PG8_SB(b, h) + boff + n * 2048 + k * 1024); } while (0)
#define PG8_MMA(ai, bj, At, Bt) do { __builtin_amdgcn_s_setprio(1); _Pragma("unroll") for (int m = 0; m < 4; ++m) _Pragma("unroll") for (int n = 0; n < 2; ++n) _Pragma("unroll") for (int k = 0; k < 2; ++k) { \
        if constexpr (I8) acc[ai][bj][m][n] = __builtin_bit_cast(f32x4, __builtin_amdgcn_mfma_i32_16x16x64_i8(__builtin_bit_cast(i32x4, Bt[n][k]), __builtin_bit_cast(i32x4, At[m][k]), __builtin_bit_cast(i32x4, acc[ai][bj][m][n]), 0, 0, 0)); \
        else acc[ai][bj][m][n] = __builtin_amdgcn_mfma_f32_16x16x32_bf16(Bt[n][k], At[m][k], acc[ai][bj][m][n], 0, 0, 0); } __builtin_amdgcn_s_setprio(0); } while (0)
#define PG8_WAIT_V(n) asm volatile("s_waitcnt vmcnt(" #n ")" ::: "memory")
#define PG8_WAIT_L(n) asm volatile("s_waitcnt lgkmcnt(" #n ")" ::: "memory")
#define PG8_BAR __builtin_amdgcn_s_barrier()
#define PG8_SCHED __builtin_amdgcn_sched_barrier(0)
    Unit cur, nxt; int ui = 0;
    if (!S.next(0, cur)) return;
    f32x4 acc[2][2][4][2];
#pragma unroll
    for (int a = 0; a < 2; ++a)
#pragma unroll
        for (int b = 0; b < 2; ++b)
#pragma unroll
            for (int m = 0; m < 4; ++m)
#pragma unroll
                for (int n = 0; n < 2; ++n) acc[a][b][m][n] = (f32x4){0.f, 0.f, 0.f, 0.f};
    bf16x8 At[4][2], B0[2][2], B1[2][2];
    const char* cA = cur.a; const char* cB = cur.b;
    if (g.amode == 2) { gload(0, gc); asm volatile("s_waitcnt lgkmcnt(0)" ::: "memory"); }
    PG8_STAGE(PG8_SB(0, 0), cB, voffB); PG8_STAGE(PG8_SB(0, 1), cB + hstepB, voffB); PG8_STAGE(PG8_SA(0, 0), cA, PG8_VA(0, false)); PG8_STAGE(PG8_SA(0, 1), cA + hstepA, PG8_VA(1, false));
    if (wr == 1) PG8_BAR;
    PG8_WAIT_V(2); PG8_BAR;
    PG8_STAGE(PG8_SB(1, 0), cB + kstepB, voffB); PG8_STAGE(PG8_SA(1, 0), cA + kstepA, PG8_VA(0, false)); PG8_STAGE(PG8_SB(1, 1), cB + hstepB + kstepB, voffB);
    PG8_WAIT_V(6); PG8_BAR;
    for (;;) {
        const bool has_next = S.next(ui + 1, nxt);
        if (g.amode == 2) { if (has_next) gload(ui + 1, gn); else { gn[0][0] = gc[0][0]; gn[0][1] = gc[0][1]; gn[1][0] = gc[1][0]; gn[1][1] = gc[1][1]; } }
        const char* nA = has_next ? nxt.a : cA; const char* nB = has_next ? nxt.b : cB;
#pragma unroll 1
        for (int t = 0; t < nt; t += 2) {
            const bool last = (t == nt - 2);
            const char* a1 = cA + (size_t)(t + 1) * kstepA;
            const char* a2 = last ? nA : cA + (size_t)(t + 2) * kstepA; const char* b2 = last ? nB : cB + (size_t)(t + 2) * kstepB;
            const char* a3 = a2 + kstepA; const char* b3 = b2 + kstepB;
            PG8_LDB(B0, 0, 0); PG8_LDB(B1, 0, 1); PG8_SCHED; PG8_LDA(At, 0, 0); PG8_STAGE(PG8_SA(1, 1), a1 + hstepA, PG8_VA(1, false));
            PG8_WAIT_V(8); PG8_WAIT_L(0); PG8_BAR; PG8_MMA(0, 0, At, B0); PG8_MMA(0, 1, At, B1); PG8_BAR; PG8_SCHED;
            PG8_LDA(At, 0, 1); PG8_STAGE(PG8_SB(0, 0), b2, voffB); PG8_STAGE(PG8_SB(0, 1), b2 + hstepB, voffB); PG8_STAGE(PG8_SA(0, 0), a2, PG8_VA(0, last));
            PG8_WAIT_V(8); PG8_WAIT_L(0); PG8_BAR; PG8_MMA(1, 0, At, B0); PG8_MMA(1, 1, At, B1); PG8_BAR; PG8_SCHED;
            PG8_LDB(B0, 1, 0); PG8_LDB(B1, 1, 1); PG8_SCHED; PG8_LDA(At, 1, 0); PG8_STAGE(PG8_SA(0, 1), a2 + hstepA, PG8_VA(1, last));
            PG8_WAIT_V(8); PG8_WAIT_L(0); PG8_BAR; PG8_MMA(0, 0, At, B0); PG8_MMA(0, 1, At, B1); PG8_BAR; PG8_SCHED;
            PG8_LDA(At, 1, 1); PG8_STAGE(PG8_SB(1, 0), b3, voffB); PG8_STAGE(PG8_SB(1, 1), b3 + hstepB, voffB); PG8_STAGE(PG8_SA(1, 0), a3, PG8_VA(0, last));
            PG8_WAIT_V(8); PG8_WAIT_L(0); PG8_BAR; PG8_MMA(1, 0, At, B0); PG8_MMA(1, 1, At, B1); PG8_BAR; PG8_SCHED;
        }
        if (wr == 0) PG8_BAR;
        if constexpr (!Epi::AFTER_DRAIN) E(acc, cur, wr, wc, fr, fq);
        if (!has_next) break;
#pragma unroll
        for (int a = 0; a < 2; ++a)
#pragma unroll
            for (int b = 0; b < 2; ++b)
#pragma unroll
                for (int m = 0; m < 4; ++m)
#pragma unroll
                    for (int n = 0; n < 2; ++n) acc[a][b][m][n] = (f32x4){0.f, 0.f, 0.f, 0.f};
        cur = nxt; cA = nA; cB = nB; ++ui;
        if (g.amode == 2) { gc[0][0] = gn[0][0]; gc[0][1] = gn[0][1]; gc[1][0] = gn[1][0]; gc[1][1] = gn[1][1]; }
        if (wr == 1) PG8_BAR;
    }
    PG8_WAIT_V(0);
    PG8_BAR;
    if constexpr (Epi::AFTER_DRAIN) E.fused(acc, cur, wr, wc, fr, fq, lds);
#undef PG8_SA
#undef PG8_SB
#undef PG8_STAGE
#undef PG8_VA
#undef PG8_LDA
#undef PG8_LDB
#undef PG8_MMA
#undef PG8_WAIT_V
#undef PG8_WAIT_L
#undef PG8_BAR
#undef PG8_SCHED
}
struct EpiBf16 {
    static constexpr bool AFTER_DRAIN = false;
    bf16_t* O; int ldc;
    DEV void operator()(const f32x4 (&acc)[2][2][4][2], const Unit& u, int wr, int wc, int fr, int fq) const {
#pragma unroll
        for (int ai = 0; ai < 2; ++ai)
#pragma unroll
            for (int m = 0; m < 4; ++m) { bf16_t* rowp = O + (size_t)(u.pm * BM + ai * HALF + wr * 64 + m * 16 + fr) * ldc + u.pn * BM + wc * 32 + 4 * fq;
#pragma unroll
                for (int bj = 0; bj < 2; ++bj)
#pragma unroll
                    for (int n = 0; n < 2; ++n) { const f32x4 v = acc[ai][bj][m][n]; u32x2 w; w.x = pk2(v[0], v[1]); w.y = pk2(v[2], v[3]); *(u32x2*)(rowp + bj * HALF + n * 16) = w; } }
    }
};
struct EpiResF32 {
    static constexpr bool AFTER_DRAIN = false;
    const float* base; float* out; int ldc;
    DEV void operator()(const f32x4 (&acc)[2][2][4][2], const Unit& u, int wr, int wc, int fr, int fq) const {
#pragma unroll
        for (int ai = 0; ai < 2; ++ai) { f32x4 b[4][2][2];
#pragma unroll
            for (int m = 0; m < 4; ++m) { const size_t off = (size_t)(u.pm * BM + ai * HALF + wr * 64 + m * 16 + fr) * ldc + u.pn * BM + wc * 32 + 4 * fq;
#pragma unroll
                for (int bj = 0; bj < 2; ++bj)
#pragma unroll
                    for (int n = 0; n < 2; ++n) b[m][bj][n] = *(const f32x4*)(base + off + bj * HALF + n * 16); }
#pragma unroll
            for (int m = 0; m < 4; ++m) { const size_t off = (size_t)(u.pm * BM + ai * HALF + wr * 64 + m * 16 + fr) * ldc + u.pn * BM + wc * 32 + 4 * fq;
#pragma unroll
                for (int bj = 0; bj < 2; ++bj)
#pragma unroll
                    for (int n = 0; n < 2; ++n) *(f32x4*)(out + off + bj * HALF + n * 16) = b[m][bj][n] + acc[ai][bj][m][n]; } }
    }
};
struct EpiMoe1 {
    static constexpr bool AFTER_DRAIN = false;
    bf16_t* O; const float* b1; const float* sw; const float* sx;
    DEV void operator()(const f32x4 (&acc)[2][2][4][2], const Unit& u, int wr, int wc, int fr, int fq) const {
        const float* bb = b1 + (size_t)u.e * 2048; const float* ss = sw + (size_t)u.e * 2048 + u.pn * BM;
        f32x4 ba[2], bu[2], sa[2], su[2];
#pragma unroll
        for (int n = 0; n < 2; ++n) { const int c = wc * 32 + n * 16 + 4 * fq; ba[n] = *(const f32x4*)(bb + u.pn * HALF + c); bu[n] = *(const f32x4*)(bb + 1024 + u.pn * HALF + c); sa[n] = *(const f32x4*)(ss + c); su[n] = *(const f32x4*)(ss + HALF + c); }
        float srv[2][4];
#pragma unroll
        for (int ai = 0; ai < 2; ++ai)
#pragma unroll
            for (int m = 0; m < 4; ++m) srv[ai][m] = sx[u.pm * BM + ai * HALF + wr * 64 + m * 16 + fr];
#pragma unroll
        for (int ai = 0; ai < 2; ++ai)
#pragma unroll
            for (int m = 0; m < 4; ++m) { const int row = u.pm * BM + ai * HALF + wr * 64 + m * 16 + fr; const float sr = srv[ai][m]; bf16_t* rowp = O + (size_t)row * DFF + u.pn * HALF + wc * 32 + 4 * fq;
#pragma unroll
                for (int n = 0; n < 2; ++n) { const i32x4 ia = __builtin_bit_cast(i32x4, acc[ai][0][m][n]), iu = __builtin_bit_cast(i32x4, acc[ai][1][m][n]); float r[4];
#pragma unroll
                    for (int j = 0; j < 4; ++j) { const float a = fminf((float)ia[j] * (sr * sa[n][j]) + ba[n][j], 7.0f), up = fminf(fmaxf((float)iu[j] * (sr * su[n][j]) + bu[n][j], -7.0f), 7.0f);
                        const float glu = a * __builtin_amdgcn_rcpf(1.0f + __expf(-1.702f * a)); r[j] = (up + 1.0f) * glu; }
                    u32x2 w; w.x = pk2(r[0], r[1]); w.y = pk2(r[2], r[3]); *(u32x2*)(rowp + n * 16) = w; } }
    }
};
struct EpiMoe2 {
    static constexpr bool AFTER_DRAIN = false;
    bf16_t* O; const float* b2; const float* rowgate;
    DEV void operator()(const f32x4 (&acc)[2][2][4][2], const Unit& u, int wr, int wc, int fr, int fq) const {
        const float* bb = b2 + (size_t)u.e * 1024;
        float gtv[2][4]; f32x4 bvv[2][2];
#pragma unroll
        for (int ai = 0; ai < 2; ++ai)
#pragma unroll
            for (int m = 0; m < 4; ++m) gtv[ai][m] = rowgate[u.pm * BM + ai * HALF + wr * 64 + m * 16 + fr];
#pragma unroll
        for (int bj = 0; bj < 2; ++bj)
#pragma unroll
            for (int n = 0; n < 2; ++n) bvv[bj][n] = *(const f32x4*)(bb + u.pn * BM + bj * HALF + wc * 32 + n * 16 + 4 * fq);
#pragma unroll
        for (int ai = 0; ai < 2; ++ai)
#pragma unroll
            for (int m = 0; m < 4; ++m) { const int row = u.pm * BM + ai * HALF + wr * 64 + m * 16 + fr; const float gt = gtv[ai][m]; bf16_t* rowp = O + (size_t)row * DM + u.pn * BM + wc * 32 + 4 * fq;
#pragma unroll
                for (int bj = 0; bj < 2; ++bj)
#pragma unroll
                    for (int n = 0; n < 2; ++n) { const f32x4 v = (acc[ai][bj][m][n] + bvv[bj][n]) * gt;
                        u32x2 w; w.x = pk2(v[0], v[1]); w.y = pk2(v[2], v[3]); *(u32x2*)(rowp + bj * HALF + n * 16) = w; } }
    }
};
struct EpiQup {
    static constexpr bool AFTER_DRAIN = false;
    bf16_t* O; const float* ropem;
    DEV void operator()(const f32x4 (&acc)[2][2][4][2], const Unit& u, int wr, int wc, int fr, int fq) const {
        const bool rope0 = ((u.pn * 8 + wc) % 3) == 2, rope1 = ((u.pn * 8 + 4 + wc) % 3) == 2;
        f32x4 cs[2][4], sn[2][4];
        if (rope0 || rope1) {
#pragma unroll
            for (int ai = 0; ai < 2; ++ai)
#pragma unroll
                for (int m = 0; m < 4; ++m) { const int row = u.pm * BM + ai * HALF + wr * 64 + m * 16 + fr; cs[ai][m] = *(const f32x4*)(ropem + (size_t)row * 32 + 4 * fq); sn[ai][m] = *(const f32x4*)(ropem + (size_t)row * 32 + 16 + 4 * fq); } }
#pragma unroll
        for (int bj = 0; bj < 2; ++bj) { const int g32 = u.pn * 8 + bj * 4 + wc; const bool rope = bj ? rope1 : rope0;
#pragma unroll
            for (int ai = 0; ai < 2; ++ai)
#pragma unroll
                for (int m = 0; m < 4; ++m) { const int row = u.pm * BM + ai * HALF + wr * 64 + m * 16 + fr; bf16_t* rowp = O + (size_t)row * 768 + g32 * 32 + 4 * fq;
                    f32x4 v0 = acc[ai][bj][m][0], v1 = acc[ai][bj][m][1];
                    if (rope) { const f32x4 c = cs[ai][m], s_ = sn[ai][m]; const f32x4 x1 = v0, x2 = v1; v0 = x1 * c - x2 * s_; v1 = x2 * c + x1 * s_; }
                    v0 = v0 * MLA_QSCALE; v1 = v1 * MLA_QSCALE;
                    u32x2 w; w.x = pk2(v0[0], v0[1]); w.y = pk2(v0[2], v0[3]); *(u32x2*)(rowp) = w; w.x = pk2(v1[0], v1[1]); w.y = pk2(v1[2], v1[3]); *(u32x2*)(rowp + 16) = w; } }
    }
};
struct EpiKvup {
    static constexpr bool AFTER_DRAIN = false;
    bf16_t* KM; bf16_t* VM;
    DEV void operator()(const f32x4 (&acc)[2][2][4][2], const Unit& u, int wr, int wc, int fr, int fq) const {
#pragma unroll
        for (int bj = 0; bj < 2; ++bj) { const int head = u.pn * 2 + bj;
#pragma unroll
            for (int ai = 0; ai < 2; ++ai)
#pragma unroll
                for (int m = 0; m < 4; ++m) { const int row = u.pm * BM + ai * HALF + wr * 64 + m * 16 + fr;
                    bf16_t* rowp = (wc < 2) ? KM + (size_t)row * 768 + head * 96 + wc * 32 + 4 * fq : VM + (size_t)row * 512 + head * 64 + (wc - 2) * 32 + 4 * fq;
#pragma unroll
                    for (int n = 0; n < 2; ++n) { const f32x4 v = acc[ai][bj][m][n]; u32x2 w; w.x = pk2(v[0], v[1]); w.y = pk2(v[2], v[3]); *(u32x2*)(rowp + n * 16) = w; } } }
    }
};
struct EpiCmp {
    static constexpr bool AFTER_DRAIN = true;
    const float* cb; const float* w2; const int* pos; bf16_t* KC; bf16_t* VC;
    DEV void fused(const f32x4 (&acc)[2][2][4][2], const Unit& u, int wr, int wc, int fr, int fq, LAS unsigned char* lds) const {
        const int c = u.e, tid = opaque_tid();
        LAS bf16_t* Hs = (LAS bf16_t*)lds;
        LAS float* W2s = (LAS float*)(lds + 256 * 136 * 2);
        { const f32x4* src = (const f32x4*)(w2 + (size_t)c * 128 * 64) + tid;
#pragma unroll
          for (int i = 0; i < 4; ++i) *((LAS f32x4*)W2s + tid + i * 512) = src[i * 512]; }
        f32x4 bb[2];
#pragma unroll
        for (int n = 0; n < 2; ++n) { bb[n] = *(const f32x4*)(cb + c * 128 + wc * 32 + n * 16 + 4 * fq);
#pragma unroll
            for (int part = 1; part < 8; ++part) bb[n] += *(const f32x4*)(cb + part * 256 + c * 128 + wc * 32 + n * 16 + 4 * fq); }
#pragma unroll
        for (int ai = 0; ai < 2; ++ai)
#pragma unroll
            for (int m = 0; m < 4; ++m) { const int row = ai * HALF + wr * 64 + m * 16 + fr;
#pragma unroll
                for (int n = 0; n < 2; ++n) { const f32x4 v = acc[ai][0][m][n] + bb[n]; float r[4];
#pragma unroll
                    for (int j = 0; j < 4; ++j) r[j] = v[j] / (1.0f + __expf(-v[j]));
                    u32x2 w; w.x = pk2(r[0], r[1]); w.y = pk2(r[2], r[3]); *(LAS u32x2*)(Hs + row * 136 + wc * 32 + n * 16 + 4 * fq) = w; } }
        __syncthreads();
        const int row = tid >> 1, dh = tid & 1; float o[32];
#pragma unroll
        for (int d = 0; d < 32; ++d) o[d] = 0.f;
#pragma unroll 2
        for (int h = 0; h < 128; ++h) { const float hv = bf2f(Hs[row * 136 + h]); const LAS f32x4* wrow = (const LAS f32x4*)(W2s + h * 64 + dh * 32);
#pragma unroll
            for (int q = 0; q < 8; ++q) { const f32x4 w = wrow[q]; o[4 * q] += hv * w.x; o[4 * q + 1] += hv * w.y; o[4 * q + 2] += hv * w.z; o[4 * q + 3] += hv * w.w; } }
        const int r = u.pm * BM + row, b = r >> 9, n = (r >> 1) & 255;
        if (c == 0 && dh == 0 && n < 255) { const float fpos = (float)pos[b * SEQ + 16 * n + 31];
#pragma unroll
            for (int i = 0; i < 8; ++i) { const float invf = powf(500000.0f, -(float)(2 * i) / 16.0f); float cs, sn; sincosf(fpos * invf, &sn, &cs); const float x1 = o[i], x2 = o[8 + i]; o[i] = x1 * cs - x2 * sn; o[8 + i] = x2 * cs + x1 * sn; } }
        bf16_t* dst = (c == 0 ? KC : VC) + (size_t)r * 64 + dh * 32;
#pragma unroll
        for (int q = 0; q < 4; ++q) { u32x4 w;
            if (n < 255) { w.x = pk2(o[8 * q], o[8 * q + 1]); w.y = pk2(o[8 * q + 2], o[8 * q + 3]); w.z = pk2(o[8 * q + 4], o[8 * q + 5]); w.w = pk2(o[8 * q + 6], o[8 * q + 7]); } else w = (u32x4){0u, 0u, 0u, 0u};
            *(u32x4*)(dst + 8 * q) = w; }
        __syncthreads();
    }
};
struct EpiProj {
    static constexpr bool AFTER_DRAIN = false;
    const int* pos; const float* qg; const float* kvg;
    bf16_t *QN, *KVN, *KM, *NQ, *KSR, *KWR, *KCC, *VCC, *VSC, *VWC; float *GATES, *ROPEM; LAS float* part;
    DEV void operator()(const f32x4 (&acc)[2][2][4][2], const Unit& u, int wr, int wc, int fr, int fq) const {
        constexpr float L2T = 18.931568569324174f;
        float rstd[2][4]; float fp[2][4];
#pragma unroll
        for (int ai = 0; ai < 2; ++ai)
#pragma unroll
            for (int m = 0; m < 4; ++m) { fp[ai][m] = (float)pos[u.pm * BM + ai * HALF + wr * 64 + m * 16 + fr]; rstd[ai][m] = 0.f; }
        if (u.pn <= 1) {
#pragma unroll
            for (int ai = 0; ai < 2; ++ai)
#pragma unroll
                for (int m = 0; m < 4; ++m) { float s_ = 0.f;
#pragma unroll
                    for (int bj = 0; bj < 2; ++bj) if (bj == 0 || u.pn == 0)
#pragma unroll
                        for (int n = 0; n < 2; ++n) { const f32x4 v = acc[ai][bj][m][n]; s_ += (v.x * v.x + v.y * v.y) + (v.z * v.z + v.w * v.w); }
                    s_ += __shfl_xor(s_, 16); s_ += __shfl_xor(s_, 32);
                    if (fq == 0) part[(ai * HALF + wr * 64 + m * 16 + fr) * 4 + wc] = s_; }
            asm volatile("s_waitcnt lgkmcnt(0)\n\ts_barrier" ::: "memory");
            const float inv = (u.pn == 0) ? (1.f / 256.f) : (1.f / 128.f);
#pragma unroll
            for (int ai = 0; ai < 2; ++ai)
#pragma unroll
                for (int m = 0; m < 4; ++m) { const f32x4 q4 = *(const LAS f32x4*)(part + (ai * HALF + wr * 64 + m * 16 + fr) * 4); rstd[ai][m] = rsqrtf(((q4.x + q4.y) + (q4.z + q4.w)) * inv + 1e-5f); }
            asm volatile("s_waitcnt lgkmcnt(0)\n\ts_barrier" ::: "memory");
        }
#pragma unroll
        for (int bj = 0; bj < 2; ++bj) { const int g32 = u.pn * 8 + bj * 4 + wc;
#pragma unroll
            for (int ai = 0; ai < 2; ++ai)
#pragma unroll
                for (int m = 0; m < 4; ++m) { const size_t row = (size_t)(u.pm * BM + ai * HALF + wr * 64 + m * 16 + fr); f32x4 v0 = acc[ai][bj][m][0], v1 = acc[ai][bj][m][1];
                    const int c4 = 4 * fq;
                    auto st8 = [&](bf16_t* dst, const f32x4& x) { u32x2 w; w.x = pk2(x.x, x.y); w.y = pk2(x.z, x.w); *(u32x2*)dst = w; };
                    auto nsa_rope = [&](f32x4& x) {
#pragma unroll
                        for (int j = 0; j < 4; ++j) { const float other = __shfl_xor(x[j], 32); const int i = 4 * (fq & 1) + j; float sn, cs; __sincosf(fp[ai][m] * fast_exp2(-(float)i * (L2T / 8.f)), &sn, &cs);
                            x[j] = (fq < 2) ? x[j] * cs - other * sn : x[j] * cs + other * sn; } };
                    if (g32 < 8) { const float r_ = rstd[ai][m]; const int c = g32 * 32 + c4; const f32x4 g0 = *(const f32x4*)(qg + c), g1 = *(const f32x4*)(qg + c + 16);
                        st8(QN + row * 256 + c, v0 * g0 * r_); st8(QN + row * 256 + c + 16, v1 * g1 * r_); }
                    else if (g32 < 12) { const float r_ = rstd[ai][m]; const int c = (g32 - 8) * 32 + c4; const f32x4 g0 = *(const f32x4*)(kvg + c), g1 = *(const f32x4*)(kvg + c + 16);
                        st8(KVN + row * 256 + c, v0 * g0 * r_); st8(KVN + row * 256 + c + 16, v1 * g1 * r_);
                        *(u32x2*)(KVN + row * 256 + 128 + c) = (u32x2){0u, 0u}; *(u32x2*)(KVN + row * 256 + 128 + c + 16) = (u32x2){0u, 0u}; }
                    else if (g32 == 12) { f32x4 cs4, sn4;
#pragma unroll
                        for (int j = 0; j < 4; ++j) { float sn, cs; __sincosf(fp[ai][m] * fast_exp2(-(float)(c4 + j) * (L2T / 16.f)), &sn, &cs); cs4[j] = cs; sn4[j] = sn; }
                        const f32x4 o1 = v0 * cs4 - v1 * sn4, o2 = v1 * cs4 + v0 * sn4;
#pragma unroll
                        for (int h = 0; h < 8; ++h) { st8(KM + row * 768 + h * 96 + 64 + c4, o1); st8(KM + row * 768 + h * 96 + 80 + c4, o2); }
                        *(f32x4*)(ROPEM + row * 32 + c4) = cs4; *(f32x4*)(ROPEM + row * 32 + 16 + c4) = sn4; }
                    else if (g32 < 29) { const int hh = (g32 - 13) >> 1, half = (g32 - 13) & 1; if (half == 0) nsa_rope(v0);
                        st8(NQ + row * 512 + hh * 64 + half * 32 + c4, v0 * NSA_QSCALE); st8(NQ + row * 512 + hh * 64 + half * 32 + 16 + c4, v1 * NSA_QSCALE); }
                    else if (g32 < 37) { bf16_t* d_ = (g32 < 33 ? KCC : VCC) + row * 128 + ((g32 - 29) & 3) * 32 + c4; st8(d_, v0); st8(d_ + 16, v1); }
                    else if (g32 < 41) { if (((g32 - 37) & 1) == 0) nsa_rope(v0); bf16_t* d_ = KSR + row * 128 + (g32 - 37) * 32 + c4; st8(d_, v0); st8(d_ + 16, v1); }
                    else if (g32 < 45) { bf16_t* d_ = VSC + row * 128 + (g32 - 41) * 32 + c4; st8(d_, v0); st8(d_ + 16, v1); }
                    else if (g32 < 49) { if (((g32 - 45) & 1) == 0) nsa_rope(v0); bf16_t* d_ = KWR + row * 128 + (g32 - 45) * 32 + c4; st8(d_, v0); st8(d_ + 16, v1); }
                    else if (g32 < 53) { bf16_t* d_ = VWC + row * 128 + (g32 - 49) * 32 + c4; st8(d_, v0); st8(d_ + 16, v1); }
                    else if (g32 == 53) { f32x4 s0, s1;
#pragma unroll
                        for (int j = 0; j < 4; ++j) { s0[j] = __builtin_amdgcn_rcpf(1.0f + __expf(-v0[j])); s1[j] = __builtin_amdgcn_rcpf(1.0f + __expf(-v1[j])); }
                        *(f32x4*)(GATES + row * 24 + c4) = s0; if (fq < 2) *(f32x4*)(GATES + row * 24 + 16 + c4) = s1; }
                } }
    }
};
struct UpOrder {
    DenseOrder q, kv; int G, c;
    DEV bool next(int i, Unit& u) const {
        const long L = (long)i * G + c;
        if (L < q.nwg) { DenseOrder t = q; t.G = 1; t.c = 0; t.next((int)L, u); u.e = 0; return true; }
        if (L < q.nwg + kv.nwg) { DenseOrder t = kv; t.G = 1; t.c = 0; t.next((int)(L - q.nwg), u); u.e = 1; return true; }
        return false;
    }
};
struct EpiUp {
    static constexpr bool AFTER_DRAIN = false;
    EpiQup eq; EpiKvup ekv;
    DEV void operator()(const f32x4 (&acc)[2][2][4][2], const Unit& u, int wr, int wc, int fr, int fq) const { if (u.e == 0) eq(acc, u, wr, wc, fr, fq); else ekv(acc, u, wr, wc, fr, fq); }
};
}

DEV void transpose_item(const float* W, int Ksrc, int Nsrc, int k0, int n0, bf16_t* WT, int ldk, int drow0, LAS float* scr, int lane) {
    { const int kr = lane >> 3, nc = 4 * (lane & 7); f32x4 v[8];
#pragma unroll
      for (int i = 0; i < 8; ++i) { const int k = k0 + 8 * i + kr; v[i] = (k < Ksrc && n0 + nc < Nsrc) ? *(const f32x4*)(W + (size_t)k * Nsrc + n0 + nc) : (f32x4){0.f, 0.f, 0.f, 0.f}; }
#pragma unroll
      for (int i = 0; i < 8; ++i) { LAS float* d = scr + (8 * i + kr) * 33 + nc; d[0] = v[i].x; d[1] = v[i].y; d[2] = v[i].z; d[3] = v[i].w; } }
    asm volatile("s_waitcnt lgkmcnt(0)" ::: "memory");
    const int c = lane & 7;
#pragma unroll
    for (int j = 0; j < 4; ++j) { const int n = (lane >> 3) + 8 * j; const LAS float* s = scr + (8 * c) * 33 + n;
        u32x4 o; o.x = pk2(s[0 * 33], s[1 * 33]); o.y = pk2(s[2 * 33], s[3 * 33]); o.z = pk2(s[4 * 33], s[5 * 33]); o.w = pk2(s[6 * 33], s[7 * 33]);
        *(u32x4*)(WT + (size_t)(drow0 + n) * ldk + k0 + 8 * c) = o; }
    asm volatile("s_waitcnt lgkmcnt(0)" ::: "memory");
}
DEV void rms_row_to_bf16(const float* xrow, const float* g, bf16_t* orow, int lane) {
    const f32x4* xr = (const f32x4*)xrow + lane; const f32x4* gr = (const f32x4*)g + lane;
    f32x4 v[4]; float s = 0.f;
#pragma unroll
    for (int j = 0; j < 4; ++j) { v[j] = xr[64 * j]; s += (v[j].x * v[j].x + v[j].y * v[j].y) + (v[j].z * v[j].z + v[j].w * v[j].w); }
    const float rstd = rsqrtf(wave_sum(s) * (1.f / 1024.f) + 1e-5f);
    u32x2* o8 = (u32x2*)orow + lane;
#pragma unroll
    for (int j = 0; j < 4; ++j) { const f32x4 gg = gr[64 * j]; u32x2 w; w.x = pk2(v[j].x * rstd * gg.x, v[j].y * rstd * gg.y); w.y = pk2(v[j].z * rstd * gg.z, v[j].w * rstd * gg.w); o8[64 * j] = w; }
}
DEV void w1_quant_item(const float* W, unsigned char* WQ, float* SW, int n0, int drow0, LAS unsigned char* lds, int tid) {
    LAS unsigned* qs = (LAS unsigned*)lds;
    LAS float* red = (LAS float*)(lds + 32 * 1040);
    const int kg = tid >> 3, c = tid & 7, wv = tid >> 6;
    f32x4 v[4][4];
#pragma unroll
    for (int i = 0; i < 4; ++i)
#pragma unroll
        for (int q = 0; q < 4; ++q) v[i][q] = *(const f32x4*)(W + (size_t)(4 * (64 * i + kg) + q) * 2048 + n0 + 4 * c);
    float mx[4] = {0.f, 0.f, 0.f, 0.f};
#pragma unroll
    for (int i = 0; i < 4; ++i)
#pragma unroll
        for (int q = 0; q < 4; ++q) { mx[0] = fmaxf(mx[0], fabsf(v[i][q].x)); mx[1] = fmaxf(mx[1], fabsf(v[i][q].y)); mx[2] = fmaxf(mx[2], fabsf(v[i][q].z)); mx[3] = fmaxf(mx[3], fabsf(v[i][q].w)); }
#pragma unroll
    for (int j = 0; j < 4; ++j) { mx[j] = fmaxf(mx[j], __shfl_xor(mx[j], 8)); mx[j] = fmaxf(mx[j], __shfl_xor(mx[j], 16)); mx[j] = fmaxf(mx[j], __shfl_xor(mx[j], 32)); }
    if ((tid & 63) < 8) *(LAS f32x4*)(red + wv * 32 + 4 * c) = (f32x4){mx[0], mx[1], mx[2], mx[3]};
    __syncthreads();
    float inv[4];
    { f32x4 m = *(const LAS f32x4*)(red + 4 * c);
#pragma unroll
      for (int w_ = 1; w_ < 8; ++w_) { const f32x4 o = *(const LAS f32x4*)(red + w_ * 32 + 4 * c); m.x = fmaxf(m.x, o.x); m.y = fmaxf(m.y, o.y); m.z = fmaxf(m.z, o.z); m.w = fmaxf(m.w, o.w); }
      m.x = fmaxf(m.x, 1e-30f); m.y = fmaxf(m.y, 1e-30f); m.z = fmaxf(m.z, 1e-30f); m.w = fmaxf(m.w, 1e-30f);
      inv[0] = 127.0f / m.x; inv[1] = 127.0f / m.y; inv[2] = 127.0f / m.z; inv[3] = 127.0f / m.w;
      if (tid < 8) *(f32x4*)(SW + drow0 + 4 * c) = m * (1.0f / 127.0f); }
#pragma unroll
    for (int i = 0; i < 4; ++i) {
#pragma unroll
        for (int j = 0; j < 4; ++j) { unsigned x = 0u;
#pragma unroll
            for (int q = 0; q < 4; ++q) { const int b = __float2int_rn(v[i][q][j] * inv[j]); x |= ((unsigned)b & 255u) << (8 * q); }
            qs[(4 * c + j) * 260 + 64 * i + kg] = x; } }
    __syncthreads();
#pragma unroll
    for (int t_ = 0; t_ < 4; ++t_) { const int id = tid + 512 * t_, n = id >> 6, ch = id & 63;
        *(u32x4*)(WQ + (size_t)(drow0 + n) * 1024 + ch * 16) = *(const LAS u32x4*)(lds + n * 1040 + ch * 16); }
    __syncthreads();
}
DEV void prep_w1_items(const Params& p, LAS unsigned char* lds) {
    const int tid = opaque_tid();
    unsigned* ctr = (unsigned*)(p.ws + OFF_CNT) + 40; LAS int* slot = (LAS int*)(lds + 40960);
    for (;;) {
        if (tid == 0) *slot = (int)__hip_atomic_fetch_add(ctr, 1u, __ATOMIC_RELAXED, __HIP_MEMORY_SCOPE_AGENT);
        __syncthreads();
        const int it = *slot;
        __syncthreads();
        if (it >= 32 * 64) break;
        const int e = it >> 6, nb = it & 63, n0 = nb * 32;
        const int bj = n0 >> 10, rr = n0 & 1023, drow = 256 * (rr >> 7) + 128 * bj + (rr & 127);
        w1_quant_item(p.moe_w1 + (size_t)e * 1024 * 2048, p.ws + OFF_W1T + (size_t)e * 2048 * 1024, (float*)(p.ws + OFF_SW1) + (size_t)e * 2048, n0, drow, lds, tid); }
}
DEV void prep_w2_items(const Params& p, LAS unsigned char* lds, int firstw, int stridew) {
    const int tid = opaque_tid(), wid = tid >> 6, lane = tid & 63;
    LAS float* scr = (LAS float*)(lds + wid * 16384); bf16_t* W2T = (bf16_t*)(p.ws + OFF_W2T);
    for (int r = firstw + wid; r < 32 * 16 * 32; r += stridew) { const int e = r / (16 * 32), q = r % (16 * 32), kb = q / 32, nb = q % 32;
        transpose_item(p.moe_w2 + (size_t)e * 1024 * 1024, 1024, 1024, kb * 64, nb * 32, W2T + (size_t)e * 1024 * 1024, 1024, nb * 32, scr, lane); }
}
DEV void phase0(const Params& p, LAS unsigned char* lds) {
    const int tid = opaque_tid(), wid = tid >> 6, lane = tid & 63;
    LAS float* scr = (LAS float*)(lds + wid * 16384);
    const int gw = blockIdx.x * 8 + wid, NGW = gridDim.x * 8;
    bf16_t* WINT = (bf16_t*)(p.ws + OFF_WINT);
    bf16_t* WQUPT = (bf16_t*)(p.ws + OFF_WQUPT); bf16_t* WKVUPT = (bf16_t*)(p.ws + OFF_WKVUPT); bf16_t* WOUTT = (bf16_t*)(p.ws + OFF_WOUTT);
    constexpr int I_IN = 16 * 56, I_QUP = 4 * 24, I_KVUP = 4 * 32, I_OUT = 16 * 32, I_CW1 = 2 * 32 * 8, I_ROWS = NTOK;
    constexpr int NITEMS = I_IN + I_QUP + I_KVUP + I_OUT + I_CW1;
    for (int it = gw; it < NITEMS; it += NGW) {
        int r = it;
        if (r < I_IN) { const int kb = r / 56, nb = r % 56; transpose_item(p.w_in, 1024, INC, kb * 64, nb * 32, WINT, 1024, nb * 32, scr, lane); continue; } r -= I_IN;
        if (r < I_QUP) { const int kb = r / 24, nb = r % 24; transpose_item(p.w_q_up, 256, 768, kb * 64, nb * 32, WQUPT, 256, nb * 32, scr, lane); continue; } r -= I_QUP;
        if (r < I_KVUP) { const int kb = r / 32, nb = r % 32; transpose_item(p.w_kv_up, 128, 1024, kb * 64, nb * 32, WKVUPT, 256, nb * 32, scr, lane); continue; } r -= I_KVUP;
        if (r < I_OUT) { const int kb = r / 32, nb = r % 32; transpose_item(p.w_out, 1024, 1024, kb * 64, nb * 32, WOUTT, 1024, nb * 32, scr, lane); continue; } r -= I_OUT;
        if (r < I_CW1) { const int c = r / 256, q = r % 256, kb = q / 8, nb = q % 8; transpose_item(p.cmp_w1 + (size_t)c * 2048 * 128, 2048, 128, kb * 64, nb * 32, (bf16_t*)(p.ws + OFF_CW1T) + (size_t)c * 256 * 2048, 2048, nb * 32, scr, lane); continue; } r -= I_CW1;
        break;
    }
    { const f32x4* gr = (const f32x4*)p.attn_norm + lane; f32x4 gg[4];
#pragma unroll
      for (int j = 0; j < 4; ++j) gg[j] = gr[64 * j];
      for (int r0 = gw * 4; r0 < NTOK; r0 += NGW * 4) { f32x4 v[4][4];
#pragma unroll
          for (int q = 0; q < 4; ++q) { const f32x4* xr = (const f32x4*)(p.x + (size_t)(r0 + q) * DM) + lane;
#pragma unroll
              for (int j = 0; j < 4; ++j) v[q][j] = xr[64 * j]; }
#pragma unroll
          for (int q = 0; q < 4; ++q) { float s_ = 0.f;
#pragma unroll
              for (int j = 0; j < 4; ++j) s_ += (v[q][j].x * v[q][j].x + v[q][j].y * v[q][j].y) + (v[q][j].z * v[q][j].z + v[q][j].w * v[q][j].w);
              const float rstd = rsqrtf(wave_sum(s_) * (1.f / 1024.f) + 1e-5f); u32x2* o8 = (u32x2*)((bf16_t*)(p.ws + OFF_U) + (size_t)(r0 + q) * DM) + lane;
#pragma unroll
              for (int j = 0; j < 4; ++j) { u32x2 w; w.x = pk2(v[q][j].x * rstd * gg[j].x, v[q][j].y * rstd * gg[j].y); w.y = pk2(v[q][j].z * rstd * gg[j].z, v[q][j].w * rstd * gg[j].w); o8[64 * j] = w; } } } }
    float* cb = (float*)(p.ws + OFF_CB);
    for (int o8 = gw; o8 < 2048; o8 += NGW) { const int o = o8 & 255, part = o8 >> 8, c = o >> 7, h = o & 127; float s = 0.f;
#pragma unroll
        for (int q = 0; q < 4; ++q) { const int i = part * 256 + q * 64 + lane; s += p.cmp_pos[c * 2048 + i] * p.cmp_w1[((size_t)c * 2048 + i) * 128 + h]; }
        s = wave_sum(s); if (lane == 0) cb[part * 256 + o] = s; }
    if (blockIdx.x == 0 && tid < 64) ((unsigned*)(p.ws + OFF_CNT))[tid] = 0u;
}

struct P2In { u32x2 wq; unsigned wkv; unsigned kp; u32x4 wqn; u32x4 wk; u32x4 wc4; unsigned gt; int pos; };
DEV void phase2(const Params& p) {
    const int tid = opaque_tid(), wid = tid >> 6, lane = tid & 63;
    const int gw = blockIdx.x * 8 + wid, NGW = gridDim.x * 8;
    const bf16_t* PROJ = (const bf16_t*)(p.ws + OFF_PROJ);
    bf16_t* QN = (bf16_t*)(p.ws + OFF_QN); bf16_t* KVN = (bf16_t*)(p.ws + OFF_KVN); bf16_t* KM = (bf16_t*)(p.ws + OFF_KM); float* ROPEM = (float*)(p.ws + OFF_ROPEM); bf16_t* NQ = (bf16_t*)(p.ws + OFF_NQ);
    bf16_t* KSR = (bf16_t*)(p.ws + OFF_KSR); bf16_t* KWR = (bf16_t*)(p.ws + OFF_KWR); float* GATES = (float*)(p.ws + OFF_GATES);
    const float invf_m = powf(500000.0f, -(float)(2 * (lane & 15)) / 32.0f);
    const float invf_n = powf(500000.0f, -(float)(2 * (lane & 7)) / 16.0f);
    const f32x4 gq = *(const f32x4*)(p.q_norm + lane * 4); const f32x2 gkv = *(const f32x2*)(p.kv_norm + lane * 2);
    const int l16 = lane & 15, sub = lane & 7, d32 = lane & 31; const int cbase = (lane < 16) ? C_KS : C_KW;
    const int grp4 = lane >> 4; const int ccol4 = (grp4 == 0) ? C_KC : (grp4 == 1) ? C_VC : (grp4 == 2) ? C_VS : C_VW;
    bf16_t* cdst4 = (bf16_t*)(p.ws + (grp4 == 0 ? OFF_KCC : grp4 == 1 ? OFF_VCC : grp4 == 2 ? OFF_VSC : OFF_VWC));
    auto load = [&](int tok) -> P2In { const bf16_t* row = PROJ + (size_t)tok * INP; P2In in;
        in.wq = *(const u32x2*)(row + C_QLAT + lane * 4); in.wkv = *(const unsigned*)(row + C_KVLAT + lane * 2);
        in.kp = (unsigned)row[C_KPE + d32] | ((unsigned)row[C_KPE + (d32 ^ 16)] << 16);
        in.wqn = *(const u32x4*)(row + C_QNSA + lane * 8); in.wk = *(const u32x4*)(row + cbase + l16 * 8); in.wc4 = *(const u32x4*)(row + ccol4 + l16 * 8);
        in.gt = row[C_G + (lane < 24 ? lane : 23)]; in.pos = p.pos[tok]; return in; };
    P2In cur = load(gw < NTOK ? gw : 0);
#pragma unroll 1
    for (int tok = gw; tok < NTOK; tok += NGW) {
        const P2In nxt = load(tok + NGW < NTOK ? tok + NGW : tok);
        const float fpos = (float)cur.pos;
        float cm, sm, cn, sn; __sincosf(fpos * invf_m, &sm, &cm); __sincosf(fpos * invf_n, &sn, &cn);
        { const u32x2 w = cur.wq; const float a = bflo(w.x), b = bfhi(w.x), c = bflo(w.y), d = bfhi(w.y);
          const float rstd = rsqrtf(wave_sum(a * a + b * b + c * c + d * d) * (1.f / 256.f) + 1e-5f);
          u32x2 o; o.x = pk2(a * rstd * gq.x, b * rstd * gq.y); o.y = pk2(c * rstd * gq.z, d * rstd * gq.w); *(u32x2*)(QN + (size_t)tok * 256 + lane * 4) = o; }
        { const unsigned w = cur.wkv; const float a = bflo(w), b = bfhi(w);
          const float rstd = rsqrtf(wave_sum(a * a + b * b) * (1.f / 128.f) + 1e-5f);
          *(unsigned*)(KVN + (size_t)tok * 256 + lane * 2) = pk2(a * rstd * gkv.x, b * rstd * gkv.y); *(unsigned*)(KVN + (size_t)tok * 256 + 128 + lane * 2) = 0u; }
        { const float xs_ = bflo(cur.kp), xo = bfhi(cur.kp); const float val = (d32 < 16) ? xs_ * cm - xo * sm : xs_ * cm + xo * sm;
          const int hh = lane >> 3, part = lane & 7; const float a0 = __shfl(val, 4 * part), a1 = __shfl(val, 4 * part + 1), a2 = __shfl(val, 4 * part + 2), a3 = __shfl(val, 4 * part + 3);
          u32x2 w; w.x = pk2(a0, a1); w.y = pk2(a2, a3); *(u32x2*)(KM + (size_t)tok * 768 + hh * 96 + 64 + 4 * part) = w;
          if (lane < 16) { ROPEM[(size_t)tok * 32 + lane] = cm; ROPEM[(size_t)tok * 32 + 16 + lane] = sm; } }
        { const u32x4 w = cur.wqn; float v[8] = {bflo(w.x), bfhi(w.x), bflo(w.y), bfhi(w.y), bflo(w.z), bfhi(w.z), bflo(w.w), bfhi(w.w)};
#pragma unroll
          for (int i = 0; i < 8; ++i) { const float other = __shfl_xor(v[i], 1); const float c = __shfl(cn, i), s = __shfl(sn, i);
              if (sub == 0) v[i] = v[i] * c - other * s; else if (sub == 1) v[i] = v[i] * c + other * s; }
          u32x4 o; o.x = pk2(v[0] * NSA_QSCALE, v[1] * NSA_QSCALE); o.y = pk2(v[2] * NSA_QSCALE, v[3] * NSA_QSCALE); o.z = pk2(v[4] * NSA_QSCALE, v[5] * NSA_QSCALE); o.w = pk2(v[6] * NSA_QSCALE, v[7] * NSA_QSCALE);
          *(u32x4*)(NQ + (size_t)tok * 512 + lane * 8) = o; }
        { const u32x4 w = cur.wk;
          float v[8] = {bflo(w.x), bfhi(w.x), bflo(w.y), bfhi(w.y), bflo(w.z), bfhi(w.z), bflo(w.w), bfhi(w.w)};
#pragma unroll
          for (int i = 0; i < 8; ++i) { const float other = __shfl_xor(v[i], 1); const float c = __shfl(cn, i), s = __shfl(sn, i);
              if (sub == 0) v[i] = v[i] * c - other * s; else if (sub == 1) v[i] = v[i] * c + other * s; }
          if (lane < 32) { u32x4 o; o.x = pk2(v[0], v[1]); o.y = pk2(v[2], v[3]); o.z = pk2(v[4], v[5]); o.w = pk2(v[6], v[7]);
              *(u32x4*)(((lane < 16) ? KSR : KWR) + (size_t)tok * 128 + l16 * 8) = o; } }
        *(u32x4*)(cdst4 + (size_t)tok * 128 + l16 * 8) = cur.wc4;
        if (lane < 24) GATES[(size_t)tok * 24 + lane] = __builtin_amdgcn_rcpf(1.0f + __expf(-bflo(cur.gt)));
        cur = nxt;
    }
}

DEV void phase4(const Params& p, LAS unsigned char* lds) {
    const int tid = opaque_tid();
    if (blockIdx.x < BATCH * 2 && tid < 128) { const int bb = blockIdx.x >> 1, c_ = blockIdx.x & 1; ((bf16_t*)(p.ws + (c_ == 0 ? OFF_KC : OFF_VC)))[((size_t)(bb * NCMPP + 255) * 2) * 64 + tid] = 0; }
    const bf16_t* PROJ = (const bf16_t*)(p.ws + OFF_PROJ); const float* cb = (const float*)(p.ws + OFF_CB);
    LAS float* hid = (LAS float*)lds;
    const int sub = tid >> 7, h = tid & 127;
    constexpr int NU = 2 * BATCH * NCMP * 2;
    for (int u0 = blockIdx.x * 4; u0 < NU; u0 += gridDim.x * 4) {
        const int u = u0 + sub; const bool act = u < NU;
        int c = 0, b = 0, n = 0, g = 0;
        if (act) { c = u / (BATCH * NCMP * 2); int r = u % (BATCH * NCMP * 2); b = r / (NCMP * 2); r %= (NCMP * 2); n = r >> 1; g = r & 1; }
        float acc = 0.f;
        if (act) {
            const bf16_t* src = PROJ + (size_t)(b * SEQ + n * 16) * INP + (c == 0 ? C_KC : C_VC) + g * 64;
            const float* w1 = p.cmp_w1 + (size_t)c * 2048 * 128 + h;
            for (int l = 0; l < 32; ++l) { const bf16_t* sr = src + (size_t)l * INP;
#pragma unroll 8
                for (int d = 0; d < 64; d += 2) { const unsigned w = *(const unsigned*)(sr + d); acc += bflo(w) * w1[(size_t)(l * 64 + d) * 128] + bfhi(w) * w1[(size_t)(l * 64 + d + 1) * 128]; } }
            acc += cb[c * 128 + h];
            acc = acc / (1.0f + __expf(-acc));
        }
        hid[sub * 128 + h] = acc;
        __syncthreads();
        if (act && h < 64) {
            const float* w2 = p.cmp_w2 + (size_t)c * 128 * 64 + h; float o = 0.f;
            for (int k = 0; k < 128; ++k) o += hid[sub * 128 + k] * w2[k * 64];
            LAS float* ob = (LAS float*)(lds + 4096) + sub * 64; ob[h] = o;
            asm volatile("s_waitcnt lgkmcnt(0)" ::: "memory");
            if (c == 0 && h < 16) { const int i = h & 7; const float fpos = (float)p.pos[b * SEQ + 16 * n + 31]; const float invf = powf(500000.0f, -(float)(2 * i) / 16.0f);
                float cs, sn; sincosf(fpos * invf, &sn, &cs); const float x1 = ob[i], x2 = ob[8 + i]; o = (h < 8) ? (x1 * cs - x2 * sn) : (x2 * cs + x1 * sn); }
            ((bf16_t*)(p.ws + (c == 0 ? OFF_KC : OFF_VC)))[((size_t)(b * NCMPP + n) * 2 + g) * 64 + h] = f2bf(o);
        }
        __syncthreads();
    }
}

template <int DQK, int DV, class KF, class VF, class MF>
DEV void naive_attn_range(const float (&q)[DQK], float (&o)[DV], float& m, float& l, int jlo, int jhi, KF kf, VF vf, MF valid) {
#pragma unroll 1
    for (int j0 = jlo; j0 < jhi; j0 += 2) {
        const int ja = __builtin_amdgcn_readfirstlane(j0), jb = __builtin_amdgcn_readfirstlane((j0 + 1 < jhi) ? j0 + 1 : j0);
        float s0 = 0.f, s1 = 0.f;
#pragma unroll
        for (int i = 0; i < DQK / 2; ++i) { const unsigned w = kf(ja, i); s0 += q[2 * i] * bflo(w); s0 += q[2 * i + 1] * bfhi(w); }
#pragma unroll
        for (int i = 0; i < DQK / 2; ++i) { const unsigned w = kf(jb, i); s1 += q[2 * i] * bflo(w); s1 += q[2 * i + 1] * bfhi(w); }
        if (!valid(ja)) s0 = -INFINITY;
        if (!(j0 + 1 < jhi && valid(jb))) s1 = -INFINITY;
        const float mn = fmaxf(m, fmaxf(s0, s1));
        const bool live = mn != -INFINITY;
        const float alpha = live ? fast_exp2(m - mn) : 1.f, p0 = live ? fast_exp2(s0 - mn) : 0.f, p1 = live ? fast_exp2(s1 - mn) : 0.f;
        l = l * alpha + p0 + p1; m = mn;
#pragma unroll
        for (int i = 0; i < DV / 2; ++i) { const unsigned w0 = vf(ja, i), w1 = vf(jb, i);
            o[2 * i] = o[2 * i] * alpha + p0 * bflo(w0) + p1 * bflo(w1); o[2 * i + 1] = o[2 * i + 1] * alpha + p0 * bfhi(w0) + p1 * bfhi(w1); }
    }
}

DEV void phase3b(const Params& p) {
    const bf16_t* QUP = (const bf16_t*)(p.ws + OFF_QUP); const bf16_t* KVUP = (const bf16_t*)(p.ws + OFF_KVUP); const bf16_t* KPE = (const bf16_t*)(p.ws + OFF_KPE);
    bf16_t* QM = (bf16_t*)(p.ws + OFF_QM); bf16_t* KM = (bf16_t*)(p.ws + OFF_KM);
    for (int id = blockIdx.x * 512 + opaque_tid(); id < NTOK * 8; id += gridDim.x * 512) {
        const int tok = id >> 3, h = id & 7;
        const u32x4* qs = (const u32x4*)(QUP + (size_t)tok * 768 + h * 96); u32x4* qd = (u32x4*)(QM + (size_t)tok * 768 + h * 96);
        const u32x4* ks = (const u32x4*)(KVUP + (size_t)tok * 1024 + h * 128); u32x4* kd = (u32x4*)(KM + (size_t)tok * 768 + h * 96);
#pragma unroll 1
        for (int c = 0; c < 8; ++c) { const u32x4 w = qs[c]; u32x4 o;
            o.x = pk2(bflo(w.x) * MLA_QSCALE, bfhi(w.x) * MLA_QSCALE); o.y = pk2(bflo(w.y) * MLA_QSCALE, bfhi(w.y) * MLA_QSCALE);
            o.z = pk2(bflo(w.z) * MLA_QSCALE, bfhi(w.z) * MLA_QSCALE); o.w = pk2(bflo(w.w) * MLA_QSCALE, bfhi(w.w) * MLA_QSCALE); qd[c] = o; kd[c] = ks[c]; }
        const u32x4* pe = (const u32x4*)(KPE + (size_t)tok * 32);
#pragma unroll 1
        for (int c = 0; c < 4; ++c) kd[8 + c] = pe[c];
        const float fpos = (float)p.pos[tok]; const bf16_t* qr = QUP + (size_t)tok * 768 + h * 96 + 64; bf16_t* qo = QM + (size_t)tok * 768 + h * 96 + 64;
#pragma unroll 1
        for (int i = 0; i < 16; ++i) { const float invf = powf(500000.0f, -(float)(2 * i) / 32.0f); float c, sn; sincosf(fpos * invf, &sn, &c);
            const float x1 = bf2f(qr[i]), x2 = bf2f(qr[16 + i]); qo[i] = f2bf((x1 * c - x2 * sn) * MLA_QSCALE); qo[16 + i] = f2bf((x2 * c + x1 * sn) * MLA_QSCALE); }
    }
}

DEV void phase5_mla(const Params& p) {
    const int tid = opaque_tid(), wid = __builtin_amdgcn_readfirstlane(tid >> 6), lane = tid & 63;
    const int gw = blockIdx.x * 8 + wid, NGW = gridDim.x * 8;
    const bf16_t* QM = (const bf16_t*)(p.ws + OFF_QM); const bf16_t* KM = (const bf16_t*)(p.ws + OFF_KM); const bf16_t* KVUP = (const bf16_t*)(p.ws + OFF_KVUP);
    bf16_t* OCAT = (bf16_t*)(p.ws + OFF_OCAT);
    constexpr int NUNIT = BATCH * 8 * (SEQ / 64);
#pragma unroll 1
    for (int uu = gw; uu < NUNIT; uu += NGW) {
        const int u = (uu & 1) ? (NUNIT - 1 - (uu >> 1)) : (uu >> 1);
        const int tb = u % (SEQ / 64), h = (u / (SEQ / 64)) & 7, b = u / (SEQ / 64 * 8);
        const int t = tb * 64 + lane; const size_t tok = (size_t)b * SEQ + t;
        unsigned qp[48];
        { const bf16_t* qr = QM + tok * 768 + h * 96;
#pragma unroll
          for (int i = 0; i < 48; ++i) qp[i] = *(const unsigned*)(qr + 2 * i); }
        float o[64];
#pragma unroll
        for (int d = 0; d < 64; ++d) o[d] = 0.f;
        float m = -INFINITY, l = 0.f;
        const bf16_t* kb = KM + (size_t)b * SEQ * 768 + h * 96; const bf16_t* vb = KVUP + (size_t)b * SEQ * 1024 + h * 128 + 64;
        const int jhi = tb * 64 + 64;
#pragma unroll 1
        for (int j0 = 0; j0 < jhi; ++j0) {
            const int j = __builtin_amdgcn_readfirstlane(j0);
            const unsigned* kr = (const unsigned*)(kb + (size_t)j * 768); const unsigned* vr = (const unsigned*)(vb + (size_t)j * 1024);
            float s0 = 0.f;
#pragma unroll
            for (int i = 0; i < 48; ++i) { const unsigned w = kr[i]; s0 += bflo(qp[i]) * bflo(w); s0 += bfhi(qp[i]) * bfhi(w); }
            if (j > t) s0 = -INFINITY;
            const float mn = fmaxf(m, s0);
            const float alpha = fast_exp2(m - mn), p0 = fast_exp2(s0 - mn);
            l = l * alpha + p0; m = mn;
#pragma unroll
            for (int i = 0; i < 32; ++i) { const unsigned w0 = vr[i]; o[2 * i] = o[2 * i] * alpha + p0 * bflo(w0); o[2 * i + 1] = o[2 * i + 1] * alpha + p0 * bfhi(w0); }
        }
        const float rl = 1.0f / l;
        bf16_t* orow = OCAT + tok * 1024 + h * 64;
#pragma unroll
        for (int i = 0; i < 32; ++i) *(unsigned*)(orow + 2 * i) = pk2(o[2 * i] * rl, o[2 * i + 1] * rl);
    }
}

namespace fa {
typedef float f32x16 __attribute__((ext_vector_type(16)));
typedef short s16x4 __attribute__((ext_vector_type(4)));
constexpr int KSLOT = 12288, VSLOT = 8192;
constexpr int L_K = 0, L_V = 2 * KSLOT, L_WSF = L_V + 3 * VSLOT, L_OST = L_WSF + 8 * 512, L_MASK = L_OST + 8 * 4096, L_SEQ = L_MASK + 512, L_VAL = L_MASK + 1024, L_IMPH = L_VAL + 0;
constexpr int L_END = L_IMPH + 65536;
#define FA_MFMA(a, b, c) __builtin_amdgcn_mfma_f32_32x32x16_bf16(a, b, c, 0, 0, 0)
DEV int crow(int r, int hi) { return (r & 3) + 8 * (r >> 2) + 4 * hi; }
DEV s16x4 vtr(const LAS unsigned char* p) { return __builtin_bit_cast(s16x4, __builtin_amdgcn_ds_read_tr16_b64_v4i16((LAS s16x4*)p)); }
DEV float xhalf_max(float m) { auto rr = __builtin_amdgcn_permlane32_swap(__float_as_uint(m), __float_as_uint(m), false, false); return fmaxf(__uint_as_float(rr[0]), __uint_as_float(rr[1])); }
DEV float xhalf_sum(float m) { auto rr = __builtin_amdgcn_permlane32_swap(__float_as_uint(m), __float_as_uint(m), false, false); return __uint_as_float(rr[0]) + __uint_as_float(rr[1]); }

template <int NCH> struct KVRegs { u32x4 k0, k1, v; };
template <int NCH> DEV void stage_load(KVRegs<NCH>& r, const bf16_t* Kb, int kpitch, const bf16_t* Vb, int vpitch, int key0, int wid, int lane) {
    r.k0 = *(const u32x4*)(Kb + (size_t)(key0 + lane) * kpitch + wid * 8);
    if (NCH > 8 && wid < NCH - 8) r.k1 = *(const u32x4*)(Kb + (size_t)(key0 + lane) * kpitch + (8 + wid) * 8);
    r.v = *(const u32x4*)(Vb + (size_t)(key0 + 16 * (wid & 3) + (lane >> 2)) * vpitch + (wid >> 2) * 32 + (lane & 3) * 8);
}
template <int NCH> DEV void stage_write(const KVRegs<NCH>& r, LAS unsigned char* lds, int buf, int wid, int lane) {
    *(LAS u32x4*)(lds + L_K + buf * KSLOT + wid * 1024 + lane * 16) = r.k0;
    if (NCH > 8 && wid < NCH - 8) *(LAS u32x4*)(lds + L_K + buf * KSLOT + (8 + wid) * 1024 + lane * 16) = r.k1;
    *(LAS u32x4*)(lds + L_V + buf * VSLOT + wid * 1024 + lane * 16) = r.v;
}
template <int ND0> DEV void qk_tile(const LAS unsigned char* kbuf, int kp0, const bf16x8 (&qr)[ND0], f32x16& p0, f32x16& p1) {
#pragma unroll
    for (int r = 0; r < 16; ++r) { p0[r] = 0.f; p1[r] = 0.f; }
#pragma unroll
    for (int d0 = 0; d0 < ND0; ++d0) { const bf16x8 k0 = *(const LAS bf16x8*)(kbuf + kp0 + d0 * 2048), k1 = *(const LAS bf16x8*)(kbuf + kp0 + d0 * 2048 + 512);
        p0 = FA_MFMA(k0, qr[d0], p0); p1 = FA_MFMA(k1, qr[d0], p1); }
}
DEV float rowmax32(const f32x16& p0, const f32x16& p1) {
    float a = fmaxf(p0[0], p1[0]);
#pragma unroll
    for (int r = 1; r < 16; ++r) a = fmaxf(a, fmaxf(p0[r], p1[r]));
    return xhalf_max(a);
}
struct SmState { float mhat, l; f32x16 o[2]; };
DEV void sm_init(SmState& st) { st.mhat = -1e30f; st.l = 0.f;
#pragma unroll
    for (int r = 0; r < 16; ++r) { st.o[0][r] = 0.f; st.o[1][r] = 0.f; } }
DEV void sm_pv_tile(SmState& st, f32x16& p0, f32x16& p1, const LAS unsigned char* vbuf, int vp0, LAS float* wsf, int r32, int hi) {
    const float rm = rowmax32(p0, p1);
    const float newm = fmaxf(st.mhat, rm);
    if (__any(newm - st.mhat > 8.0f)) {
        const float f = fast_exp2(st.mhat - newm); st.mhat = newm; st.l *= f;
        if (hi == 0) wsf[r32] = f;
        asm volatile("s_waitcnt lgkmcnt(0)" ::: "memory");
#pragma unroll
        for (int r = 0; r < 16; ++r) { const float fr = wsf[crow(r, hi)]; st.o[0][r] *= fr; st.o[1][r] *= fr; }
        asm volatile("s_waitcnt lgkmcnt(0)" ::: "memory");
    }
    const float nm = -st.mhat; float sacc = 0.f;
#pragma unroll
    for (int r = 0; r < 16; ++r) { p0[r] = fast_exp2(p0[r] + nm); p1[r] = fast_exp2(p1[r] + nm); sacc += p0[r] + p1[r]; }
    st.l += sacc;
    u32x4 pw[4];
#pragma unroll
    for (int k = 0; k < 2; ++k) { pw[k] = (u32x4){pk2(p0[8 * k], p0[8 * k + 1]), pk2(p0[8 * k + 2], p0[8 * k + 3]), pk2(p0[8 * k + 4], p0[8 * k + 5]), pk2(p0[8 * k + 6], p0[8 * k + 7])};
        pw[2 + k] = (u32x4){pk2(p1[8 * k], p1[8 * k + 1]), pk2(p1[8 * k + 2], p1[8 * k + 3]), pk2(p1[8 * k + 4], p1[8 * k + 5]), pk2(p1[8 * k + 6], p1[8 * k + 7])}; }
#pragma unroll
    for (int dh = 0; dh < 2; ++dh)
#pragma unroll
        for (int ks = 0; ks < 4; ++ks) { const s16x4 lo = vtr(vbuf + vp0 + dh * 4096 + ks * 1024), hi4 = vtr(vbuf + vp0 + dh * 4096 + ks * 1024 + 512);
            const bf16x8 vf = (bf16x8){lo[0], lo[1], lo[2], lo[3], hi4[0], hi4[1], hi4[2], hi4[3]};
            st.o[dh] = FA_MFMA(__builtin_bit_cast(bf16x8, pw[ks]), vf, st.o[dh]); }
}
#define FA_MX3(a, b, c) __builtin_fmaxf(__builtin_fmaxf((a), (b)), (c))
template <int ND0> DEV void qk_tile_rel(const LAS unsigned char* kbuf, int kp0, const bf16x8 (&qr)[ND0], const f32x16& mC, f32x16& p0, f32x16& p1) {
    p0 = mC; p1 = mC;
#pragma unroll
    for (int d0 = 0; d0 < ND0; ++d0) { const bf16x8 k0 = *(const LAS bf16x8*)(kbuf + kp0 + d0 * 2048), k1 = *(const LAS bf16x8*)(kbuf + kp0 + d0 * 2048 + 512);
        p0 = FA_MFMA(k0, qr[d0], p0); p1 = FA_MFMA(k1, qr[d0], p1); }
}
DEV void sm_decide(SmState& st, f32x16& mC, f32x16& p0, f32x16& p1, bool firsttile, LAS float* wsf, int r32, int hi) {
    float a = FA_MX3(p0[0], p1[0], p0[1]), b = FA_MX3(p1[1], p0[2], p1[2]);
#pragma unroll
    for (int r = 3; r < 15; r += 2) { a = FA_MX3(a, p0[r], p1[r]); b = FA_MX3(b, p0[r + 1], p1[r + 1]); }
    a = FA_MX3(a, p0[15], p1[15]);
    const float rm = xhalf_max(fmaxf(a, b));
    if (firsttile) { const float m0 = (rm > -1e30f) ? rm : 0.f; st.mhat = m0;
#pragma unroll
        for (int r = 0; r < 16; ++r) { p0[r] -= m0; p1[r] -= m0; mC[r] = -m0; }
    } else if (__any(rm > 8.0f)) {
        const float dl = fmaxf(rm, 0.f); const float f = fast_exp2(-dl); st.mhat += dl; st.l *= f;
        if (hi == 0) wsf[r32] = f;
        asm volatile("s_waitcnt lgkmcnt(0)" ::: "memory");
#pragma unroll
        for (int r = 0; r < 16; ++r) { const float fr = wsf[crow(r, hi)]; st.o[0][r] *= fr; st.o[1][r] *= fr; p0[r] -= dl; p1[r] -= dl; mC[r] = -st.mhat; }
        asm volatile("s_waitcnt lgkmcnt(0)" ::: "memory");
    }
}
DEV void sm_exp_pv(SmState& st, f32x16& p0, f32x16& p1, const LAS unsigned char* vbuf, int vp0) {
    float s0 = 0.f, s1 = 0.f;
#pragma unroll
    for (int r = 0; r < 16; ++r) { p0[r] = fast_exp2(p0[r]); p1[r] = fast_exp2(p1[r]); s0 += p0[r]; s1 += p1[r]; }
    st.l += s0 + s1;
    u32x4 pw[4];
#pragma unroll
    for (int k = 0; k < 2; ++k) { pw[k] = (u32x4){pk2(p0[8 * k], p0[8 * k + 1]), pk2(p0[8 * k + 2], p0[8 * k + 3]), pk2(p0[8 * k + 4], p0[8 * k + 5]), pk2(p0[8 * k + 6], p0[8 * k + 7])};
        pw[2 + k] = (u32x4){pk2(p1[8 * k], p1[8 * k + 1]), pk2(p1[8 * k + 2], p1[8 * k + 3]), pk2(p1[8 * k + 4], p1[8 * k + 5]), pk2(p1[8 * k + 6], p1[8 * k + 7])}; }
#pragma unroll
    for (int dh = 0; dh < 2; ++dh)
#pragma unroll
        for (int ks = 0; ks < 4; ++ks) { const s16x4 lo = vtr(vbuf + vp0 + dh * 4096 + ks * 1024), hi4 = vtr(vbuf + vp0 + dh * 4096 + ks * 1024 + 512);
            const bf16x8 vf = (bf16x8){lo[0], lo[1], lo[2], lo[3], hi4[0], hi4[1], hi4[2], hi4[3]};
            st.o[dh] = FA_MFMA(__builtin_bit_cast(bf16x8, pw[ks]), vf, st.o[dh]); }
}
DEV void row_to_olayout(float fq, float (&out)[16], LAS float* wsf, int r32, int hi) {
    if (hi == 0) wsf[32 + r32] = fq;
    asm volatile("s_waitcnt lgkmcnt(0)" ::: "memory");
#pragma unroll
    for (int r = 0; r < 16; ++r) out[r] = wsf[32 + crow(r, hi)];
    asm volatile("s_waitcnt lgkmcnt(0)" ::: "memory");
}
DEV void store_o_rows(const f32x16 (&o)[2], bf16_t* dst, size_t pitch, LAS unsigned char* ost, int lane, int r32, int hi) {
    LAS bf16_t* stg = (LAS bf16_t*)ost;
#pragma unroll
    for (int r = 0; r < 16; ++r) { const int orow = crow(r, hi);
#pragma unroll
        for (int d0 = 0; d0 < 2; ++d0) stg[orow * 64 + d0 * 32 + r32] = f2bf(o[d0][r]); }
    asm volatile("s_waitcnt lgkmcnt(0)" ::: "memory");
#pragma unroll
    for (int i = 0; i < 4; ++i) { const int row = i * 8 + (lane >> 3), ch = lane & 7; *(u32x4*)(dst + (size_t)row * pitch + ch * 8) = *(const LAS u32x4*)(stg + row * 64 + ch * 8); }
    asm volatile("s_waitcnt lgkmcnt(0)" ::: "memory");
}

#define FT_SBAR() __builtin_amdgcn_sched_barrier(0)
#define FT_PIN(x) asm volatile("" : "+v"(x))
#define FT_WAIT_BAR(N) asm volatile("s_waitcnt vmcnt(" #N ") lgkmcnt(0)\n\ts_barrier" ::: "memory")
DEV unsigned ft_cvtpk(float lo, float hi) { unsigned r; asm("v_cvt_pk_bf16_f32 %0, %1, %2" : "=v"(r) : "v"(lo), "v"(hi)); return r; }
DEV void ft_glds16(const void* g, unsigned lds_base) { unsigned sv; asm volatile("s_mov_b32 %0, m0\n\ts_mov_b32 m0, %2\n\ts_nop 0\n\tglobal_load_lds_dwordx4 %1, off\n\ts_mov_b32 m0, %0" : "=&s"(sv) : "v"(g), "s"(lds_base) : "memory"); }
typedef LAS const char* ft_cptr;
DEV void ft_kload2(bf16x8* kf, ft_cptr kp, int d0) { kf[2 * d0] = *(const LAS bf16x8*)(kp + d0 * 2048); kf[2 * d0 + 1] = *(const LAS bf16x8*)(kp + d0 * 2048 + 512); }
DEV s16x4 ft_vtr(ft_cptr p) { return __builtin_bit_cast(s16x4, __builtin_amdgcn_ds_read_tr16_b64_v4i16((LAS s16x4*)p)); }
DEV float ft_rowmax(const f32x16& p0, const f32x16& p1) {
    float a = FA_MX3(p0[0], p0[1], p1[0]), b = FA_MX3(p0[2], p0[3], p1[1]); a = FA_MX3(a, p1[2], p1[3]);
#pragma unroll
    for (int r = 4; r < 16; r += 4) { a = FA_MX3(a, p0[r], p0[r + 1]); b = FA_MX3(b, p0[r + 2], p0[r + 3]); a = FA_MX3(a, p1[r], p1[r + 1]); b = FA_MX3(b, p1[r + 2], p1[r + 3]); }
    return xhalf_max(__builtin_fmaxf(a, b)); }
template <int MODE>
DEV void fa64_tuned(f32x16 (&o)[2], float& l_out, const bf16x8 (&qr)[4], const bf16_t* Kb, int kpitch, const bf16_t* Vb, int vpitch, unsigned long long um, int jlast, int NT,
                    unsigned long long rowmask, int tb, int tokl, LAS unsigned char* lds, LAS float* wsf, int wid, int lane, int r32, int hi) {
    constexpr int SLOTB = 8192; constexpr float THR = 8.0f;
    const unsigned lds0 = (unsigned)(uintptr_t)lds;
    const bf16_t* ksrc = Kb + (size_t)lane * kpitch + wid * 8;
    const bf16_t* vsrc = Vb + (size_t)(16 * (wid & 3) + (lane >> 2)) * vpitch + (wid >> 2) * 32 + (lane & 3) * 8;
    const unsigned kdst = lds0 + L_K + wid * 1024, vdst = lds0 + L_V + wid * 1024;
    unsigned long long rem_ = um; int jn_ = tb;
    auto gen = [&]() -> int { if (MODE == 0) { if (rem_ == 0ull) return 128; const int j = (int)__builtin_ctzll(rem_); rem_ &= rem_ - 1ull; return j; } else { if (jn_ < jlast) return 128; return jn_--; } };
    int w0 = gen(), w1 = gen(), w2 = gen(), w3 = gen();
#define FT_SHIFT() do { w0 = w1; w1 = w2; w2 = w3; w3 = gen(); } while (0)
#define FT_DMA_K(id, slot) ft_glds16(ksrc + (size_t)(((id) & 63) * 64) * kpitch, (unsigned)__builtin_amdgcn_readfirstlane(kdst + (slot)))
#define FT_DMA_V(id, slot) ft_glds16(vsrc + (size_t)(((id) & 63) * 64) * vpitch, (unsigned)__builtin_amdgcn_readfirstlane(vdst + (slot)))
    const ft_cptr vp0 = (ft_cptr)lds + L_V + ((lane >> 4) & 1) * 32 + (lane & 3) * 8 + (4 * hi + ((lane & 15) >> 2)) * 64;
    const ft_cptr kp0 = (ft_cptr)lds + L_K + hi * 1024 + r32 * 16;
    FT_DMA_K(w0, 0); FT_DMA_V(w0, 0); FT_DMA_K(w1, SLOTB); FT_DMA_K(w2, 2 * SLOTB);
    float mhat = 0.f, l_reg = 0.f; o[0] = f32x16{}; o[1] = f32x16{};
    const f32x16 zero16 = f32x16{};
    bool resc = false;
    f32x16 pA0, pA1, pB0, pB1; bf16x8 kf[8]; s16x4 vlo[8], vhi[8]; u32x4 pw0, pw1, pw2, pw3;
    int sl_prev = 0, sl_cur = 0, sl_next = SLOTB;
#define FT_ROT() do { sl_prev = sl_cur; sl_cur = sl_next; sl_next = (sl_next == 2 * SLOTB) ? 0 : sl_next + SLOTB; } while (0)
#define FT_EX(v) __builtin_amdgcn_exp2f((v) + nmh)
#define FT_RESC() do { if (resc) { _Pragma("unroll") for (int d_ = 0; d_ < 2; ++d_) _Pragma("unroll") for (int r = 0; r < 16; ++r) o[d_][r] *= wsf[crow(r, hi)]; } } while (0)
    auto emask = [&](int id, f32x16& p0, f32x16& p1) {
        const int j = id & 63, kb = 4 * hi;
        if (j == tb) {
#pragma unroll
            for (int r = 0; r < 16; ++r) { const int kv_ = kb + (r & 3) + 8 * (r >> 2); if (kv_ > tokl) p0[r] = -INFINITY; if (kv_ + 32 > tokl) p1[r] = -INFINITY; }
        } else if (MODE == 1 && j == tb - 8) {
#pragma unroll
            for (int r = 0; r < 16; ++r) { const int kv_ = kb + (r & 3) + 8 * (r >> 2); if (kv_ <= tokl) p0[r] = -INFINITY; if (kv_ + 32 <= tokl) p1[r] = -INFINITY; } } };
    auto rowsel = [&](int id) -> bool { if (id & 128) return false; if (MODE == 0) return (rowmask >> (id & 63)) & 1ull; return true; };
    FT_WAIT_BAR(3);
    _Pragma("unroll") for (int d0 = 0; d0 < 4; ++d0) ft_kload2(kf, kp0, d0);
    pA0 = FA_MFMA(kf[0], qr[0], zero16); pA1 = FA_MFMA(kf[1], qr[0], zero16); pA0 = FA_MFMA(kf[2], qr[1], pA0); pA1 = FA_MFMA(kf[3], qr[1], pA1);
    pA0 = FA_MFMA(kf[4], qr[2], pA0); pA1 = FA_MFMA(kf[5], qr[2], pA1); pA0 = FA_MFMA(kf[6], qr[3], pA0); pA1 = FA_MFMA(kf[7], qr[3], pA1);
    emask(w0, pA0, pA1);
    { const float rm = ft_rowmax(pA0, pA1); mhat = rm; const float nmh = -mhat;
#pragma unroll
      for (int r = 0; r < 16; ++r) { pA0[r] = FT_EX(pA0[r]); pA1[r] = FT_EX(pA1[r]); } }
    FT_WAIT_BAR(0);
    FT_DMA_K(w3, 0); FT_DMA_V(w1, SLOTB); FT_ROT(); FT_SHIFT();
    _Pragma("unroll") for (int d0 = 0; d0 < 4; ++d0) ft_kload2(kf, kp0 + sl_cur, d0);
    FT_WAIT_BAR(2);
#define FT_PKW(P, i) ft_cvtpk(P[i], P[i + 1])
#define FT_PAF(k) __builtin_bit_cast(bf16x8, pw##k)
#define FT_VFR(i) (bf16x8){vlo[i][0], vlo[i][1], vlo[i][2], vlo[i][3], vhi[i][0], vhi[i][1], vhi[i][2], vhi[i][3]}
#define FT_VRD(i) do { vlo[i] = ft_vtr(vp_ + (((i) >> 2) * 4096 + ((i) & 3) * 1024)); vhi[i] = ft_vtr(vp_ + (((i) >> 2) * 4096 + ((i) & 3) * 1024 + 512)); } while (0)
#define FT_KRD(G, d0) do { if (G) { ft_kload2(kf, kp0 + sl_next, d0); FT_SBAR(); } } while (0)
#define FT_GAPA(MF, a0, a1, a2, a3, W0, W1, PW) do { MF; sacc += a0; sacc += a1; sacc += a2; sacc += a3; W0; W1; FT_PIN(PW); FT_PIN(sacc); FT_SBAR(); } while (0)
#define FT_GAPB(MF, X, i) do { MF; X[i] = FT_EX(X[i]); X[i + 1] = FT_EX(X[i + 1]); X[i + 2] = FT_EX(X[i + 2]); X[i + 3] = FT_EX(X[i + 3]); FT_PIN(X); FT_SBAR(); } while (0)
#define FT_STEP(C0, C1, P0, P1, t, MASK, GK, GV, GL) do { FT_SBAR(); \
    const ft_cptr vp_ = vp0 + sl_prev; const int id_ = w0; \
    FT_VRD(0); FT_SBAR(); float sacc = P0[0] + P0[1]; \
                       FT_GAPA(C0 = FA_MFMA(kf[0], qr[0], zero16), P0[2], P0[3], P0[4], P0[5],     pw0[0] = FT_PKW(P0, 0),  pw0[1] = FT_PKW(P0, 2),  pw0); \
    FT_VRD(4); FT_SBAR(); FT_GAPA(C1 = FA_MFMA(kf[1], qr[0], zero16), P0[6], P0[7], P0[8], P0[9],     pw0[2] = FT_PKW(P0, 4),  pw0[3] = FT_PKW(P0, 6),  pw0); \
    FT_VRD(1); FT_SBAR(); FT_GAPA(C0 = FA_MFMA(kf[2], qr[1], C0),    P0[10], P0[11], P0[12], P0[13], pw1[0] = FT_PKW(P0, 8),  pw1[1] = FT_PKW(P0, 10), pw1); \
    FT_VRD(5); FT_SBAR(); FT_GAPA(C1 = FA_MFMA(kf[3], qr[1], C1),    P0[14], P0[15], P1[0], P1[1],   pw1[2] = FT_PKW(P0, 12), pw1[3] = FT_PKW(P0, 14), pw1); \
    FT_VRD(2); FT_SBAR(); FT_GAPA(C0 = FA_MFMA(kf[4], qr[2], C0),    P1[2], P1[3], P1[4], P1[5],     pw2[0] = FT_PKW(P1, 0),  pw2[1] = FT_PKW(P1, 2),  pw2); \
    FT_VRD(6); FT_SBAR(); FT_GAPA(C1 = FA_MFMA(kf[5], qr[2], C1),    P1[6], P1[7], P1[8], P1[9],     pw2[2] = FT_PKW(P1, 4),  pw2[3] = FT_PKW(P1, 6),  pw2); \
    FT_VRD(3); FT_SBAR(); FT_GAPA(C0 = FA_MFMA(kf[6], qr[3], C0),    P1[10], P1[11], P1[12], P1[13], pw3[0] = FT_PKW(P1, 8),  pw3[1] = FT_PKW(P1, 10), pw3); \
    FT_VRD(7); FT_SBAR(); FT_GAPA(C1 = FA_MFMA(kf[7], qr[3], C1),    P1[14], P1[15], 0.f, 0.f,       pw3[2] = FT_PKW(P1, 12), pw3[3] = FT_PKW(P1, 14), pw3); \
    l_reg += sacc; \
    if (GK) FT_DMA_K(w3, sl_cur); if (GV) FT_DMA_V(w1, sl_next); \
    if (MASK) emask(id_, C0, C1); \
    const bool rs_ = rowsel(id_); \
    { float rmx = ft_rowmax(C0, C1); if (!rs_) rmx = -INFINITY; const float rm = rmx - mhat; resc = false; \
      if (__builtin_expect(__any(rm > THR), 0)) { const float dl = __builtin_fmaxf(rm, 0.f); mhat += dl; \
          const float f = __builtin_amdgcn_exp2f(-dl); l_reg *= f; if (hi == 0) wsf[r32] = f; resc = true; } } \
    const float nmh = rs_ ? -mhat : -INFINITY; FT_SBAR(); \
    FT_GAPB(o[0] = FA_MFMA(FT_PAF(0), FT_VFR(0), o[0]), C0, 0);              FT_GAPB(o[1] = FA_MFMA(FT_PAF(0), FT_VFR(4), o[1]), C0, 4); \
    FT_KRD(GL, 0); FT_GAPB(o[0] = FA_MFMA(FT_PAF(1), FT_VFR(1), o[0]), C0, 8);  FT_KRD(GL, 1); FT_GAPB(o[1] = FA_MFMA(FT_PAF(1), FT_VFR(5), o[1]), C0, 12); \
    FT_KRD(GL, 2); FT_GAPB(o[0] = FA_MFMA(FT_PAF(2), FT_VFR(2), o[0]), C1, 0);  FT_KRD(GL, 3); FT_GAPB(o[1] = FA_MFMA(FT_PAF(2), FT_VFR(6), o[1]), C1, 4); \
    FT_GAPB(o[0] = FA_MFMA(FT_PAF(3), FT_VFR(3), o[0]), C1, 8);              FT_GAPB(o[1] = FA_MFMA(FT_PAF(3), FT_VFR(7), o[1]), C1, 12); \
    } while (0)
    int t = 1;
    for (; t + 5 < NT; t += 2) {
        FT_STEP(pB0, pB1, pA0, pA1, t, false, true, true, true);     FT_WAIT_BAR(2); FT_RESC(); FT_ROT(); FT_SHIFT();
        FT_STEP(pA0, pA1, pB0, pB1, t + 1, false, true, true, true); FT_WAIT_BAR(2); FT_RESC(); FT_ROT(); FT_SHIFT();
    }
#define FT_ENDW(tt) do { if ((tt) + 3 < NT) { FT_WAIT_BAR(2); } else if ((tt) + 2 < NT) { FT_WAIT_BAR(1); } else { FT_WAIT_BAR(0); } } while (0)
    for (; t + 1 < NT; t += 2) {
        FT_STEP(pB0, pB1, pA0, pA1, t, true, (t + 3 < NT), (t + 1 < NT), (t + 1 < NT));         FT_ENDW(t);     FT_RESC(); FT_ROT(); FT_SHIFT();
        FT_STEP(pA0, pA1, pB0, pB1, t + 1, true, (t + 4 < NT), (t + 2 < NT), (t + 2 < NT));     FT_ENDW(t + 1); FT_RESC(); FT_ROT(); FT_SHIFT();
    }
    FT_STEP(pB0, pB1, pA0, pA1, NT - 1, true, false, false, false); FT_RESC();
    { float sacc = pB0[0] + pB0[1];
#pragma unroll
      for (int r = 2; r < 16; ++r) sacc += pB0[r];
#pragma unroll
      for (int r = 0; r < 16; ++r) sacc += pB1[r];
      l_reg += sacc;
      pw0 = (u32x4){FT_PKW(pB0, 0), FT_PKW(pB0, 2), FT_PKW(pB0, 4), FT_PKW(pB0, 6)}; pw1 = (u32x4){FT_PKW(pB0, 8), FT_PKW(pB0, 10), FT_PKW(pB0, 12), FT_PKW(pB0, 14)};
      pw2 = (u32x4){FT_PKW(pB1, 0), FT_PKW(pB1, 2), FT_PKW(pB1, 4), FT_PKW(pB1, 6)}; pw3 = (u32x4){FT_PKW(pB1, 8), FT_PKW(pB1, 10), FT_PKW(pB1, 12), FT_PKW(pB1, 14)};
      const ft_cptr vp_ = vp0 + sl_cur; _Pragma("unroll") for (int i = 0; i < 8; ++i) FT_VRD(i);
      o[0] = FA_MFMA(FT_PAF(0), FT_VFR(0), o[0]); o[1] = FA_MFMA(FT_PAF(0), FT_VFR(4), o[1]); o[0] = FA_MFMA(FT_PAF(1), FT_VFR(1), o[0]); o[1] = FA_MFMA(FT_PAF(1), FT_VFR(5), o[1]);
      o[0] = FA_MFMA(FT_PAF(2), FT_VFR(2), o[0]); o[1] = FA_MFMA(FT_PAF(2), FT_VFR(6), o[1]); o[0] = FA_MFMA(FT_PAF(3), FT_VFR(3), o[0]); o[1] = FA_MFMA(FT_PAF(3), FT_VFR(7), o[1]); }
    l_out = l_reg;
    asm volatile("s_waitcnt lgkmcnt(0)\n\ts_barrier" ::: "memory");
#undef FT_SHIFT
#undef FT_DMA_K
#undef FT_DMA_V
#undef FT_ROT
#undef FT_EX
#undef FT_RESC
#undef FT_PKW
#undef FT_PAF
#undef FT_VFR
#undef FT_VRD
#undef FT_KRD
#undef FT_ENDW
#undef FT_GAPA
#undef FT_GAPB
#undef FT_STEP
}

constexpr int M_KSLOT = 12288, M_LK = 0, M_LV = 4 * M_KSLOT, M_LWSF = M_LV + 3 * 8192, M_LOST = M_LWSF + 8 * 512, M_LEND = M_LOST + 8 * 4096;
DEV void ft_wait_bar(int n) {
    if (n == 0) asm volatile("s_waitcnt vmcnt(0) lgkmcnt(0)\n\ts_barrier" ::: "memory");
    else if (n == 1) asm volatile("s_waitcnt vmcnt(1) lgkmcnt(0)\n\ts_barrier" ::: "memory");
    else if (n == 2) asm volatile("s_waitcnt vmcnt(2) lgkmcnt(0)\n\ts_barrier" ::: "memory");
    else if (n == 3) asm volatile("s_waitcnt vmcnt(3) lgkmcnt(0)\n\ts_barrier" ::: "memory");
    else asm volatile("s_waitcnt vmcnt(5) lgkmcnt(0)\n\ts_barrier" ::: "memory");
}
DEV void fa96_tuned(f32x16 (&o)[2], float& l_out, const bf16x8 (&qr)[6], const bf16_t* Kb, const bf16_t* Vb, int NT, int qrel, LAS unsigned char* lds, LAS float* wsf, int wid, int lane, int r32, int hi) {
    constexpr int SLOTB = 8192; constexpr float THR = 8.0f;
    const unsigned lds0 = (unsigned)(uintptr_t)lds;
    const int kc = (wid < 4) ? 2 : 1;
    const bf16_t* ksrc = Kb + (size_t)lane * 768 + wid * 8;
    const bf16_t* vsrc = Vb + (size_t)(16 * (wid & 3) + (lane >> 2)) * 512 + (wid >> 2) * 32 + (lane & 3) * 8;
    const unsigned kdst = lds0 + M_LK + wid * 1024, vdst = lds0 + M_LV + wid * 1024;
#define MT_DMA_K(t) do { const unsigned sl_ = (unsigned)(((t) & 3) * M_KSLOT); ft_glds16(ksrc + (size_t)(t) * 64 * 768, (unsigned)__builtin_amdgcn_readfirstlane(kdst + sl_)); \
        if (wid < 4) ft_glds16(ksrc + (size_t)(t) * 64 * 768 + 64, (unsigned)__builtin_amdgcn_readfirstlane(kdst + 8192 + sl_)); } while (0)
#define MT_DMA_V(t, slot) ft_glds16(vsrc + (size_t)(t) * 64 * 512, (unsigned)__builtin_amdgcn_readfirstlane(vdst + (slot)))
    const ft_cptr vp0 = (ft_cptr)lds + M_LV + ((lane >> 4) & 1) * 32 + (lane & 3) * 8 + (4 * hi + ((lane & 15) >> 2)) * 64;
    const ft_cptr kp0 = (ft_cptr)lds + M_LK + hi * 1024 + r32 * 16;
#define MT_KFR(kp, f) (*(const LAS bf16x8*)((kp) + ((f) >> 1) * 2048 + ((f) & 1) * 512))
    MT_DMA_K(0); MT_DMA_V(0, 0); MT_DMA_K(1); MT_DMA_K(2);
    float mhat = 0.f, l_reg = 0.f; o[0] = f32x16{}; o[1] = f32x16{};
    const f32x16 zero16 = f32x16{};
    bool resc = false;
    f32x16 pA0, pA1, pB0, pB1; bf16x8 kf[4]; s16x4 vlo[8], vhi[8]; u32x4 pw0, pw1, pw2, pw3;
    int sl_prev = 0, sl_cur = 0, sl_next = SLOTB;
    const int band0 = NT - 4;
#define MT_ROT() do { sl_prev = sl_cur; sl_cur = sl_next; sl_next = (sl_next == 2 * SLOTB) ? 0 : sl_next + SLOTB; } while (0)
#define MT_EX(v) __builtin_amdgcn_exp2f((v) + nmh)
#define MT_RESC() do { if (resc) { _Pragma("unroll") for (int d_ = 0; d_ < 2; ++d_) _Pragma("unroll") for (int r = 0; r < 16; ++r) o[d_][r] *= wsf[crow(r, hi)]; } } while (0)
    auto cmask = [&](int t, f32x16& p0, f32x16& p1) { const int jb = t - band0; if (jb >= 0) { const int kb = 64 * jb + 4 * hi;
#pragma unroll
            for (int r = 0; r < 16; ++r) { const int kv_ = kb + (r & 3) + 8 * (r >> 2); if (kv_ > qrel) p0[r] = -INFINITY; if (kv_ + 32 > qrel) p1[r] = -INFINITY; } } };
    ft_wait_bar(kc == 2 ? 5 : 3);
    { const ft_cptr kp = kp0;
      pA0 = zero16; pA1 = zero16;
#pragma unroll
      for (int d0 = 0; d0 < 6; ++d0) { const bf16x8 k0 = MT_KFR(kp, 2 * d0), k1 = MT_KFR(kp, 2 * d0 + 1); pA0 = FA_MFMA(k0, qr[d0], pA0); pA1 = FA_MFMA(k1, qr[d0], pA1); } }
    cmask(0, pA0, pA1);
    { const float rm = ft_rowmax(pA0, pA1); mhat = rm; const float nmh = -mhat;
#pragma unroll
      for (int r = 0; r < 16; ++r) { pA0[r] = MT_EX(pA0[r]); pA1[r] = MT_EX(pA1[r]); } }
    ft_wait_bar(0);
    MT_DMA_K(3); MT_DMA_V(1, SLOTB); MT_ROT();
    { const ft_cptr kp = kp0 + M_KSLOT;
#pragma unroll
      for (int f = 0; f < 4; ++f) kf[f] = MT_KFR(kp, f); }
    ft_wait_bar(kc + 1);
#define MT_PKW(P, i) ft_cvtpk(P[i], P[i + 1])
#define MT_PAF(k) __builtin_bit_cast(bf16x8, pw##k)
#define MT_VFR(i) (bf16x8){vlo[i][0], vlo[i][1], vlo[i][2], vlo[i][3], vhi[i][0], vhi[i][1], vhi[i][2], vhi[i][3]}
#define MT_VRD(i) do { vlo[i] = ft_vtr(vp_ + (((i) >> 2) * 4096 + ((i) & 3) * 1024)); vhi[i] = ft_vtr(vp_ + (((i) >> 2) * 4096 + ((i) & 3) * 1024 + 512)); } while (0)
#define MT_GAPA(i, C, a0, a1, a2, a3, W0, W1, PW) do { C = FA_MFMA(kf[(i) & 3], qr[(i) >> 1], ((i) < 2) ? zero16 : C); if ((i) + 4 < 12) kf[(i) & 3] = MT_KFR(kp_, (i) + 4); \
        sacc += a0; sacc += a1; sacc += a2; sacc += a3; W0; W1; FT_PIN(PW); FT_PIN(sacc); FT_SBAR(); } while (0)
#define MT_GAPA0(i, C) do { C = FA_MFMA(kf[(i) & 3], qr[(i) >> 1], C); if ((i) + 4 < 12) kf[(i) & 3] = MT_KFR(kp_, (i) + 4); FT_SBAR(); } while (0)
#define MT_GAPB(MF, X, i) do { MF; X[i] = MT_EX(X[i]); X[i + 1] = MT_EX(X[i + 1]); X[i + 2] = MT_EX(X[i + 2]); X[i + 3] = MT_EX(X[i + 3]); FT_PIN(X); FT_SBAR(); } while (0)
#define MT_STEP(C0, C1, P0, P1, t, MASK, GK, GV, GL) do { FT_SBAR(); \
    const ft_cptr vp_ = vp0 + sl_prev; const ft_cptr kp_ = kp0 + ((t) & 3) * M_KSLOT; \
    MT_VRD(0); FT_SBAR(); float sacc = P0[0] + P0[1]; \
                          MT_GAPA(0, C0, P0[2], P0[3], P0[4], P0[5],     pw0[0] = MT_PKW(P0, 0),  pw0[1] = MT_PKW(P0, 2),  pw0); \
    MT_VRD(4); FT_SBAR(); MT_GAPA(1, C1, P0[6], P0[7], P0[8], P0[9],     pw0[2] = MT_PKW(P0, 4),  pw0[3] = MT_PKW(P0, 6),  pw0); \
    MT_VRD(1); FT_SBAR(); MT_GAPA(2, C0, P0[10], P0[11], P0[12], P0[13], pw1[0] = MT_PKW(P0, 8),  pw1[1] = MT_PKW(P0, 10), pw1); \
    MT_VRD(5); FT_SBAR(); MT_GAPA(3, C1, P0[14], P0[15], P1[0], P1[1],   pw1[2] = MT_PKW(P0, 12), pw1[3] = MT_PKW(P0, 14), pw1); \
    MT_VRD(2); FT_SBAR(); MT_GAPA(4, C0, P1[2], P1[3], P1[4], P1[5],     pw2[0] = MT_PKW(P1, 0),  pw2[1] = MT_PKW(P1, 2),  pw2); \
    MT_VRD(6); FT_SBAR(); MT_GAPA(5, C1, P1[6], P1[7], P1[8], P1[9],     pw2[2] = MT_PKW(P1, 4),  pw2[3] = MT_PKW(P1, 6),  pw2); \
    MT_VRD(3); FT_SBAR(); MT_GAPA(6, C0, P1[10], P1[11], P1[12], P1[13], pw3[0] = MT_PKW(P1, 8),  pw3[1] = MT_PKW(P1, 10), pw3); \
    MT_VRD(7); FT_SBAR(); MT_GAPA(7, C1, P1[14], P1[15], 0.f, 0.f,       pw3[2] = MT_PKW(P1, 12), pw3[3] = MT_PKW(P1, 14), pw3); \
    MT_GAPA0(8, C0); MT_GAPA0(9, C1); MT_GAPA0(10, C0); MT_GAPA0(11, C1); \
    l_reg += sacc; \
    if (GK) MT_DMA_K((t) + 3); if (GV) MT_DMA_V((t) + 1, sl_next); \
    if (MASK) cmask((t), C0, C1); \
    { const float rm = ft_rowmax(C0, C1) - mhat; resc = false; \
      if (__builtin_expect(__any(rm > THR), 0)) { const float dl = __builtin_fmaxf(rm, 0.f); mhat += dl; \
          const float f = __builtin_amdgcn_exp2f(-dl); l_reg *= f; if (hi == 0) wsf[r32] = f; resc = true; } } \
    const float nmh = -mhat; FT_SBAR(); \
    MT_GAPB(o[0] = FA_MFMA(MT_PAF(0), MT_VFR(0), o[0]), C0, 0);  MT_GAPB(o[1] = FA_MFMA(MT_PAF(0), MT_VFR(4), o[1]), C0, 4); \
    MT_GAPB(o[0] = FA_MFMA(MT_PAF(1), MT_VFR(1), o[0]), C0, 8);  MT_GAPB(o[1] = FA_MFMA(MT_PAF(1), MT_VFR(5), o[1]), C0, 12); \
    MT_GAPB(o[0] = FA_MFMA(MT_PAF(2), MT_VFR(2), o[0]), C1, 0);  MT_GAPB(o[1] = FA_MFMA(MT_PAF(2), MT_VFR(6), o[1]), C1, 4); \
    MT_GAPB(o[0] = FA_MFMA(MT_PAF(3), MT_VFR(3), o[0]), C1, 8);  MT_GAPB(o[1] = FA_MFMA(MT_PAF(3), MT_VFR(7), o[1]), C1, 12); \
    if (GL) { const ft_cptr kn_ = kp0 + (((t) + 1) & 3) * M_KSLOT; _Pragma("unroll") for (int f = 0; f < 4; ++f) kf[f] = MT_KFR(kn_, f); } \
    } while (0)
#define MT_ENDW(tt) do { if ((tt) + 3 < NT) ft_wait_bar(kc + 1); else if ((tt) + 2 < NT) ft_wait_bar(1); else ft_wait_bar(0); } while (0)
    int t = 1;
    for (; t + 5 < NT; t += 2) {
        MT_STEP(pB0, pB1, pA0, pA1, t, false, true, true, true);     ft_wait_bar(kc + 1); MT_RESC(); MT_ROT();
        MT_STEP(pA0, pA1, pB0, pB1, t + 1, false, true, true, true); ft_wait_bar(kc + 1); MT_RESC(); MT_ROT();
    }
    for (; t + 1 < NT; t += 2) {
        MT_STEP(pB0, pB1, pA0, pA1, t, true, (t + 3 < NT), (t + 1 < NT), (t + 1 < NT));         MT_ENDW(t);     MT_RESC(); MT_ROT();
        MT_STEP(pA0, pA1, pB0, pB1, t + 1, true, (t + 4 < NT), (t + 2 < NT), (t + 2 < NT));     MT_ENDW(t + 1); MT_RESC(); MT_ROT();
    }
    MT_STEP(pB0, pB1, pA0, pA1, NT - 1, true, false, false, false); MT_RESC();
    { float sacc = pB0[0] + pB0[1];
#pragma unroll
      for (int r = 2; r < 16; ++r) sacc += pB0[r];
#pragma unroll
      for (int r = 0; r < 16; ++r) sacc += pB1[r];
      l_reg += sacc;
      pw0 = (u32x4){MT_PKW(pB0, 0), MT_PKW(pB0, 2), MT_PKW(pB0, 4), MT_PKW(pB0, 6)}; pw1 = (u32x4){MT_PKW(pB0, 8), MT_PKW(pB0, 10), MT_PKW(pB0, 12), MT_PKW(pB0, 14)};
      pw2 = (u32x4){MT_PKW(pB1, 0), MT_PKW(pB1, 2), MT_PKW(pB1, 4), MT_PKW(pB1, 6)}; pw3 = (u32x4){MT_PKW(pB1, 8), MT_PKW(pB1, 10), MT_PKW(pB1, 12), MT_PKW(pB1, 14)};
      const ft_cptr vp_ = vp0 + sl_cur; _Pragma("unroll") for (int i = 0; i < 8; ++i) MT_VRD(i);
      o[0] = FA_MFMA(MT_PAF(0), MT_VFR(0), o[0]); o[1] = FA_MFMA(MT_PAF(0), MT_VFR(4), o[1]); o[0] = FA_MFMA(MT_PAF(1), MT_VFR(1), o[0]); o[1] = FA_MFMA(MT_PAF(1), MT_VFR(5), o[1]);
      o[0] = FA_MFMA(MT_PAF(2), MT_VFR(2), o[0]); o[1] = FA_MFMA(MT_PAF(2), MT_VFR(6), o[1]); o[0] = FA_MFMA(MT_PAF(3), MT_VFR(3), o[0]); o[1] = FA_MFMA(MT_PAF(3), MT_VFR(7), o[1]); }
    l_out = l_reg;
    asm volatile("s_waitcnt lgkmcnt(0)\n\ts_barrier" ::: "memory");
#undef MT_DMA_K
#undef MT_DMA_V
#undef MT_KFR
#undef MT_ROT
#undef MT_EX
#undef MT_RESC
#undef MT_PKW
#undef MT_PAF
#undef MT_VFR
#undef MT_VRD
#undef MT_GAPA
#undef MT_GAPA0
#undef MT_GAPB
#undef MT_STEP
#undef MT_ENDW
}
}

DEV void mla_unit(const Params& p, LAS unsigned char* lds, int b, int h, int qb) {
    using namespace fa;
    const int tid = opaque_tid(), wid = __builtin_amdgcn_readfirstlane(tid >> 6), lane = tid & 63, r32 = lane & 31, hi = lane >> 5;
    const bf16_t* QM = (const bf16_t*)(p.ws + OFF_QM); const bf16_t* Kb = (const bf16_t*)(p.ws + OFF_KM) + (size_t)b * SEQ * 768 + h * 96;
    const bf16_t* Vb = (const bf16_t*)(p.ws + OFF_VM) + (size_t)b * SEQ * 512 + h * 64; bf16_t* OCAT = (bf16_t*)(p.ws + OFF_OCAT);
    const int q0 = qb * 256, NT = (q0 + 256) / 64;
    LAS float* wsf = (LAS float*)(lds + M_LWSF) + wid * 128;
    bf16x8 qr[6];
    { const bf16_t* qrow = QM + ((size_t)b * SEQ + q0 + wid * 32 + r32) * 768 + h * 96 + hi * 8;
#pragma unroll
      for (int d0 = 0; d0 < 6; ++d0) qr[d0] = *(const bf16x8*)(qrow + d0 * 16); }
    f32x16 o[2]; float lpart;
    fa96_tuned(o, lpart, qr, Kb, Vb, NT, wid * 32 + r32, lds, wsf, wid, lane, r32, hi);
    const float l = xhalf_sum(lpart); float rl[16]; row_to_olayout(1.0f / l, rl, wsf, r32, hi);
#pragma unroll
    for (int r = 0; r < 16; ++r) { o[0][r] *= rl[r]; o[1][r] *= rl[r]; }
    store_o_rows(o, OCAT + ((size_t)b * SEQ + q0 + wid * 32) * 1024 + h * 64, 1024, lds + M_LOST + wid * 4096, lane, r32, hi);
    __syncthreads();
}
DEV void nsa_unit(const Params& p, LAS unsigned char* lds, int b, int g, int tb) {
    using namespace fa;
    const int tid = opaque_tid(), wid = __builtin_amdgcn_readfirstlane(tid >> 6), lane = tid & 63, r32 = lane & 31, hi = lane >> 5;
    const int hl = wid >> 1, head = 4 * g + hl, q0 = 64 * tb, tokl = 32 * (wid & 1) + r32, t = q0 + tokl;
    const size_t tok = (size_t)b * SEQ + t;
    const bf16_t* PROJ = (const bf16_t*)(p.ws + OFF_PROJ); const float* GATES = (const float*)(p.ws + OFF_GATES);
    LAS float* wsf = (LAS float*)(lds + L_WSF) + wid * 128;
    LAS float* impH = (LAS float*)(lds + L_IMPH);
    const int kp0 = hi * 1024 + r32 * 16;
    const int vp0 = ((lane >> 4) & 1) * 32 + (lane & 3) * 8 + (4 * hi + ((lane & 15) >> 2)) * 64;
    bf16x8 qr[4];
    { const bf16_t* qrow = (const bf16_t*)(p.ws + OFF_NQ) + tok * 512 + head * 64 + hi * 8;
#pragma unroll
      for (int d0 = 0; d0 < 4; ++d0) qr[d0] = *(const bf16x8*)(qrow + d0 * 16); }
    if (hi == 0) { const float* gp_ = GATES + tok * 24 + head * 3; wsf[64 + r32] = gp_[0]; wsf[96 + r32] = gp_[1]; }
    const float g2reg = GATES[tok * 24 + head * 3 + 2];
    { LAS f32x4* z = (LAS f32x4*)impH + tid;
#pragma unroll
      for (int i = 0; i < 8; ++i) z[i * 512] = (f32x4){0.f, 0.f, 0.f, 0.f}; }
    KVRegs<8> kv;
    f32x16 res[2];
    const int cntq = (t >= 31) ? ((t - 31) >> 4) + 1 : 0;
    const int ntc = (4 * tb + 3 + 63) >> 6;
    const bf16_t* Kc = (const bf16_t*)(p.ws + OFF_KC) + ((size_t)b * NCMPP * 2 + g) * 64; const bf16_t* Vc = (const bf16_t*)(p.ws + OFF_VC) + ((size_t)b * NCMPP * 2 + g) * 64;
    float mc = -1e30f, lc = 0.f;
    {   KVRegs<8> kc4[4];
#pragma unroll
        for (int c = 0; c < 4; ++c) if (c < ntc) stage_load<8>(kc4[c], Kc, 128, Vc, 128, c * 64, wid, lane);

#pragma unroll
        for (int c = 0; c < 4; ++c) if (c < ntc) { *(LAS u32x4*)(lds + L_K + c * 8192 + wid * 1024 + lane * 16) = kc4[c].k0; *(LAS u32x4*)(lds + L_OST + c * 8192 + wid * 1024 + lane * 16) = kc4[c].v; } }
    __syncthreads();
#pragma unroll 1
    for (int c = 0; c < ntc; ++c) {
        f32x16 p0, p1; qk_tile<4>(lds + L_K + c * 8192, kp0, qr, p0, p1);
        const int nb = 64 * c + 4 * hi;
#pragma unroll
        for (int r = 0; r < 16; ++r) { const int n = nb + (r & 3) + 8 * (r >> 2); if (n >= cntq) p0[r] = -INFINITY; if (n + 32 >= cntq) p1[r] = -INFINITY; }
        const float newm = fmaxf(mc, rowmax32(p0, p1)); float sacc = 0.f;
#pragma unroll
        for (int r = 0; r < 16; ++r) sacc += fast_exp2(p0[r] - newm) + fast_exp2(p1[r] - newm);
        lc = lc * fast_exp2(mc - newm) + sacc; mc = newm;
    }
    lc = xhalf_sum(lc);
    const float rlc = (lc > 0.f) ? 1.0f / lc : 0.f;
    float carry = 0.f;
    f32x16 oc[2];
#pragma unroll
    for (int r = 0; r < 16; ++r) { oc[0][r] = 0.f; oc[1][r] = 0.f; }
#pragma unroll 1
    for (int c = 0; c < ntc; ++c) {
        f32x16 p0, p1; qk_tile<4>(lds + L_K + c * 8192, kp0, qr, p0, p1);
        const int nb = 64 * c + 4 * hi;
#pragma unroll
        for (int r = 0; r < 16; ++r) { const int n = nb + (r & 3) + 8 * (r >> 2);
            p0[r] = (n >= cntq) ? 0.f : fast_exp2(p0[r] - mc) * rlc; p1[r] = (n + 32 >= cntq) ? 0.f : fast_exp2(p1[r] - mc) * rlc; }
        { LAS float* ih = impH + (size_t)hl * 4096 + tokl; float b0[4], b1[4];
#pragma unroll
          for (int k = 0; k < 4; ++k) { b0[k] = __shfl_xor(p0[4 * k + 3], 32); b1[k] = __shfl_xor(p1[4 * k + 3], 32); }
#pragma unroll
          for (int k = 0; k < 4; ++k) { const int j0 = 16 * c + 2 * k + hi, j1 = j0 + 8;
              const float G0 = (p0[4 * k] + p0[4 * k + 1]) + (p0[4 * k + 2] + p0[4 * k + 3]), G1 = (p1[4 * k] + p1[4 * k + 1]) + (p1[4 * k + 2] + p1[4 * k + 3]);
              const float e0 = hi ? b0[k] : (k ? b0[k > 0 ? k - 1 : 0] : carry), e1 = hi ? b1[k] : (k ? b1[k > 0 ? k - 1 : 0] : b0[3]);
              ih[j0 * 64] = G0 + e0; ih[j1 * 64] = G1 + e1; }
          carry = b1[3]; }
        u32x4 pw[4];
#pragma unroll
        for (int k = 0; k < 2; ++k) { pw[k] = (u32x4){pk2(p0[8 * k], p0[8 * k + 1]), pk2(p0[8 * k + 2], p0[8 * k + 3]), pk2(p0[8 * k + 4], p0[8 * k + 5]), pk2(p0[8 * k + 6], p0[8 * k + 7])};
            pw[2 + k] = (u32x4){pk2(p1[8 * k], p1[8 * k + 1]), pk2(p1[8 * k + 2], p1[8 * k + 3]), pk2(p1[8 * k + 4], p1[8 * k + 5]), pk2(p1[8 * k + 6], p1[8 * k + 7])}; }
        const LAS unsigned char* vbuf = lds + L_OST + c * 8192;
#pragma unroll
        for (int dh = 0; dh < 2; ++dh)
#pragma unroll
            for (int ks = 0; ks < 4; ++ks) { const s16x4 lo = vtr(vbuf + vp0 + dh * 4096 + ks * 1024), hi4 = vtr(vbuf + vp0 + dh * 4096 + ks * 1024 + 512);
                const bf16x8 vf = (bf16x8){lo[0], lo[1], lo[2], lo[3], hi4[0], hi4[1], hi4[2], hi4[3]};
                oc[dh] = FA_MFMA(__builtin_bit_cast(bf16x8, pw[ks]), vf, oc[dh]); }
    }
    __syncthreads();
    {   const int tk = tid & 63; const int cur = tb;
        float v[8];
#pragma unroll
        for (int k = 0; k < 8; ++k) { const int j = 8 * wid + k; const LAS float* q_ = impH + j * 64 + tk;
            const float s4 = ((q_[0] + q_[4096]) + q_[2 * 4096]) + q_[3 * 4096]; const bool forced = (j == 0) || (j <= cur && j > cur - 2); v[k] = forced ? 1e30f : s4; }
#pragma unroll
        for (int k = 0; k < 8; ++k) impH[(8 * wid + k) * 64 + tk] = v[k];
        __syncthreads();
        unsigned bits = 0u; int rank[8];
#pragma unroll
        for (int k = 0; k < 8; ++k) rank[k] = 0;
        if (cur >= 16)
#pragma unroll 4
        for (int q_ = 0; q_ <= cur; ++q_) { const float vq = impH[q_ * 64 + tk];
#pragma unroll
            for (int k = 0; k < 8; ++k) rank[k] += (vq > v[k] || (vq == v[k] && q_ < 8 * wid + k)) ? 1 : 0; }
#pragma unroll
        for (int k = 0; k < 8; ++k) if (8 * wid + k <= cur && rank[k] < 16) bits |= (1u << k);
        ((LAS unsigned char*)(lds + L_MASK))[tk * 8 + wid] = (unsigned char)bits;
        __syncthreads();
    }
    LAS float* resL = impH + wid * 2048 + lane;
    { float f[16]; row_to_olayout(wsf[64 + r32], f, wsf, r32, hi);
#pragma unroll
      for (int r = 0; r < 16; ++r) { resL[r * 64] = oc[0][r] * f[r]; resL[(16 + r) * 64] = oc[1][r] * f[r]; } }
    const unsigned long long mymask = *(const LAS unsigned long long*)(lds + L_MASK + tokl * 8);
    unsigned long long um;
    { const unsigned long long mm = *(const LAS unsigned long long*)(lds + L_MASK + lane * 8); unsigned ulo = (unsigned)mm, uhi = (unsigned)(mm >> 32);
#pragma unroll
      for (int o_ = 1; o_ < 64; o_ <<= 1) { ulo |= __shfl_xor(ulo, o_); uhi |= __shfl_xor(uhi, o_); }
      um = ((unsigned long long)(unsigned)__builtin_amdgcn_readfirstlane(uhi) << 32) | (unsigned)__builtin_amdgcn_readfirstlane(ulo); }
    {   const bf16_t* Kb = (const bf16_t*)(p.ws + OFF_KSR) + (size_t)b * SEQ * 128 + g * 64; const bf16_t* Vb = (const bf16_t*)(p.ws + OFF_VSC) + (size_t)b * SEQ * 128 + g * 64;
        int nt = __builtin_popcountll(um);
        while (nt < 4 || (nt & 1)) ++nt;
        f32x16 o[2]; float lpart;
        fa64_tuned<0>(o, lpart, qr, Kb, 128, Vb, 128, um, 0, nt, mymask, tb, tokl, lds, wsf, wid, lane, r32, hi);
        const float l = xhalf_sum(lpart); float f[16]; row_to_olayout(wsf[96 + r32] / l, f, wsf, r32, hi);
#pragma unroll
        for (int r = 0; r < 16; ++r) { resL[r * 64] += o[0][r] * f[r]; resL[(16 + r) * 64] += o[1][r] * f[r]; }
    }
    {   const bf16_t* Kb = (const bf16_t*)(p.ws + OFF_KWR) + (size_t)b * SEQ * 128 + g * 64; const bf16_t* Vb = (const bf16_t*)(p.ws + OFF_VWC) + (size_t)b * SEQ * 128 + g * 64;
        const int jlast = (tb - 8 > 0) ? tb - 8 : 0; int nt = tb - jlast + 1;
        while (nt < 4 || (nt & 1)) ++nt;
        f32x16 o[2]; float lpart;
        fa64_tuned<1>(o, lpart, qr, Kb, 128, Vb, 128, 0ull, jlast, nt, 0ull, tb, tokl, lds, wsf, wid, lane, r32, hi);
        const float l = xhalf_sum(lpart); float f[16]; row_to_olayout(g2reg / l, f, wsf, r32, hi);
#pragma unroll
        for (int r = 0; r < 16; ++r) { res[0][r] = resL[r * 64] + o[0][r] * f[r]; res[1][r] = resL[(16 + r) * 64] + o[1][r] * f[r]; }
        asm volatile("s_waitcnt lgkmcnt(0)" ::: "memory");
    }
    store_o_rows(res, (bf16_t*)(p.ws + OFF_OCAT) + ((size_t)b * SEQ + q0 + 32 * (wid & 1)) * 1024 + 512 + head * 64, 1024, lds + L_OST + wid * 4096, lane, r32, hi);
    __syncthreads();
}
DEV void phase5_nsa_fa(const Params& p, LAS unsigned char* lds) {
    constexpr int NU = BATCH * 2 * 64;
    const int G = gridDim.x;
    for (int r = 0; r * G < NU; ++r) {
        const int k = r * G + ((r & 1) ? (G - 1 - (int)blockIdx.x) : (int)blockIdx.x);
        if (k >= NU) continue;
        const int tb = 63 - k / 16, bg = k % 16;
        nsa_unit(p, lds, bg >> 1, bg & 1, tb);
    }
}
DEV void phase5_mla_fa(const Params& p, LAS unsigned char* lds) {
    constexpr int NU = BATCH * 8 * 16;
    const int G = gridDim.x;
    for (int r = 0; r * G < NU; ++r) {
        const int k = r * G + ((r & 1) ? (G - 1 - (int)blockIdx.x) : (int)blockIdx.x);
        if (k >= NU) continue;
        const int qb = 15 - k / 64, bh = k % 64;
        mla_unit(p, lds, bh >> 3, bh & 7, qb);
    }
}

DEV void phase5_cmp(const Params& p, LAS unsigned char* lds) {
    const int tid = opaque_tid(), hl = tid >> 7, tl = tid & 127;
    const bf16_t* NQ = (const bf16_t*)(p.ws + OFF_NQ); const bf16_t* KC = (const bf16_t*)(p.ws + OFF_KC); const bf16_t* VC = (const bf16_t*)(p.ws + OFF_VC);
    float* OCMP = (float*)(p.ws + OFF_OCMP); unsigned long long* SELM = (unsigned long long*)(p.ws + OFF_SELM);
    LAS float* imp = (LAS float*)lds;
    constexpr int NU = BATCH * 2 * (SEQ / 128);
    for (int u = blockIdx.x; u < NU; u += gridDim.x) {
        const int tb = u % (SEQ / 128), g = (u / (SEQ / 128)) & 1, b = u / (SEQ / 128 * 2);
        const int t = tb * 128 + tl, head = g * 4 + hl; const size_t tok = (size_t)b * SEQ + t;
        float q[64];
        { const bf16_t* qr = NQ + tok * 512 + head * 64;
#pragma unroll
          for (int i = 0; i < 32; ++i) { const unsigned w = *(const unsigned*)(qr + 2 * i); q[2 * i] = bflo(w); q[2 * i + 1] = bfhi(w); } }
        for (int j = 0; j < 64; ++j) imp[(hl * 64 + j) * 128 + tl] = 0.f;
        const int cnt = (t >= 31) ? ((t - 31) / 16 + 1) : 0;
        const int tmaxw = tb * 128 + (tl | 63); const int cntw = (tmaxw >= 31) ? ((tmaxw - 31) / 16 + 1) : 0;
        const bf16_t* kb = KC + ((size_t)b * NCMPP * 2 + g) * 64; const bf16_t* vb = VC + ((size_t)b * NCMPP * 2 + g) * 64;
        float m = -INFINITY, l = 0.f;
        for (int n = 0; n < cntw; ++n) { float a = 0.f;
#pragma unroll
            for (int i = 0; i < 32; ++i) { const unsigned w = *(const unsigned*)(kb + (size_t)n * 128 + 2 * i); a += q[2 * i] * bflo(w); a += q[2 * i + 1] * bfhi(w); }
            if (n < cnt) { const float mn = fmaxf(m, a); l = l * fast_exp2(m - mn) + fast_exp2(a - mn); m = mn; } }
        const float rl = (cnt > 0) ? 1.0f / l : 0.f;
        float o[64];
#pragma unroll
        for (int d = 0; d < 64; ++d) o[d] = 0.f;
        for (int n = 0; n < cntw; ++n) { float a = 0.f;
#pragma unroll
            for (int i = 0; i < 32; ++i) { const unsigned w = *(const unsigned*)(kb + (size_t)n * 128 + 2 * i); a += q[2 * i] * bflo(w); a += q[2 * i + 1] * bfhi(w); }
            const float pr = (n < cnt) ? fast_exp2(a - m) * rl : 0.f;
#pragma unroll
            for (int i = 0; i < 32; ++i) { const unsigned w = *(const unsigned*)(vb + (size_t)n * 128 + 2 * i); o[2 * i] += pr * bflo(w); o[2 * i + 1] += pr * bfhi(w); }
            const int jj = n >> 2; imp[(hl * 64 + jj) * 128 + tl] += pr; if ((n & 3) == 3 && jj + 1 < 64) imp[(hl * 64 + jj + 1) * 128 + tl] += pr; }
        { float* orow = OCMP + tok * 512 + head * 64; const float g0 = ((const float*)(p.ws + OFF_GATES))[tok * 24 + head * 3 + 0];
#pragma unroll
          for (int i = 0; i < 16; ++i) *(f32x4*)(orow + 4 * i) = (f32x4){g0 * o[4 * i], g0 * o[4 * i + 1], g0 * o[4 * i + 2], g0 * o[4 * i + 3]}; }
        __syncthreads();
        if (tid < 128) {
            const int cur = t >> 6;
            for (int j = 0; j < 64; ++j) { const float v = ((imp[(0 * 64 + j) * 128 + tl] + imp[(1 * 64 + j) * 128 + tl]) + imp[(2 * 64 + j) * 128 + tl]) + imp[(3 * 64 + j) * 128 + tl];
                const bool forced = (j == 0) || (j <= cur && j > cur - 2);
                imp[j * 128 + tl] = forced ? 1e30f : v; }
            unsigned long long mask = 0ull;
            for (int j = 0; j <= cur; ++j) { const float vj = imp[j * 128 + tl]; int rank = 0;
                for (int k = 0; k <= cur; ++k) { const float vk = imp[k * 128 + tl]; rank += (vk > vj || (vk == vj && k < j)) ? 1 : 0; }
                if (rank < 16) mask |= (1ull << j); }
            SELM[((size_t)b * 2 + g) * SEQ + t] = mask;
        }
        __syncthreads();
    }
}

DEV void phase5_selwin(const Params& p) {
    const int tid = opaque_tid(), wid = __builtin_amdgcn_readfirstlane(tid >> 6), lane = tid & 63;
    const int gw = blockIdx.x * 8 + wid, NGW = gridDim.x * 8;
    const bf16_t* NQ = (const bf16_t*)(p.ws + OFF_NQ); const bf16_t* KSR = (const bf16_t*)(p.ws + OFF_KSR); const bf16_t* KWR = (const bf16_t*)(p.ws + OFF_KWR);
    const bf16_t* PROJ = (const bf16_t*)(p.ws + OFF_PROJ); float* OCMP = (float*)(p.ws + OFF_OCMP); const float* GATES = (const float*)(p.ws + OFF_GATES);
    const unsigned long long* SELM = (const unsigned long long*)(p.ws + OFF_SELM); bf16_t* OCAT = (bf16_t*)(p.ws + OFF_OCAT);
    constexpr int NUNIT = BATCH * 8 * (SEQ / 64);
#pragma unroll 1
    for (int uu = gw; uu < NUNIT; uu += NGW) {
        const int u = (uu & 1) ? (NUNIT - 1 - (uu >> 1)) : (uu >> 1);
        const int tb = u % (SEQ / 64), head = (u / (SEQ / 64)) & 7, b = u / (SEQ / 64 * 8), g = head >> 2;
        const int t = tb * 64 + lane; const size_t tok = (size_t)b * SEQ + t;
        float q[64];
        { const bf16_t* qr = NQ + tok * 512 + head * 64;
#pragma unroll
          for (int i = 0; i < 32; ++i) { const unsigned w = *(const unsigned*)(qr + 2 * i); q[2 * i] = bflo(w); q[2 * i + 1] = bfhi(w); } }
        const unsigned long long mask = SELM[((size_t)b * 2 + g) * SEQ + t];
        unsigned ulo = (unsigned)mask, uhi = (unsigned)(mask >> 32);
#pragma unroll
        for (int o_ = 1; o_ < 64; o_ <<= 1) { ulo |= __shfl_xor(ulo, o_); uhi |= __shfl_xor(uhi, o_); }
        const unsigned long long um = ((unsigned long long)__builtin_amdgcn_readfirstlane(uhi) << 32) | (unsigned)__builtin_amdgcn_readfirstlane(ulo);
        float* oc = OCMP + tok * 512 + head * 64;
        { float o[64];
#pragma unroll
          for (int d = 0; d < 64; ++d) o[d] = 0.f;
          float m = -INFINITY, l = 0.f;
          const bf16_t* kb = KSR + (size_t)b * SEQ * 128 + g * 64; const bf16_t* vb = PROJ + (size_t)b * SEQ * INP + C_VS + g * 64;
#pragma unroll 1
          for (int blk = 0; blk <= tb; ++blk) { if (!((um >> blk) & 1ull)) continue; const bool sel = (mask >> blk) & 1ull;
              naive_attn_range<64, 64>(q, o, m, l, blk * 64, blk * 64 + 64,
                  [&](int j, int i) -> unsigned { return *(const unsigned*)(kb + (size_t)j * 128 + 2 * i); },
                  [&](int j, int i) -> unsigned { return *(const unsigned*)(vb + (size_t)j * INP + 2 * i); },
                  [&](int j) -> bool { return sel && j <= t; }); }
          const float g1 = GATES[tok * 24 + head * 3 + 1] / l;
#pragma unroll
          for (int i = 0; i < 16; ++i) { f32x4 c4 = *(f32x4*)(oc + 4 * i); c4.x += g1 * o[4 * i]; c4.y += g1 * o[4 * i + 1]; c4.z += g1 * o[4 * i + 2]; c4.w += g1 * o[4 * i + 3]; *(f32x4*)(oc + 4 * i) = c4; } }
        { float o[64];
#pragma unroll
          for (int d = 0; d < 64; ++d) o[d] = 0.f;
          float m = -INFINITY, l = 0.f;
          const bf16_t* kb = KWR + (size_t)b * SEQ * 128 + g * 64; const bf16_t* vb = PROJ + (size_t)b * SEQ * INP + C_VW + g * 64;
          const int jlo = (tb * 64 - 511 > 0) ? tb * 64 - 511 : 0;
          naive_attn_range<64, 64>(q, o, m, l, jlo, tb * 64 + 64,
              [&](int j, int i) -> unsigned { return *(const unsigned*)(kb + (size_t)j * 128 + 2 * i); },
              [&](int j, int i) -> unsigned { return *(const unsigned*)(vb + (size_t)j * INP + 2 * i); },
              [&](int j) -> bool { return j <= t && j > t - 512; });
          const float g2 = GATES[tok * 24 + head * 3 + 2] / l; bf16_t* orow = OCAT + tok * 1024 + 512 + head * 64;
#pragma unroll
          for (int i = 0; i < 16; ++i) { const f32x4 c4 = *(const f32x4*)(oc + 4 * i); u32x2 w; w.x = pk2(c4.x + g2 * o[4 * i], c4.y + g2 * o[4 * i + 1]); w.y = pk2(c4.z + g2 * o[4 * i + 2], c4.w + g2 * o[4 * i + 3]);
              *(u32x2*)(orow + 4 * i) = w; } }
    }
}

DEV void phase7(const Params& p, LAS unsigned char* lds) {
    const int tid = opaque_tid(), wid = __builtin_amdgcn_readfirstlane(tid >> 6), lane = tid & 63;
    const float* H1 = (const float*)(p.ws + OFF_H1); unsigned char* XN = p.ws + OFF_XN; float* SXTOK = (float*)(p.ws + OFF_SXTOK);
    int* TOPI = (int*)(p.ws + OFF_TOPI); float* TOPG = (float*)(p.ws + OFF_TOPG); int* POS = (int*)(p.ws + OFF_POS); unsigned* CNT = (unsigned*)(p.ws + OFF_CNT);
    LAS float* xt = (LAS float*)lds;
    LAS float* part = (LAS float*)(lds + 16 * 1028 * 4);
    LAS unsigned* lcnt = (LAS unsigned*)(lds + 16 * 1028 * 4 + 16384);
    const int ej = lane & 15, kq = lane >> 4, k0_ = 128 * wid + 32 * kq;
    float rw0[32], rw1[32];
#pragma unroll
    for (int i = 0; i < 32; ++i) { rw0[i] = p.router_w[(size_t)(k0_ + i) * 32 + ej]; rw1[i] = p.router_w[(size_t)(k0_ + i) * 32 + 16 + ej]; }
    const f32x4* gr = (const f32x4*)p.ffn_norm + lane;
    f32x4 gg[4];
#pragma unroll
    for (int j = 0; j < 4; ++j) gg[j] = gr[64 * j];
    for (int ch = blockIdx.x; ch < NTOK / 128; ch += gridDim.x) {
        if (tid < 32) lcnt[tid] = 0u;
        f32x4 nx[2][4];
#pragma unroll
        for (int rr = 0; rr < 2; ++rr) { const f32x4* xr = (const f32x4*)(H1 + (size_t)(ch * 128 + 2 * wid + rr) * DM) + lane;
#pragma unroll
            for (int j = 0; j < 4; ++j) nx[rr][j] = xr[64 * j]; }
        __syncthreads();
#pragma unroll 1
        for (int sub = 0; sub < 8; ++sub) {
            const int tok0 = ch * 128 + sub * 16;
#pragma unroll
            for (int rr = 0; rr < 2; ++rr) { const int row = 2 * wid + rr, tok = tok0 + row;
                f32x4 v[4]; float s_ = 0.f;
#pragma unroll
                for (int j = 0; j < 4; ++j) { v[j] = nx[rr][j]; s_ += (v[j].x * v[j].x + v[j].y * v[j].y) + (v[j].z * v[j].z + v[j].w * v[j].w); }
                if (sub + 1 < 8) { const f32x4* xr = (const f32x4*)(H1 + (size_t)(tok + 16) * DM) + lane;
#pragma unroll
                    for (int j = 0; j < 4; ++j) nx[rr][j] = xr[64 * j]; }
                const float rstd = rsqrtf(wave_sum(s_) * (1.f / 1024.f) + 1e-5f);
                float amax = 0.f;
#pragma unroll
                for (int j = 0; j < 4; ++j) { v[j].x *= rstd * gg[j].x; v[j].y *= rstd * gg[j].y; v[j].z *= rstd * gg[j].z; v[j].w *= rstd * gg[j].w;
                    amax = fmaxf(fmaxf(amax, fmaxf(fabsf(v[j].x), fabsf(v[j].y))), fmaxf(fabsf(v[j].z), fabsf(v[j].w))); *(LAS f32x4*)(xt + row * 1028 + 256 * j + 4 * lane) = v[j]; }
#pragma unroll
                for (int o_ = 1; o_ < 64; o_ <<= 1) amax = fmaxf(amax, __shfl_xor(amax, o_));
                amax = fmaxf(amax, 1e-30f); const float qinv = 127.0f / amax; if (lane == 0) SXTOK[tok] = amax * (1.0f / 127.0f);
                unsigned* o4 = (unsigned*)(XN + (size_t)tok * DM) + lane;
#pragma unroll
                for (int j = 0; j < 4; ++j) { const unsigned q0 = (unsigned)__float2int_rn(v[j].x * qinv) & 255u, q1 = (unsigned)__float2int_rn(v[j].y * qinv) & 255u, q2 = (unsigned)__float2int_rn(v[j].z * qinv) & 255u, q3 = (unsigned)__float2int_rn(v[j].w * qinv) & 255u;
                    o4[64 * j] = q0 | (q1 << 8) | (q2 << 16) | (q3 << 24); } }
            __syncthreads();
            { f32x4 acc0 = (f32x4){0.f, 0.f, 0.f, 0.f}, acc1 = acc0; const LAS float* xrow = xt + ej * 1028 + k0_;
#pragma unroll
              for (int s4 = 0; s4 < 8; ++s4) { const f32x4 xv = *(const LAS f32x4*)(xrow + 4 * s4);
#pragma unroll
                  for (int i = 0; i < 4; ++i) { acc0 = __builtin_amdgcn_mfma_f32_16x16x4f32(xv[i], rw0[4 * s4 + i], acc0, 0, 0, 0); acc1 = __builtin_amdgcn_mfma_f32_16x16x4f32(xv[i], rw1[4 * s4 + i], acc1, 0, 0, 0); } }
#pragma unroll
              for (int r = 0; r < 4; ++r) { part[(wid * 16 + 4 * kq + r) * 32 + ej] = acc0[r]; part[(wid * 16 + 4 * kq + r) * 32 + 16 + ej] = acc1[r]; } }
            __syncthreads();
            { const int tk = tid >> 5, e = tid & 31, tok = tok0 + tk; float logit = p.router_b[e];
#pragma unroll
              for (int w_ = 0; w_ < 8; ++w_) logit += part[(w_ * 16 + tk) * 32 + e];
              int ti[4]; float tv[4]; float cur = logit;
#pragma unroll
              for (int r = 0; r < 4; ++r) { float bv = cur; int bi = e;
#pragma unroll
                  for (int o_ = 1; o_ < 32; o_ <<= 1) { const float ov = __shfl_xor(bv, o_); const int oi = __shfl_xor(bi, o_); if (ov > bv || (ov == bv && oi < bi)) { bv = ov; bi = oi; } }
                  ti[r] = bi; tv[r] = bv; if (e == bi) cur = -INFINITY; }
              const float e1 = __expf(tv[1] - tv[0]), e2 = __expf(tv[2] - tv[0]), e3 = __expf(tv[3] - tv[0]); const float inv = 1.0f / (1.0f + e1 + e2 + e3);
              if (e == 0) {
                  *(f32x4*)(TOPG + (size_t)tok * 4) = (f32x4){inv, e1 * inv, e2 * inv, e3 * inv};
                  int ps[4];
#pragma unroll
                  for (int r = 0; r < 4; ++r) ps[r] = (int)__hip_atomic_fetch_add(&lcnt[ti[r]], 1u, __ATOMIC_RELAXED, __HIP_MEMORY_SCOPE_WORKGROUP);
                  int* ti_o = TOPI + (size_t)tok * 4; int* ps_o = POS + (size_t)tok * 4;
#pragma unroll
                  for (int r = 0; r < 4; ++r) { ti_o[r] = ti[r]; ps_o[r] = ps[r]; }
              } }
            __syncthreads();
        }
        if (tid < 32) lcnt[32 + tid] = atomicAdd(&CNT[tid], lcnt[tid]);
        __syncthreads();
        if (tid < 128) { const int tok = ch * 128 + tid; const int* ti_o = TOPI + (size_t)tok * 4; int* ps_o = POS + (size_t)tok * 4;
#pragma unroll
            for (int r = 0; r < 4; ++r) ps_o[r] += (int)lcnt[32 + ti_o[r]]; }
        __syncthreads();
    }
}

DEV void moe_offsets(const Params& p, LAS unsigned* tab) {
    const unsigned* CNT = (const unsigned*)(p.ws + OFF_CNT);
    const int tid = opaque_tid();
    if (tid < 64) {
        const int e = tid & 31; const unsigned c = __hip_atomic_load(&CNT[e], __ATOMIC_RELAXED, __HIP_MEMORY_SCOPE_AGENT);
        const unsigned pad = ((c + 255u) >> 8) << 8; unsigned inc = pad;
#pragma unroll
        for (int o_ = 1; o_ < 32; o_ <<= 1) { const unsigned v = __shfl_up(inc, o_, 32); if (e >= o_) inc += v; }
        if (tid < 32) { tab[e] = inc - pad; tab[32 + e] = inc >> 8; if (e == 31) tab[64] = inc; }
    }
    __syncthreads();
}
typedef int i32x4_ __attribute__((ext_vector_type(4)));
DEV void phase8(const Params& p, LAS unsigned char* lds) {
    const int tid = opaque_tid();
    LAS unsigned* tab = (LAS unsigned*)lds; moe_offsets(p, tab);
    const int* TOPI = (const int*)(p.ws + OFF_TOPI); const float* TOPG = (const float*)(p.ws + OFF_TOPG); int* POS = (int*)(p.ws + OFF_POS); float* RG = (float*)(p.ws + OFF_ROWGATE);
    const float* SXTOK = (const float*)(p.ws + OFF_SXTOK); float* SXROW = (float*)(p.ws + OFF_SXROW); int* ROWTOK = (int*)(p.ws + OFF_ROWTOK); const unsigned* CNT = (const unsigned*)(p.ws + OFF_CNT);
    for (int id = blockIdx.x * 512 + tid; id < NTOK * 4; id += gridDim.x * 512) { const int tok = id >> 2;
        const int e = TOPI[id]; const int slot = (int)tab[e] + POS[id];
        ROWTOK[slot] = tok; RG[slot] = TOPG[id]; SXROW[slot] = SXTOK[tok]; POS[id] = slot; }
    if (blockIdx.x < NEXP) { const int e = blockIdx.x; const int beg = (int)tab[e] + (int)__hip_atomic_load(&CNT[e], __ATOMIC_RELAXED, __HIP_MEMORY_SCOPE_AGENT), end = (int)tab[32 + e] * 256;
        for (int s_ = beg + tid; s_ < end; s_ += 512) ROWTOK[s_] = 0; }
}

DEV void phase11(const Params& p) {
    const int tid = opaque_tid(), wid = tid >> 6, lane = tid & 63;
    const int gw = blockIdx.x * 8 + wid, NGW = gridDim.x * 8;
    const float* H1 = (const float*)(p.ws + OFF_H1); const bf16_t* Y = (const bf16_t*)(p.ws + OFF_Y); const int* POS = (const int*)(p.ws + OFF_POS);
    const f32x4* gr = (const f32x4*)p.final_norm + lane; f32x4 gg[4];
#pragma unroll
    for (int j = 0; j < 4; ++j) gg[j] = gr[64 * j];
    i32x4_ slot[2];
#pragma unroll
    for (int q = 0; q < 2; ++q) { const int t0 = 2 * gw + q; slot[q] = *(const i32x4_*)(POS + (size_t)(t0 < NTOK ? t0 : 0) * 4); }
#pragma unroll 1
    for (int tok2 = gw * 2; tok2 < NTOK; tok2 += NGW * 2) {
        f32x4 v[2][4]; u32x2 y[2][4][4];
#pragma unroll
        for (int q = 0; q < 2; ++q) { const f32x4* xr = (const f32x4*)(H1 + (size_t)(tok2 + q) * DM) + lane;
#pragma unroll
            for (int j = 0; j < 4; ++j) v[q][j] = xr[64 * j];
#pragma unroll
            for (int r = 0; r < 4; ++r) { const u32x2* yr = (const u32x2*)(Y + (size_t)slot[q][r] * DM) + lane;
#pragma unroll
                for (int j = 0; j < 4; ++j) y[q][r][j] = yr[64 * j]; } }
        i32x4_ nslot[2];
#pragma unroll
        for (int q = 0; q < 2; ++q) { const int t1 = tok2 + NGW * 2 + q; nslot[q] = *(const i32x4_*)(POS + (size_t)(t1 < NTOK ? t1 : 0) * 4); }
#pragma unroll
        for (int q = 0; q < 2; ++q) {
#pragma unroll
            for (int r = 0; r < 4; ++r)
#pragma unroll
                for (int j = 0; j < 4; ++j) { const u32x2 w = y[q][r][j]; v[q][j].x += bflo(w.x); v[q][j].y += bfhi(w.x); v[q][j].z += bflo(w.y); v[q][j].w += bfhi(w.y); }
            float s = 0.f;
#pragma unroll
            for (int j = 0; j < 4; ++j) s += (v[q][j].x * v[q][j].x + v[q][j].y * v[q][j].y) + (v[q][j].z * v[q][j].z + v[q][j].w * v[q][j].w);
            const float rstd = rsqrtf(wave_sum(s) * (1.f / 1024.f) + 1e-5f);
            f32x4* orow = (f32x4*)(p.out + (size_t)(tok2 + q) * DM) + lane;
#pragma unroll
            for (int j = 0; j < 4; ++j) orow[64 * j] = (f32x4){v[q][j].x * rstd * gg[j].x, v[q][j].y * rstd * gg[j].y, v[q][j].z * rstd * gg[j].z, v[q][j].w * rstd * gg[j].w}; }
        slot[0] = nslot[0]; slot[1] = nslot[1];
    }
}

constexpr int NPHASE = 14;
constexpr int LDS_BYTES = 163840;
template <int PH> DEV void run_phase(const Params& p, LAS unsigned char* lds) {
    using namespace pg8;
    const int G = gridDim.x, bid = blockIdx.x;
    if constexpr (PH == 0) phase0(p, lds);
    if constexpr (PH == 1) { Gemm g{1024, 0}; DenseOrder S; S.init(p.ws + OFF_U, p.ws + OFF_WINT, 1024, NTOK, INP, G, bid);
        EpiProj E{p.pos, p.q_norm, p.kv_norm, (bf16_t*)(p.ws + OFF_QN), (bf16_t*)(p.ws + OFF_KVN), (bf16_t*)(p.ws + OFF_KM), (bf16_t*)(p.ws + OFF_NQ), (bf16_t*)(p.ws + OFF_KSR), (bf16_t*)(p.ws + OFF_KWR),
                  (bf16_t*)(p.ws + OFF_KCC), (bf16_t*)(p.ws + OFF_VCC), (bf16_t*)(p.ws + OFF_VSC), (bf16_t*)(p.ws + OFF_VWC), (float*)(p.ws + OFF_GATES), (float*)(p.ws + OFF_ROPEM), (LAS float*)(lds + STAGE_BYTES + 1024)};
        gemm_phase(lds, g, S, E);
        const int rem = S.nwg % G;
        if (rem > 0 && rem < G) { if (bid >= rem) prep_w2_items(p, lds, (bid - rem) * 8, (G - rem) * 8); } else prep_w2_items(p, lds, bid * 8, G * 8);
    }
    if constexpr (PH == 2) phase2(p);
    if constexpr (PH == 3) {
        const int NC = (G >= 64) ? 32 : 0;
        if (bid < NC) { Gemm g{2048, 1}; CmpOrder S{(const char*)(p.ws + OFF_KCC), (const char*)(p.ws + OFF_VCC), (const char*)(p.ws + OFF_CW1T), bid};
            EpiCmp E{(const float*)(p.ws + OFF_CB), p.cmp_w2, p.pos, (bf16_t*)(p.ws + OFF_KC), (bf16_t*)(p.ws + OFF_VC)}; gemm_phase(lds, g, S, E); }
        else {
            { Gemm g{256, 0}; UpOrder S; S.q.init(p.ws + OFF_QN, p.ws + OFF_WQUPT, 256, NTOK, 768, 1, 0); S.kv.init(p.ws + OFF_KVN, p.ws + OFF_WKVUPT, 256, NTOK, 1024, 1, 0); S.G = G - NC; S.c = bid - NC;
              EpiUp E{EpiQup{(bf16_t*)(p.ws + OFF_QM), (const float*)(p.ws + OFF_ROPEM)}, EpiKvup{(bf16_t*)(p.ws + OFF_KM), (bf16_t*)(p.ws + OFF_VM)}}; gemm_phase(lds, g, S, E); }
        }
        if (NC == 0) for (int k = bid; k < 32; k += G) { Gemm g{2048, 1}; CmpOrder S{(const char*)(p.ws + OFF_KCC), (const char*)(p.ws + OFF_VCC), (const char*)(p.ws + OFF_CW1T), k};
            EpiCmp E{(const float*)(p.ws + OFF_CB), p.cmp_w2, p.pos, (bf16_t*)(p.ws + OFF_KC), (bf16_t*)(p.ws + OFF_VC)}; gemm_phase(lds, g, S, E); }
        prep_w1_items(p, lds);
    }
    if constexpr (PH == 5) phase5_mla_fa(p, lds);
    if constexpr (PH == 6) phase5_nsa_fa(p, lds);
    if constexpr (PH == 8) { Gemm g{1024, 0}; DenseOrder S; S.init(p.ws + OFF_OCAT, p.ws + OFF_WOUTT, 1024, NTOK, 1024, G, bid);
        EpiResF32 E{p.x, (float*)(p.ws + OFF_H1), 1024}; gemm_phase(lds, g, S, E); }
    if constexpr (PH == 9) phase7(p, lds);
    if constexpr (PH == 10) phase8(p, lds);
    if constexpr (PH == 11) { LAS unsigned* tab = (LAS unsigned*)(lds + STAGE_BYTES); moe_offsets(p, tab);
        MoeOrder S; S.d.init(p.ws + OFF_XN, p.ws + OFF_W1T, 512, (int)tab[64], 2048, G, bid); S.tend = tab + 32; S.nNt = 8; S.gatherA = true;
        LAS int* rt = (LAS int*)(lds + STAGE_BYTES + 2048);
        { const int* ROWTOK = (const int*)(p.ws + OFF_ROWTOK); const int tid_ = opaque_tid(); Unit u_;
          for (int i = 0; S.next(i, u_); ++i) if (tid_ < 256) rt[i * 256 + tid_] = ROWTOK[u_.pm * 256 + tid_];
          __syncthreads(); }
        Gemm g{512, 2, rt};
        EpiMoe1 E{(bf16_t*)(p.ws + OFF_HMID), p.moe_b1, (const float*)(p.ws + OFF_SW1), (const float*)(p.ws + OFF_SXROW)}; gemm_phase<EpiMoe1, MoeOrder, true>(lds, g, S, E); }
    if constexpr (PH == 12) { LAS unsigned* tab = (LAS unsigned*)(lds + STAGE_BYTES); moe_offsets(p, tab);
        Gemm g{1024, 0}; MoeOrder S; S.d.init(p.ws + OFF_HMID, p.ws + OFF_W2T, 1024, (int)tab[64], 1024, G, bid); S.tend = tab + 32; S.nNt = 4;
        EpiMoe2 E{(bf16_t*)(p.ws + OFF_Y), p.moe_b2, (const float*)(p.ws + OFF_ROWGATE)}; gemm_phase(lds, g, S, E); }
    if constexpr (PH == 13) phase11(p);
}

template <int PH> __global__ void __launch_bounds__(512) phase_kernel(Params p) {
    extern __shared__ __attribute__((aligned(16))) unsigned char smem[];
    run_phase<PH>(p, (LAS unsigned char*)smem);
}

#if MK_ONE_LAUNCH
__global__ void __launch_bounds__(512) mega_kernel(Params p) {
    extern __shared__ __attribute__((aligned(16))) unsigned char smem[];
    LAS unsigned char* lds = (LAS unsigned char*)smem;
    cg::grid_group grid = cg::this_grid();
    volatile LAS unsigned* st = (volatile LAS unsigned*)(lds + LDS_BYTES - 16);
    if (threadIdx.x == 0) { st[0] = 0u; st[1] = 0u; }
    __syncthreads();
    const XcdBarrier xb = xcd_barrier_post((unsigned*)(p.ws + OFF_BAR), st);
#define GSYNC() xcd_barrier(xb)
    if (p.ws == nullptr) grid.sync();
    run_phase<0>(p, lds); GSYNC();
    run_phase<1>(p, lds); GSYNC();
    run_phase<3>(p, lds); GSYNC();
    run_phase<5>(p, lds); run_phase<6>(p, lds); GSYNC();
    run_phase<8>(p, lds); GSYNC();
    run_phase<9>(p, lds); GSYNC();
    run_phase<10>(p, lds); GSYNC();
    run_phase<11>(p, lds); GSYNC();
    run_phase<12>(p, lds); GSYNC();
    run_phase<13>(p, lds);
}
#endif

template <int PH> static void launch_phase(const Params& p, int grid, hipStream_t stream) {
    static bool attr = false;
    if (!attr) { (void)hipFuncSetAttribute((const void*)phase_kernel<PH>, hipFuncAttributeMaxDynamicSharedMemorySize, LDS_BYTES); attr = true; }
    hipLaunchKernelGGL(phase_kernel<PH>, dim3(grid), dim3(512), LDS_BYTES, stream, p);
}

extern "C" void kernel_launch(void* const* d_in, const int* in_sizes, int n_in, void* d_out, int out_size, void* d_ws, size_t ws_size, hipStream_t stream) {
    static int grid = 0;
    if (grid == 0) {
        if (n_in != 20 || out_size != NTOK * DM || ws_size < WS_END) { fprintf(stderr, "kernel_launch: unexpected shapes (n_in %d, out %d, ws %zu < %zu)\n", n_in, out_size, ws_size, (size_t)WS_END); grid = -1; return; }
        int dev = 0, cus = 0, per_cu = 0;
        (void)hipGetDevice(&dev); (void)hipDeviceGetAttribute(&cus, hipDeviceAttributeMultiprocessorCount, dev);
#if MK_ONE_LAUNCH
        (void)hipFuncSetAttribute((const void*)mega_kernel, hipFuncAttributeMaxDynamicSharedMemorySize, LDS_BYTES);
        (void)hipOccupancyMaxActiveBlocksPerMultiprocessor(&per_cu, (const void*)mega_kernel, 512, LDS_BYTES);
        if (per_cu < 1) { fprintf(stderr, "kernel_launch: occupancy query says %d blocks per CU\n", per_cu); per_cu = 1; }
#endif
        (void)hipGetLastError();
        grid = cus * 1;
        if (grid <= 0) grid = 256;
    }
    if (grid < 0) return;
    Params p; memset(&p, 0, sizeof(p));
    p.x = (const float*)d_in[0]; p.pos = (const int*)d_in[1]; p.attn_norm = (const float*)d_in[2]; p.w_in = (const float*)d_in[3]; p.q_norm = (const float*)d_in[4];
    p.w_q_up = (const float*)d_in[5]; p.kv_norm = (const float*)d_in[6]; p.w_kv_up = (const float*)d_in[7]; p.cmp_pos = (const float*)d_in[8]; p.cmp_w1 = (const float*)d_in[9];
    p.cmp_w2 = (const float*)d_in[10]; p.w_out = (const float*)d_in[11]; p.ffn_norm = (const float*)d_in[12]; p.router_w = (const float*)d_in[13]; p.router_b = (const float*)d_in[14];
    p.moe_w1 = (const float*)d_in[15]; p.moe_b1 = (const float*)d_in[16]; p.moe_w2 = (const float*)d_in[17]; p.moe_b2 = (const float*)d_in[18]; p.final_norm = (const float*)d_in[19];
    p.out = (float*)d_out; p.ws = (unsigned char*)d_ws;
#if MK_ONE_LAUNCH
    (void)hipMemsetAsync((unsigned char*)d_ws + OFF_BAR, 0, XCD_BAR_WORDS * 4, stream);
    void* args[] = {&p};
    hipError_t e = hipLaunchCooperativeKernel((const void*)mega_kernel, dim3(grid), dim3(512), args, LDS_BYTES, stream);
    if (e != hipSuccess) fprintf(stderr, "cooperative launch failed: %s (grid %d)\n", hipGetErrorString(e), grid);
#else
    launch_phase<0>(p, grid, stream); launch_phase<1>(p, grid, stream); launch_phase<2>(p, grid, stream); launch_phase<3>(p, grid, stream); launch_phase<4>(p, grid, stream);
    launch_phase<5>(p, grid, stream); launch_phase<6>(p, grid, stream); launch_phase<7>(p, grid, stream); launch_phase<8>(p, grid, stream); launch_phase<9>(p, grid, stream);
    launch_phase<10>(p, grid, stream); launch_phase<11>(p, grid, stream); launch_phase<12>(p, grid, stream); launch_phase<13>(p, grid, stream);
#endif
}
```

```cpp
#include <hip/hip_runtime.h>
#include <hip/hip_cooperative_groups.h>
#include <cstdint>
#include <cstdio>
#include <cstring>
namespace cg = cooperative_groups;

#ifndef MK_ONE_LAUNCH
#define MK_ONE_LAUNCH 1
#endif

#define LAS __attribute__((address_space(3)))
#define DEV __device__ __forceinline__
typedef unsigned short bf16_t;
typedef short bf16x8 __attribute__((ext_vector_type(8)));
typedef float f32x4 __attribute__((ext_vector_type(4)));
typedef float f32x2 __attribute__((ext_vector_type(2)));
typedef unsigned u32x4 __attribute__((ext_vector_type(4)));
typedef unsigned u32x2 __attribute__((ext_vector_type(2)));

constexpr int BATCH = 8, SEQ = 4096, NTOK = BATCH * SEQ, DM = 1024;
constexpr int INC = 1720, INP = 1792;
constexpr int C_QLAT = 0, C_KVLAT = 256, C_KPE = 384, C_QNSA = 416, C_KC = 928, C_VC = 1056, C_KS = 1184, C_VS = 1312, C_KW = 1440, C_VW = 1568, C_G = 1696;
constexpr int NEXP = 32, TOPK = 4, DFF = 1024;
constexpr int NCMP = 255, NCMPP = 256;
constexpr int MAXROWS = 139264;
constexpr float LOG2E = 1.4426950408889634f;
constexpr float MLA_QSCALE = 0.10206207261596577f * LOG2E;
constexpr float NSA_QSCALE = 0.125f * LOG2E;

constexpr size_t MiB = 1ull << 20;
constexpr size_t OFF_W1T = 0;
constexpr size_t OFF_W2T = 128 * MiB;
constexpr size_t OFF_WINT = 192 * MiB;
constexpr size_t OFF_WQUPT = 196 * MiB;
constexpr size_t OFF_WKVUPT = 197 * MiB;
constexpr size_t OFF_WOUTT = 198 * MiB;
constexpr size_t OFF_CW1T = 200 * MiB;
constexpr size_t OFF_MISC = 202 * MiB;
constexpr size_t OFF_CB = OFF_MISC + 8192;
constexpr size_t OFF_CNT = OFF_MISC + 4096;
constexpr size_t OFF_BAR = OFF_MISC + 16384;
constexpr size_t OFF_TOPI = OFF_MISC + 64 * 1024;
constexpr size_t OFF_TOPG = OFF_TOPI + (size_t)NTOK * 16;
constexpr size_t OFF_POS = OFF_TOPG + (size_t)NTOK * 16;
constexpr size_t OFF_ROWGATE = OFF_POS + (size_t)NTOK * 16;
constexpr size_t OFF_SXROW = OFF_ROWGATE + (size_t)MAXROWS * 4;
constexpr size_t OFF_SXTOK = OFF_SXROW + (size_t)MAXROWS * 4;
constexpr size_t OFF_ROWTOK = OFF_SXTOK + (size_t)NTOK * 4;
constexpr size_t OFF_SW1 = OFF_ROWTOK + (size_t)MAXROWS * 4;
constexpr size_t OFF_H1 = 206 * MiB;
constexpr size_t OFF_R1 = 334 * MiB;
constexpr size_t OFF_R2 = 606 * MiB;
constexpr size_t WS_END = 878 * MiB;
constexpr size_t OFF_U = OFF_R1;
constexpr size_t OFF_QM = OFF_R1;
constexpr size_t OFF_OCAT = OFF_R1 + 64 * MiB;
constexpr size_t OFF_OCMP = OFF_R1 + 160 * MiB;
constexpr size_t OFF_KCC = OFF_R1 + 128 * MiB;
constexpr size_t OFF_VCC = OFF_R1 + 136 * MiB;
constexpr size_t OFF_VSC = OFF_R1 + 144 * MiB;
constexpr size_t OFF_VWC = OFF_R1 + 152 * MiB;
constexpr size_t OFF_SELM = OFF_R1 + 240 * MiB;
constexpr size_t OFF_KC = OFF_R1 + 241 * MiB;
constexpr size_t OFF_VC = OFF_R1 + 242 * MiB;
constexpr size_t OFF_GATES = OFF_R1 + 243 * MiB;
constexpr size_t OFF_ROPEM = OFF_R1 + 246 * MiB;
constexpr size_t OFF_KSR = OFF_R1 + 250 * MiB;
constexpr size_t OFF_KWR = OFF_R1 + 258 * MiB;
constexpr size_t OFF_PROJ = OFF_R2;
constexpr size_t OFF_NQ = OFF_R2 + 112 * MiB;
constexpr size_t OFF_QN = OFF_R2 + 144 * MiB;
constexpr size_t OFF_KVN = OFF_R2 + 160 * MiB;
constexpr size_t OFF_KM = OFF_R2 + 176 * MiB;
constexpr size_t OFF_VM = OFF_R2 + 224 * MiB;
constexpr size_t OFF_QUP = OFF_R2 + 256 * MiB;
constexpr size_t OFF_KVUP = OFF_R2 + 256 * MiB;
constexpr size_t OFF_KPE = OFF_R2 + 256 * MiB;
constexpr size_t OFF_XN = OFF_R1 + 0;
constexpr size_t OFF_XG = OFF_R1;
constexpr size_t OFF_Y = OFF_R1;
constexpr size_t OFF_HMID = OFF_R2;

struct Params {
    const float* x; const int* pos; const float* attn_norm; const float* w_in; const float* q_norm; const float* w_q_up; const float* kv_norm; const float* w_kv_up;
    const float* cmp_pos; const float* cmp_w1; const float* cmp_w2; const float* w_out; const float* ffn_norm; const float* router_w; const float* router_b;
    const float* moe_w1; const float* moe_b1; const float* moe_w2; const float* moe_b2; const float* final_norm;
    float* out; unsigned char* ws;
};

DEV float bf2f(bf16_t b) { return __uint_as_float((unsigned)b << 16); }
DEV float bflo(unsigned u) { return __uint_as_float(u << 16); }
DEV float bfhi(unsigned u) { return __uint_as_float(u & 0xffff0000u); }
DEV unsigned pk2(float lo, float hi) { unsigned r; asm volatile("v_cvt_pk_bf16_f32 %0, %1, %2" : "=v"(r) : "v"(lo), "v"(hi)); return r; }
DEV bf16_t f2bf(float f) { return (bf16_t)(pk2(f, 0.f) & 0xffffu); }
DEV float wave_sum(float v) {
#pragma unroll
    for (int o = 1; o < 64; o <<= 1) v += __shfl_xor(v, o);
    return v;
}
DEV float fast_exp2(float x) { return __builtin_amdgcn_exp2f(x); }
DEV int opaque_tid() { int t = threadIdx.x; asm volatile("" : "+v"(t)); return t; }

#define XB_TMO      128
#define XB_XCNT(j)  (256  + 64 * (j))
#define XB_XSUB(j)  (1280 + 64 * (j))
#define XB_XGEN(j)  (2304 + 64 * (j))
#define XB_TOP      3328
#define XB_TOPGEN   3392
#define XCD_BAR_WORDS 3456
#define XB_SPIN_CAP (1u << 22)
DEV unsigned xb_ld(unsigned* p) { return __hip_atomic_load(p, __ATOMIC_RELAXED, __HIP_MEMORY_SCOPE_AGENT); }
DEV unsigned xb_add(unsigned* p, unsigned v) { return __hip_atomic_fetch_add(p, v, __ATOMIC_RELAXED, __HIP_MEMORY_SCOPE_AGENT); }
DEV unsigned xb_xcc_id() { return (unsigned)__builtin_amdgcn_s_getreg((3 << 11) | 20) & 0xFu; }
#define XB_SPIN(cond, bar) do { unsigned _sp = 0; while (cond) { __builtin_amdgcn_s_sleep(1); \
    if ((++_sp & 255u) == 0u) { if (xb_ld(&(bar)[XB_TMO])) break; if (_sp > XB_SPIN_CAP) { atomicAdd(&(bar)[XB_TMO], 1u); break; } } } } while (0)
struct XcdBarrier { unsigned* bar; unsigned x; volatile LAS unsigned* st; };
DEV XcdBarrier xcd_barrier_post(unsigned* bar, volatile LAS unsigned* st) {
    XcdBarrier b; b.bar = bar; b.x = xb_xcc_id(); b.st = st;
    if (threadIdx.x == 0) (void)xb_add(&bar[XB_XCNT(b.x)], 1u);
    return b;
}
DEV void xcd_barrier_complete(unsigned* bar, unsigned x, unsigned& nloc, unsigned& nx) {
    const unsigned G = gridDim.x * gridDim.y * gridDim.z;
    unsigned sum, cnt, mine, sp = 0u;
    for (;;) {
        sum = 0u; cnt = 0u; mine = 0u;
#pragma unroll
        for (unsigned j = 0; j < 16; ++j) { const unsigned c = xb_ld(&bar[XB_XCNT(j)]); sum += c; cnt += (c > 0u) ? 1u : 0u; mine = (j == x) ? c : mine; }
        if (sum == G) break;
        __builtin_amdgcn_s_sleep(1);
        if ((++sp & 255u) == 0u) { if (xb_ld(&bar[XB_TMO])) break; if (sp > XB_SPIN_CAP) { atomicAdd(&bar[XB_TMO], 1u); break; } }
    }
    nloc = mine > 0u ? mine : 1u; nx = cnt > 0u ? cnt : 1u;
}
DEV void xcd_barrier(const XcdBarrier& b) {
    asm volatile("s_waitcnt vmcnt(0)" ::: "memory");
    __syncthreads();
    if (threadIdx.x == 0) {
        unsigned* bar = b.bar;
        __builtin_amdgcn_s_waitcnt(0);
        unsigned nloc = b.st[0], nx = b.st[1];
        if (nloc == 0u) { xcd_barrier_complete(bar, b.x, nloc, nx); b.st[0] = nloc; b.st[1] = nx; }
        const unsigned old = xb_add(&bar[XB_XSUB(b.x)], 1u);
        const unsigned gen = old / nloc;
        if (old + 1u == (gen + 1u) * nloc) {
            __builtin_amdgcn_fence(__ATOMIC_RELEASE, "agent");
            asm volatile("s_waitcnt vmcnt(0)" ::: "memory");
            const unsigned og = xb_add(&bar[XB_TOP], 1u);
            const unsigned tg = og / nx;
            if (og + 1u == (tg + 1u) * nx) xb_add(&bar[XB_TOPGEN], 1u);
            else XB_SPIN(xb_ld(&bar[XB_TOPGEN]) == tg, bar);
            __builtin_amdgcn_fence(__ATOMIC_ACQUIRE, "agent");
            xb_add(&bar[XB_XGEN(b.x)], 1u);
            asm volatile("s_waitcnt vmcnt(0)" ::: "memory");
        } else {
            XB_SPIN(xb_ld(&bar[XB_XGEN(b.x)]) == gen, bar);
            __builtin_amdgcn_fence(__ATOMIC_ACQUIRE, "agent");
            asm volatile("s_waitcnt vmcnt(0)" ::: "memory");
        }
    }
    __syncthreads();
}

namespace pg8 {
constexpr int BM = 256, BK = 64, HALF = 128, HTB = HALF * BK * 2, STAGE_BYTES = 8 * HTB, NXCD = 8, WGM = 8;
DEV int lds_byte(int r, int c) { const int st = (r >> 4) * 2 + (c >> 5), rr = r & 15, cc = c & 31, ob = rr * 64 + cc * 2; return st * 1024 + (ob ^ (((ob >> 9) & 1) << 5)); }
DEV void stage_rc(int b, int& R, int& C) { const int st = b / 1024, sb = b % 1024, swz = sb ^ (((sb >> 9) & 1) << 5); R = (st >> 1) * 16 + swz / 64; C = (st & 1) * 32 + (swz % 64) / 2; }

struct Unit { int pm, pn, e; const char* a; const char* b; };
struct Gemm { int K; int amode; const LAS int* rt = nullptr; };

struct DenseOrder {
    int nM, nN, nwg, G, c; const char* A; const char* Bt; size_t tstep;
    DEV void init(const void* A_, const void* Bt_, int K, int M, int N, int G_, int c_) { A = (const char*)A_; Bt = (const char*)Bt_; tstep = (size_t)BM * K * 2; nM = M / BM; nN = N / BM; nwg = nM * nN; G = G_; c = c_; }
    DEV bool next(int i, Unit& u) const {
        const long L = (long)i * G + c; if (L >= nwg) return false;
        int wgid = (int)L; { const int q = nwg / NXCD, r = nwg % NXCD, xcd = wgid % NXCD, off = wgid / NXCD; wgid = (xcd < r ? xcd * (q + 1) : r * (q + 1) + (xcd - r) * q) + off; }
        const int nig = WGM * nN, gid = wgid / nig, fm = gid * WGM, gsz = (nM - fm) < WGM ? (nM - fm) : WGM;
        u.pm = fm + ((wgid % nig) % gsz); u.pn = (wgid % nig) / gsz; u.e = 0; u.a = A + (size_t)u.pm * tstep; u.b = Bt + (size_t)u.pn * tstep; return true;
    }
};
struct MoeOrder {
    DenseOrder d; const LAS unsigned* tend;
    int nNt;
    bool gatherA = false;
    DEV bool next(int i, Unit& u) const {
        if (!d.next(i, u)) return false;
        const int e = __builtin_popcountll(__ballot(u.pm >= (int)tend[threadIdx.x & 31]) & 0xffffffffull);
        u.e = e; u.b = d.Bt + (size_t)(e * nNt + u.pn) * d.tstep; if (gatherA) u.a = d.A; return true;
    }
};

struct CmpOrder {
    const char* KCC; const char* VCC; const char* W; int k;
    DEV bool next(int i, Unit& u) const {
        if (i != 0 || k < 0) return false;
        const int c = k >> 4, pm = k & 15, b = pm >> 1, n0 = (pm & 1) * 128;
        u.pm = pm; u.pn = 0; u.e = c; u.a = (c == 0 ? KCC : VCC) + (size_t)(b * SEQ + 16 * n0) * 128 * 2; u.b = W + (size_t)c * 256 * 2048 * 2; return true;
    }
};

typedef int i32x4 __attribute__((ext_vector_type(4)));
template <class Epi, class Sched, bool I8 = false>
DEV void gemm_phase(LAS unsigned char* lds, const Gemm g, const Sched& S, const Epi& E) {
    const int tid = opaque_tid(), wid = __builtin_amdgcn_readfirstlane(tid >> 6), lane = tid & 63, wr = wid >> 2, wc = wid & 3, fr = lane & 15, fq = lane >> 4;
    const int K = g.K; int nt = K / BK; asm volatile("" : "+s"(nt));
    unsigned voffA[2], voffB[2];
#pragma unroll
    for (int i = 0; i < 2; ++i) { int R, C; stage_rc(tid * 16 + i * 8192, R, C); voffB[i] = (unsigned)(R * K + C) * 2u;
        voffA[i] = (g.amode == 1) ? (unsigned)((R >> 1) * 16 * 128 + (R & 1) * 64 + C) * 2u : voffB[i]; }
    const size_t kstepB = (size_t)(BK * 2), kstepA = (g.amode == 1) ? (size_t)128 * 2 : kstepB;
    const size_t hstepB = (size_t)HALF * K * 2, hstepA = (g.amode == 0) ? hstepB : (g.amode == 1) ? (size_t)64 * 16 * 128 * 2 : (size_t)0;
    int RA[2], CA[2];
#pragma unroll
    for (int i = 0; i < 2; ++i) stage_rc(tid * 16 + i * 8192, RA[i], CA[i]);
    unsigned gc[2][2], gn[2][2];
    auto gload = [&](int ui_, unsigned (&o_)[2][2]) {
#pragma unroll
        for (int h = 0; h < 2; ++h)
#pragma unroll
            for (int i = 0; i < 2; ++i) o_[h][i] = (unsigned)g.rt[ui_ * 256 + h * HALF + RA[i]] * (unsigned)(K * 2) + (unsigned)(CA[i] * 2); };
    const unsigned ldsw = (unsigned)wid * 1024u;
    const int aoff = lds_byte(wr * 64 + fr, fq * 8), boff = lds_byte(wc * 32 + fr, fq * 8);
#define PG8_SA(b, h) (((b) * 2 + (h)) * HTB)
#define PG8_SB(b, h) ((4 + (b) * 2 + (h)) * HTB)
#define PG8_STAGE(bufoff, gbase, voff) do { _Pragma("unroll") for (int _i = 0; _i < 2; ++_i) \
        __builtin_amdgcn_global_load_lds((const unsigned*)((const char*)(gbase) + (voff)[_i]), (LAS unsigned*)(lds + (bufoff) + ldsw + _i * 8192), 16, 0, 0); } while (0)
#define PG8_VA(h, nx) ((g.amode == 2) ? ((nx) ? gn[h] : gc[h]) : voffA)
#define PG8_LDA(dst, b, h) do { _Pragma("unroll") for (int m = 0; m < 4; ++m) _Pragma("unroll") for (int k = 0; k < 2; ++k) dst[m][k] = *(const LAS bf16x8*)(lds + PG8_SA(b, h) + aoff + m * 2048 + k * 1024); } while (0)
#define PG8_LDB(dst, b, h) do { _Pragma("unroll") for (int n = 0; n < 2; ++n) _Pragma("unroll") for (int k = 0; k < 2; ++k) dst[n][k] = *(const LAS bf16x8*)(lds + PG8_SB(b, h) + boff + n * 2048 + k * 1024); } while (0)
#define PG8_MMA(ai, bj, At, Bt) do { __builtin_amdgcn_s_setprio(1); _Pragma("unroll") for (int m = 0; m < 4; ++m) _Pragma("unroll") for (int n = 0; n < 2; ++n) _Pragma("unroll") for (int k = 0; k < 2; ++k) { \
        if constexpr (I8) acc[ai][bj][m][n] = __builtin_bit_cast(f32x4, __builtin_amdgcn_mfma_i32_16x16x64_i8(__builtin_bit_cast(i32x4, Bt[n][k]), __builtin_bit_cast(i32x4, At[m][k]), __builtin_bit_cast(i32x4, acc[ai][bj][m][n]), 0, 0, 0)); \
        else acc[ai][bj][m][n] = __builtin_amdgcn_mfma_f32_16x16x32_bf16(Bt[n][k], At[m][k], acc[ai][bj][m][n], 0, 0, 0); } __builtin_amdgcn_s_setprio(0); } while (0)
#define PG8_WAIT_V(n) asm volatile("s_waitcnt vmcnt(" #n ")" ::: "memory")
#define PG8_WAIT_L(n) asm volatile("s_waitcnt lgkmcnt(" #n ")" ::: "memory")
#define PG8_BAR __builtin_amdgcn_s_barrier()
#define PG8_SCHED __builtin_amdgcn_sched_barrier(0)
    Unit cur, nxt; int ui = 0;
    if (!S.next(0, cur)) return;
    f32x4 acc[2][2][4][2];
#pragma unroll
    for (int a = 0; a < 2; ++a)
#pragma unroll
        for (int b = 0; b < 2; ++b)
#pragma unroll
            for (int m = 0; m < 4; ++m)
#pragma unroll
                for (int n = 0; n < 2; ++n) acc[a][b][m][n] = (f32x4){0.f, 0.f, 0.f, 0.f};
    bf16x8 At[4][2], B0[2][2], B1[2][2];
    const char* cA = cur.a; const char* cB = cur.b;
    if (g.amode == 2) { gload(0, gc); asm volatile("s_waitcnt lgkmcnt(0)" ::: "memory"); }
    PG8_STAGE(PG8_SB(0, 0), cB, voffB); PG8_STAGE(PG8_SB(0, 1), cB + hstepB, voffB); PG8_STAGE(PG8_SA(0, 0), cA, PG8_VA(0, false)); PG8_STAGE(PG8_SA(0, 1), cA + hstepA, PG8_VA(1, false));
    if (wr == 1) PG8_BAR;
    PG8_WAIT_V(2); PG8_BAR;
    PG8_STAGE(PG8_SB(1, 0), cB + kstepB, voffB); PG8_STAGE(PG8_SA(1, 0), cA + kstepA, PG8_VA(0, false)); PG8_STAGE(PG8_SB(1, 1), cB + hstepB + kstepB, voffB);
    PG8_WAIT_V(6); PG8_BAR;
    for (;;) {
        const bool has_next = S.next(ui + 1, nxt);
        if (g.amode == 2) { if (has_next) gload(ui + 1, gn); else { gn[0][0] = gc[0][0]; gn[0][1] = gc[0][1]; gn[1][0] = gc[1][0]; gn[1][1] = gc[1][1]; } }
        const char* nA = has_next ? nxt.a : cA; const char* nB = has_next ? nxt.b : cB;
#pragma unroll 1
        for (int t = 0; t < nt; t += 2) {
            const bool last = (t == nt - 2);
            const char* a1 = cA + (size_t)(t + 1) * kstepA;
            const char* a2 = last ? nA : cA + (size_t)(t + 2) * kstepA; const char* b2 = last ? nB : cB + (size_t)(t + 2) * kstepB;
            const char* a3 = a2 + kstepA; const char* b3 = b2 + kstepB;
            PG8_LDB(B0, 0, 0); PG8_LDB(B1, 0, 1); PG8_SCHED; PG8_LDA(At, 0, 0); PG8_STAGE(PG8_SA(1, 1), a1 + hstepA, PG8_VA(1, false));
            PG8_WAIT_V(8); PG8_WAIT_L(0); PG8_BAR; PG8_MMA(0, 0, At, B0); PG8_MMA(0, 1, At, B1); PG8_BAR; PG8_SCHED;
            PG8_LDA(At, 0, 1); PG8_STAGE(PG8_SB(0, 0), b2, voffB); PG8_STAGE(PG8_SB(0, 1), b2 + hstepB, voffB); PG8_STAGE(PG8_SA(0, 0), a2, PG8_VA(0, last));
            PG8_WAIT_V(8); PG8_WAIT_L(0); PG8_BAR; PG8_MMA(1, 0, At, B0); PG8_MMA(1, 1, At, B1); PG8_BAR; PG8_SCHED;
            PG8_LDB(B0, 1, 0); PG8_LDB(B1, 1, 1); PG8_SCHED; PG8_LDA(At, 1, 0); PG8_STAGE(PG8_SA(0, 1), a2 + hstepA, PG8_VA(1, last));
            PG8_WAIT_V(8); PG8_WAIT_L(0); PG8_BAR; PG8_MMA(0, 0, At, B0); PG8_MMA(0, 1, At, B1); PG8_BAR; PG8_SCHED;
            PG8_LDA(At, 1, 1); PG8_STAGE(PG8_SB(1, 0), b3, voffB); PG8_STAGE(PG8_SB(1, 1), b3 + hstepB, voffB); PG8_STAGE(PG8_SA(1, 0), a3, PG8_VA(0, last));
            PG8_WAIT_V(8); PG8_WAIT_L(0); PG8_BAR; PG8_MMA(1, 0, At, B0); PG8_MMA(1, 1, At, B1); PG8_BAR; PG8_SCHED;
        }
        if (wr == 0) PG8_BAR;
        if constexpr (!Epi::AFTER_DRAIN) E(acc, cur, wr, wc, fr, fq);
        if (!has_next) break;
#pragma unroll
        for (int a = 0; a < 2; ++a)
#pragma unroll
            for (int b = 0; b < 2; ++b)
#pragma unroll
                for (int m = 0; m < 4; ++m)
#pragma unroll
                    for (int n = 0; n < 2; ++n) acc[a][b][m][n] = (f32x4){0.f, 0.f, 0.f, 0.f};
        cur = nxt; cA = nA; cB = nB; ++ui;
        if (g.amode == 2) { gc[0][0] = gn[0][0]; gc[0][1] = gn[0][1]; gc[1][0] = gn[1][0]; gc[1][1] = gn[1][1]; }
        if (wr == 1) PG8_BAR;
    }
    PG8_WAIT_V(0);
    PG8_BAR;
    if constexpr (Epi::AFTER_DRAIN) E.fused(acc, cur, wr, wc, fr, fq, lds);
#undef PG8_SA
#undef PG8_SB
#undef PG8_STAGE
#undef PG8_VA
#undef PG8_LDA
#undef PG8_LDB
#undef PG8_MMA
#undef PG8_WAIT_V
#undef PG8_WAIT_L
#undef PG8_BAR
#undef PG8_SCHED
}
struct EpiBf16 {
    static constexpr bool AFTER_DRAIN = false;
    bf16_t* O; int ldc;
    DEV void operator()(const f32x4 (&acc)[2][2][4][2], const Unit& u, int wr, int wc, int fr, int fq) const {
#pragma unroll
        for (int ai = 0; ai < 2; ++ai)
#pragma unroll
            for (int m = 0; m < 4; ++m) { bf16_t* rowp = O + (size_t)(u.pm * BM + ai * HALF + wr * 64 + m * 16 + fr) * ldc + u.pn * BM + wc * 32 + 4 * fq;
#pragma unroll
                for (int bj = 0; bj < 2; ++bj)
#pragma unroll
                    for (int n = 0; n < 2; ++n) { const f32x4 v = acc[ai][bj][m][n]; u32x2 w; w.x = pk2(v[0], v[1]); w.y = pk2(v[2], v[3]); *(u32x2*)(rowp + bj * HALF + n * 16) = w; } }
    }
};
struct EpiResF32 {
    static constexpr bool AFTER_DRAIN = false;
    const float* base; float* out; int ldc;
    DEV void operator()(const f32x4 (&acc)[2][2][4][2], const Unit& u, int wr, int wc, int fr, int fq) const {
#pragma unroll
        for (int ai = 0; ai < 2; ++ai) { f32x4 b[4][2][2];
#pragma unroll
            for (int m = 0; m < 4; ++m) { const size_t off = (size_t)(u.pm * BM + ai * HALF + wr * 64 + m * 16 + fr) * ldc + u.pn * BM + wc * 32 + 4 * fq;
#pragma unroll
                for (int bj = 0; bj < 2; ++bj)
#pragma unroll
                    for (int n = 0; n < 2; ++n) b[m][bj][n] = *(const f32x4*)(base + off + bj * HALF + n * 16); }
#pragma unroll
            for (int m = 0; m < 4; ++m) { const size_t off = (size_t)(u.pm * BM + ai * HALF + wr * 64 + m * 16 + fr) * ldc + u.pn * BM + wc * 32 + 4 * fq;
#pragma unroll
                for (int bj = 0; bj < 2; ++bj)
#pragma unroll
                    for (int n = 0; n < 2; ++n) *(f32x4*)(out + off + bj * HALF + n * 16) = b[m][bj][n] + acc[ai][bj][m][n]; } }
    }
};
struct EpiMoe1 {
    static constexpr bool AFTER_DRAIN = false;
    bf16_t* O; const float* b1; const float* sw; const float* sx;
    DEV void operator()(const f32x4 (&acc)[2][2][4][2], const Unit& u, int wr, int wc, int fr, int fq) const {
        const float* bb = b1 + (size_t)u.e * 2048; const float* ss = sw + (size_t)u.e * 2048 + u.pn * BM;
        f32x4 ba[2], bu[2], sa[2], su[2];
#pragma unroll
        for (int n = 0; n < 2; ++n) { const int c = wc * 32 + n * 16 + 4 * fq; ba[n] = *(const f32x4*)(bb + u.pn * HALF + c); bu[n] = *(const f32x4*)(bb + 1024 + u.pn * HALF + c); sa[n] = *(const f32x4*)(ss + c); su[n] = *(const f32x4*)(ss + HALF + c); }
        float srv[2][4];
#pragma unroll
        for (int ai = 0; ai < 2; ++ai)
#pragma unroll
            for (int m = 0; m < 4; ++m) srv[ai][m] = sx[u.pm * BM + ai * HALF + wr * 64 + m * 16 + fr];
#pragma unroll
        for (int ai = 0; ai < 2; ++ai)
#pragma unroll
            for (int m = 0; m < 4; ++m) { const int row = u.pm * BM + ai * HALF + wr * 64 + m * 16 + fr; const float sr = srv[ai][m]; bf16_t* rowp = O + (size_t)row * DFF + u.pn * HALF + wc * 32 + 4 * fq;
#pragma unroll
                for (int n = 0; n < 2; ++n) { const i32x4 ia = __builtin_bit_cast(i32x4, acc[ai][0][m][n]), iu = __builtin_bit_cast(i32x4, acc[ai][1][m][n]); float r[4];
#pragma unroll
                    for (int j = 0; j < 4; ++j) { const float a = fminf((float)ia[j] * (sr * sa[n][j]) + ba[n][j], 7.0f), up = fminf(fmaxf((float)iu[j] * (sr * su[n][j]) + bu[n][j], -7.0f), 7.0f);
                        const float glu = a * __builtin_amdgcn_rcpf(1.0f + __expf(-1.702f * a)); r[j] = (up + 1.0f) * glu; }
                    u32x2 w; w.x = pk2(r[0], r[1]); w.y = pk2(r[2], r[3]); *(u32x2*)(rowp + n * 16) = w; } }
    }
};
struct EpiMoe2 {
    static constexpr bool AFTER_DRAIN = false;
    bf16_t* O; const float* b2; const float* rowgate;
    DEV void operator()(const f32x4 (&acc)[2][2][4][2], const Unit& u, int wr, int wc, int fr, int fq) const {
        const float* bb = b2 + (size_t)u.e * 1024;
        float gtv[2][4]; f32x4 bvv[2][2];
#pragma unroll
        for (int ai = 0; ai < 2; ++ai)
#pragma unroll
            for (int m = 0; m < 4; ++m) gtv[ai][m] = rowgate[u.pm * BM + ai * HALF + wr * 64 + m * 16 + fr];
#pragma unroll
        for (int bj = 0; bj < 2; ++bj)
#pragma unroll
            for (int n = 0; n < 2; ++n) bvv[bj][n] = *(const f32x4*)(bb + u.pn * BM + bj * HALF + wc * 32 + n * 16 + 4 * fq);
#pragma unroll
        for (int ai = 0; ai < 2; ++ai)
#pragma unroll
            for (int m = 0; m < 4; ++m) { const int row = u.pm * BM + ai * HALF + wr * 64 + m * 16 + fr; const float gt = gtv[ai][m]; bf16_t* rowp = O + (size_t)row * DM + u.pn * BM + wc * 32 + 4 * fq;
#pragma unroll
                for (int bj = 0; bj < 2; ++bj)
#pragma unroll
                    for (int n = 0; n < 2; ++n) { const f32x4 v = (acc[ai][bj][m][n] + bvv[bj][n]) * gt;
                        u32x2 w; w.x = pk2(v[0], v[1]); w.y = pk2(v[2], v[3]); *(u32x2*)(rowp + bj * HALF + n * 16) = w; } }
    }
};
struct EpiQup {
    static constexpr bool AFTER_DRAIN = false;
    bf16_t* O; const float* ropem;
    DEV void operator()(const f32x4 (&acc)[2][2][4][2], const Unit& u, int wr, int wc, int fr, int fq) const {
        const bool rope0 = ((u.pn * 8 + wc) % 3) == 2, rope1 = ((u.pn * 8 + 4 + wc) % 3) == 2;
        f32x4 cs[2][4], sn[2][4];
        if (rope0 || rope1) {
#pragma unroll
            for (int ai = 0; ai < 2; ++ai)
#pragma unroll
                for (int m = 0; m < 4; ++m) { const int row = u.pm * BM + ai * HALF + wr * 64 + m * 16 + fr; cs[ai][m] = *(const f32x4*)(ropem + (size_t)row * 32 + 4 * fq); sn[ai][m] = *(const f32x4*)(ropem + (size_t)row * 32 + 16 + 4 * fq); } }
#pragma unroll
        for (int bj = 0; bj < 2; ++bj) { const int g32 = u.pn * 8 + bj * 4 + wc; const bool rope = bj ? rope1 : rope0;
#pragma unroll
            for (int ai = 0; ai < 2; ++ai)
#pragma unroll
                for (int m = 0; m < 4; ++m) { const int row = u.pm * BM + ai * HALF + wr * 64 + m * 16 + fr; bf16_t* rowp = O + (size_t)row * 768 + g32 * 32 + 4 * fq;
                    f32x4 v0 = acc[ai][bj][m][0], v1 = acc[ai][bj][m][1];
                    if (rope) { const f32x4 c = cs[ai][m], s_ = sn[ai][m]; const f32x4 x1 = v0, x2 = v1; v0 = x1 * c - x2 * s_; v1 = x2 * c + x1 * s_; }
                    v0 = v0 * MLA_QSCALE; v1 = v1 * MLA_QSCALE;
                    u32x2 w; w.x = pk2(v0[0], v0[1]); w.y = pk2(v0[2], v0[3]); *(u32x2*)(rowp) = w; w.x = pk2(v1[0], v1[1]); w.y = pk2(v1[2], v1[3]); *(u32x2*)(rowp + 16) = w; } }
    }
};
struct EpiKvup {
    static constexpr bool AFTER_DRAIN = false;
    bf16_t* KM; bf16_t* VM;
    DEV void operator()(const f32x4 (&acc)[2][2][4][2], const Unit& u, int wr, int wc, int fr, int fq) const {
#pragma unroll
        for (int bj = 0; bj < 2; ++bj) { const int head = u.pn * 2 + bj;
#pragma unroll
            for (int ai = 0; ai < 2; ++ai)
#pragma unroll
                for (int m = 0; m < 4; ++m) { const int row = u.pm * BM + ai * HALF + wr * 64 + m * 16 + fr;
                    bf16_t* rowp = (wc < 2) ? KM + (size_t)row * 768 + head * 96 + wc * 32 + 4 * fq : VM + (size_t)row * 512 + head * 64 + (wc - 2) * 32 + 4 * fq;
#pragma unroll
                    for (int n = 0; n < 2; ++n) { const f32x4 v = acc[ai][bj][m][n]; u32x2 w; w.x = pk2(v[0], v[1]); w.y = pk2(v[2], v[3]); *(u32x2*)(rowp + n * 16) = w; } } }
    }
};
struct EpiCmp {
    static constexpr bool AFTER_DRAIN = true;
    const float* cb; const float* w2; const int* pos; bf16_t* KC; bf16_t* VC;
    DEV void fused(const f32x4 (&acc)[2][2][4][2], const Unit& u, int wr, int wc, int fr, int fq, LAS unsigned char* lds) const {
        const int c = u.e, tid = opaque_tid();
        LAS bf16_t* Hs = (LAS bf16_t*)lds;
        LAS float* W2s = (LAS float*)(lds + 256 * 136 * 2);
        { const f32x4* src = (const f32x4*)(w2 + (size_t)c * 128 * 64) + tid;
#pragma unroll
          for (int i = 0; i < 4; ++i) *((LAS f32x4*)W2s + tid + i * 512) = src[i * 512]; }
        f32x4 bb[2];
#pragma unroll
        for (int n = 0; n < 2; ++n) { bb[n] = *(const f32x4*)(cb + c * 128 + wc * 32 + n * 16 + 4 * fq);
#pragma unroll
            for (int part = 1; part < 8; ++part) bb[n] += *(const f32x4*)(cb + part * 256 + c * 128 + wc * 32 + n * 16 + 4 * fq); }
#pragma unroll
        for (int ai = 0; ai < 2; ++ai)
#pragma unroll
            for (int m = 0; m < 4; ++m) { const int row = ai * HALF + wr * 64 + m * 16 + fr;
#pragma unroll
                for (int n = 0; n < 2; ++n) { const f32x4 v = acc[ai][0][m][n] + bb[n]; float r[4];
#pragma unroll
                    for (int j = 0; j < 4; ++j) r[j] = v[j] / (1.0f + __expf(-v[j]));
                    u32x2 w; w.x = pk2(r[0], r[1]); w.y = pk2(r[2], r[3]); *(LAS u32x2*)(Hs + row * 136 + wc * 32 + n * 16 + 4 * fq) = w; } }
        __syncthreads();
        const int row = tid >> 1, dh = tid & 1; float o[32];
#pragma unroll
        for (int d = 0; d < 32; ++d) o[d] = 0.f;
#pragma unroll 2
        for (int h = 0; h < 128; ++h) { const float hv = bf2f(Hs[row * 136 + h]); const LAS f32x4* wrow = (const LAS f32x4*)(W2s + h * 64 + dh * 32);
#pragma unroll
            for (int q = 0; q < 8; ++q) { const f32x4 w = wrow[q]; o[4 * q] += hv * w.x; o[4 * q + 1] += hv * w.y; o[4 * q + 2] += hv * w.z; o[4 * q + 3] += hv * w.w; } }
        const int r = u.pm * BM + row, b = r >> 9, n = (r >> 1) & 255;
        if (c == 0 && dh == 0 && n < 255) { const float fpos = (float)pos[b * SEQ + 16 * n + 31];
#pragma unroll
            for (int i = 0; i < 8; ++i) { const float invf = powf(500000.0f, -(float)(2 * i) / 16.0f); float cs, sn; sincosf(fpos * invf, &sn, &cs); const float x1 = o[i], x2 = o[8 + i]; o[i] = x1 * cs - x2 * sn; o[8 + i] = x2 * cs + x1 * sn; } }
        bf16_t* dst = (c == 0 ? KC : VC) + (size_t)r * 64 + dh * 32;
#pragma unroll
        for (int q = 0; q < 4; ++q) { u32x4 w;
            if (n < 255) { w.x = pk2(o[8 * q], o[8 * q + 1]); w.y = pk2(o[8 * q + 2], o[8 * q + 3]); w.z = pk2(o[8 * q + 4], o[8 * q + 5]); w.w = pk2(o[8 * q + 6], o[8 * q + 7]); } else w = (u32x4){0u, 0u, 0u, 0u};
            *(u32x4*)(dst + 8 * q) = w; }
        __syncthreads();
    }
};
struct EpiProj {
    static constexpr bool AFTER_DRAIN = false;
    const int* pos; const float* qg; const float* kvg;
    bf16_t *QN, *KVN, *KM, *NQ, *KSR, *KWR, *KCC, *VCC, *VSC, *VWC; float *GATES, *ROPEM; LAS float* part;
    DEV void operator()(const f32x4 (&acc)[2][2][4][2], const Unit& u, int wr, int wc, int fr, int fq) const {
        constexpr float L2T = 18.931568569324174f;
        float rstd[2][4]; float fp[2][4];
#pragma unroll
        for (int ai = 0; ai < 2; ++ai)
#pragma unroll
            for (int m = 0; m < 4; ++m) { fp[ai][m] = (float)pos[u.pm * BM + ai * HALF + wr * 64 + m * 16 + fr]; rstd[ai][m] = 0.f; }
        if (u.pn <= 1) {
#pragma unroll
            for (int ai = 0; ai < 2; ++ai)
#pragma unroll
                for (int m = 0; m < 4; ++m) { float s_ = 0.f;
#pragma unroll
                    for (int bj = 0; bj < 2; ++bj) if (bj == 0 || u.pn == 0)
#pragma unroll
                        for (int n = 0; n < 2; ++n) { const f32x4 v = acc[ai][bj][m][n]; s_ += (v.x * v.x + v.y * v.y) + (v.z * v.z + v.w * v.w); }
                    s_ += __shfl_xor(s_, 16); s_ += __shfl_xor(s_, 32);
                    if (fq == 0) part[(ai * HALF + wr * 64 + m * 16 + fr) * 4 + wc] = s_; }
            asm volatile("s_waitcnt lgkmcnt(0)\n\ts_barrier" ::: "memory");
            const float inv = (u.pn == 0) ? (1.f / 256.f) : (1.f / 128.f);
#pragma unroll
            for (int ai = 0; ai < 2; ++ai)
#pragma unroll
                for (int m = 0; m < 4; ++m) { const f32x4 q4 = *(const LAS f32x4*)(part + (ai * HALF + wr * 64 + m * 16 + fr) * 4); rstd[ai][m] = rsqrtf(((q4.x + q4.y) + (q4.z + q4.w)) * inv + 1e-5f); }
            asm volatile("s_waitcnt lgkmcnt(0)\n\ts_barrier" ::: "memory");
        }
#pragma unroll
        for (int bj = 0; bj < 2; ++bj) { const int g32 = u.pn * 8 + bj * 4 + wc;
#pragma unroll
            for (int ai = 0; ai < 2; ++ai)
#pragma unroll
                for (int m = 0; m < 4; ++m) { const size_t row = (size_t)(u.pm * BM + ai * HALF + wr * 64 + m * 16 + fr); f32x4 v0 = acc[ai][bj][m][0], v1 = acc[ai][bj][m][1];
                    const int c4 = 4 * fq;
                    auto st8 = [&](bf16_t* dst, const f32x4& x) { u32x2 w; w.x = pk2(x.x, x.y); w.y = pk2(x.z, x.w); *(u32x2*)dst = w; };
                    auto nsa_rope = [&](f32x4& x) {
#pragma unroll
                        for (int j = 0; j < 4; ++j) { const float other = __shfl_xor(x[j], 32); const int i = 4 * (fq & 1) + j; float sn, cs; __sincosf(fp[ai][m] * fast_exp2(-(float)i * (L2T / 8.f)), &sn, &cs);
                            x[j] = (fq < 2) ? x[j] * cs - other * sn : x[j] * cs + other * sn; } };
                    if (g32 < 8) { const float r_ = rstd[ai][m]; const int c = g32 * 32 + c4; const f32x4 g0 = *(const f32x4*)(qg + c), g1 = *(const f32x4*)(qg + c + 16);
                        st8(QN + row * 256 + c, v0 * g0 * r_); st8(QN + row * 256 + c + 16, v1 * g1 * r_); }
                    else if (g32 < 12) { const float r_ = rstd[ai][m]; const int c = (g32 - 8) * 32 + c4; const f32x4 g0 = *(const f32x4*)(kvg + c), g1 = *(const f32x4*)(kvg + c + 16);
                        st8(KVN + row * 256 + c, v0 * g0 * r_); st8(KVN + row * 256 + c + 16, v1 * g1 * r_);
                        *(u32x2*)(KVN + row * 256 + 128 + c) = (u32x2){0u, 0u}; *(u32x2*)(KVN + row * 256 + 128 + c + 16) = (u32x2){0u, 0u}; }
                    else if (g32 == 12) { f32x4 cs4, sn4;
#pragma unroll
                        for (int j = 0; j < 4; ++j) { float sn, cs; __sincosf(fp[ai][m] * fast_exp2(-(float)(c4 + j) * (L2T / 16.f)), &sn, &cs); cs4[j] = cs; sn4[j] = sn; }
                        const f32x4 o1 = v0 * cs4 - v1 * sn4, o2 = v1 * cs4 + v0 * sn4;
#pragma unroll
                        for (int h = 0; h < 8; ++h) { st8(KM + row * 768 + h * 96 + 64 + c4, o1); st8(KM + row * 768 + h * 96 + 80 + c4, o2); }
                        *(f32x4*)(ROPEM + row * 32 + c4) = cs4; *(f32x4*)(ROPEM + row * 32 + 16 + c4) = sn4; }
                    else if (g32 < 29) { const int hh = (g32 - 13) >> 1, half = (g32 - 13) & 1; if (half == 0) nsa_rope(v0);
                        st8(NQ + row * 512 + hh * 64 + half * 32 + c4, v0 * NSA_QSCALE); st8(NQ + row * 512 + hh * 64 + half * 32 + 16 + c4, v1 * NSA_QSCALE); }
                    else if (g32 < 37) { bf16_t* d_ = (g32 < 33 ? KCC : VCC) + row * 128 + ((g32 - 29) & 3) * 32 + c4; st8(d_, v0); st8(d_ + 16, v1); }
                    else if (g32 < 41) { if (((g32 - 37) & 1) == 0) nsa_rope(v0); bf16_t* d_ = KSR + row * 128 + (g32 - 37) * 32 + c4; st8(d_, v0); st8(d_ + 16, v1); }
                    else if (g32 < 45) { bf16_t* d_ = VSC + row * 128 + (g32 - 41) * 32 + c4; st8(d_, v0); st8(d_ + 16, v1); }
                    else if (g32 < 49) { if (((g32 - 45) & 1) == 0) nsa_rope(v0); bf16_t* d_ = KWR + row * 128 + (g32 - 45) * 32 + c4; st8(d_, v0); st8(d_ + 16, v1); }
                    else if (g32 < 53) { bf16_t* d_ = VWC + row * 128 + (g32 - 49) * 32 + c4; st8(d_, v0); st8(d_ + 16, v1); }
                    else if (g32 == 53) { f32x4 s0, s1;
#pragma unroll
                        for (int j = 0; j < 4; ++j) { s0[j] = __builtin_amdgcn_rcpf(1.0f + __expf(-v0[j])); s1[j] = __builtin_amdgcn_rcpf(1.0f + __expf(-v1[j])); }
                        *(f32x4*)(GATES + row * 24 + c4) = s0; if (fq < 2) *(f32x4*)(GATES + row * 24 + 16 + c4) = s1; }
                } }
    }
};
struct UpOrder {
    DenseOrder q, kv; int G, c;
    DEV bool next(int i, Unit& u) const {
        const long L = (long)i * G + c;
        if (L < q.nwg) { DenseOrder t = q; t.G = 1; t.c = 0; t.next((int)L, u); u.e = 0; return true; }
        if (L < q.nwg + kv.nwg) { DenseOrder t = kv; t.G = 1; t.c = 0; t.next((int)(L - q.nwg), u); u.e = 1; return true; }
        return false;
    }
};
struct EpiUp {
    static constexpr bool AFTER_DRAIN = false;
    EpiQup eq; EpiKvup ekv;
    DEV void operator()(const f32x4 (&acc)[2][2][4][2], const Unit& u, int wr, int wc, int fr, int fq) const { if (u.e == 0) eq(acc, u, wr, wc, fr, fq); else ekv(acc, u, wr, wc, fr, fq); }
};
}

DEV void transpose_item(const float* W, int Ksrc, int Nsrc, int k0, int n0, bf16_t* WT, int ldk, int drow0, LAS float* scr, int lane) {
    { const int kr = lane >> 3, nc = 4 * (lane & 7); f32x4 v[8];
#pragma unroll
      for (int i = 0; i < 8; ++i) { const int k = k0 + 8 * i + kr; v[i] = (k < Ksrc && n0 + nc < Nsrc) ? __builtin_nontemporal_load((const f32x4*)(W + (size_t)k * Nsrc + n0 + nc)) : (f32x4){0.f, 0.f, 0.f, 0.f}; }
#pragma unroll
      for (int i = 0; i < 8; ++i) { LAS float* d = scr + (8 * i + kr) * 33 + nc; d[0] = v[i].x; d[1] = v[i].y; d[2] = v[i].z; d[3] = v[i].w; } }
    asm volatile("s_waitcnt lgkmcnt(0)" ::: "memory");
    const int c = lane & 7;
#pragma unroll
    for (int j = 0; j < 4; ++j) { const int n = (lane >> 3) + 8 * j; const LAS float* s = scr + (8 * c) * 33 + n;
        u32x4 o; o.x = pk2(s[0 * 33], s[1 * 33]); o.y = pk2(s[2 * 33], s[3 * 33]); o.z = pk2(s[4 * 33], s[5 * 33]); o.w = pk2(s[6 * 33], s[7 * 33]);
        *(u32x4*)(WT + (size_t)(drow0 + n) * ldk + k0 + 8 * c) = o; }
    asm volatile("s_waitcnt lgkmcnt(0)" ::: "memory");
}
DEV void rms_row_to_bf16(const float* xrow, const float* g, bf16_t* orow, int lane) {
    const f32x4* xr = (const f32x4*)xrow + lane; const f32x4* gr = (const f32x4*)g + lane;
    f32x4 v[4]; float s = 0.f;
#pragma unroll
    for (int j = 0; j < 4; ++j) { v[j] = xr[64 * j]; s += (v[j].x * v[j].x + v[j].y * v[j].y) + (v[j].z * v[j].z + v[j].w * v[j].w); }
    const float rstd = rsqrtf(wave_sum(s) * (1.f / 1024.f) + 1e-5f);
    u32x2* o8 = (u32x2*)orow + lane;
#pragma unroll
    for (int j = 0; j < 4; ++j) { const f32x4 gg = gr[64 * j]; u32x2 w; w.x = pk2(v[j].x * rstd * gg.x, v[j].y * rstd * gg.y); w.y = pk2(v[j].z * rstd * gg.z, v[j].w * rstd * gg.w); o8[64 * j] = w; }
}
DEV void w1_quant_item(const float* W, unsigned char* WQ, float* SW, int n0, int drow0, LAS unsigned char* lds, int tid) {
    LAS unsigned* qs = (LAS unsigned*)lds;
    LAS float* red = (LAS float*)(lds + 32 * 1040);
    const int kg = tid >> 3, c = tid & 7, wv = tid >> 6;
    f32x4 v[4][4];
#pragma unroll
    for (int i = 0; i < 4; ++i)
#pragma unroll
        for (int q = 0; q < 4; ++q) v[i][q] = __builtin_nontemporal_load((const f32x4*)(W + (size_t)(4 * (64 * i + kg) + q) * 2048 + n0 + 4 * c));
    float mx[4] = {0.f, 0.f, 0.f, 0.f};
#pragma unroll
    for (int i = 0; i < 4; ++i)
#pragma unroll
        for (int q = 0; q < 4; ++q) { mx[0] = fmaxf(mx[0], fabsf(v[i][q].x)); mx[1] = fmaxf(mx[1], fabsf(v[i][q].y)); mx[2] = fmaxf(mx[2], fabsf(v[i][q].z)); mx[3] = fmaxf(mx[3], fabsf(v[i][q].w)); }
#pragma unroll
    for (int j = 0; j < 4; ++j) { mx[j] = fmaxf(mx[j], __shfl_xor(mx[j], 8)); mx[j] = fmaxf(mx[j], __shfl_xor(mx[j], 16)); mx[j] = fmaxf(mx[j], __shfl_xor(mx[j], 32)); }
    if ((tid & 63) < 8) *(LAS f32x4*)(red + wv * 32 + 4 * c) = (f32x4){mx[0], mx[1], mx[2], mx[3]};
    __syncthreads();
    float inv[4];
    { f32x4 m = *(const LAS f32x4*)(red + 4 * c);
#pragma unroll
      for (int w_ = 1; w_ < 8; ++w_) { const f32x4 o = *(const LAS f32x4*)(red + w_ * 32 + 4 * c); m.x = fmaxf(m.x, o.x); m.y = fmaxf(m.y, o.y); m.z = fmaxf(m.z, o.z); m.w = fmaxf(m.w, o.w); }
      m.x = fmaxf(m.x, 1e-30f); m.y = fmaxf(m.y, 1e-30f); m.z = fmaxf(m.z, 1e-30f); m.w = fmaxf(m.w, 1e-30f);
      inv[0] = 127.0f / m.x; inv[1] = 127.0f / m.y; inv[2] = 127.0f / m.z; inv[3] = 127.0f / m.w;
      if (tid < 8) *(f32x4*)(SW + drow0 + 4 * c) = m * (1.0f / 127.0f); }
#pragma unroll
    for (int i = 0; i < 4; ++i) {
#pragma unroll
        for (int j = 0; j < 4; ++j) { unsigned x = 0u;
#pragma unroll
            for (int q = 0; q < 4; ++q) { const int b = __float2int_rn(v[i][q][j] * inv[j]); x |= ((unsigned)b & 255u) << (8 * q); }
            qs[(4 * c + j) * 260 + 64 * i + kg] = x; } }
    __syncthreads();
#pragma unroll
    for (int t_ = 0; t_ < 4; ++t_) { const int id = tid + 512 * t_, n = id >> 6, ch = id & 63;
        *(u32x4*)(WQ + (size_t)(drow0 + n) * 1024 + ch * 16) = *(const LAS u32x4*)(lds + n * 1040 + ch * 16); }
    __syncthreads();
}
DEV void prep_w1_items(const Params& p, LAS unsigned char* lds) {
    const int tid = opaque_tid();
    unsigned* ctr = (unsigned*)(p.ws + OFF_CNT) + 40; LAS int* slot = (LAS int*)(lds + 40960);
    for (;;) {
        if (tid == 0) *slot = (int)__hip_atomic_fetch_add(ctr, 1u, __ATOMIC_RELAXED, __HIP_MEMORY_SCOPE_AGENT);
        __syncthreads();
        const int it = *slot;
        __syncthreads();
        if (it >= 32 * 64) break;
        const int e = it >> 6, nb = it & 63, n0 = nb * 32;
        const int bj = n0 >> 10, rr = n0 & 1023, drow = 256 * (rr >> 7) + 128 * bj + (rr & 127);
        w1_quant_item(p.moe_w1 + (size_t)e * 1024 * 2048, p.ws + OFF_W1T + (size_t)e * 2048 * 1024, (float*)(p.ws + OFF_SW1) + (size_t)e * 2048, n0, drow, lds, tid); }
}
DEV void prep_w2_items(const Params& p, LAS unsigned char* lds, int firstw, int stridew) {
    const int tid = opaque_tid(), wid = tid >> 6, lane = tid & 63;
    LAS float* scr = (LAS float*)(lds + wid * 16384); bf16_t* W2T = (bf16_t*)(p.ws + OFF_W2T);
    for (int r = firstw + wid; r < 32 * 16 * 32; r += stridew) { const int e = r / (16 * 32), q = r % (16 * 32), kb = q / 32, nb = q % 32;
        transpose_item(p.moe_w2 + (size_t)e * 1024 * 1024, 1024, 1024, kb * 64, nb * 32, W2T + (size_t)e * 1024 * 1024, 1024, nb * 32, scr, lane); }
}
DEV void phase0(const Params& p, LAS unsigned char* lds) {
    const int tid = opaque_tid(), wid = tid >> 6, lane = tid & 63;
    LAS float* scr = (LAS float*)(lds + wid * 16384);
    const int gw = blockIdx.x * 8 + wid, NGW = gridDim.x * 8;
    bf16_t* WINT = (bf16_t*)(p.ws + OFF_WINT);
    bf16_t* WQUPT = (bf16_t*)(p.ws + OFF_WQUPT); bf16_t* WKVUPT = (bf16_t*)(p.ws + OFF_WKVUPT); bf16_t* WOUTT = (bf16_t*)(p.ws + OFF_WOUTT);
    constexpr int I_IN = 16 * 56, I_QUP = 4 * 24, I_KVUP = 4 * 32, I_OUT = 16 * 32, I_CW1 = 2 * 32 * 8, I_ROWS = NTOK;
    constexpr int NITEMS = I_IN + I_QUP + I_KVUP + I_OUT + I_CW1;
    for (int it = gw; it < NITEMS; it += NGW) {
        int r = it;
        if (r < I_IN) { const int kb = r / 56, nb = r % 56; transpose_item(p.w_in, 1024, INC, kb * 64, nb * 32, WINT, 1024, nb * 32, scr, lane); continue; } r -= I_IN;
        if (r < I_QUP) { const int kb = r / 24, nb = r % 24; transpose_item(p.w_q_up, 256, 768, kb * 64, nb * 32, WQUPT, 256, nb * 32, scr, lane); continue; } r -= I_QUP;
        if (r < I_KVUP) { const int kb = r / 32, nb = r % 32; transpose_item(p.w_kv_up, 128, 1024, kb * 64, nb * 32, WKVUPT, 256, nb * 32, scr, lane); continue; } r -= I_KVUP;
        if (r < I_OUT) { const int kb = r / 32, nb = r % 32; transpose_item(p.w_out, 1024, 1024, kb * 64, nb * 32, WOUTT, 1024, nb * 32, scr, lane); continue; } r -= I_OUT;
        if (r < I_CW1) { const int c = r / 256, q = r % 256, kb = q / 8, nb = q % 8; transpose_item(p.cmp_w1 + (size_t)c * 2048 * 128, 2048, 128, kb * 64, nb * 32, (bf16_t*)(p.ws + OFF_CW1T) + (size_t)c * 256 * 2048, 2048, nb * 32, scr, lane); continue; } r -= I_CW1;
        break;
    }
    { const f32x4* gr = (const f32x4*)p.attn_norm + lane; f32x4 gg[4];
#pragma unroll
      for (int j = 0; j < 4; ++j) gg[j] = gr[64 * j];
      for (int r0 = gw * 4; r0 < NTOK; r0 += NGW * 4) { f32x4 v[4][4];
#pragma unroll
          for (int q = 0; q < 4; ++q) { const f32x4* xr = (const f32x4*)(p.x + (size_t)(r0 + q) * DM) + lane;
#pragma unroll
              for (int j = 0; j < 4; ++j) v[q][j] = xr[64 * j]; }
#pragma unroll
          for (int q = 0; q < 4; ++q) { float s_ = 0.f;
#pragma unroll
              for (int j = 0; j < 4; ++j) s_ += (v[q][j].x * v[q][j].x + v[q][j].y * v[q][j].y) + (v[q][j].z * v[q][j].z + v[q][j].w * v[q][j].w);
              const float rstd = rsqrtf(wave_sum(s_) * (1.f / 1024.f) + 1e-5f); u32x2* o8 = (u32x2*)((bf16_t*)(p.ws + OFF_U) + (size_t)(r0 + q) * DM) + lane;
#pragma unroll
              for (int j = 0; j < 4; ++j) { u32x2 w; w.x = pk2(v[q][j].x * rstd * gg[j].x, v[q][j].y * rstd * gg[j].y); w.y = pk2(v[q][j].z * rstd * gg[j].z, v[q][j].w * rstd * gg[j].w); o8[64 * j] = w; } } } }
    float* cb = (float*)(p.ws + OFF_CB);
    for (int o8 = gw; o8 < 2048; o8 += NGW) { const int o = o8 & 255, part = o8 >> 8, c = o >> 7, h = o & 127; float s = 0.f;
#pragma unroll
        for (int q = 0; q < 4; ++q) { const int i = part * 256 + q * 64 + lane; s += p.cmp_pos[c * 2048 + i] * p.cmp_w1[((size_t)c * 2048 + i) * 128 + h]; }
        s = wave_sum(s); if (lane == 0) cb[part * 256 + o] = s; }
    if (blockIdx.x == 0 && tid < 64) ((unsigned*)(p.ws + OFF_CNT))[tid] = 0u;
}

struct P2In { u32x2 wq; unsigned wkv; unsigned kp; u32x4 wqn; u32x4 wk; u32x4 wc4; unsigned gt; int pos; };
DEV void phase2(const Params& p) {
    const int tid = opaque_tid(), wid = tid >> 6, lane = tid & 63;
    const int gw = blockIdx.x * 8 + wid, NGW = gridDim.x * 8;
    const bf16_t* PROJ = (const bf16_t*)(p.ws + OFF_PROJ);
    bf16_t* QN = (bf16_t*)(p.ws + OFF_QN); bf16_t* KVN = (bf16_t*)(p.ws + OFF_KVN); bf16_t* KM = (bf16_t*)(p.ws + OFF_KM); float* ROPEM = (float*)(p.ws + OFF_ROPEM); bf16_t* NQ = (bf16_t*)(p.ws + OFF_NQ);
    bf16_t* KSR = (bf16_t*)(p.ws + OFF_KSR); bf16_t* KWR = (bf16_t*)(p.ws + OFF_KWR); float* GATES = (float*)(p.ws + OFF_GATES);
    const float invf_m = powf(500000.0f, -(float)(2 * (lane & 15)) / 32.0f);
    const float invf_n = powf(500000.0f, -(float)(2 * (lane & 7)) / 16.0f);
    const f32x4 gq = *(const f32x4*)(p.q_norm + lane * 4); const f32x2 gkv = *(const f32x2*)(p.kv_norm + lane * 2);
    const int l16 = lane & 15, sub = lane & 7, d32 = lane & 31; const int cbase = (lane < 16) ? C_KS : C_KW;
    const int grp4 = lane >> 4; const int ccol4 = (grp4 == 0) ? C_KC : (grp4 == 1) ? C_VC : (grp4 == 2) ? C_VS : C_VW;
    bf16_t* cdst4 = (bf16_t*)(p.ws + (grp4 == 0 ? OFF_KCC : grp4 == 1 ? OFF_VCC : grp4 == 2 ? OFF_VSC : OFF_VWC));
    auto load = [&](int tok) -> P2In { const bf16_t* row = PROJ + (size_t)tok * INP; P2In in;
        in.wq = *(const u32x2*)(row + C_QLAT + lane * 4); in.wkv = *(const unsigned*)(row + C_KVLAT + lane * 2);
        in.kp = (unsigned)row[C_KPE + d32] | ((unsigned)row[C_KPE + (d32 ^ 16)] << 16);
        in.wqn = *(const u32x4*)(row + C_QNSA + lane * 8); in.wk = *(const u32x4*)(row + cbase + l16 * 8); in.wc4 = *(const u32x4*)(row + ccol4 + l16 * 8);
        in.gt = row[C_G + (lane < 24 ? lane : 23)]; in.pos = p.pos[tok]; return in; };
    P2In cur = load(gw < NTOK ? gw : 0);
#pragma unroll 1
    for (int tok = gw; tok < NTOK; tok += NGW) {
        const P2In nxt = load(tok + NGW < NTOK ? tok + NGW : tok);
        const float fpos = (float)cur.pos;
        float cm, sm, cn, sn; __sincosf(fpos * invf_m, &sm, &cm); __sincosf(fpos * invf_n, &sn, &cn);
        { const u32x2 w = cur.wq; const float a = bflo(w.x), b = bfhi(w.x), c = bflo(w.y), d = bfhi(w.y);
          const float rstd = rsqrtf(wave_sum(a * a + b * b + c * c + d * d) * (1.f / 256.f) + 1e-5f);
          u32x2 o; o.x = pk2(a * rstd * gq.x, b * rstd * gq.y); o.y = pk2(c * rstd * gq.z, d * rstd * gq.w); *(u32x2*)(QN + (size_t)tok * 256 + lane * 4) = o; }
        { const unsigned w = cur.wkv; const float a = bflo(w), b = bfhi(w);
          const float rstd = rsqrtf(wave_sum(a * a + b * b) * (1.f / 128.f) + 1e-5f);
          *(unsigned*)(KVN + (size_t)tok * 256 + lane * 2) = pk2(a * rstd * gkv.x, b * rstd * gkv.y); *(unsigned*)(KVN + (size_t)tok * 256 + 128 + lane * 2) = 0u; }
        { const float xs_ = bflo(cur.kp), xo = bfhi(cur.kp); const float val = (d32 < 16) ? xs_ * cm - xo * sm : xs_ * cm + xo * sm;
          const int hh = lane >> 3, part = lane & 7; const float a0 = __shfl(val, 4 * part), a1 = __shfl(val, 4 * part + 1), a2 = __shfl(val, 4 * part + 2), a3 = __shfl(val, 4 * part + 3);
          u32x2 w; w.x = pk2(a0, a1); w.y = pk2(a2, a3); *(u32x2*)(KM + (size_t)tok * 768 + hh * 96 + 64 + 4 * part) = w;
          if (lane < 16) { ROPEM[(size_t)tok * 32 + lane] = cm; ROPEM[(size_t)tok * 32 + 16 + lane] = sm; } }
        { const u32x4 w = cur.wqn; float v[8] = {bflo(w.x), bfhi(w.x), bflo(w.y), bfhi(w.y), bflo(w.z), bfhi(w.z), bflo(w.w), bfhi(w.w)};
#pragma unroll
          for (int i = 0; i < 8; ++i) { const float other = __shfl_xor(v[i], 1); const float c = __shfl(cn, i), s = __shfl(sn, i);
              if (sub == 0) v[i] = v[i] * c - other * s; else if (sub == 1) v[i] = v[i] * c + other * s; }
          u32x4 o; o.x = pk2(v[0] * NSA_QSCALE, v[1] * NSA_QSCALE); o.y = pk2(v[2] * NSA_QSCALE, v[3] * NSA_QSCALE); o.z = pk2(v[4] * NSA_QSCALE, v[5] * NSA_QSCALE); o.w = pk2(v[6] * NSA_QSCALE, v[7] * NSA_QSCALE);
          *(u32x4*)(NQ + (size_t)tok * 512 + lane * 8) = o; }
        { const u32x4 w = cur.wk;
          float v[8] = {bflo(w.x), bfhi(w.x), bflo(w.y), bfhi(w.y), bflo(w.z), bfhi(w.z), bflo(w.w), bfhi(w.w)};
#pragma unroll
          for (int i = 0; i < 8; ++i) { const float other = __shfl_xor(v[i], 1); const float c = __shfl(cn, i), s = __shfl(sn, i);
              if (sub == 0) v[i] = v[i] * c - other * s; else if (sub == 1) v[i] = v[i] * c + other * s; }
          if (lane < 32) { u32x4 o; o.x = pk2(v[0], v[1]); o.y = pk2(v[2], v[3]); o.z = pk2(v[4], v[5]); o.w = pk2(v[6], v[7]);
              *(u32x4*)(((lane < 16) ? KSR : KWR) + (size_t)tok * 128 + l16 * 8) = o; } }
        *(u32x4*)(cdst4 + (size_t)tok * 128 + l16 * 8) = cur.wc4;
        if (lane < 24) GATES[(size_t)tok * 24 + lane] = __builtin_amdgcn_rcpf(1.0f + __expf(-bflo(cur.gt)));
        cur = nxt;
    }
}

DEV void phase4(const Params& p, LAS unsigned char* lds) {
    const int tid = opaque_tid();
    if (blockIdx.x < BATCH * 2 && tid < 128) { const int bb = blockIdx.x >> 1, c_ = blockIdx.x & 1; ((bf16_t*)(p.ws + (c_ == 0 ? OFF_KC : OFF_VC)))[((size_t)(bb * NCMPP + 255) * 2) * 64 + tid] = 0; }
    const bf16_t* PROJ = (const bf16_t*)(p.ws + OFF_PROJ); const float* cb = (const float*)(p.ws + OFF_CB);
    LAS float* hid = (LAS float*)lds;
    const int sub = tid >> 7, h = tid & 127;
    constexpr int NU = 2 * BATCH * NCMP * 2;
    for (int u0 = blockIdx.x * 4; u0 < NU; u0 += gridDim.x * 4) {
        const int u = u0 + sub; const bool act = u < NU;
        int c = 0, b = 0, n = 0, g = 0;
        if (act) { c = u / (BATCH * NCMP * 2); int r = u % (BATCH * NCMP * 2); b = r / (NCMP * 2); r %= (NCMP * 2); n = r >> 1; g = r & 1; }
        float acc = 0.f;
        if (act) {
            const bf16_t* src = PROJ + (size_t)(b * SEQ + n * 16) * INP + (c == 0 ? C_KC : C_VC) + g * 64;
            const float* w1 = p.cmp_w1 + (size_t)c * 2048 * 128 + h;
            for (int l = 0; l < 32; ++l) { const bf16_t* sr = src + (size_t)l * INP;
#pragma unroll 8
                for (int d = 0; d < 64; d += 2) { const unsigned w = *(const unsigned*)(sr + d); acc += bflo(w) * w1[(size_t)(l * 64 + d) * 128] + bfhi(w) * w1[(size_t)(l * 64 + d + 1) * 128]; } }
            acc += cb[c * 128 + h];
            acc = acc / (1.0f + __expf(-acc));
        }
        hid[sub * 128 + h] = acc;
        __syncthreads();
        if (act && h < 64) {
            const float* w2 = p.cmp_w2 + (size_t)c * 128 * 64 + h; float o = 0.f;
            for (int k = 0; k < 128; ++k) o += hid[sub * 128 + k] * w2[k * 64];
            LAS float* ob = (LAS float*)(lds + 4096) + sub * 64; ob[h] = o;
            asm volatile("s_waitcnt lgkmcnt(0)" ::: "memory");
            if (c == 0 && h < 16) { const int i = h & 7; const float fpos = (float)p.pos[b * SEQ + 16 * n + 31]; const float invf = powf(500000.0f, -(float)(2 * i) / 16.0f);
                float cs, sn; sincosf(fpos * invf, &sn, &cs); const float x1 = ob[i], x2 = ob[8 + i]; o = (h < 8) ? (x1 * cs - x2 * sn) : (x2 * cs + x1 * sn); }
            ((bf16_t*)(p.ws + (c == 0 ? OFF_KC : OFF_VC)))[((size_t)(b * NCMPP + n) * 2 + g) * 64 + h] = f2bf(o);
        }
        __syncthreads();
    }
}

template <int DQK, int DV, class KF, class VF, class MF>
DEV void naive_attn_range(const float (&q)[DQK], float (&o)[DV], float& m, float& l, int jlo, int jhi, KF kf, VF vf, MF valid) {
#pragma unroll 1
    for (int j0 = jlo; j0 < jhi; j0 += 2) {
        const int ja = __builtin_amdgcn_readfirstlane(j0), jb = __builtin_amdgcn_readfirstlane((j0 + 1 < jhi) ? j0 + 1 : j0);
        float s0 = 0.f, s1 = 0.f;
#pragma unroll
        for (int i = 0; i < DQK / 2; ++i) { const unsigned w = kf(ja, i); s0 += q[2 * i] * bflo(w); s0 += q[2 * i + 1] * bfhi(w); }
#pragma unroll
        for (int i = 0; i < DQK / 2; ++i) { const unsigned w = kf(jb, i); s1 += q[2 * i] * bflo(w); s1 += q[2 * i + 1] * bfhi(w); }
        if (!valid(ja)) s0 = -INFINITY;
        if (!(j0 + 1 < jhi && valid(jb))) s1 = -INFINITY;
        const float mn = fmaxf(m, fmaxf(s0, s1));
        const bool live = mn != -INFINITY;
        const float alpha = live ? fast_exp2(m - mn) : 1.f, p0 = live ? fast_exp2(s0 - mn) : 0.f, p1 = live ? fast_exp2(s1 - mn) : 0.f;
        l = l * alpha + p0 + p1; m = mn;
#pragma unroll
        for (int i = 0; i < DV / 2; ++i) { const unsigned w0 = vf(ja, i), w1 = vf(jb, i);
            o[2 * i] = o[2 * i] * alpha + p0 * bflo(w0) + p1 * bflo(w1); o[2 * i + 1] = o[2 * i + 1] * alpha + p0 * bfhi(w0) + p1 * bfhi(w1); }
    }
}

DEV void phase3b(const Params& p) {
    const bf16_t* QUP = (const bf16_t*)(p.ws + OFF_QUP); const bf16_t* KVUP = (const bf16_t*)(p.ws + OFF_KVUP); const bf16_t* KPE = (const bf16_t*)(p.ws + OFF_KPE);
    bf16_t* QM = (bf16_t*)(p.ws + OFF_QM); bf16_t* KM = (bf16_t*)(p.ws + OFF_KM);
    for (int id = blockIdx.x * 512 + opaque_tid(); id < NTOK * 8; id += gridDim.x * 512) {
        const int tok = id >> 3, h = id & 7;
        const u32x4* qs = (const u32x4*)(QUP + (size_t)tok * 768 + h * 96); u32x4* qd = (u32x4*)(QM + (size_t)tok * 768 + h * 96);
        const u32x4* ks = (const u32x4*)(KVUP + (size_t)tok * 1024 + h * 128); u32x4* kd = (u32x4*)(KM + (size_t)tok * 768 + h * 96);
#pragma unroll 1
        for (int c = 0; c < 8; ++c) { const u32x4 w = qs[c]; u32x4 o;
            o.x = pk2(bflo(w.x) * MLA_QSCALE, bfhi(w.x) * MLA_QSCALE); o.y = pk2(bflo(w.y) * MLA_QSCALE, bfhi(w.y) * MLA_QSCALE);
            o.z = pk2(bflo(w.z) * MLA_QSCALE, bfhi(w.z) * MLA_QSCALE); o.w = pk2(bflo(w.w) * MLA_QSCALE, bfhi(w.w) * MLA_QSCALE); qd[c] = o; kd[c] = ks[c]; }
        const u32x4* pe = (const u32x4*)(KPE + (size_t)tok * 32);
#pragma unroll 1
        for (int c = 0; c < 4; ++c) kd[8 + c] = pe[c];
        const float fpos = (float)p.pos[tok]; const bf16_t* qr = QUP + (size_t)tok * 768 + h * 96 + 64; bf16_t* qo = QM + (size_t)tok * 768 + h * 96 + 64;
#pragma unroll 1
        for (int i = 0; i < 16; ++i) { const float invf = powf(500000.0f, -(float)(2 * i) / 32.0f); float c, sn; sincosf(fpos * invf, &sn, &c);
            const float x1 = bf2f(qr[i]), x2 = bf2f(qr[16 + i]); qo[i] = f2bf((x1 * c - x2 * sn) * MLA_QSCALE); qo[16 + i] = f2bf((x2 * c + x1 * sn) * MLA_QSCALE); }
    }
}

DEV void phase5_mla(const Params& p) {
    const int tid = opaque_tid(), wid = __builtin_amdgcn_readfirstlane(tid >> 6), lane = tid & 63;
    const int gw = blockIdx.x * 8 + wid, NGW = gridDim.x * 8;
    const bf16_t* QM = (const bf16_t*)(p.ws + OFF_QM); const bf16_t* KM = (const bf16_t*)(p.ws + OFF_KM); const bf16_t* KVUP = (const bf16_t*)(p.ws + OFF_KVUP);
    bf16_t* OCAT = (bf16_t*)(p.ws + OFF_OCAT);
    constexpr int NUNIT = BATCH * 8 * (SEQ / 64);
#pragma unroll 1
    for (int uu = gw; uu < NUNIT; uu += NGW) {
        const int u = (uu & 1) ? (NUNIT - 1 - (uu >> 1)) : (uu >> 1);
        const int tb = u % (SEQ / 64), h = (u / (SEQ / 64)) & 7, b = u / (SEQ / 64 * 8);
        const int t = tb * 64 + lane; const size_t tok = (size_t)b * SEQ + t;
        unsigned qp[48];
        { const bf16_t* qr = QM + tok * 768 + h * 96;
#pragma unroll
          for (int i = 0; i < 48; ++i) qp[i] = *(const unsigned*)(qr + 2 * i); }
        float o[64];
#pragma unroll
        for (int d = 0; d < 64; ++d) o[d] = 0.f;
        float m = -INFINITY, l = 0.f;
        const bf16_t* kb = KM + (size_t)b * SEQ * 768 + h * 96; const bf16_t* vb = KVUP + (size_t)b * SEQ * 1024 + h * 128 + 64;
        const int jhi = tb * 64 + 64;
#pragma unroll 1
        for (int j0 = 0; j0 < jhi; ++j0) {
            const int j = __builtin_amdgcn_readfirstlane(j0);
            const unsigned* kr = (const unsigned*)(kb + (size_t)j * 768); const unsigned* vr = (const unsigned*)(vb + (size_t)j * 1024);
            float s0 = 0.f;
#pragma unroll
            for (int i = 0; i < 48; ++i) { const unsigned w = kr[i]; s0 += bflo(qp[i]) * bflo(w); s0 += bfhi(qp[i]) * bfhi(w); }
            if (j > t) s0 = -INFINITY;
            const float mn = fmaxf(m, s0);
            const float alpha = fast_exp2(m - mn), p0 = fast_exp2(s0 - mn);
            l = l * alpha + p0; m = mn;
#pragma unroll
            for (int i = 0; i < 32; ++i) { const unsigned w0 = vr[i]; o[2 * i] = o[2 * i] * alpha + p0 * bflo(w0); o[2 * i + 1] = o[2 * i + 1] * alpha + p0 * bfhi(w0); }
        }
        const float rl = 1.0f / l;
        bf16_t* orow = OCAT + tok * 1024 + h * 64;
#pragma unroll
        for (int i = 0; i < 32; ++i) *(unsigned*)(orow + 2 * i) = pk2(o[2 * i] * rl, o[2 * i + 1] * rl);
    }
}

namespace fa {
typedef float f32x16 __attribute__((ext_vector_type(16)));
typedef short s16x4 __attribute__((ext_vector_type(4)));
constexpr int KSLOT = 12288, VSLOT = 8192;
constexpr int L_K = 0, L_V = 2 * KSLOT, L_WSF = L_V + 3 * VSLOT, L_OST = L_WSF + 8 * 512, L_MASK = L_OST + 8 * 4096, L_SEQ = L_MASK + 512, L_VAL = L_MASK + 1024, L_IMPH = L_VAL + 0;
constexpr int L_END = L_IMPH + 65536;
#define FA_MFMA(a, b, c) __builtin_amdgcn_mfma_f32_32x32x16_bf16(a, b, c, 0, 0, 0)
DEV int crow(int r, int hi) { return (r & 3) + 8 * (r >> 2) + 4 * hi; }
DEV s16x4 vtr(const LAS unsigned char* p) { return __builtin_bit_cast(s16x4, __builtin_amdgcn_ds_read_tr16_b64_v4i16((LAS s16x4*)p)); }
DEV float xhalf_max(float m) { auto rr = __builtin_amdgcn_permlane32_swap(__float_as_uint(m), __float_as_uint(m), false, false); return fmaxf(__uint_as_float(rr[0]), __uint_as_float(rr[1])); }
DEV float xhalf_sum(float m) { auto rr = __builtin_amdgcn_permlane32_swap(__float_as_uint(m), __float_as_uint(m), false, false); return __uint_as_float(rr[0]) + __uint_as_float(rr[1]); }

template <int NCH> struct KVRegs { u32x4 k0, k1, v; };
template <int NCH> DEV void stage_load(KVRegs<NCH>& r, const bf16_t* Kb, int kpitch, const bf16_t* Vb, int vpitch, int key0, int wid, int lane) {
    r.k0 = *(const u32x4*)(Kb + (size_t)(key0 + lane) * kpitch + wid * 8);
    if (NCH > 8 && wid < NCH - 8) r.k1 = *(const u32x4*)(Kb + (size_t)(key0 + lane) * kpitch + (8 + wid) * 8);
    r.v = *(const u32x4*)(Vb + (size_t)(key0 + 16 * (wid & 3) + (lane >> 2)) * vpitch + (wid >> 2) * 32 + (lane & 3) * 8);
}
template <int NCH> DEV void stage_write(const KVRegs<NCH>& r, LAS unsigned char* lds, int buf, int wid, int lane) {
    *(LAS u32x4*)(lds + L_K + buf * KSLOT + wid * 1024 + lane * 16) = r.k0;
    if (NCH > 8 && wid < NCH - 8) *(LAS u32x4*)(lds + L_K + buf * KSLOT + (8 + wid) * 1024 + lane * 16) = r.k1;
    *(LAS u32x4*)(lds + L_V + buf * VSLOT + wid * 1024 + lane * 16) = r.v;
}
template <int ND0> DEV void qk_tile(const LAS unsigned char* kbuf, int kp0, const bf16x8 (&qr)[ND0], f32x16& p0, f32x16& p1) {
#pragma unroll
    for (int r = 0; r < 16; ++r) { p0[r] = 0.f; p1[r] = 0.f; }
#pragma unroll
    for (int d0 = 0; d0 < ND0; ++d0) { const bf16x8 k0 = *(const LAS bf16x8*)(kbuf + kp0 + d0 * 2048), k1 = *(const LAS bf16x8*)(kbuf + kp0 + d0 * 2048 + 512);
        p0 = FA_MFMA(k0, qr[d0], p0); p1 = FA_MFMA(k1, qr[d0], p1); }
}
DEV float rowmax32(const f32x16& p0, const f32x16& p1) {
    float a = fmaxf(p0[0], p1[0]);
#pragma unroll
    for (int r = 1; r < 16; ++r) a = fmaxf(a, fmaxf(p0[r], p1[r]));
    return xhalf_max(a);
}
struct SmState { float mhat, l; f32x16 o[2]; };
DEV void sm_init(SmState& st) { st.mhat = -1e30f; st.l = 0.f;
#pragma unroll
    for (int r = 0; r < 16; ++r) { st.o[0][r] = 0.f; st.o[1][r] = 0.f; } }
DEV void sm_pv_tile(SmState& st, f32x16& p0, f32x16& p1, const LAS unsigned char* vbuf, int vp0, LAS float* wsf, int r32, int hi) {
    const float rm = rowmax32(p0, p1);
    const float newm = fmaxf(st.mhat, rm);
    if (__any(newm - st.mhat > 8.0f)) {
        const float f = fast_exp2(st.mhat - newm); st.mhat = newm; st.l *= f;
        if (hi == 0) wsf[r32] = f;
        asm volatile("s_waitcnt lgkmcnt(0)" ::: "memory");
#pragma unroll
        for (int r = 0; r < 16; ++r) { const float fr = wsf[crow(r, hi)]; st.o[0][r] *= fr; st.o[1][r] *= fr; }
        asm volatile("s_waitcnt lgkmcnt(0)" ::: "memory");
    }
    const float nm = -st.mhat; float sacc = 0.f;
#pragma unroll
    for (int r = 0; r < 16; ++r) { p0[r] = fast_exp2(p0[r] + nm); p1[r] = fast_exp2(p1[r] + nm); sacc += p0[r] + p1[r]; }
    st.l += sacc;
    u32x4 pw[4];
#pragma unroll
    for (int k = 0; k < 2; ++k) { pw[k] = (u32x4){pk2(p0[8 * k], p0[8 * k + 1]), pk2(p0[8 * k + 2], p0[8 * k + 3]), pk2(p0[8 * k + 4], p0[8 * k + 5]), pk2(p0[8 * k + 6], p0[8 * k + 7])};
        pw[2 + k] = (u32x4){pk2(p1[8 * k], p1[8 * k + 1]), pk2(p1[8 * k + 2], p1[8 * k + 3]), pk2(p1[8 * k + 4], p1[8 * k + 5]), pk2(p1[8 * k + 6], p1[8 * k + 7])}; }
#pragma unroll
    for (int dh = 0; dh < 2; ++dh)
#pragma unroll
        for (int ks = 0; ks < 4; ++ks) { const s16x4 lo = vtr(vbuf + vp0 + dh * 4096 + ks * 1024), hi4 = vtr(vbuf + vp0 + dh * 4096 + ks * 1024 + 512);
            const bf16x8 vf = (bf16x8){lo[0], lo[1], lo[2], lo[3], hi4[0], hi4[1], hi4[2], hi4[3]};
            st.o[dh] = FA_MFMA(__builtin_bit_cast(bf16x8, pw[ks]), vf, st.o[dh]); }
}
#define FA_MX3(a, b, c) __builtin_fmaxf(__builtin_fmaxf((a), (b)), (c))
template <int ND0> DEV void qk_tile_rel(const LAS unsigned char* kbuf, int kp0, const bf16x8 (&qr)[ND0], const f32x16& mC, f32x16& p0, f32x16& p1) {
    p0 = mC; p1 = mC;
#pragma unroll
    for (int d0 = 0; d0 < ND0; ++d0) { const bf16x8 k0 = *(const LAS bf16x8*)(kbuf + kp0 + d0 * 2048), k1 = *(const LAS bf16x8*)(kbuf + kp0 + d0 * 2048 + 512);
        p0 = FA_MFMA(k0, qr[d0], p0); p1 = FA_MFMA(k1, qr[d0], p1); }
}
DEV void sm_decide(SmState& st, f32x16& mC, f32x16& p0, f32x16& p1, bool firsttile, LAS float* wsf, int r32, int hi) {
    float a = FA_MX3(p0[0], p1[0], p0[1]), b = FA_MX3(p1[1], p0[2], p1[2]);
#pragma unroll
    for (int r = 3; r < 15; r += 2) { a = FA_MX3(a, p0[r], p1[r]); b = FA_MX3(b, p0[r + 1], p1[r + 1]); }
    a = FA_MX3(a, p0[15], p1[15]);
    const float rm = xhalf_max(fmaxf(a, b));
    if (firsttile) { const float m0 = (rm > -1e30f) ? rm : 0.f; st.mhat = m0;
#pragma unroll
        for (int r = 0; r < 16; ++r) { p0[r] -= m0; p1[r] -= m0; mC[r] = -m0; }
    } else if (__any(rm > 8.0f)) {
        const float dl = fmaxf(rm, 0.f); const float f = fast_exp2(-dl); st.mhat += dl; st.l *= f;
        if (hi == 0) wsf[r32] = f;
        asm volatile("s_waitcnt lgkmcnt(0)" ::: "memory");
#pragma unroll
        for (int r = 0; r < 16; ++r) { const float fr = wsf[crow(r, hi)]; st.o[0][r] *= fr; st.o[1][r] *= fr; p0[r] -= dl; p1[r] -= dl; mC[r] = -st.mhat; }
        asm volatile("s_waitcnt lgkmcnt(0)" ::: "memory");
    }
}
DEV void sm_exp_pv(SmState& st, f32x16& p0, f32x16& p1, const LAS unsigned char* vbuf, int vp0) {
    float s0 = 0.f, s1 = 0.f;
#pragma unroll
    for (int r = 0; r < 16; ++r) { p0[r] = fast_exp2(p0[r]); p1[r] = fast_exp2(p1[r]); s0 += p0[r]; s1 += p1[r]; }
    st.l += s0 + s1;
    u32x4 pw[4];
#pragma unroll
    for (int k = 0; k < 2; ++k) { pw[k] = (u32x4){pk2(p0[8 * k], p0[8 * k + 1]), pk2(p0[8 * k + 2], p0[8 * k + 3]), pk2(p0[8 * k + 4], p0[8 * k + 5]), pk2(p0[8 * k + 6], p0[8 * k + 7])};
        pw[2 + k] = (u32x4){pk2(p1[8 * k], p1[8 * k + 1]), pk2(p1[8 * k + 2], p1[8 * k + 3]), pk2(p1[8 * k + 4], p1[8 * k + 5]), pk2(p1[8 * k + 6], p1[8 * k + 7])}; }
#pragma unroll
    for (int dh = 0; dh < 2; ++dh)
#pragma unroll
        for (int ks = 0; ks < 4; ++ks) { const s16x4 lo = vtr(vbuf + vp0 + dh * 4096 + ks * 1024), hi4 = vtr(vbuf + vp0 + dh * 4096 + ks * 1024 + 512);
            const bf16x8 vf = (bf16x8){lo[0], lo[1], lo[2], lo[3], hi4[0], hi4[1], hi4[2], hi4[3]};
            st.o[dh] = FA_MFMA(__builtin_bit_cast(bf16x8, pw[ks]), vf, st.o[dh]); }
}
DEV void row_to_olayout(float fq, float (&out)[16], LAS float* wsf, int r32, int hi) {
    if (hi == 0) wsf[32 + r32] = fq;
    asm volatile("s_waitcnt lgkmcnt(0)" ::: "memory");
#pragma unroll
    for (int r = 0; r < 16; ++r) out[r] = wsf[32 + crow(r, hi)];
    asm volatile("s_waitcnt lgkmcnt(0)" ::: "memory");
}
DEV void store_o_rows(const f32x16 (&o)[2], bf16_t* dst, size_t pitch, LAS unsigned char* ost, int lane, int r32, int hi) {
    LAS bf16_t* stg = (LAS bf16_t*)ost;
#pragma unroll
    for (int r = 0; r < 16; ++r) { const int orow = crow(r, hi);
#pragma unroll
        for (int d0 = 0; d0 < 2; ++d0) stg[orow * 64 + d0 * 32 + r32] = f2bf(o[d0][r]); }
    asm volatile("s_waitcnt lgkmcnt(0)" ::: "memory");
#pragma unroll
    for (int i = 0; i < 4; ++i) { const int row = i * 8 + (lane >> 3), ch = lane & 7; *(u32x4*)(dst + (size_t)row * pitch + ch * 8) = *(const LAS u32x4*)(stg + row * 64 + ch * 8); }
    asm volatile("s_waitcnt lgkmcnt(0)" ::: "memory");
}

#define FT_SBAR() __builtin_amdgcn_sched_barrier(0)
#define FT_PIN(x) asm volatile("" : "+v"(x))
#define FT_WAIT_BAR(N) asm volatile("s_waitcnt vmcnt(" #N ") lgkmcnt(0)\n\ts_barrier" ::: "memory")
DEV unsigned ft_cvtpk(float lo, float hi) { unsigned r; asm("v_cvt_pk_bf16_f32 %0, %1, %2" : "=v"(r) : "v"(lo), "v"(hi)); return r; }
DEV void ft_glds16(const void* g, unsigned lds_base) { unsigned sv; asm volatile("s_mov_b32 %0, m0\n\ts_mov_b32 m0, %2\n\ts_nop 0\n\tglobal_load_lds_dwordx4 %1, off\n\ts_mov_b32 m0, %0" : "=&s"(sv) : "v"(g), "s"(lds_base) : "memory"); }
typedef LAS const char* ft_cptr;
DEV void ft_kload2(bf16x8* kf, ft_cptr kp, int d0) { kf[2 * d0] = *(const LAS bf16x8*)(kp + d0 * 2048); kf[2 * d0 + 1] = *(const LAS bf16x8*)(kp + d0 * 2048 + 512); }
DEV s16x4 ft_vtr(ft_cptr p) { return __builtin_bit_cast(s16x4, __builtin_amdgcn_ds_read_tr16_b64_v4i16((LAS s16x4*)p)); }
DEV float ft_rowmax(const f32x16& p0, const f32x16& p1) {
    float a = FA_MX3(p0[0], p0[1], p1[0]), b = FA_MX3(p0[2], p0[3], p1[1]); a = FA_MX3(a, p1[2], p1[3]);
#pragma unroll
    for (int r = 4; r < 16; r += 4) { a = FA_MX3(a, p0[r], p0[r + 1]); b = FA_MX3(b, p0[r + 2], p0[r + 3]); a = FA_MX3(a, p1[r], p1[r + 1]); b = FA_MX3(b, p1[r + 2], p1[r + 3]); }
    return xhalf_max(__builtin_fmaxf(a, b)); }
template <int MODE>
DEV void fa64_tuned(f32x16 (&o)[2], float& l_out, const bf16x8 (&qr)[4], const bf16_t* Kb, int kpitch, const bf16_t* Vb, int vpitch, unsigned long long um, int jlast, int NT,
                    unsigned long long rowmask, int tb, int tokl, LAS unsigned char* lds, LAS float* wsf, int wid, int lane, int r32, int hi) {
    constexpr int SLOTB = 8192; constexpr float THR = 8.0f;
    const unsigned lds0 = (unsigned)(uintptr_t)lds;
    const bf16_t* ksrc = Kb + (size_t)lane * kpitch + wid * 8;
    const bf16_t* vsrc = Vb + (size_t)(16 * (wid & 3) + (lane >> 2)) * vpitch + (wid >> 2) * 32 + (lane & 3) * 8;
    const unsigned kdst = lds0 + L_K + wid * 1024, vdst = lds0 + L_V + wid * 1024;
    unsigned long long rem_ = um; int jn_ = tb;
    auto gen = [&]() -> int { if (MODE == 0) { if (rem_ == 0ull) return 128; const int j = (int)__builtin_ctzll(rem_); rem_ &= rem_ - 1ull; return j; } else { if (jn_ < jlast) return 128; return jn_--; } };
    int w0 = gen(), w1 = gen(), w2 = gen(), w3 = gen();
#define FT_SHIFT() do { w0 = w1; w1 = w2; w2 = w3; w3 = gen(); } while (0)
#define FT_DMA_K(id, slot) ft_glds16(ksrc + (size_t)(((id) & 63) * 64) * kpitch, (unsigned)__builtin_amdgcn_readfirstlane(kdst + (slot)))
#define FT_DMA_V(id, slot) ft_glds16(vsrc + (size_t)(((id) & 63) * 64) * vpitch, (unsigned)__builtin_amdgcn_readfirstlane(vdst + (slot)))
    const ft_cptr vp0 = (ft_cptr)lds + L_V + ((lane >> 4) & 1) * 32 + (lane & 3) * 8 + (4 * hi + ((lane & 15) >> 2)) * 64;
    const ft_cptr kp0 = (ft_cptr)lds + L_K + hi * 1024 + r32 * 16;
    FT_DMA_K(w0, 0); FT_DMA_V(w0, 0); FT_DMA_K(w1, SLOTB); FT_DMA_K(w2, 2 * SLOTB);
    float mhat = 0.f, l_reg = 0.f; o[0] = f32x16{}; o[1] = f32x16{};
    const f32x16 zero16 = f32x16{};
    bool resc = false;
    f32x16 pA0, pA1, pB0, pB1; bf16x8 kf[8]; s16x4 vlo[8], vhi[8]; u32x4 pw0, pw1, pw2, pw3;
    int sl_prev = 0, sl_cur = 0, sl_next = SLOTB;
#define FT_ROT() do { sl_prev = sl_cur; sl_cur = sl_next; sl_next = (sl_next == 2 * SLOTB) ? 0 : sl_next + SLOTB; } while (0)
#define FT_EX(v) __builtin_amdgcn_exp2f((v) + nmh)
#define FT_RESC() do { if (resc) { _Pragma("unroll") for (int d_ = 0; d_ < 2; ++d_) _Pragma("unroll") for (int r = 0; r < 16; ++r) o[d_][r] *= wsf[crow(r, hi)]; } } while (0)
    auto emask = [&](int id, f32x16& p0, f32x16& p1) {
        const int j = id & 63, kb = 4 * hi;
        if (j == tb) {
#pragma unroll
            for (int r = 0; r < 16; ++r) { const int kv_ = kb + (r & 3) + 8 * (r >> 2); if (kv_ > tokl) p0[r] = -INFINITY; if (kv_ + 32 > tokl) p1[r] = -INFINITY; }
        } else if (MODE == 1 && j == tb - 8) {
#pragma unroll
            for (int r = 0; r < 16; ++r) { const int kv_ = kb + (r & 3) + 8 * (r >> 2); if (kv_ <= tokl) p0[r] = -INFINITY; if (kv_ + 32 <= tokl) p1[r] = -INFINITY; } } };
    auto rowsel = [&](int id) -> bool { if (id & 128) return false; if (MODE == 0) return (rowmask >> (id & 63)) & 1ull; return true; };
    FT_WAIT_BAR(3);
    _Pragma("unroll") for (int d0 = 0; d0 < 4; ++d0) ft_kload2(kf, kp0, d0);
    pA0 = FA_MFMA(kf[0], qr[0], zero16); pA1 = FA_MFMA(kf[1], qr[0], zero16); pA0 = FA_MFMA(kf[2], qr[1], pA0); pA1 = FA_MFMA(kf[3], qr[1], pA1);
    pA0 = FA_MFMA(kf[4], qr[2], pA0); pA1 = FA_MFMA(kf[5], qr[2], pA1); pA0 = FA_MFMA(kf[6], qr[3], pA0); pA1 = FA_MFMA(kf[7], qr[3], pA1);
    emask(w0, pA0, pA1);
    { const float rm = ft_rowmax(pA0, pA1); mhat = rm; const float nmh = -mhat;
#pragma unroll
      for (int r = 0; r < 16; ++r) { pA0[r] = FT_EX(pA0[r]); pA1[r] = FT_EX(pA1[r]); } }
    FT_WAIT_BAR(0);
    FT_DMA_K(w3, 0); FT_DMA_V(w1, SLOTB); FT_ROT(); FT_SHIFT();
    _Pragma("unroll") for (int d0 = 0; d0 < 4; ++d0) ft_kload2(kf, kp0 + sl_cur, d0);
    FT_WAIT_BAR(2);
#define FT_PKW(P, i) ft_cvtpk(P[i], P[i + 1])
#define FT_PAF(k) __builtin_bit_cast(bf16x8, pw##k)
#define FT_VFR(i) (bf16x8){vlo[i][0], vlo[i][1], vlo[i][2], vlo[i][3], vhi[i][0], vhi[i][1], vhi[i][2], vhi[i][3]}
#define FT_VRD(i) do { vlo[i] = ft_vtr(vp_ + (((i) >> 2) * 4096 + ((i) & 3) * 1024)); vhi[i] = ft_vtr(vp_ + (((i) >> 2) * 4096 + ((i) & 3) * 1024 + 512)); } while (0)
#define FT_KRD(G, d0) do { if (G) { ft_kload2(kf, kp0 + sl_next, d0); FT_SBAR(); } } while (0)
#define FT_GAPA(MF, a0, a1, a2, a3, W0, W1, PW) do { MF; sacc += a0; sacc += a1; sacc += a2; sacc += a3; W0; W1; FT_PIN(PW); FT_PIN(sacc); FT_SBAR(); } while (0)
#define FT_GAPB(MF, X, i) do { MF; X[i] = FT_EX(X[i]); X[i + 1] = FT_EX(X[i + 1]); X[i + 2] = FT_EX(X[i + 2]); X[i + 3] = FT_EX(X[i + 3]); FT_PIN(X); FT_SBAR(); } while (0)
#define FT_STEP(C0, C1, P0, P1, t, MASK, GK, GV, GL) do { FT_SBAR(); \
    const ft_cptr vp_ = vp0 + sl_prev; const int id_ = w0; \
    FT_VRD(0); FT_SBAR(); float sacc = P0[0] + P0[1]; \
                       FT_GAPA(C0 = FA_MFMA(kf[0], qr[0], zero16), P0[2], P0[3], P0[4], P0[5],     pw0[0] = FT_PKW(P0, 0),  pw0[1] = FT_PKW(P0, 2),  pw0); \
    FT_VRD(4); FT_SBAR(); FT_GAPA(C1 = FA_MFMA(kf[1], qr[0], zero16), P0[6], P0[7], P0[8], P0[9],     pw0[2] = FT_PKW(P0, 4),  pw0[3] = FT_PKW(P0, 6),  pw0); \
    FT_VRD(1); FT_SBAR(); FT_GAPA(C0 = FA_MFMA(kf[2], qr[1], C0),    P0[10], P0[11], P0[12], P0[13], pw1[0] = FT_PKW(P0, 8),  pw1[1] = FT_PKW(P0, 10), pw1); \
    FT_VRD(5); FT_SBAR(); FT_GAPA(C1 = FA_MFMA(kf[3], qr[1], C1),    P0[14], P0[15], P1[0], P1[1],   pw1[2] = FT_PKW(P0, 12), pw1[3] = FT_PKW(P0, 14), pw1); \
    FT_VRD(2); FT_SBAR(); FT_GAPA(C0 = FA_MFMA(kf[4], qr[2], C0),    P1[2], P1[3], P1[4], P1[5],     pw2[0] = FT_PKW(P1, 0),  pw2[1] = FT_PKW(P1, 2),  pw2); \
    FT_VRD(6); FT_SBAR(); FT_GAPA(C1 = FA_MFMA(kf[5], qr[2], C1),    P1[6], P1[7], P1[8], P1[9],     pw2[2] = FT_PKW(P1, 4),  pw2[3] = FT_PKW(P1, 6),  pw2); \
    FT_VRD(3); FT_SBAR(); FT_GAPA(C0 = FA_MFMA(kf[6], qr[3], C0),    P1[10], P1[11], P1[12], P1[13], pw3[0] = FT_PKW(P1, 8),  pw3[1] = FT_PKW(P1, 10), pw3); \
    FT_VRD(7); FT_SBAR(); FT_GAPA(C1 = FA_MFMA(kf[7], qr[3], C1),    P1[14], P1[15], 0.f, 0.f,       pw3[2] = FT_PKW(P1, 12), pw3[3] = FT_PKW(P1, 14), pw3); \
    l_reg += sacc; \
    if (GK) FT_DMA_K(w3, sl_cur); if (GV) FT_DMA_V(w1, sl_next); \
    if (MASK) emask(id_, C0, C1); \
    const bool rs_ = rowsel(id_); \
    { float rmx = ft_rowmax(C0, C1); if (!rs_) rmx = -INFINITY; const float rm = rmx - mhat; resc = false; \
      if (__builtin_expect(__any(rm > THR), 0)) { const float dl = __builtin_fmaxf(rm, 0.f); mhat += dl; \
          const float f = __builtin_amdgcn_exp2f(-dl); l_reg *= f; if (hi == 0) wsf[r32] = f; resc = true; } } \
    const float nmh = rs_ ? -mhat : -INFINITY; FT_SBAR(); \
    FT_GAPB(o[0] = FA_MFMA(FT_PAF(0), FT_VFR(0), o[0]), C0, 0);              FT_GAPB(o[1] = FA_MFMA(FT_PAF(0), FT_VFR(4), o[1]), C0, 4); \
    FT_KRD(GL, 0); FT_GAPB(o[0] = FA_MFMA(FT_PAF(1), FT_VFR(1), o[0]), C0, 8);  FT_KRD(GL, 1); FT_GAPB(o[1] = FA_MFMA(FT_PAF(1), FT_VFR(5), o[1]), C0, 12); \
    FT_KRD(GL, 2); FT_GAPB(o[0] = FA_MFMA(FT_PAF(2), FT_VFR(2), o[0]), C1, 0);  FT_KRD(GL, 3); FT_GAPB(o[1] = FA_MFMA(FT_PAF(2), FT_VFR(6), o[1]), C1, 4); \
    FT_GAPB(o[0] = FA_MFMA(FT_PAF(3), FT_VFR(3), o[0]), C1, 8);              FT_GAPB(o[1] = FA_MFMA(FT_PAF(3), FT_VFR(7), o[1]), C1, 12); \
    } while (0)
    int t = 1;
    for (; t + 5 < NT; t += 2) {
        FT_STEP(pB0, pB1, pA0, pA1, t, false, true, true, true);     FT_WAIT_BAR(2); FT_RESC(); FT_ROT(); FT_SHIFT();
        FT_STEP(pA0, pA1, pB0, pB1, t + 1, false, true, true, true); FT_WAIT_BAR(2); FT_RESC(); FT_ROT(); FT_SHIFT();
    }
#define FT_ENDW(tt) do { if ((tt) + 3 < NT) { FT_WAIT_BAR(2); } else if ((tt) + 2 < NT) { FT_WAIT_BAR(1); } else { FT_WAIT_BAR(0); } } while (0)
    for (; t + 1 < NT; t += 2) {
        FT_STEP(pB0, pB1, pA0, pA1, t, true, (t + 3 < NT), (t + 1 < NT), (t + 1 < NT));         FT_ENDW(t);     FT_RESC(); FT_ROT(); FT_SHIFT();
        FT_STEP(pA0, pA1, pB0, pB1, t + 1, true, (t + 4 < NT), (t + 2 < NT), (t + 2 < NT));     FT_ENDW(t + 1); FT_RESC(); FT_ROT(); FT_SHIFT();
    }
    FT_STEP(pB0, pB1, pA0, pA1, NT - 1, true, false, false, false); FT_RESC();
    { float sacc = pB0[0] + pB0[1];
#pragma unroll
      for (int r = 2; r < 16; ++r) sacc += pB0[r];
#pragma unroll
      for (int r = 0; r < 16; ++r) sacc += pB1[r];
      l_reg += sacc;
      pw0 = (u32x4){FT_PKW(pB0, 0), FT_PKW(pB0, 2), FT_PKW(pB0, 4), FT_PKW(pB0, 6)}; pw1 = (u32x4){FT_PKW(pB0, 8), FT_PKW(pB0, 10), FT_PKW(pB0, 12), FT_PKW(pB0, 14)};
      pw2 = (u32x4){FT_PKW(pB1, 0), FT_PKW(pB1, 2), FT_PKW(pB1, 4), FT_PKW(pB1, 6)}; pw3 = (u32x4){FT_PKW(pB1, 8), FT_PKW(pB1, 10), FT_PKW(pB1, 12), FT_PKW(pB1, 14)};
      const ft_cptr vp_ = vp0 + sl_cur; _Pragma("unroll") for (int i = 0; i < 8; ++i) FT_VRD(i);
      o[0] = FA_MFMA(FT_PAF(0), FT_VFR(0), o[0]); o[1] = FA_MFMA(FT_PAF(0), FT_VFR(4), o[1]); o[0] = FA_MFMA(FT_PAF(1), FT_VFR(1), o[0]); o[1] = FA_MFMA(FT_PAF(1), FT_VFR(5), o[1]);
      o[0] = FA_MFMA(FT_PAF(2), FT_VFR(2), o[0]); o[1] = FA_MFMA(FT_PAF(2), FT_VFR(6), o[1]); o[0] = FA_MFMA(FT_PAF(3), FT_VFR(3), o[0]); o[1] = FA_MFMA(FT_PAF(3), FT_VFR(7), o[1]); }
    l_out = l_reg;
    asm volatile("s_waitcnt lgkmcnt(0)\n\ts_barrier" ::: "memory");
#undef FT_SHIFT
#undef FT_DMA_K
#undef FT_DMA_V
#undef FT_ROT
#undef FT_EX
#undef FT_RESC
#undef FT_PKW
#undef FT_PAF
#undef FT_VFR
#undef FT_VRD
#undef FT_KRD
#undef FT_ENDW
#undef FT_GAPA
#undef FT_GAPB
#undef FT_STEP
}

constexpr int M_KSLOT = 12288, M_LK = 0, M_LV = 4 * M_KSLOT, M_LWSF = M_LV + 3 * 8192, M_LOST = M_LWSF + 8 * 512, M_LEND = M_LOST + 8 * 4096;
DEV void ft_wait_bar(int n) {
    if (n == 0) asm volatile("s_waitcnt vmcnt(0) lgkmcnt(0)\n\ts_barrier" ::: "memory");
    else if (n == 1) asm volatile("s_waitcnt vmcnt(1) lgkmcnt(0)\n\ts_barrier" ::: "memory");
    else if (n == 2) asm volatile("s_waitcnt vmcnt(2) lgkmcnt(0)\n\ts_barrier" ::: "memory");
    else if (n == 3) asm volatile("s_waitcnt vmcnt(3) lgkmcnt(0)\n\ts_barrier" ::: "memory");
    else asm volatile("s_waitcnt vmcnt(5) lgkmcnt(0)\n\ts_barrier" ::: "memory");
}
DEV void fa96_tuned(f32x16 (&o)[2], float& l_out, const bf16x8 (&qr)[6], const bf16_t* Kb, const bf16_t* Vb, int NT, int qrel, LAS unsigned char* lds, LAS float* wsf, int wid, int lane, int r32, int hi) {
    constexpr int SLOTB = 8192; constexpr float THR = 8.0f;
    const unsigned lds0 = (unsigned)(uintptr_t)lds;
    const int kc = (wid < 4) ? 2 : 1;
    const bf16_t* ksrc = Kb + (size_t)lane * 768 + wid * 8;
    const bf16_t* vsrc = Vb + (size_t)(16 * (wid & 3) + (lane >> 2)) * 512 + (wid >> 2) * 32 + (lane & 3) * 8;
    const unsigned kdst = lds0 + M_LK + wid * 1024, vdst = lds0 + M_LV + wid * 1024;
#define MT_DMA_K(t) do { const unsigned sl_ = (unsigned)(((t) & 3) * M_KSLOT); ft_glds16(ksrc + (size_t)(t) * 64 * 768, (unsigned)__builtin_amdgcn_readfirstlane(kdst + sl_)); \
        if (wid < 4) ft_glds16(ksrc + (size_t)(t) * 64 * 768 + 64, (unsigned)__builtin_amdgcn_readfirstlane(kdst + 8192 + sl_)); } while (0)
#define MT_DMA_V(t, slot) ft_glds16(vsrc + (size_t)(t) * 64 * 512, (unsigned)__builtin_amdgcn_readfirstlane(vdst + (slot)))
    const ft_cptr vp0 = (ft_cptr)lds + M_LV + ((lane >> 4) & 1) * 32 + (lane & 3) * 8 + (4 * hi + ((lane & 15) >> 2)) * 64;
    const ft_cptr kp0 = (ft_cptr)lds + M_LK + hi * 1024 + r32 * 16;
#define MT_KFR(kp, f) (*(const LAS bf16x8*)((kp) + ((f) >> 1) * 2048 + ((f) & 1) * 512))
    MT_DMA_K(0); MT_DMA_V(0, 0); MT_DMA_K(1); MT_DMA_K(2);
    float mhat = 0.f, l_reg = 0.f; o[0] = f32x16{}; o[1] = f32x16{};
    const f32x16 zero16 = f32x16{};
    bool resc = false;
    f32x16 pA0, pA1, pB0, pB1; bf16x8 kf[4]; s16x4 vlo[8], vhi[8]; u32x4 pw0, pw1, pw2, pw3;
    int sl_prev = 0, sl_cur = 0, sl_next = SLOTB;
    const int band0 = NT - 4;
#define MT_ROT() do { sl_prev = sl_cur; sl_cur = sl_next; sl_next = (sl_next == 2 * SLOTB) ? 0 : sl_next + SLOTB; } while (0)
#define MT_EX(v) __builtin_amdgcn_exp2f((v) + nmh)
#define MT_RESC() do { if (resc) { _Pragma("unroll") for (int d_ = 0; d_ < 2; ++d_) _Pragma("unroll") for (int r = 0; r < 16; ++r) o[d_][r] *= wsf[crow(r, hi)]; } } while (0)
    auto cmask = [&](int t, f32x16& p0, f32x16& p1) { const int jb = t - band0; if (jb >= 0) { const int kb = 64 * jb + 4 * hi;
#pragma unroll
            for (int r = 0; r < 16; ++r) { const int kv_ = kb + (r & 3) + 8 * (r >> 2); if (kv_ > qrel) p0[r] = -INFINITY; if (kv_ + 32 > qrel) p1[r] = -INFINITY; } } };
    ft_wait_bar(kc == 2 ? 5 : 3);
    { const ft_cptr kp = kp0;
      pA0 = zero16; pA1 = zero16;
#pragma unroll
      for (int d0 = 0; d0 < 6; ++d0) { const bf16x8 k0 = MT_KFR(kp, 2 * d0), k1 = MT_KFR(kp, 2 * d0 + 1); pA0 = FA_MFMA(k0, qr[d0], pA0); pA1 = FA_MFMA(k1, qr[d0], pA1); } }
    cmask(0, pA0, pA1);
    { const float rm = ft_rowmax(pA0, pA1); mhat = rm; const float nmh = -mhat;
#pragma unroll
      for (int r = 0; r < 16; ++r) { pA0[r] = MT_EX(pA0[r]); pA1[r] = MT_EX(pA1[r]); } }
    ft_wait_bar(0);
    MT_DMA_K(3); MT_DMA_V(1, SLOTB); MT_ROT();
    { const ft_cptr kp = kp0 + M_KSLOT;
#pragma unroll
      for (int f = 0; f < 4; ++f) kf[f] = MT_KFR(kp, f); }
    ft_wait_bar(kc + 1);
#define MT_PKW(P, i) ft_cvtpk(P[i], P[i + 1])
#define MT_PAF(k) __builtin_bit_cast(bf16x8, pw##k)
#define MT_VFR(i) (bf16x8){vlo[i][0], vlo[i][1], vlo[i][2], vlo[i][3], vhi[i][0], vhi[i][1], vhi[i][2], vhi[i][3]}
#define MT_VRD(i) do { vlo[i] = ft_vtr(vp_ + (((i) >> 2) * 4096 + ((i) & 3) * 1024)); vhi[i] = ft_vtr(vp_ + (((i) >> 2) * 4096 + ((i) & 3) * 1024 + 512)); } while (0)
#define MT_GAPA(i, C, a0, a1, a2, a3, W0, W1, PW) do { C = FA_MFMA(kf[(i) & 3], qr[(i) >> 1], ((i) < 2) ? zero16 : C); if ((i) + 4 < 12) kf[(i) & 3] = MT_KFR(kp_, (i) + 4); \
        sacc += a0; sacc += a1; sacc += a2; sacc += a3; W0; W1; FT_PIN(PW); FT_PIN(sacc); FT_SBAR(); } while (0)
#define MT_GAPA0(i, C) do { C = FA_MFMA(kf[(i) & 3], qr[(i) >> 1], C); if ((i) + 4 < 12) kf[(i) & 3] = MT_KFR(kp_, (i) + 4); FT_SBAR(); } while (0)
#define MT_GAPB(MF, X, i) do { MF; X[i] = MT_EX(X[i]); X[i + 1] = MT_EX(X[i + 1]); X[i + 2] = MT_EX(X[i + 2]); X[i + 3] = MT_EX(X[i + 3]); FT_PIN(X); FT_SBAR(); } while (0)
#define MT_STEP(C0, C1, P0, P1, t, MASK, GK, GV, GL) do { FT_SBAR(); \
    const ft_cptr vp_ = vp0 + sl_prev; const ft_cptr kp_ = kp0 + ((t) & 3) * M_KSLOT; \
    MT_VRD(0); FT_SBAR(); float sacc = P0[0] + P0[1]; \
                          MT_GAPA(0, C0, P0[2], P0[3], P0[4], P0[5],     pw0[0] = MT_PKW(P0, 0),  pw0[1] = MT_PKW(P0, 2),  pw0); \
    MT_VRD(4); FT_SBAR(); MT_GAPA(1, C1, P0[6], P0[7], P0[8], P0[9],     pw0[2] = MT_PKW(P0, 4),  pw0[3] = MT_PKW(P0, 6),  pw0); \
    MT_VRD(1); FT_SBAR(); MT_GAPA(2, C0, P0[10], P0[11], P0[12], P0[13], pw1[0] = MT_PKW(P0, 8),  pw1[1] = MT_PKW(P0, 10), pw1); \
    MT_VRD(5); FT_SBAR(); MT_GAPA(3, C1, P0[14], P0[15], P1[0], P1[1],   pw1[2] = MT_PKW(P0, 12), pw1[3] = MT_PKW(P0, 14), pw1); \
    MT_VRD(2); FT_SBAR(); MT_GAPA(4, C0, P1[2], P1[3], P1[4], P1[5],     pw2[0] = MT_PKW(P1, 0),  pw2[1] = MT_PKW(P1, 2),  pw2); \
    MT_VRD(6); FT_SBAR(); MT_GAPA(5, C1, P1[6], P1[7], P1[8], P1[9],     pw2[2] = MT_PKW(P1, 4),  pw2[3] = MT_PKW(P1, 6),  pw2); \
    MT_VRD(3); FT_SBAR(); MT_GAPA(6, C0, P1[10], P1[11], P1[12], P1[13], pw3[0] = MT_PKW(P1, 8),  pw3[1] = MT_PKW(P1, 10), pw3); \
    MT_VRD(7); FT_SBAR(); MT_GAPA(7, C1, P1[14], P1[15], 0.f, 0.f,       pw3[2] = MT_PKW(P1, 12), pw3[3] = MT_PKW(P1, 14), pw3); \
    MT_GAPA0(8, C0); MT_GAPA0(9, C1); MT_GAPA0(10, C0); MT_GAPA0(11, C1); \
    l_reg += sacc; \
    if (GK) MT_DMA_K((t) + 3); if (GV) MT_DMA_V((t) + 1, sl_next); \
    if (MASK) cmask((t), C0, C1); \
    { const float rm = ft_rowmax(C0, C1) - mhat; resc = false; \
      if (__builtin_expect(__any(rm > THR), 0)) { const float dl = __builtin_fmaxf(rm, 0.f); mhat += dl; \
          const float f = __builtin_amdgcn_exp2f(-dl); l_reg *= f; if (hi == 0) wsf[r32] = f; resc = true; } } \
    const float nmh = -mhat; FT_SBAR(); \
    MT_GAPB(o[0] = FA_MFMA(MT_PAF(0), MT_VFR(0), o[0]), C0, 0);  MT_GAPB(o[1] = FA_MFMA(MT_PAF(0), MT_VFR(4), o[1]), C0, 4); \
    MT_GAPB(o[0] = FA_MFMA(MT_PAF(1), MT_VFR(1), o[0]), C0, 8);  MT_GAPB(o[1] = FA_MFMA(MT_PAF(1), MT_VFR(5), o[1]), C0, 12); \
    MT_GAPB(o[0] = FA_MFMA(MT_PAF(2), MT_VFR(2), o[0]), C1, 0);  MT_GAPB(o[1] = FA_MFMA(MT_PAF(2), MT_VFR(6), o[1]), C1, 4); \
    MT_GAPB(o[0] = FA_MFMA(MT_PAF(3), MT_VFR(3), o[0]), C1, 8);  MT_GAPB(o[1] = FA_MFMA(MT_PAF(3), MT_VFR(7), o[1]), C1, 12); \
    if (GL) { const ft_cptr kn_ = kp0 + (((t) + 1) & 3) * M_KSLOT; _Pragma("unroll") for (int f = 0; f < 4; ++f) kf[f] = MT_KFR(kn_, f); } \
    } while (0)
#define MT_ENDW(tt) do { if ((tt) + 3 < NT) ft_wait_bar(kc + 1); else if ((tt) + 2 < NT) ft_wait_bar(1); else ft_wait_bar(0); } while (0)
    int t = 1;
    for (; t + 5 < NT; t += 2) {
        MT_STEP(pB0, pB1, pA0, pA1, t, false, true, true, true);     ft_wait_bar(kc + 1); MT_RESC(); MT_ROT();
        MT_STEP(pA0, pA1, pB0, pB1, t + 1, false, true, true, true); ft_wait_bar(kc + 1); MT_RESC(); MT_ROT();
    }
    for (; t + 1 < NT; t += 2) {
        MT_STEP(pB0, pB1, pA0, pA1, t, true, (t + 3 < NT), (t + 1 < NT), (t + 1 < NT));         MT_ENDW(t);     MT_RESC(); MT_ROT();
        MT_STEP(pA0, pA1, pB0, pB1, t + 1, true, (t + 4 < NT), (t + 2 < NT), (t + 2 < NT));     MT_ENDW(t + 1); MT_RESC(); MT_ROT();
    }
    MT_STEP(pB0, pB1, pA0, pA1, NT - 1, true, false, false, false); MT_RESC();
    { float sacc = pB0[0] + pB0[1];
#pragma unroll
      for (int r = 2; r < 16; ++r) sacc += pB0[r];
#pragma unroll
      for (int r = 0; r < 16; ++r) sacc += pB1[r];
      l_reg += sacc;
      pw0 = (u32x4){MT_PKW(pB0, 0), MT_PKW(pB0, 2), MT_PKW(pB0, 4), MT_PKW(pB0, 6)}; pw1 = (u32x4){MT_PKW(pB0, 8), MT_PKW(pB0, 10), MT_PKW(pB0, 12), MT_PKW(pB0, 14)};
      pw2 = (u32x4){MT_PKW(pB1, 0), MT_PKW(pB1, 2), MT_PKW(pB1, 4), MT_PKW(pB1, 6)}; pw3 = (u32x4){MT_PKW(pB1, 8), MT_PKW(pB1, 10), MT_PKW(pB1, 12), MT_PKW(pB1, 14)};
      const ft_cptr vp_ = vp0 + sl_cur; _Pragma("unroll") for (int i = 0; i < 8; ++i) MT_VRD(i);
      o[0] = FA_MFMA(MT_PAF(0), MT_VFR(0), o[0]); o[1] = FA_MFMA(MT_PAF(0), MT_VFR(4), o[1]); o[0] = FA_MFMA(MT_PAF(1), MT_VFR(1), o[0]); o[1] = FA_MFMA(MT_PAF(1), MT_VFR(5), o[1]);
      o[0] = FA_MFMA(MT_PAF(2), MT_VFR(2), o[0]); o[1] = FA_MFMA(MT_PAF(2), MT_VFR(6), o[1]); o[0] = FA_MFMA(MT_PAF(3), MT_VFR(3), o[0]); o[1] = FA_MFMA(MT_PAF(3), MT_VFR(7), o[1]); }
    l_out = l_reg;
    asm volatile("s_waitcnt lgkmcnt(0)\n\ts_barrier" ::: "memory");
#undef MT_DMA_K
#undef MT_DMA_V
#undef MT_KFR
#undef MT_ROT
#undef MT_EX
#undef MT_RESC
#undef MT_PKW
#undef MT_PAF
#undef MT_VFR
#undef MT_VRD
#undef MT_GAPA
#undef MT_GAPA0
#undef MT_GAPB
#undef MT_STEP
#undef MT_ENDW
}
}

DEV void mla_unit(const Params& p, LAS unsigned char* lds, int b, int h, int qb) {
    using namespace fa;
    const int tid = opaque_tid(), wid = __builtin_amdgcn_readfirstlane(tid >> 6), lane = tid & 63, r32 = lane & 31, hi = lane >> 5;
    const bf16_t* QM = (const bf16_t*)(p.ws + OFF_QM); const bf16_t* Kb = (const bf16_t*)(p.ws + OFF_KM) + (size_t)b * SEQ * 768 + h * 96;
    const bf16_t* Vb = (const bf16_t*)(p.ws + OFF_VM) + (size_t)b * SEQ * 512 + h * 64; bf16_t* OCAT = (bf16_t*)(p.ws + OFF_OCAT);
    const int q0 = qb * 256, NT = (q0 + 256) / 64;
    LAS float* wsf = (LAS float*)(lds + M_LWSF) + wid * 128;
    bf16x8 qr[6];
    { const bf16_t* qrow = QM + ((size_t)b * SEQ + q0 + wid * 32 + r32) * 768 + h * 96 + hi * 8;
#pragma unroll
      for (int d0 = 0; d0 < 6; ++d0) qr[d0] = *(const bf16x8*)(qrow + d0 * 16); }
    f32x16 o[2]; float lpart;
    fa96_tuned(o, lpart, qr, Kb, Vb, NT, wid * 32 + r32, lds, wsf, wid, lane, r32, hi);
    const float l = xhalf_sum(lpart); float rl[16]; row_to_olayout(1.0f / l, rl, wsf, r32, hi);
#pragma unroll
    for (int r = 0; r < 16; ++r) { o[0][r] *= rl[r]; o[1][r] *= rl[r]; }
    store_o_rows(o, OCAT + ((size_t)b * SEQ + q0 + wid * 32) * 1024 + h * 64, 1024, lds + M_LOST + wid * 4096, lane, r32, hi);
    __syncthreads();
}
DEV void nsa_unit(const Params& p, LAS unsigned char* lds, int b, int g, int tb) {
    using namespace fa;
    const int tid = opaque_tid(), wid = __builtin_amdgcn_readfirstlane(tid >> 6), lane = tid & 63, r32 = lane & 31, hi = lane >> 5;
    const int hl = wid >> 1, head = 4 * g + hl, q0 = 64 * tb, tokl = 32 * (wid & 1) + r32, t = q0 + tokl;
    const size_t tok = (size_t)b * SEQ + t;
    const bf16_t* PROJ = (const bf16_t*)(p.ws + OFF_PROJ); const float* GATES = (const float*)(p.ws + OFF_GATES);
    LAS float* wsf = (LAS float*)(lds + L_WSF) + wid * 128;
    LAS float* impH = (LAS float*)(lds + L_IMPH);
    const int kp0 = hi * 1024 + r32 * 16;
    const int vp0 = ((lane >> 4) & 1) * 32 + (lane & 3) * 8 + (4 * hi + ((lane & 15) >> 2)) * 64;
    bf16x8 qr[4];
    { const bf16_t* qrow = (const bf16_t*)(p.ws + OFF_NQ) + tok * 512 + head * 64 + hi * 8;
#pragma unroll
      for (int d0 = 0; d0 < 4; ++d0) qr[d0] = *(const bf16x8*)(qrow + d0 * 16); }
    if (hi == 0) { const float* gp_ = GATES + tok * 24 + head * 3; wsf[64 + r32] = gp_[0]; wsf[96 + r32] = gp_[1]; }
    const float g2reg = GATES[tok * 24 + head * 3 + 2];
    { LAS f32x4* z = (LAS f32x4*)impH + tid;
#pragma unroll
      for (int i = 0; i < 8; ++i) z[i * 512] = (f32x4){0.f, 0.f, 0.f, 0.f}; }
    KVRegs<8> kv;
    f32x16 res[2];
    const int cntq = (t >= 31) ? ((t - 31) >> 4) + 1 : 0;
    const int ntc = (4 * tb + 3 + 63) >> 6;
    const bf16_t* Kc = (const bf16_t*)(p.ws + OFF_KC) + ((size_t)b * NCMPP * 2 + g) * 64; const bf16_t* Vc = (const bf16_t*)(p.ws + OFF_VC) + ((size_t)b * NCMPP * 2 + g) * 64;
    float mc = -1e30f, lc = 0.f;
    {   KVRegs<8> kc4[4];
#pragma unroll
        for (int c = 0; c < 4; ++c) if (c < ntc) stage_load<8>(kc4[c], Kc, 128, Vc, 128, c * 64, wid, lane);

#pragma unroll
        for (int c = 0; c < 4; ++c) if (c < ntc) { *(LAS u32x4*)(lds + L_K + c * 8192 + wid * 1024 + lane * 16) = kc4[c].k0; *(LAS u32x4*)(lds + L_OST + c * 8192 + wid * 1024 + lane * 16) = kc4[c].v; } }
    __syncthreads();
#pragma unroll 1
    for (int c = 0; c < ntc; ++c) {
        f32x16 p0, p1; qk_tile<4>(lds + L_K + c * 8192, kp0, qr, p0, p1);
        const int nb = 64 * c + 4 * hi;
#pragma unroll
        for (int r = 0; r < 16; ++r) { const int n = nb + (r & 3) + 8 * (r >> 2); if (n >= cntq) p0[r] = -INFINITY; if (n + 32 >= cntq) p1[r] = -INFINITY; }
        const float newm = fmaxf(mc, rowmax32(p0, p1)); float sacc = 0.f;
#pragma unroll
        for (int r = 0; r < 16; ++r) sacc += fast_exp2(p0[r] - newm) + fast_exp2(p1[r] - newm);
        lc = lc * fast_exp2(mc - newm) + sacc; mc = newm;
    }
    lc = xhalf_sum(lc);
    const float rlc = (lc > 0.f) ? 1.0f / lc : 0.f;
    float carry = 0.f;
    f32x16 oc[2];
#pragma unroll
    for (int r = 0; r < 16; ++r) { oc[0][r] = 0.f; oc[1][r] = 0.f; }
#pragma unroll 1
    for (int c = 0; c < ntc; ++c) {
        f32x16 p0, p1; qk_tile<4>(lds + L_K + c * 8192, kp0, qr, p0, p1);
        const int nb = 64 * c + 4 * hi;
#pragma unroll
        for (int r = 0; r < 16; ++r) { const int n = nb + (r & 3) + 8 * (r >> 2);
            p0[r] = (n >= cntq) ? 0.f : fast_exp2(p0[r] - mc) * rlc; p1[r] = (n + 32 >= cntq) ? 0.f : fast_exp2(p1[r] - mc) * rlc; }
        { LAS float* ih = impH + (size_t)hl * 4096 + tokl; float b0[4], b1[4];
#pragma unroll
          for (int k = 0; k < 4; ++k) { b0[k] = __shfl_xor(p0[4 * k + 3], 32); b1[k] = __shfl_xor(p1[4 * k + 3], 32); }
#pragma unroll
          for (int k = 0; k < 4; ++k) { const int j0 = 16 * c + 2 * k + hi, j1 = j0 + 8;
              const float G0 = (p0[4 * k] + p0[4 * k + 1]) + (p0[4 * k + 2] + p0[4 * k + 3]), G1 = (p1[4 * k] + p1[4 * k + 1]) + (p1[4 * k + 2] + p1[4 * k + 3]);
              const float e0 = hi ? b0[k] : (k ? b0[k > 0 ? k - 1 : 0] : carry), e1 = hi ? b1[k] : (k ? b1[k > 0 ? k - 1 : 0] : b0[3]);
              ih[j0 * 64] = G0 + e0; ih[j1 * 64] = G1 + e1; }
          carry = b1[3]; }
        u32x4 pw[4];
#pragma unroll
        for (int k = 0; k < 2; ++k) { pw[k] = (u32x4){pk2(p0[8 * k], p0[8 * k + 1]), pk2(p0[8 * k + 2], p0[8 * k + 3]), pk2(p0[8 * k + 4], p0[8 * k + 5]), pk2(p0[8 * k + 6], p0[8 * k + 7])};
            pw[2 + k] = (u32x4){pk2(p1[8 * k], p1[8 * k + 1]), pk2(p1[8 * k + 2], p1[8 * k + 3]), pk2(p1[8 * k + 4], p1[8 * k + 5]), pk2(p1[8 * k + 6], p1[8 * k + 7])}; }
        const LAS unsigned char* vbuf = lds + L_OST + c * 8192;
#pragma unroll
        for (int dh = 0; dh < 2; ++dh)
#pragma unroll
            for (int ks = 0; ks < 4; ++ks) { const s16x4 lo = vtr(vbuf + vp0 + dh * 4096 + ks * 1024), hi4 = vtr(vbuf + vp0 + dh * 4096 + ks * 1024 + 512);
                const bf16x8 vf = (bf16x8){lo[0], lo[1], lo[2], lo[3], hi4[0], hi4[1], hi4[2], hi4[3]};
                oc[dh] = FA_MFMA(__builtin_bit_cast(bf16x8, pw[ks]), vf, oc[dh]); }
    }
    __syncthreads();
    {   const int tk = tid & 63; const int cur = tb;
        float v[8];
#pragma unroll
        for (int k = 0; k < 8; ++k) { const int j = 8 * wid + k; const LAS float* q_ = impH + j * 64 + tk;
            const float s4 = ((q_[0] + q_[4096]) + q_[2 * 4096]) + q_[3 * 4096]; const bool forced = (j == 0) || (j <= cur && j > cur - 2); v[k] = forced ? 1e30f : s4; }
#pragma unroll
        for (int k = 0; k < 8; ++k) impH[(8 * wid + k) * 64 + tk] = v[k];
        __syncthreads();
        unsigned bits = 0u; int rank[8];
#pragma unroll
        for (int k = 0; k < 8; ++k) rank[k] = 0;
        if (cur >= 16)
#pragma unroll 4
        for (int q_ = 0; q_ <= cur; ++q_) { const float vq = impH[q_ * 64 + tk];
#pragma unroll
            for (int k = 0; k < 8; ++k) rank[k] += (vq > v[k] || (vq == v[k] && q_ < 8 * wid + k)) ? 1 : 0; }
#pragma unroll
        for (int k = 0; k < 8; ++k) if (8 * wid + k <= cur && rank[k] < 16) bits |= (1u << k);
        ((LAS unsigned char*)(lds + L_MASK))[tk * 8 + wid] = (unsigned char)bits;
        __syncthreads();
    }
    LAS float* resL = impH + wid * 2048 + lane;
    { float f[16]; row_to_olayout(wsf[64 + r32], f, wsf, r32, hi);
#pragma unroll
      for (int r = 0; r < 16; ++r) { resL[r * 64] = oc[0][r] * f[r]; resL[(16 + r) * 64] = oc[1][r] * f[r]; } }
    const unsigned long long mymask = *(const LAS unsigned long long*)(lds + L_MASK + tokl * 8);
    unsigned long long um;
    { const unsigned long long mm = *(const LAS unsigned long long*)(lds + L_MASK + lane * 8); unsigned ulo = (unsigned)mm, uhi = (unsigned)(mm >> 32);
#pragma unroll
      for (int o_ = 1; o_ < 64; o_ <<= 1) { ulo |= __shfl_xor(ulo, o_); uhi |= __shfl_xor(uhi, o_); }
      um = ((unsigned long long)(unsigned)__builtin_amdgcn_readfirstlane(uhi) << 32) | (unsigned)__builtin_amdgcn_readfirstlane(ulo); }
    {   const bf16_t* Kb = (const bf16_t*)(p.ws + OFF_KSR) + (size_t)b * SEQ * 128 + g * 64; const bf16_t* Vb = (const bf16_t*)(p.ws + OFF_VSC) + (size_t)b * SEQ * 128 + g * 64;
        int nt = __builtin_popcountll(um);
        while (nt < 4 || (nt & 1)) ++nt;
        f32x16 o[2]; float lpart;
        fa64_tuned<0>(o, lpart, qr, Kb, 128, Vb, 128, um, 0, nt, mymask, tb, tokl, lds, wsf, wid, lane, r32, hi);
        const float l = xhalf_sum(lpart); float f[16]; row_to_olayout(wsf[96 + r32] / l, f, wsf, r32, hi);
#pragma unroll
        for (int r = 0; r < 16; ++r) { resL[r * 64] += o[0][r] * f[r]; resL[(16 + r) * 64] += o[1][r] * f[r]; }
    }
    {   const bf16_t* Kb = (const bf16_t*)(p.ws + OFF_KWR) + (size_t)b * SEQ * 128 + g * 64; const bf16_t* Vb = (const bf16_t*)(p.ws + OFF_VWC) + (size_t)b * SEQ * 128 + g * 64;
        const int jlast = (tb - 8 > 0) ? tb - 8 : 0; int nt = tb - jlast + 1;
        while (nt < 4 || (nt & 1)) ++nt;
        f32x16 o[2]; float lpart;
        fa64_tuned<1>(o, lpart, qr, Kb, 128, Vb, 128, 0ull, jlast, nt, 0ull, tb, tokl, lds, wsf, wid, lane, r32, hi);
        const float l = xhalf_sum(lpart); float f[16]; row_to_olayout(g2reg / l, f, wsf, r32, hi);
#pragma unroll
        for (int r = 0; r < 16; ++r) { res[0][r] = resL[r * 64] + o[0][r] * f[r]; res[1][r] = resL[(16 + r) * 64] + o[1][r] * f[r]; }
        asm volatile("s_waitcnt lgkmcnt(0)" ::: "memory");
    }
    store_o_rows(res, (bf16_t*)(p.ws + OFF_OCAT) + ((size_t)b * SEQ + q0 + 32 * (wid & 1)) * 1024 + 512 + head * 64, 1024, lds + L_OST + wid * 4096, lane, r32, hi);
    __syncthreads();
}
DEV void phase5_nsa_fa(const Params& p, LAS unsigned char* lds) {
    constexpr int NU = BATCH * 2 * 64;
    const int G = gridDim.x;
    for (int r = 0; r * G < NU; ++r) {
        const int k = r * G + ((r & 1) ? (G - 1 - (int)blockIdx.x) : (int)blockIdx.x);
        if (k >= NU) continue;
        const int tb = 63 - k / 16, bg = k % 16;
        nsa_unit(p, lds, bg >> 1, bg & 1, tb);
    }
}
DEV void phase5_mla_fa(const Params& p, LAS unsigned char* lds) {
    constexpr int NU = BATCH * 8 * 16;
    const int G = gridDim.x;
    for (int r = 0; r * G < NU; ++r) {
        const int k = r * G + ((r & 1) ? (G - 1 - (int)blockIdx.x) : (int)blockIdx.x);
        if (k >= NU) continue;
        const int qb = 15 - k / 64, bh = k % 64;
        mla_unit(p, lds, bh >> 3, bh & 7, qb);
    }
}

DEV void phase5_cmp(const Params& p, LAS unsigned char* lds) {
    const int tid = opaque_tid(), hl = tid >> 7, tl = tid & 127;
    const bf16_t* NQ = (const bf16_t*)(p.ws + OFF_NQ); const bf16_t* KC = (const bf16_t*)(p.ws + OFF_KC); const bf16_t* VC = (const bf16_t*)(p.ws + OFF_VC);
    float* OCMP = (float*)(p.ws + OFF_OCMP); unsigned long long* SELM = (unsigned long long*)(p.ws + OFF_SELM);
    LAS float* imp = (LAS float*)lds;
    constexpr int NU = BATCH * 2 * (SEQ / 128);
    for (int u = blockIdx.x; u < NU; u += gridDim.x) {
        const int tb = u % (SEQ / 128), g = (u / (SEQ / 128)) & 1, b = u / (SEQ / 128 * 2);
        const int t = tb * 128 + tl, head = g * 4 + hl; const size_t tok = (size_t)b * SEQ + t;
        float q[64];
        { const bf16_t* qr = NQ + tok * 512 + head * 64;
#pragma unroll
          for (int i = 0; i < 32; ++i) { const unsigned w = *(const unsigned*)(qr + 2 * i); q[2 * i] = bflo(w); q[2 * i + 1] = bfhi(w); } }
        for (int j = 0; j < 64; ++j) imp[(hl * 64 + j) * 128 + tl] = 0.f;
        const int cnt = (t >= 31) ? ((t - 31) / 16 + 1) : 0;
        const int tmaxw = tb * 128 + (tl | 63); const int cntw = (tmaxw >= 31) ? ((tmaxw - 31) / 16 + 1) : 0;
        const bf16_t* kb = KC + ((size_t)b * NCMPP * 2 + g) * 64; const bf16_t* vb = VC + ((size_t)b * NCMPP * 2 + g) * 64;
        float m = -INFINITY, l = 0.f;
        for (int n = 0; n < cntw; ++n) { float a = 0.f;
#pragma unroll
            for (int i = 0; i < 32; ++i) { const unsigned w = *(const unsigned*)(kb + (size_t)n * 128 + 2 * i); a += q[2 * i] * bflo(w); a += q[2 * i + 1] * bfhi(w); }
            if (n < cnt) { const float mn = fmaxf(m, a); l = l * fast_exp2(m - mn) + fast_exp2(a - mn); m = mn; } }
        const float rl = (cnt > 0) ? 1.0f / l : 0.f;
        float o[64];
#pragma unroll
        for (int d = 0; d < 64; ++d) o[d] = 0.f;
        for (int n = 0; n < cntw; ++n) { float a = 0.f;
#pragma unroll
            for (int i = 0; i < 32; ++i) { const unsigned w = *(const unsigned*)(kb + (size_t)n * 128 + 2 * i); a += q[2 * i] * bflo(w); a += q[2 * i + 1] * bfhi(w); }
            const float pr = (n < cnt) ? fast_exp2(a - m) * rl : 0.f;
#pragma unroll
            for (int i = 0; i < 32; ++i) { const unsigned w = *(const unsigned*)(vb + (size_t)n * 128 + 2 * i); o[2 * i] += pr * bflo(w); o[2 * i + 1] += pr * bfhi(w); }
            const int jj = n >> 2; imp[(hl * 64 + jj) * 128 + tl] += pr; if ((n & 3) == 3 && jj + 1 < 64) imp[(hl * 64 + jj + 1) * 128 + tl] += pr; }
        { float* orow = OCMP + tok * 512 + head * 64; const float g0 = ((const float*)(p.ws + OFF_GATES))[tok * 24 + head * 3 + 0];
#pragma unroll
          for (int i = 0; i < 16; ++i) *(f32x4*)(orow + 4 * i) = (f32x4){g0 * o[4 * i], g0 * o[4 * i + 1], g0 * o[4 * i + 2], g0 * o[4 * i + 3]}; }
        __syncthreads();
        if (tid < 128) {
            const int cur = t >> 6;
            for (int j = 0; j < 64; ++j) { const float v = ((imp[(0 * 64 + j) * 128 + tl] + imp[(1 * 64 + j) * 128 + tl]) + imp[(2 * 64 + j) * 128 + tl]) + imp[(3 * 64 + j) * 128 + tl];
                const bool forced = (j == 0) || (j <= cur && j > cur - 2);
                imp[j * 128 + tl] = forced ? 1e30f : v; }
            unsigned long long mask = 0ull;
            for (int j = 0; j <= cur; ++j) { const float vj = imp[j * 128 + tl]; int rank = 0;
                for (int k = 0; k <= cur; ++k) { const float vk = imp[k * 128 + tl]; rank += (vk > vj || (vk == vj && k < j)) ? 1 : 0; }
                if (rank < 16) mask |= (1ull << j); }
            SELM[((size_t)b * 2 + g) * SEQ + t] = mask;
        }
        __syncthreads();
    }
}

DEV void phase5_selwin(const Params& p) {
    const int tid = opaque_tid(), wid = __builtin_amdgcn_readfirstlane(tid >> 6), lane = tid & 63;
    const int gw = blockIdx.x * 8 + wid, NGW = gridDim.x * 8;
    const bf16_t* NQ = (const bf16_t*)(p.ws + OFF_NQ); const bf16_t* KSR = (const bf16_t*)(p.ws + OFF_KSR); const bf16_t* KWR = (const bf16_t*)(p.ws + OFF_KWR);
    const bf16_t* PROJ = (const bf16_t*)(p.ws + OFF_PROJ); float* OCMP = (float*)(p.ws + OFF_OCMP); const float* GATES = (const float*)(p.ws + OFF_GATES);
    const unsigned long long* SELM = (const unsigned long long*)(p.ws + OFF_SELM); bf16_t* OCAT = (bf16_t*)(p.ws + OFF_OCAT);
    constexpr int NUNIT = BATCH * 8 * (SEQ / 64);
#pragma unroll 1
    for (int uu = gw; uu < NUNIT; uu += NGW) {
        const int u = (uu & 1) ? (NUNIT - 1 - (uu >> 1)) : (uu >> 1);
        const int tb = u % (SEQ / 64), head = (u / (SEQ / 64)) & 7, b = u / (SEQ / 64 * 8), g = head >> 2;
        const int t = tb * 64 + lane; const size_t tok = (size_t)b * SEQ + t;
        float q[64];
        { const bf16_t* qr = NQ + tok * 512 + head * 64;
#pragma unroll
          for (int i = 0; i < 32; ++i) { const unsigned w = *(const unsigned*)(qr + 2 * i); q[2 * i] = bflo(w); q[2 * i + 1] = bfhi(w); } }
        const unsigned long long mask = SELM[((size_t)b * 2 + g) * SEQ + t];
        unsigned ulo = (unsigned)mask, uhi = (unsigned)(mask >> 32);
#pragma unroll
        for (int o_ = 1; o_ < 64; o_ <<= 1) { ulo |= __shfl_xor(ulo, o_); uhi |= __shfl_xor(uhi, o_); }
        const unsigned long long um = ((unsigned long long)__builtin_amdgcn_readfirstlane(uhi) << 32) | (unsigned)__builtin_amdgcn_readfirstlane(ulo);
        float* oc = OCMP + tok * 512 + head * 64;
        { float o[64];
#pragma unroll
          for (int d = 0; d < 64; ++d) o[d] = 0.f;
          float m = -INFINITY, l = 0.f;
          const bf16_t* kb = KSR + (size_t)b * SEQ * 128 + g * 64; const bf16_t* vb = PROJ + (size_t)b * SEQ * INP + C_VS + g * 64;
#pragma unroll 1
          for (int blk = 0; blk <= tb; ++blk) { if (!((um >> blk) & 1ull)) continue; const bool sel = (mask >> blk) & 1ull;
              naive_attn_range<64, 64>(q, o, m, l, blk * 64, blk * 64 + 64,
                  [&](int j, int i) -> unsigned { return *(const unsigned*)(kb + (size_t)j * 128 + 2 * i); },
                  [&](int j, int i) -> unsigned { return *(const unsigned*)(vb + (size_t)j * INP + 2 * i); },
                  [&](int j) -> bool { return sel && j <= t; }); }
          const float g1 = GATES[tok * 24 + head * 3 + 1] / l;
#pragma unroll
          for (int i = 0; i < 16; ++i) { f32x4 c4 = *(f32x4*)(oc + 4 * i); c4.x += g1 * o[4 * i]; c4.y += g1 * o[4 * i + 1]; c4.z += g1 * o[4 * i + 2]; c4.w += g1 * o[4 * i + 3]; *(f32x4*)(oc + 4 * i) = c4; } }
        { float o[64];
#pragma unroll
          for (int d = 0; d < 64; ++d) o[d] = 0.f;
          float m = -INFINITY, l = 0.f;
          const bf16_t* kb = KWR + (size_t)b * SEQ * 128 + g * 64; const bf16_t* vb = PROJ + (size_t)b * SEQ * INP + C_VW + g * 64;
          const int jlo = (tb * 64 - 511 > 0) ? tb * 64 - 511 : 0;
          naive_attn_range<64, 64>(q, o, m, l, jlo, tb * 64 + 64,
              [&](int j, int i) -> unsigned { return *(const unsigned*)(kb + (size_t)j * 128 + 2 * i); },
              [&](int j, int i) -> unsigned { return *(const unsigned*)(vb + (size_t)j * INP + 2 * i); },
              [&](int j) -> bool { return j <= t && j > t - 512; });
          const float g2 = GATES[tok * 24 + head * 3 + 2] / l; bf16_t* orow = OCAT + tok * 1024 + 512 + head * 64;
#pragma unroll
          for (int i = 0; i < 16; ++i) { const f32x4 c4 = *(const f32x4*)(oc + 4 * i); u32x2 w; w.x = pk2(c4.x + g2 * o[4 * i], c4.y + g2 * o[4 * i + 1]); w.y = pk2(c4.z + g2 * o[4 * i + 2], c4.w + g2 * o[4 * i + 3]);
              *(u32x2*)(orow + 4 * i) = w; } }
    }
}

DEV void phase7(const Params& p, LAS unsigned char* lds) {
    const int tid = opaque_tid(), wid = __builtin_amdgcn_readfirstlane(tid >> 6), lane = tid & 63;
    const float* H1 = (const float*)(p.ws + OFF_H1); unsigned char* XN = p.ws + OFF_XN; float* SXTOK = (float*)(p.ws + OFF_SXTOK);
    int* TOPI = (int*)(p.ws + OFF_TOPI); float* TOPG = (float*)(p.ws + OFF_TOPG); int* POS = (int*)(p.ws + OFF_POS); unsigned* CNT = (unsigned*)(p.ws + OFF_CNT);
    LAS float* xt = (LAS float*)lds;
    LAS float* part = (LAS float*)(lds + 16 * 1028 * 4);
    LAS unsigned* lcnt = (LAS unsigned*)(lds + 16 * 1028 * 4 + 16384);
    const int ej = lane & 15, kq = lane >> 4, k0_ = 128 * wid + 32 * kq;
    float rw0[32], rw1[32];
#pragma unroll
    for (int i = 0; i < 32; ++i) { rw0[i] = p.router_w[(size_t)(k0_ + i) * 32 + ej]; rw1[i] = p.router_w[(size_t)(k0_ + i) * 32 + 16 + ej]; }
    const f32x4* gr = (const f32x4*)p.ffn_norm + lane;
    f32x4 gg[4];
#pragma unroll
    for (int j = 0; j < 4; ++j) gg[j] = gr[64 * j];
    for (int ch = blockIdx.x; ch < NTOK / 128; ch += gridDim.x) {
        if (tid < 32) lcnt[tid] = 0u;
        f32x4 nx[2][4];
#pragma unroll
        for (int rr = 0; rr < 2; ++rr) { const f32x4* xr = (const f32x4*)(H1 + (size_t)(ch * 128 + 2 * wid + rr) * DM) + lane;
#pragma unroll
            for (int j = 0; j < 4; ++j) nx[rr][j] = xr[64 * j]; }
        __syncthreads();
#pragma unroll 1
        for (int sub = 0; sub < 8; ++sub) {
            const int tok0 = ch * 128 + sub * 16;
#pragma unroll
            for (int rr = 0; rr < 2; ++rr) { const int row = 2 * wid + rr, tok = tok0 + row;
                f32x4 v[4]; float s_ = 0.f;
#pragma unroll
                for (int j = 0; j < 4; ++j) { v[j] = nx[rr][j]; s_ += (v[j].x * v[j].x + v[j].y * v[j].y) + (v[j].z * v[j].z + v[j].w * v[j].w); }
                if (sub + 1 < 8) { const f32x4* xr = (const f32x4*)(H1 + (size_t)(tok + 16) * DM) + lane;
#pragma unroll
                    for (int j = 0; j < 4; ++j) nx[rr][j] = xr[64 * j]; }
                const float rstd = rsqrtf(wave_sum(s_) * (1.f / 1024.f) + 1e-5f);
                float amax = 0.f;
#pragma unroll
                for (int j = 0; j < 4; ++j) { v[j].x *= rstd * gg[j].x; v[j].y *= rstd * gg[j].y; v[j].z *= rstd * gg[j].z; v[j].w *= rstd * gg[j].w;
                    amax = fmaxf(fmaxf(amax, fmaxf(fabsf(v[j].x), fabsf(v[j].y))), fmaxf(fabsf(v[j].z), fabsf(v[j].w))); *(LAS f32x4*)(xt + row * 1028 + 256 * j + 4 * lane) = v[j]; }
#pragma unroll
                for (int o_ = 1; o_ < 64; o_ <<= 1) amax = fmaxf(amax, __shfl_xor(amax, o_));
                amax = fmaxf(amax, 1e-30f); const float qinv = 127.0f / amax; if (lane == 0) SXTOK[tok] = amax * (1.0f / 127.0f);
                unsigned* o4 = (unsigned*)(XN + (size_t)tok * DM) + lane;
#pragma unroll
                for (int j = 0; j < 4; ++j) { const unsigned q0 = (unsigned)__float2int_rn(v[j].x * qinv) & 255u, q1 = (unsigned)__float2int_rn(v[j].y * qinv) & 255u, q2 = (unsigned)__float2int_rn(v[j].z * qinv) & 255u, q3 = (unsigned)__float2int_rn(v[j].w * qinv) & 255u;
                    o4[64 * j] = q0 | (q1 << 8) | (q2 << 16) | (q3 << 24); } }
            __syncthreads();
            { f32x4 acc0 = (f32x4){0.f, 0.f, 0.f, 0.f}, acc1 = acc0; const LAS float* xrow = xt + ej * 1028 + k0_;
#pragma unroll
              for (int s4 = 0; s4 < 8; ++s4) { const f32x4 xv = *(const LAS f32x4*)(xrow + 4 * s4);
#pragma unroll
                  for (int i = 0; i < 4; ++i) { acc0 = __builtin_amdgcn_mfma_f32_16x16x4f32(xv[i], rw0[4 * s4 + i], acc0, 0, 0, 0); acc1 = __builtin_amdgcn_mfma_f32_16x16x4f32(xv[i], rw1[4 * s4 + i], acc1, 0, 0, 0); } }
#pragma unroll
              for (int r = 0; r < 4; ++r) { part[(wid * 16 + 4 * kq + r) * 32 + ej] = acc0[r]; part[(wid * 16 + 4 * kq + r) * 32 + 16 + ej] = acc1[r]; } }
            __syncthreads();
            { const int tk = tid >> 5, e = tid & 31, tok = tok0 + tk; float logit = p.router_b[e];
#pragma unroll
              for (int w_ = 0; w_ < 8; ++w_) logit += part[(w_ * 16 + tk) * 32 + e];
              int ti[4]; float tv[4]; float cur = logit;
#pragma unroll
              for (int r = 0; r < 4; ++r) { float bv = cur; int bi = e;
#pragma unroll
                  for (int o_ = 1; o_ < 32; o_ <<= 1) { const float ov = __shfl_xor(bv, o_); const int oi = __shfl_xor(bi, o_); if (ov > bv || (ov == bv && oi < bi)) { bv = ov; bi = oi; } }
                  ti[r] = bi; tv[r] = bv; if (e == bi) cur = -INFINITY; }
              const float e1 = __expf(tv[1] - tv[0]), e2 = __expf(tv[2] - tv[0]), e3 = __expf(tv[3] - tv[0]); const float inv = 1.0f / (1.0f + e1 + e2 + e3);
              if (e == 0) {
                  *(f32x4*)(TOPG + (size_t)tok * 4) = (f32x4){inv, e1 * inv, e2 * inv, e3 * inv};
                  int ps[4];
#pragma unroll
                  for (int r = 0; r < 4; ++r) ps[r] = (int)__hip_atomic_fetch_add(&lcnt[ti[r]], 1u, __ATOMIC_RELAXED, __HIP_MEMORY_SCOPE_WORKGROUP);
                  int* ti_o = TOPI + (size_t)tok * 4; int* ps_o = POS + (size_t)tok * 4;
#pragma unroll
                  for (int r = 0; r < 4; ++r) { ti_o[r] = ti[r]; ps_o[r] = ps[r]; }
              } }
            __syncthreads();
        }
        if (tid < 32) lcnt[32 + tid] = atomicAdd(&CNT[tid], lcnt[tid]);
        __syncthreads();
        if (tid < 128) { const int tok = ch * 128 + tid; const int* ti_o = TOPI + (size_t)tok * 4; int* ps_o = POS + (size_t)tok * 4;
#pragma unroll
            for (int r = 0; r < 4; ++r) ps_o[r] += (int)lcnt[32 + ti_o[r]]; }
        __syncthreads();
    }
}

DEV void moe_offsets(const Params& p, LAS unsigned* tab) {
    const unsigned* CNT = (const unsigned*)(p.ws + OFF_CNT);
    const int tid = opaque_tid();
    if (tid < 64) {
        const int e = tid & 31; const unsigned c = __hip_atomic_load(&CNT[e], __ATOMIC_RELAXED, __HIP_MEMORY_SCOPE_AGENT);
        const unsigned pad = ((c + 255u) >> 8) << 8; unsigned inc = pad;
#pragma unroll
        for (int o_ = 1; o_ < 32; o_ <<= 1) { const unsigned v = __shfl_up(inc, o_, 32); if (e >= o_) inc += v; }
        if (tid < 32) { tab[e] = inc - pad; tab[32 + e] = inc >> 8; if (e == 31) tab[64] = inc; }
    }
    __syncthreads();
}
typedef int i32x4_ __attribute__((ext_vector_type(4)));
DEV void phase8(const Params& p, LAS unsigned char* lds) {
    const int tid = opaque_tid();
    LAS unsigned* tab = (LAS unsigned*)lds; moe_offsets(p, tab);
    const int* TOPI = (const int*)(p.ws + OFF_TOPI); const float* TOPG = (const float*)(p.ws + OFF_TOPG); int* POS = (int*)(p.ws + OFF_POS); float* RG = (float*)(p.ws + OFF_ROWGATE);
    const float* SXTOK = (const float*)(p.ws + OFF_SXTOK); float* SXROW = (float*)(p.ws + OFF_SXROW); int* ROWTOK = (int*)(p.ws + OFF_ROWTOK); const unsigned* CNT = (const unsigned*)(p.ws + OFF_CNT);
    for (int id = blockIdx.x * 512 + tid; id < NTOK * 4; id += gridDim.x * 512) { const int tok = id >> 2;
        const int e = TOPI[id]; const int slot = (int)tab[e] + POS[id];
        ROWTOK[slot] = tok; RG[slot] = TOPG[id]; SXROW[slot] = SXTOK[tok]; POS[id] = slot; }
    if (blockIdx.x < NEXP) { const int e = blockIdx.x; const int beg = (int)tab[e] + (int)__hip_atomic_load(&CNT[e], __ATOMIC_RELAXED, __HIP_MEMORY_SCOPE_AGENT), end = (int)tab[32 + e] * 256;
        for (int s_ = beg + tid; s_ < end; s_ += 512) ROWTOK[s_] = 0; }
}

DEV void phase11(const Params& p) {
    const int tid = opaque_tid(), wid = tid >> 6, lane = tid & 63;
    const int gw = blockIdx.x * 8 + wid, NGW = gridDim.x * 8;
    const float* H1 = (const float*)(p.ws + OFF_H1); const bf16_t* Y = (const bf16_t*)(p.ws + OFF_Y); const int* POS = (const int*)(p.ws + OFF_POS);
    const f32x4* gr = (const f32x4*)p.final_norm + lane; f32x4 gg[4];
#pragma unroll
    for (int j = 0; j < 4; ++j) gg[j] = gr[64 * j];
    i32x4_ slot[2];
#pragma unroll
    for (int q = 0; q < 2; ++q) { const int t0 = 2 * gw + q; slot[q] = *(const i32x4_*)(POS + (size_t)(t0 < NTOK ? t0 : 0) * 4); }
#pragma unroll 1
    for (int tok2 = gw * 2; tok2 < NTOK; tok2 += NGW * 2) {
        f32x4 v[2][4]; u32x2 y[2][4][4];
#pragma unroll
        for (int q = 0; q < 2; ++q) { const f32x4* xr = (const f32x4*)(H1 + (size_t)(tok2 + q) * DM) + lane;
#pragma unroll
            for (int j = 0; j < 4; ++j) v[q][j] = xr[64 * j];
#pragma unroll
            for (int r = 0; r < 4; ++r) { const u32x2* yr = (const u32x2*)(Y + (size_t)slot[q][r] * DM) + lane;
#pragma unroll
                for (int j = 0; j < 4; ++j) y[q][r][j] = yr[64 * j]; } }
        i32x4_ nslot[2];
#pragma unroll
        for (int q = 0; q < 2; ++q) { const int t1 = tok2 + NGW * 2 + q; nslot[q] = *(const i32x4_*)(POS + (size_t)(t1 < NTOK ? t1 : 0) * 4); }
#pragma unroll
        for (int q = 0; q < 2; ++q) {
#pragma unroll
            for (int r = 0; r < 4; ++r)
#pragma unroll
                for (int j = 0; j < 4; ++j) { const u32x2 w = y[q][r][j]; v[q][j].x += bflo(w.x); v[q][j].y += bfhi(w.x); v[q][j].z += bflo(w.y); v[q][j].w += bfhi(w.y); }
            float s = 0.f;
#pragma unroll
            for (int j = 0; j < 4; ++j) s += (v[q][j].x * v[q][j].x + v[q][j].y * v[q][j].y) + (v[q][j].z * v[q][j].z + v[q][j].w * v[q][j].w);
            const float rstd = rsqrtf(wave_sum(s) * (1.f / 1024.f) + 1e-5f);
            f32x4* orow = (f32x4*)(p.out + (size_t)(tok2 + q) * DM) + lane;
#pragma unroll
            for (int j = 0; j < 4; ++j) orow[64 * j] = (f32x4){v[q][j].x * rstd * gg[j].x, v[q][j].y * rstd * gg[j].y, v[q][j].z * rstd * gg[j].z, v[q][j].w * rstd * gg[j].w}; }
        slot[0] = nslot[0]; slot[1] = nslot[1];
    }
}

constexpr int NPHASE = 14;
constexpr int LDS_BYTES = 163840;
template <int PH> DEV void run_phase(const Params& p, LAS unsigned char* lds) {
    using namespace pg8;
    const int G = gridDim.x, bid = blockIdx.x;
    if constexpr (PH == 0) phase0(p, lds);
    if constexpr (PH == 1) { Gemm g{1024, 0}; DenseOrder S; S.init(p.ws + OFF_U, p.ws + OFF_WINT, 1024, NTOK, INP, G, bid);
        EpiProj E{p.pos, p.q_norm, p.kv_norm, (bf16_t*)(p.ws + OFF_QN), (bf16_t*)(p.ws + OFF_KVN), (bf16_t*)(p.ws + OFF_KM), (bf16_t*)(p.ws + OFF_NQ), (bf16_t*)(p.ws + OFF_KSR), (bf16_t*)(p.ws + OFF_KWR),
                  (bf16_t*)(p.ws + OFF_KCC), (bf16_t*)(p.ws + OFF_VCC), (bf16_t*)(p.ws + OFF_VSC), (bf16_t*)(p.ws + OFF_VWC), (float*)(p.ws + OFF_GATES), (float*)(p.ws + OFF_ROPEM), (LAS float*)(lds + STAGE_BYTES + 1024)};
        gemm_phase(lds, g, S, E);
        const int rem = S.nwg % G;
        if (rem > 0 && rem < G) { if (bid >= rem) prep_w2_items(p, lds, (bid - rem) * 8, (G - rem) * 8); } else prep_w2_items(p, lds, bid * 8, G * 8);
    }
    if constexpr (PH == 2) phase2(p);
    if constexpr (PH == 3) {
        const int NC = (G >= 64) ? 32 : 0;
        if (bid < NC) { Gemm g{2048, 1}; CmpOrder S{(const char*)(p.ws + OFF_KCC), (const char*)(p.ws + OFF_VCC), (const char*)(p.ws + OFF_CW1T), bid};
            EpiCmp E{(const float*)(p.ws + OFF_CB), p.cmp_w2, p.pos, (bf16_t*)(p.ws + OFF_KC), (bf16_t*)(p.ws + OFF_VC)}; gemm_phase(lds, g, S, E); }
        else {
            { Gemm g{256, 0}; UpOrder S; S.q.init(p.ws + OFF_QN, p.ws + OFF_WQUPT, 256, NTOK, 768, 1, 0); S.kv.init(p.ws + OFF_KVN, p.ws + OFF_WKVUPT, 256, NTOK, 1024, 1, 0); S.G = G - NC; S.c = bid - NC;
              EpiUp E{EpiQup{(bf16_t*)(p.ws + OFF_QM), (const float*)(p.ws + OFF_ROPEM)}, EpiKvup{(bf16_t*)(p.ws + OFF_KM), (bf16_t*)(p.ws + OFF_VM)}}; gemm_phase(lds, g, S, E); }
        }
        if (NC == 0) for (int k = bid; k < 32; k += G) { Gemm g{2048, 1}; CmpOrder S{(const char*)(p.ws + OFF_KCC), (const char*)(p.ws + OFF_VCC), (const char*)(p.ws + OFF_CW1T), k};
            EpiCmp E{(const float*)(p.ws + OFF_CB), p.cmp_w2, p.pos, (bf16_t*)(p.ws + OFF_KC), (bf16_t*)(p.ws + OFF_VC)}; gemm_phase(lds, g, S, E); }
        prep_w1_items(p, lds);
    }
    if constexpr (PH == 5) phase5_mla_fa(p, lds);
    if constexpr (PH == 6) phase5_nsa_fa(p, lds);
    if constexpr (PH == 8) { Gemm g{1024, 0}; DenseOrder S; S.init(p.ws + OFF_OCAT, p.ws + OFF_WOUTT, 1024, NTOK, 1024, G, bid);
        EpiResF32 E{p.x, (float*)(p.ws + OFF_H1), 1024}; gemm_phase(lds, g, S, E); }
    if constexpr (PH == 9) phase7(p, lds);
    if constexpr (PH == 10) phase8(p, lds);
    if constexpr (PH == 11) { LAS unsigned* tab = (LAS unsigned*)(lds + STAGE_BYTES); moe_offsets(p, tab);
        MoeOrder S; S.d.init(p.ws + OFF_XN, p.ws + OFF_W1T, 512, (int)tab[64], 2048, G, bid); S.tend = tab + 32; S.nNt = 8; S.gatherA = true;
        LAS int* rt = (LAS int*)(lds + STAGE_BYTES + 2048);
        { const int* ROWTOK = (const int*)(p.ws + OFF_ROWTOK); const int tid_ = opaque_tid(); Unit u_;
          for (int i = 0; S.next(i, u_); ++i) if (tid_ < 256) rt[i * 256 + tid_] = ROWTOK[u_.pm * 256 + tid_];
          __syncthreads(); }
        Gemm g{512, 2, rt};
        EpiMoe1 E{(bf16_t*)(p.ws + OFF_HMID), p.moe_b1, (const float*)(p.ws + OFF_SW1), (const float*)(p.ws + OFF_SXROW)}; gemm_phase<EpiMoe1, MoeOrder, true>(lds, g, S, E); }
    if constexpr (PH == 12) { LAS unsigned* tab = (LAS unsigned*)(lds + STAGE_BYTES); moe_offsets(p, tab);
        Gemm g{1024, 0}; MoeOrder S; S.d.init(p.ws + OFF_HMID, p.ws + OFF_W2T, 1024, (int)tab[64], 1024, G, bid); S.tend = tab + 32; S.nNt = 4;
        EpiMoe2 E{(bf16_t*)(p.ws + OFF_Y), p.moe_b2, (const float*)(p.ws + OFF_ROWGATE)}; gemm_phase(lds, g, S, E); }
    if constexpr (PH == 13) phase11(p);
}

template <int PH> __global__ void __launch_bounds__(512) phase_kernel(Params p) {
    extern __shared__ __attribute__((aligned(16))) unsigned char smem[];
    run_phase<PH>(p, (LAS unsigned char*)smem);
}

#if MK_ONE_LAUNCH
__global__ void __launch_bounds__(512) mega_kernel(Params p) {
    extern __shared__ __attribute__((aligned(16))) unsigned char smem[];
    LAS unsigned char* lds = (LAS unsigned char*)smem;
    cg::grid_group grid = cg::this_grid();
    volatile LAS unsigned* st = (volatile LAS unsigned*)(lds + LDS_BYTES - 16);
    if (threadIdx.x == 0) { st[0] = 0u; st[1] = 0u; }
    __syncthreads();
    const XcdBarrier xb = xcd_barrier_post((unsigned*)(p.ws + OFF_BAR), st);
#define GSYNC() xcd_barrier(xb)
    if (p.ws == nullptr) grid.sync();
    run_phase<0>(p, lds); GSYNC();
    run_phase<1>(p, lds); GSYNC();
    run_phase<3>(p, lds); GSYNC();
    run_phase<5>(p, lds); run_phase<6>(p, lds); GSYNC();
    run_phase<8>(p, lds); GSYNC();
    run_phase<9>(p, lds); GSYNC();
    run_phase<10>(p, lds); GSYNC();
    run_phase<11>(p, lds); GSYNC();
    run_phase<12>(p, lds); GSYNC();
    run_phase<13>(p, lds);
}
#endif

template <int PH> static void launch_phase(const Params& p, int grid, hipStream_t stream) {
    static bool attr = false;
    if (!attr) { (void)hipFuncSetAttribute((const void*)phase_kernel<PH>, hipFuncAttributeMaxDynamicSharedMemorySize, LDS_BYTES); attr = true; }
    hipLaunchKernelGGL(phase_kernel<PH>, dim3(grid), dim3(512), LDS_BYTES, stream, p);
}

extern "C" void kernel_launch(void* const* d_in, const int* in_sizes, int n_in, void* d_out, int out_size, void* d_ws, size_t ws_size, hipStream_t stream) {
    static int grid = 0;
    if (grid == 0) {
        if (n_in != 20 || out_size != NTOK * DM || ws_size < WS_END) { fprintf(stderr, "kernel_launch: unexpected shapes (n_in %d, out %d, ws %zu < %zu)\n", n_in, out_size, ws_size, (size_t)WS_END); grid = -1; return; }
        int dev = 0, cus = 0, per_cu = 0;
        (void)hipGetDevice(&dev); (void)hipDeviceGetAttribute(&cus, hipDeviceAttributeMultiprocessorCount, dev);
#if MK_ONE_LAUNCH
        (void)hipFuncSetAttribute((const void*)mega_kernel, hipFuncAttributeMaxDynamicSharedMemorySize, LDS_BYTES);
        (void)hipOccupancyMaxActiveBlocksPerMultiprocessor(&per_cu, (const void*)mega_kernel, 512, LDS_BYTES);
        if (per_cu < 1) { fprintf(stderr, "kernel_launch: occupancy query says %d blocks per CU\n", per_cu); per_cu = 1; }
#endif
        (void)hipGetLastError();
        grid = cus * 1;
        if (grid <= 0) grid = 256;
    }
    if (grid < 0) return;
    Params p; memset(&p, 0, sizeof(p));
    p.x = (const float*)d_in[0]; p.pos = (const int*)d_in[1]; p.attn_norm = (const float*)d_in[2]; p.w_in = (const float*)d_in[3]; p.q_norm = (const float*)d_in[4];
    p.w_q_up = (const float*)d_in[5]; p.kv_norm = (const float*)d_in[6]; p.w_kv_up = (const float*)d_in[7]; p.cmp_pos = (const float*)d_in[8]; p.cmp_w1 = (const float*)d_in[9];
    p.cmp_w2 = (const float*)d_in[10]; p.w_out = (const float*)d_in[11]; p.ffn_norm = (const float*)d_in[12]; p.router_w = (const float*)d_in[13]; p.router_b = (const float*)d_in[14];
    p.moe_w1 = (const float*)d_in[15]; p.moe_b1 = (const float*)d_in[16]; p.moe_w2 = (const float*)d_in[17]; p.moe_b2 = (const float*)d_in[18]; p.final_norm = (const float*)d_in[19];
    p.out = (float*)d_out; p.ws = (unsigned char*)d_ws;
#if MK_ONE_LAUNCH
    (void)hipMemsetAsync((unsigned char*)d_ws + OFF_BAR, 0, XCD_BAR_WORDS * 4, stream);
    void* args[] = {&p};
    hipError_t e = hipLaunchCooperativeKernel((const void*)mega_kernel, dim3(grid), dim3(512), args, LDS_BYTES, stream);
    if (e != hipSuccess) fprintf(stderr, "cooperative launch failed: %s (grid %d)\n", hipGetErrorString(e), grid);
#else
    launch_phase<0>(p, grid, stream); launch_phase<1>(p, grid, stream); launch_phase<2>(p, grid, stream); launch_phase<3>(p, grid, stream); launch_phase<4>(p, grid, stream);
    launch_phase<5>(p, grid, stream); launch_phase<6>(p, grid, stream); launch_phase<7>(p, grid, stream); launch_phase<8>(p, grid, stream); launch_phase<9>(p, grid, stream);
    launch_phase<10>(p, grid, stream); launch_phase<11>(p, grid, stream); launch_phase<12>(p, grid, stream); launch_phase<13>(p, grid, stream);
#endif
}
```

```cpp
#include <hip/hip_runtime.h>
#include <hip/hip_cooperative_groups.h>
#include <cstdint>
#include <cstdio>
#include <cstring>
namespace cg = cooperative_groups;

#ifndef MK_ONE_LAUNCH
#define MK_ONE_LAUNCH 1
#endif

#define LAS __attribute__((address_space(3)))
#define DEV __device__ __forceinline__
typedef unsigned short bf16_t;
typedef short bf16x8 __attribute__((ext_vector_type(8)));
typedef float f32x4 __attribute__((ext_vector_type(4)));
typedef float f32x2 __attribute__((ext_vector_type(2)));
typedef unsigned u32x4 __attribute__((ext_vector_type(4)));
typedef unsigned u32x2 __attribute__((ext_vector_type(2)));

constexpr int BATCH = 8, SEQ = 4096, NTOK = BATCH * SEQ, DM = 1024;
constexpr int INC = 1720, INP = 1792;
constexpr int C_QLAT = 0, C_KVLAT = 256, C_KPE = 384, C_QNSA = 416, C_KC = 928, C_VC = 1056, C_KS = 1184, C_VS = 1312, C_KW = 1440, C_VW = 1568, C_G = 1696;
constexpr int NEXP = 32, TOPK = 4, DFF = 1024;
constexpr int NCMP = 255, NCMPP = 256;
constexpr int MAXROWS = 139264;
constexpr float LOG2E = 1.4426950408889634f;
constexpr float MLA_QSCALE = 0.10206207261596577f * LOG2E;
constexpr float NSA_QSCALE = 0.125f * LOG2E;

constexpr size_t MiB = 1ull << 20;
constexpr size_t OFF_W1T = 0;
constexpr size_t OFF_W2T = 128 * MiB;
constexpr size_t OFF_WINT = 192 * MiB;
constexpr size_t OFF_WQUPT = 196 * MiB;
constexpr size_t OFF_WKVUPT = 197 * MiB;
constexpr size_t OFF_WOUTT = 198 * MiB;
constexpr size_t OFF_CW1T = 200 * MiB;
constexpr size_t OFF_MISC = 202 * MiB;
constexpr size_t OFF_CB = OFF_MISC + 8192;
constexpr size_t OFF_CNT = OFF_MISC + 4096;
constexpr size_t OFF_BAR = OFF_MISC + 16384;
constexpr size_t OFF_TOPI = OFF_MISC + 64 * 1024;
constexpr size_t OFF_TOPG = OFF_TOPI + (size_t)NTOK * 16;
constexpr size_t OFF_POS = OFF_TOPG + (size_t)NTOK * 16;
constexpr size_t OFF_ROWGATE = OFF_POS + (size_t)NTOK * 16;
constexpr size_t OFF_SXROW = OFF_ROWGATE + (size_t)MAXROWS * 4;
constexpr size_t OFF_SXTOK = OFF_SXROW + (size_t)MAXROWS * 4;
constexpr size_t OFF_ROWTOK = OFF_SXTOK + (size_t)NTOK * 4;
constexpr size_t OFF_SW1 = OFF_ROWTOK + (size_t)MAXROWS * 4;
constexpr size_t OFF_H1 = 206 * MiB;
constexpr size_t OFF_R1 = 334 * MiB;
constexpr size_t OFF_R2 = 606 * MiB;
constexpr size_t WS_END = 878 * MiB;
constexpr size_t OFF_U = OFF_R1;
constexpr size_t OFF_QM = OFF_R1;
constexpr size_t OFF_OCAT = OFF_R1 + 64 * MiB;
constexpr size_t OFF_OCMP = OFF_R1 + 160 * MiB;
constexpr size_t OFF_KCC = OFF_R1 + 128 * MiB;
constexpr size_t OFF_VCC = OFF_R1 + 136 * MiB;
constexpr size_t OFF_VSC = OFF_R1 + 144 * MiB;
constexpr size_t OFF_VWC = OFF_R1 + 152 * MiB;
constexpr size_t OFF_SELM = OFF_R1 + 240 * MiB;
constexpr size_t OFF_KC = OFF_R1 + 241 * MiB;
constexpr size_t OFF_VC = OFF_R1 + 242 * MiB;
constexpr size_t OFF_GATES = OFF_R1 + 243 * MiB;
constexpr size_t OFF_ROPEM = OFF_R1 + 246 * MiB;
constexpr size_t OFF_KSR = OFF_R1 + 250 * MiB;
constexpr size_t OFF_KWR = OFF_R1 + 258 * MiB;
constexpr size_t OFF_PROJ = OFF_R2;
constexpr size_t OFF_NQ = OFF_R2 + 112 * MiB;
constexpr size_t OFF_QN = OFF_R2 + 144 * MiB;
constexpr size_t OFF_KVN = OFF_R2 + 160 * MiB;
constexpr size_t OFF_KM = OFF_R2 + 176 * MiB;
constexpr size_t OFF_VM = OFF_R2 + 224 * MiB;
constexpr size_t OFF_QUP = OFF_R2 + 256 * MiB;
constexpr size_t OFF_KVUP = OFF_R2 + 256 * MiB;
constexpr size_t OFF_KPE = OFF_R2 + 256 * MiB;
constexpr size_t OFF_XN = OFF_R1 + 0;
constexpr size_t OFF_XG = OFF_R1;
constexpr size_t OFF_Y = OFF_R1;
constexpr size_t OFF_HMID = OFF_R2;

struct Params {
    const float* x; const int* pos; const float* attn_norm; const float* w_in; const float* q_norm; const float* w_q_up; const float* kv_norm; const float* w_kv_up;
    const float* cmp_pos; const float* cmp_w1; const float* cmp_w2; const float* w_out; const float* ffn_norm; const float* router_w; const float* router_b;
    const float* moe_w1; const float* moe_b1; const float* moe_w2; const float* moe_b2; const float* final_norm;
    float* out; unsigned char* ws;
};

DEV float bf2f(bf16_t b) { return __uint_as_float((unsigned)b << 16); }
DEV float bflo(unsigned u) { return __uint_as_float(u << 16); }
DEV float bfhi(unsigned u) { return __uint_as_float(u & 0xffff0000u); }
DEV unsigned pk2(float lo, float hi) { unsigned r; asm volatile("v_cvt_pk_bf16_f32 %0, %1, %2" : "=v"(r) : "v"(lo), "v"(hi)); return r; }
DEV bf16_t f2bf(float f) { return (bf16_t)(pk2(f, 0.f) & 0xffffu); }
DEV float wave_sum(float v) {
#pragma unroll
    for (int o = 1; o < 64; o <<= 1) v += __shfl_xor(v, o);
    return v;
}
DEV float fast_exp2(float x) { return __builtin_amdgcn_exp2f(x); }
DEV int opaque_tid() { int t = threadIdx.x; asm volatile("" : "+v"(t)); return t; }

#define XB_TMO      128
#define XB_XCNT(j)  (256  + 64 * (j))
#define XB_XSUB(j)  (1280 + 64 * (j))
#define XB_XGEN(j)  (2304 + 64 * (j))
#define XB_TOP      3328
#define XB_TOPGEN   3392
#define XCD_BAR_WORDS 3456
#define XB_SPIN_CAP (1u << 22)
DEV unsigned xb_ld(unsigned* p) { return __hip_atomic_load(p, __ATOMIC_RELAXED, __HIP_MEMORY_SCOPE_AGENT); }
DEV unsigned xb_add(unsigned* p, unsigned v) { return __hip_atomic_fetch_add(p, v, __ATOMIC_RELAXED, __HIP_MEMORY_SCOPE_AGENT); }
DEV unsigned xb_xcc_id() { return (unsigned)__builtin_amdgcn_s_getreg((3 << 11) | 20) & 0xFu; }
#define XB_SPIN(cond, bar) do { unsigned _sp = 0; while (cond) { __builtin_amdgcn_s_sleep(1); \
    if ((++_sp & 255u) == 0u) { if (xb_ld(&(bar)[XB_TMO])) break; if (_sp > XB_SPIN_CAP) { atomicAdd(&(bar)[XB_TMO], 1u); break; } } } } while (0)
struct XcdBarrier { unsigned* bar; unsigned x; volatile LAS unsigned* st; };
DEV XcdBarrier xcd_barrier_post(unsigned* bar, volatile LAS unsigned* st) {
    XcdBarrier b; b.bar = bar; b.x = xb_xcc_id(); b.st = st;
    if (threadIdx.x == 0) (void)xb_add(&bar[XB_XCNT(b.x)], 1u);
    return b;
}
DEV void xcd_barrier_complete(unsigned* bar, unsigned x, unsigned& nloc, unsigned& nx) {
    const unsigned G = gridDim.x * gridDim.y * gridDim.z;
    unsigned sum, cnt, mine, sp = 0u;
    for (;;) {
        sum = 0u; cnt = 0u; mine = 0u;
#pragma unroll
        for (unsigned j = 0; j < 16; ++j) { const unsigned c = xb_ld(&bar[XB_XCNT(j)]); sum += c; cnt += (c > 0u) ? 1u : 0u; mine = (j == x) ? c : mine; }
        if (sum == G) break;
        __builtin_amdgcn_s_sleep(1);
        if ((++sp & 255u) == 0u) { if (xb_ld(&bar[XB_TMO])) break; if (sp > XB_SPIN_CAP) { atomicAdd(&bar[XB_TMO], 1u); break; } }
    }
    nloc = mine > 0u ? mine : 1u; nx = cnt > 0u ? cnt : 1u;
}
DEV void xcd_barrier(const XcdBarrier& b) {
    asm volatile("s_waitcnt vmcnt(0)" ::: "memory");
    __syncthreads();
    if (threadIdx.x == 0) {
        unsigned* bar = b.bar;
        __builtin_amdgcn_s_waitcnt(0);
        unsigned nloc = b.st[0], nx = b.st[1];
        if (nloc == 0u) { xcd_barrier_complete(bar, b.x, nloc, nx); b.st[0] = nloc; b.st[1] = nx; }
        const unsigned old = xb_add(&bar[XB_XSUB(b.x)], 1u);
        const unsigned gen = old / nloc;
        if (old + 1u == (gen + 1u) * nloc) {
            __builtin_amdgcn_fence(__ATOMIC_RELEASE, "agent");
            asm volatile("s_waitcnt vmcnt(0)" ::: "memory");
            const unsigned og = xb_add(&bar[XB_TOP], 1u);
            const unsigned tg = og / nx;
            if (og + 1u == (tg + 1u) * nx) xb_add(&bar[XB_TOPGEN], 1u);
            else XB_SPIN(xb_ld(&bar[XB_TOPGEN]) == tg, bar);
            __builtin_amdgcn_fence(__ATOMIC_ACQUIRE, "agent");
            xb_add(&bar[XB_XGEN(b.x)], 1u);
            asm volatile("s_waitcnt vmcnt(0)" ::: "memory");
        } else {
            XB_SPIN(xb_ld(&bar[XB_XGEN(b.x)]) == gen, bar);
            __builtin_amdgcn_fence(__ATOMIC_ACQUIRE, "agent");
            asm volatile("s_waitcnt vmcnt(0)" ::: "memory");
        }
    }
    __syncthreads();
}

namespace pg8 {
constexpr int BM = 256, BK = 64, HALF = 128, HTB = HALF * BK * 2, STAGE_BYTES = 8 * HTB, NXCD = 8, WGM = 8;
DEV int lds_byte(int r, int c) { const int st = (r >> 4) * 2 + (c >> 5), rr = r & 15, cc = c & 31, ob = rr * 64 + cc * 2; return st * 1024 + (ob ^ (((ob >> 9) & 1) << 5)); }
DEV void stage_rc(int b, int& R, int& C) { const int st = b / 1024, sb = b % 1024, swz = sb ^ (((sb >> 9) & 1) << 5); R = (st >> 1) * 16 + swz / 64; C = (st & 1) * 32 + (swz % 64) / 2; }

struct Unit { int pm, pn, e; const char* a; const char* b; };
struct Gemm { int K; int amode; const LAS int* rt = nullptr; };

struct DenseOrder {
    int nM, nN, nwg, G, c; const char* A; const char* Bt; size_t tstep;
    DEV void init(const void* A_, const void* Bt_, int K, int M, int N, int G_, int c_) { A = (const char*)A_; Bt = (const char*)Bt_; tstep = (size_t)BM * K * 2; nM = M / BM; nN = N / BM; nwg = nM * nN; G = G_; c = c_; }
    DEV bool next(int i, Unit& u) const {
        const long L = (long)i * G + c; if (L >= nwg) return false;
        int wgid = (int)L; { const int q = nwg / NXCD, r = nwg % NXCD, xcd = wgid % NXCD, off = wgid / NXCD; wgid = (xcd < r ? xcd * (q + 1) : r * (q + 1) + (xcd - r) * q) + off; }
        const int nig = WGM * nN, gid = wgid / nig, fm = gid * WGM, gsz = (nM - fm) < WGM ? (nM - fm) : WGM;
        u.pm = fm + ((wgid % nig) % gsz); u.pn = (wgid % nig) / gsz; u.e = 0; u.a = A + (size_t)u.pm * tstep; u.b = Bt + (size_t)u.pn * tstep; return true;
    }
};
struct MoeOrder {
    DenseOrder d; const LAS unsigned* tend;
    int nNt;
    bool gatherA = false;
    DEV bool next(int i, Unit& u) const {
        if (!d.next(i, u)) return false;
        const int e = __builtin_popcountll(__ballot(u.pm >= (int)tend[threadIdx.x & 31]) & 0xffffffffull);
        u.e = e; u.b = d.Bt + (size_t)(e * nNt + u.pn) * d.tstep; if (gatherA) u.a = d.A; return true;
    }
};

struct CmpOrder {
    const char* KCC; const char* VCC; const char* W; int k;
    DEV bool next(int i, Unit& u) const {
        if (i != 0 || k < 0) return false;
        const int c = k >> 4, pm = k & 15, b = pm >> 1, n0 = (pm & 1) * 128;
        u.pm = pm; u.pn = 0; u.e = c; u.a = (c == 0 ? KCC : VCC) + (size_t)(b * SEQ + 16 * n0) * 128 * 2; u.b = W + (size_t)c * 256 * 2048 * 2; return true;
    }
};

typedef int i32x4 __attribute__((ext_vector_type(4)));
template <class Epi, class Sched, bool I8 = false>
DEV void gemm_phase(LAS unsigned char* lds, const Gemm g, const Sched& S, const Epi& E) {
    const int tid = opaque_tid(), wid = __builtin_amdgcn_readfirstlane(tid >> 6), lane = tid & 63, wr = wid >> 2, wc = wid & 3, fr = lane & 15, fq = lane >> 4;
    const int K = g.K; int nt = K / BK; asm volatile("" : "+s"(nt));
    unsigned voffA[2], voffB[2];
#pragma unroll
    for (int i = 0; i < 2; ++i) { int R, C; stage_rc(tid * 16 + i * 8192, R, C); voffB[i] = (unsigned)(R * K + C) * 2u;
        voffA[i] = (g.amode == 1) ? (unsigned)((R >> 1) * 16 * 128 + (R & 1) * 64 + C) * 2u : voffB[i]; }
    const size_t kstepB = (size_t)(BK * 2), kstepA = (g.amode == 1) ? (size_t)128 * 2 : kstepB;
    const size_t hstepB = (size_t)HALF * K * 2, hstepA = (g.amode == 0) ? hstepB : (g.amode == 1) ? (size_t)64 * 16 * 128 * 2 : (size_t)0;
    int RA[2], CA[2];
#pragma unroll
    for (int i = 0; i < 2; ++i) stage_rc(tid * 16 + i * 8192, RA[i], CA[i]);
    unsigned gc[2][2], gn[2][2];
    auto gload = [&](int ui_, unsigned (&o_)[2][2]) {
#pragma unroll
        for (int h = 0; h < 2; ++h)
#pragma unroll
            for (int i = 0; i < 2; ++i) o_[h][i] = (unsigned)g.rt[ui_ * 256 + h * HALF + RA[i]] * (unsigned)(K * 2) + (unsigned)(CA[i] * 2); };
    const unsigned ldsw = (unsigned)wid * 1024u;
    const int aoff = lds_byte(wr * 64 + fr, fq * 8), boff = lds_byte(wc * 32 + fr, fq * 8);
#define PG8_SA(b, h) (((b) * 2 + (h)) * HTB)
#define PG8_SB(b, h) ((4 + (b) * 2 + (h)) * HTB)
#define PG8_STAGE(bufoff, gbase, voff) do { _Pragma("unroll") for (int _i = 0; _i < 2; ++_i) \
        __builtin_amdgcn_global_load_lds((const unsigned*)((const char*)(gbase) + (voff)[_i]), (LAS unsigned*)(lds + (bufoff) + ldsw + _i * 8192), 16, 0, 0); } while (0)
#define PG8_VA(h, nx) ((g.amode == 2) ? ((nx) ? gn[h] : gc[h]) : voffA)
#define PG8_LDA(dst, b, h) do { _Pragma("unroll") for (int m = 0; m < 4; ++m) _Pragma("unroll") for (int k = 0; k < 2; ++k) dst[m][k] = *(const LAS bf16x8*)(lds + PG8_SA(b, h) + aoff + m * 2048 + k * 1024); } while (0)
#define PG8_LDB(dst, b, h) do { _Pragma("unroll") for (int n = 0; n < 2; ++n) _Pragma("unroll") for (int k = 0; k < 2; ++k) dst[n][k] = *(const LAS bf16x8*)(lds + PG8_SB(b, h) + boff + n * 2048 + k * 1024); } while (0)
#define PG8_MMA(ai, bj, At, Bt) do { __builtin_amdgcn_s_setprio(1); _Pragma("unroll") for (int m = 0; m < 4; ++m) _Pragma("unroll") for (int n = 0; n < 2; ++n) _Pragma("unroll") for (int k = 0; k < 2; ++k) { \
        if constexpr (I8) acc[ai][bj][m][n] = __builtin_bit_cast(f32x4, __builtin_amdgcn_mfma_i32_16x16x64_i8(__builtin_bit_cast(i32x4, Bt[n][k]), __builtin_bit_cast(i32x4, At[m][k]), __builtin_bit_cast(i32x4, acc[ai][bj][m][n]), 0, 0, 0)); \
        else acc[ai][bj][m][n] = __builtin_amdgcn_mfma_f32_16x16x32_bf16(Bt[n][k], At[m][k], acc[ai][bj][m][n], 0, 0, 0); } __builtin_amdgcn_s_setprio(0); } while (0)
#define PG8_WAIT_V(n) asm volatile("s_waitcnt vmcnt(" #n ")" ::: "memory")
#define PG8_WAIT_L(n) asm volatile("s_waitcnt lgkmcnt(" #n ")" ::: "memory")
#define PG8_BAR __builtin_amdgcn_s_barrier()
#define PG8_SCHED __builtin_amdgcn_sched_barrier(0)
    Unit cur, nxt; int ui = 0;
    if (!S.next(0, cur)) return;
    f32x4 acc[2][2][4][2];
#pragma unroll
    for (int a = 0; a < 2; ++a)
#pragma unroll
        for (int b = 0; b < 2; ++b)
#pragma unroll
            for (int m = 0; m < 4; ++m)
#pragma unroll
                for (int n = 0; n < 2; ++n) acc[a][b][m][n] = (f32x4){0.f, 0.f, 0.f, 0.f};
    bf16x8 At[4][2], B0[2][2], B1[2][2];
    const char* cA = cur.a; const char* cB = cur.b;
    if (g.amode == 2) { gload(0, gc); asm volatile("s_waitcnt lgkmcnt(0)" ::: "memory"); }
    PG8_STAGE(PG8_SB(0, 0), cB, voffB); PG8_STAGE(PG8_SB(0, 1), cB + hstepB, voffB); PG8_STAGE(PG8_SA(0, 0), cA, PG8_VA(0, false)); PG8_STAGE(PG8_SA(0, 1), cA + hstepA, PG8_VA(1, false));
    if (wr == 1) PG8_BAR;
    PG8_WAIT_V(2); PG8_BAR;
    PG8_STAGE(PG8_SB(1, 0), cB + kstepB, voffB); PG8_STAGE(PG8_SA(1, 0), cA + kstepA, PG8_VA(0, false)); PG8_STAGE(PG8_SB(1, 1), cB + hstepB + kstepB, voffB);
    PG8_WAIT_V(6); PG8_BAR;
    for (;;) {
        const bool has_next = S.next(ui + 1, nxt);
        if (g.amode == 2) { if (has_next) gload(ui + 1, gn); else { gn[0][0] = gc[0][0]; gn[0][1] = gc[0][1]; gn[1][0] = gc[1][0]; gn[1][1] = gc[1][1]; } }
        const char* nA = has_next ? nxt.a : cA; const char* nB = has_next ? nxt.b : cB;
#pragma unroll 1
        for (int t = 0; t < nt; t += 2) {
            const bool last = (t == nt - 2);
            const char* a1 = cA + (size_t)(t + 1) * kstepA;
            const char* a2 = last ? nA : cA + (size_t)(t + 2) * kstepA; const char* b2 = last ? nB : cB + (size_t)(t + 2) * kstepB;
            const char* a3 = a2 + kstepA; const char* b3 = b2 + kstepB;
            PG8_LDB(B0, 0, 0); PG8_LDB(B1, 0, 1); PG8_SCHED; PG8_LDA(At, 0, 0); PG8_STAGE(PG8_SA(1, 1), a1 + hstepA, PG8_VA(1, false));
            PG8_WAIT_V(8); PG8_WAIT_L(0); PG8_BAR; PG8_MMA(0, 0, At, B0); PG8_MMA(0, 1, At, B1); PG8_BAR; PG8_SCHED;
            PG8_LDA(At, 0, 1); PG8_STAGE(PG8_SB(0, 0), b2, voffB); PG8_STAGE(PG8_SB(0, 1), b2 + hstepB, voffB); PG8_STAGE(PG8_SA(0, 0), a2, PG8_VA(0, last));
            PG8_WAIT_V(8); PG8_WAIT_L(0); PG8_BAR; PG8_MMA(1, 0, At, B0); PG8_MMA(1, 1, At, B1); PG8_BAR; PG8_SCHED;
            PG8_LDB(B0, 1, 0); PG8_LDB(B1, 1, 1); PG8_SCHED; PG8_LDA(At, 1, 0); PG8_STAGE(PG8_SA(0, 1), a2 + hstepA, PG8_VA(1, last));
            PG8_WAIT_V(8); PG8_WAIT_L(0); PG8_BAR; PG8_MMA(0, 0, At, B0); PG8_MMA(0, 1, At, B1); PG8_BAR; PG8_SCHED;
            PG8_LDA(At, 1, 1); PG8_STAGE(PG8_SB(1, 0), b3, voffB); PG8_STAGE(PG8_SB(1, 1), b3 + hstepB, voffB); PG8_STAGE(PG8_SA(1, 0), a3, PG8_VA(0, last));
            PG8_WAIT_V(8); PG8_WAIT_L(0); PG8_BAR; PG8_MMA(1, 0, At, B0); PG8_MMA(1, 1, At, B1); PG8_BAR; PG8_SCHED;
        }
        if (wr == 0) PG8_BAR;
        if constexpr (!Epi::AFTER_DRAIN) E(acc, cur, wr, wc, fr, fq);
        if (!has_next) break;
#pragma unroll
        for (int a = 0; a < 2; ++a)
#pragma unroll
            for (int b = 0; b < 2; ++b)
#pragma unroll
                for (int m = 0; m < 4; ++m)
#pragma unroll
                    for (int n = 0; n < 2; ++n) acc[a][b][m][n] = (f32x4){0.f, 0.f, 0.f, 0.f};
        cur = nxt; cA = nA; cB = nB; ++ui;
        if (g.amode == 2) { gc[0][0] = gn[0][0]; gc[0][1] = gn[0][1]; gc[1][0] = gn[1][0]; gc[1][1] = gn[1][1]; }
        if (wr == 1) PG8_BAR;
    }
    PG8_WAIT_V(0);
    PG8_BAR;
    if constexpr (Epi::AFTER_DRAIN) E.fused(acc, cur, wr, wc, fr, fq, lds);
#undef PG8_SA
#undef PG8_SB
#undef PG8_STAGE
#undef PG8_VA
#undef PG8_LDA
#undef PG8_LDB
#undef PG8_MMA
#undef PG8_WAIT_V
#undef PG8_WAIT_L
#undef PG8_BAR
#undef PG8_SCHED
}
struct EpiBf16 {
    static constexpr bool AFTER_DRAIN = false;
    bf16_t* O; int ldc;
    DEV void operator()(const f32x4 (&acc)[2][2][4][2], const Unit& u, int wr, int wc, int fr, int fq) const {
#pragma unroll
        for (int ai = 0; ai < 2; ++ai)
#pragma unroll
            for (int m = 0; m < 4; ++m) { bf16_t* rowp = O + (size_t)(u.pm * BM + ai * HALF + wr * 64 + m * 16 + fr) * ldc + u.pn * BM + wc * 32 + 4 * fq;
#pragma unroll
                for (int bj = 0; bj < 2; ++bj)
#pragma unroll
                    for (int n = 0; n < 2; ++n) { const f32x4 v = acc[ai][bj][m][n]; u32x2 w; w.x = pk2(v[0], v[1]); w.y = pk2(v[2], v[3]); *(u32x2*)(rowp + bj * HALF + n * 16) = w; } }
    }
};
struct EpiResF32 {
    static constexpr bool AFTER_DRAIN = false;
    const float* base; float* out; int ldc;
    DEV void operator()(const f32x4 (&acc)[2][2][4][2], const Unit& u, int wr, int wc, int fr, int fq) const {
#pragma unroll
        for (int ai = 0; ai < 2; ++ai) { f32x4 b[4][2][2];
#pragma unroll
            for (int m = 0; m < 4; ++m) { const size_t off = (size_t)(u.pm * BM + ai * HALF + wr * 64 + m * 16 + fr) * ldc + u.pn * BM + wc * 32 + 4 * fq;
#pragma unroll
                for (int bj = 0; bj < 2; ++bj)
#pragma unroll
                    for (int n = 0; n < 2; ++n) b[m][bj][n] = __builtin_nontemporal_load((const f32x4*)(base + off + bj * HALF + n * 16)); }
#pragma unroll
            for (int m = 0; m < 4; ++m) { const size_t off = (size_t)(u.pm * BM + ai * HALF + wr * 64 + m * 16 + fr) * ldc + u.pn * BM + wc * 32 + 4 * fq;
#pragma unroll
                for (int bj = 0; bj < 2; ++bj)
#pragma unroll
                    for (int n = 0; n < 2; ++n) *(f32x4*)(out + off + bj * HALF + n * 16) = b[m][bj][n] + acc[ai][bj][m][n]; } }
    }
};
struct EpiMoe1 {
    static constexpr bool AFTER_DRAIN = false;
    bf16_t* O; const float* b1; const float* sw; const float* sx;
    DEV void operator()(const f32x4 (&acc)[2][2][4][2], const Unit& u, int wr, int wc, int fr, int fq) const {
        const float* bb = b1 + (size_t)u.e * 2048; const float* ss = sw + (size_t)u.e * 2048 + u.pn * BM;
        f32x4 ba[2], bu[2], sa[2], su[2];
#pragma unroll
        for (int n = 0; n < 2; ++n) { const int c = wc * 32 + n * 16 + 4 * fq; ba[n] = *(const f32x4*)(bb + u.pn * HALF + c); bu[n] = *(const f32x4*)(bb + 1024 + u.pn * HALF + c); sa[n] = *(const f32x4*)(ss + c); su[n] = *(const f32x4*)(ss + HALF + c); }
        float srv[2][4];
#pragma unroll
        for (int ai = 0; ai < 2; ++ai)
#pragma unroll
            for (int m = 0; m < 4; ++m) srv[ai][m] = sx[u.pm * BM + ai * HALF + wr * 64 + m * 16 + fr];
#pragma unroll
        for (int ai = 0; ai < 2; ++ai)
#pragma unroll
            for (int m = 0; m < 4; ++m) { const int row = u.pm * BM + ai * HALF + wr * 64 + m * 16 + fr; const float sr = srv[ai][m]; bf16_t* rowp = O + (size_t)row * DFF + u.pn * HALF + wc * 32 + 4 * fq;
#pragma unroll
                for (int n = 0; n < 2; ++n) { const i32x4 ia = __builtin_bit_cast(i32x4, acc[ai][0][m][n]), iu = __builtin_bit_cast(i32x4, acc[ai][1][m][n]); float r[4];
#pragma unroll
                    for (int j = 0; j < 4; ++j) { const float a = fminf((float)ia[j] * (sr * sa[n][j]) + ba[n][j], 7.0f), up = fminf(fmaxf((float)iu[j] * (sr * su[n][j]) + bu[n][j], -7.0f), 7.0f);
                        const float glu = a * __builtin_amdgcn_rcpf(1.0f + __expf(-1.702f * a)); r[j] = (up + 1.0f) * glu; }
                    u32x2 w; w.x = pk2(r[0], r[1]); w.y = pk2(r[2], r[3]); *(u32x2*)(rowp + n * 16) = w; } }
    }
};
struct EpiMoe2 {
    static constexpr bool AFTER_DRAIN = false;
    bf16_t* O; const float* b2; const float* rowgate;
    DEV void operator()(const f32x4 (&acc)[2][2][4][2], const Unit& u, int wr, int wc, int fr, int fq) const {
        const float* bb = b2 + (size_t)u.e * 1024;
        float gtv[2][4]; f32x4 bvv[2][2];
#pragma unroll
        for (int ai = 0; ai < 2; ++ai)
#pragma unroll
            for (int m = 0; m < 4; ++m) gtv[ai][m] = rowgate[u.pm * BM + ai * HALF + wr * 64 + m * 16 + fr];
#pragma unroll
        for (int bj = 0; bj < 2; ++bj)
#pragma unroll
            for (int n = 0; n < 2; ++n) bvv[bj][n] = *(const f32x4*)(bb + u.pn * BM + bj * HALF + wc * 32 + n * 16 + 4 * fq);
#pragma unroll
        for (int ai = 0; ai < 2; ++ai)
#pragma unroll
            for (int m = 0; m < 4; ++m) { const int row = u.pm * BM + ai * HALF + wr * 64 + m * 16 + fr; const float gt = gtv[ai][m]; bf16_t* rowp = O + (size_t)row * DM + u.pn * BM + wc * 32 + 4 * fq;
#pragma unroll
                for (int bj = 0; bj < 2; ++bj)
#pragma unroll
                    for (int n = 0; n < 2; ++n) { const f32x4 v = (acc[ai][bj][m][n] + bvv[bj][n]) * gt;
                        u32x2 w; w.x = pk2(v[0], v[1]); w.y = pk2(v[2], v[3]); *(u32x2*)(rowp + bj * HALF + n * 16) = w; } }
    }
};
struct EpiQup {
    static constexpr bool AFTER_DRAIN = false;
    bf16_t* O; const float* ropem;
    DEV void operator()(const f32x4 (&acc)[2][2][4][2], const Unit& u, int wr, int wc, int fr, int fq) const {
        const bool rope0 = ((u.pn * 8 + wc) % 3) == 2, rope1 = ((u.pn * 8 + 4 + wc) % 3) == 2;
        f32x4 cs[2][4], sn[2][4];
        if (rope0 || rope1) {
#pragma unroll
            for (int ai = 0; ai < 2; ++ai)
#pragma unroll
                for (int m = 0; m < 4; ++m) { const int row = u.pm * BM + ai * HALF + wr * 64 + m * 16 + fr; cs[ai][m] = *(const f32x4*)(ropem + (size_t)row * 32 + 4 * fq); sn[ai][m] = *(const f32x4*)(ropem + (size_t)row * 32 + 16 + 4 * fq); } }
#pragma unroll
        for (int bj = 0; bj < 2; ++bj) { const int g32 = u.pn * 8 + bj * 4 + wc; const bool rope = bj ? rope1 : rope0;
#pragma unroll
            for (int ai = 0; ai < 2; ++ai)
#pragma unroll
                for (int m = 0; m < 4; ++m) { const int row = u.pm * BM + ai * HALF + wr * 64 + m * 16 + fr; bf16_t* rowp = O + (size_t)row * 768 + g32 * 32 + 4 * fq;
                    f32x4 v0 = acc[ai][bj][m][0], v1 = acc[ai][bj][m][1];
                    if (rope) { const f32x4 c = cs[ai][m], s_ = sn[ai][m]; const f32x4 x1 = v0, x2 = v1; v0 = x1 * c - x2 * s_; v1 = x2 * c + x1 * s_; }
                    v0 = v0 * MLA_QSCALE; v1 = v1 * MLA_QSCALE;
                    u32x2 w; w.x = pk2(v0[0], v0[1]); w.y = pk2(v0[2], v0[3]); *(u32x2*)(rowp) = w; w.x = pk2(v1[0], v1[1]); w.y = pk2(v1[2], v1[3]); *(u32x2*)(rowp + 16) = w; } }
    }
};
struct EpiKvup {
    static constexpr bool AFTER_DRAIN = false;
    bf16_t* KM; bf16_t* VM;
    DEV void operator()(const f32x4 (&acc)[2][2][4][2], const Unit& u, int wr, int wc, int fr, int fq) const {
#pragma unroll
        for (int bj = 0; bj < 2; ++bj) { const int head = u.pn * 2 + bj;
#pragma unroll
            for (int ai = 0; ai < 2; ++ai)
#pragma unroll
                for (int m = 0; m < 4; ++m) { const int row = u.pm * BM + ai * HALF + wr * 64 + m * 16 + fr;
                    bf16_t* rowp = (wc < 2) ? KM + (size_t)row * 768 + head * 96 + wc * 32 + 4 * fq : VM + (size_t)row * 512 + head * 64 + (wc - 2) * 32 + 4 * fq;
#pragma unroll
                    for (int n = 0; n < 2; ++n) { const f32x4 v = acc[ai][bj][m][n]; u32x2 w; w.x = pk2(v[0], v[1]); w.y = pk2(v[2], v[3]); *(u32x2*)(rowp + n * 16) = w; } } }
    }
};
struct EpiCmp {
    static constexpr bool AFTER_DRAIN = true;
    const float* cb; const float* w2; const int* pos; bf16_t* KC; bf16_t* VC;
    DEV void fused(const f32x4 (&acc)[2][2][4][2], const Unit& u, int wr, int wc, int fr, int fq, LAS unsigned char* lds) const {
        const int c = u.e, tid = opaque_tid();
        LAS bf16_t* Hs = (LAS bf16_t*)lds;
        LAS float* W2s = (LAS float*)(lds + 256 * 136 * 2);
        { const f32x4* src = (const f32x4*)(w2 + (size_t)c * 128 * 64) + tid;
#pragma unroll
          for (int i = 0; i < 4; ++i) *((LAS f32x4*)W2s + tid + i * 512) = src[i * 512]; }
        f32x4 bb[2];
#pragma unroll
        for (int n = 0; n < 2; ++n) { bb[n] = *(const f32x4*)(cb + c * 128 + wc * 32 + n * 16 + 4 * fq);
#pragma unroll
            for (int part = 1; part < 8; ++part) bb[n] += *(const f32x4*)(cb + part * 256 + c * 128 + wc * 32 + n * 16 + 4 * fq); }
#pragma unroll
        for (int ai = 0; ai < 2; ++ai)
#pragma unroll
            for (int m = 0; m < 4; ++m) { const int row = ai * HALF + wr * 64 + m * 16 + fr;
#pragma unroll
                for (int n = 0; n < 2; ++n) { const f32x4 v = acc[ai][0][m][n] + bb[n]; float r[4];
#pragma unroll
                    for (int j = 0; j < 4; ++j) r[j] = v[j] / (1.0f + __expf(-v[j]));
                    u32x2 w; w.x = pk2(r[0], r[1]); w.y = pk2(r[2], r[3]); *(LAS u32x2*)(Hs + row * 136 + wc * 32 + n * 16 + 4 * fq) = w; } }
        __syncthreads();
        const int row = tid >> 1, dh = tid & 1; float o[32];
#pragma unroll
        for (int d = 0; d < 32; ++d) o[d] = 0.f;
#pragma unroll 2
        for (int h = 0; h < 128; ++h) { const float hv = bf2f(Hs[row * 136 + h]); const LAS f32x4* wrow = (const LAS f32x4*)(W2s + h * 64 + dh * 32);
#pragma unroll
            for (int q = 0; q < 8; ++q) { const f32x4 w = wrow[q]; o[4 * q] += hv * w.x; o[4 * q + 1] += hv * w.y; o[4 * q + 2] += hv * w.z; o[4 * q + 3] += hv * w.w; } }
        const int r = u.pm * BM + row, b = r >> 9, n = (r >> 1) & 255;
        if (c == 0 && dh == 0 && n < 255) { const float fpos = (float)pos[b * SEQ + 16 * n + 31];
#pragma unroll
            for (int i = 0; i < 8; ++i) { const float invf = powf(500000.0f, -(float)(2 * i) / 16.0f); float cs, sn; sincosf(fpos * invf, &sn, &cs); const float x1 = o[i], x2 = o[8 + i]; o[i] = x1 * cs - x2 * sn; o[8 + i] = x2 * cs + x1 * sn; } }
        bf16_t* dst = (c == 0 ? KC : VC) + (size_t)r * 64 + dh * 32;
#pragma unroll
        for (int q = 0; q < 4; ++q) { u32x4 w;
            if (n < 255) { w.x = pk2(o[8 * q], o[8 * q + 1]); w.y = pk2(o[8 * q + 2], o[8 * q + 3]); w.z = pk2(o[8 * q + 4], o[8 * q + 5]); w.w = pk2(o[8 * q + 6], o[8 * q + 7]); } else w = (u32x4){0u, 0u, 0u, 0u};
            *(u32x4*)(dst + 8 * q) = w; }
        __syncthreads();
    }
};
struct EpiProj {
    static constexpr bool AFTER_DRAIN = false;
    const int* pos; const float* qg; const float* kvg;
    bf16_t *QN, *KVN, *KM, *NQ, *KSR, *KWR, *KCC, *VCC, *VSC, *VWC; float *GATES, *ROPEM; LAS float* part;
    DEV void operator()(const f32x4 (&acc)[2][2][4][2], const Unit& u, int wr, int wc, int fr, int fq) const {
        constexpr float L2T = 18.931568569324174f;
        float rstd[2][4]; float fp[2][4];
#pragma unroll
        for (int ai = 0; ai < 2; ++ai)
#pragma unroll
            for (int m = 0; m < 4; ++m) { fp[ai][m] = (float)pos[u.pm * BM + ai * HALF + wr * 64 + m * 16 + fr]; rstd[ai][m] = 0.f; }
        if (u.pn <= 1) {
#pragma unroll
            for (int ai = 0; ai < 2; ++ai)
#pragma unroll
                for (int m = 0; m < 4; ++m) { float s_ = 0.f;
#pragma unroll
                    for (int bj = 0; bj < 2; ++bj) if (bj == 0 || u.pn == 0)
#pragma unroll
                        for (int n = 0; n < 2; ++n) { const f32x4 v = acc[ai][bj][m][n]; s_ += (v.x * v.x + v.y * v.y) + (v.z * v.z + v.w * v.w); }
                    s_ += __shfl_xor(s_, 16); s_ += __shfl_xor(s_, 32);
                    if (fq == 0) part[(ai * HALF + wr * 64 + m * 16 + fr) * 4 + wc] = s_; }
            asm volatile("s_waitcnt lgkmcnt(0)\n\ts_barrier" ::: "memory");
            const float inv = (u.pn == 0) ? (1.f / 256.f) : (1.f / 128.f);
#pragma unroll
            for (int ai = 0; ai < 2; ++ai)
#pragma unroll
                for (int m = 0; m < 4; ++m) { const f32x4 q4 = *(const LAS f32x4*)(part + (ai * HALF + wr * 64 + m * 16 + fr) * 4); rstd[ai][m] = rsqrtf(((q4.x + q4.y) + (q4.z + q4.w)) * inv + 1e-5f); }
            asm volatile("s_waitcnt lgkmcnt(0)\n\ts_barrier" ::: "memory");
        }
#pragma unroll
        for (int bj = 0; bj < 2; ++bj) { const int g32 = u.pn * 8 + bj * 4 + wc;
#pragma unroll
            for (int ai = 0; ai < 2; ++ai)
#pragma unroll
                for (int m = 0; m < 4; ++m) { const size_t row = (size_t)(u.pm * BM + ai * HALF + wr * 64 + m * 16 + fr); f32x4 v0 = acc[ai][bj][m][0], v1 = acc[ai][bj][m][1];
                    const int c4 = 4 * fq;
                    auto st8 = [&](bf16_t* dst, const f32x4& x) { u32x2 w; w.x = pk2(x.x, x.y); w.y = pk2(x.z, x.w); *(u32x2*)dst = w; };
                    auto nsa_rope = [&](f32x4& x) {
#pragma unroll
                        for (int j = 0; j < 4; ++j) { const float other = __shfl_xor(x[j], 32); const int i = 4 * (fq & 1) + j; float sn, cs; __sincosf(fp[ai][m] * fast_exp2(-(float)i * (L2T / 8.f)), &sn, &cs);
                            x[j] = (fq < 2) ? x[j] * cs - other * sn : x[j] * cs + other * sn; } };
                    if (g32 < 8) { const float r_ = rstd[ai][m]; const int c = g32 * 32 + c4; const f32x4 g0 = *(const f32x4*)(qg + c), g1 = *(const f32x4*)(qg + c + 16);
                        st8(QN + row * 256 + c, v0 * g0 * r_); st8(QN + row * 256 + c + 16, v1 * g1 * r_); }
                    else if (g32 < 12) { const float r_ = rstd[ai][m]; const int c = (g32 - 8) * 32 + c4; const f32x4 g0 = *(const f32x4*)(kvg + c), g1 = *(const f32x4*)(kvg + c + 16);
                        st8(KVN + row * 256 + c, v0 * g0 * r_); st8(KVN + row * 256 + c + 16, v1 * g1 * r_);
                        *(u32x2*)(KVN + row * 256 + 128 + c) = (u32x2){0u, 0u}; *(u32x2*)(KVN + row * 256 + 128 + c + 16) = (u32x2){0u, 0u}; }
                    else if (g32 == 12) { f32x4 cs4, sn4;
#pragma unroll
                        for (int j = 0; j < 4; ++j) { float sn, cs; __sincosf(fp[ai][m] * fast_exp2(-(float)(c4 + j) * (L2T / 16.f)), &sn, &cs); cs4[j] = cs; sn4[j] = sn; }
                        const f32x4 o1 = v0 * cs4 - v1 * sn4, o2 = v1 * cs4 + v0 * sn4;
#pragma unroll
                        for (int h = 0; h < 8; ++h) { st8(KM + row * 768 + h * 96 + 64 + c4, o1); st8(KM + row * 768 + h * 96 + 80 + c4, o2); }
                        *(f32x4*)(ROPEM + row * 32 + c4) = cs4; *(f32x4*)(ROPEM + row * 32 + 16 + c4) = sn4; }
                    else if (g32 < 29) { const int hh = (g32 - 13) >> 1, half = (g32 - 13) & 1; if (half == 0) nsa_rope(v0);
                        st8(NQ + row * 512 + hh * 64 + half * 32 + c4, v0 * NSA_QSCALE); st8(NQ + row * 512 + hh * 64 + half * 32 + 16 + c4, v1 * NSA_QSCALE); }
                    else if (g32 < 37) { bf16_t* d_ = (g32 < 33 ? KCC : VCC) + row * 128 + ((g32 - 29) & 3) * 32 + c4; st8(d_, v0); st8(d_ + 16, v1); }
                    else if (g32 < 41) { if (((g32 - 37) & 1) == 0) nsa_rope(v0); bf16_t* d_ = KSR + row * 128 + (g32 - 37) * 32 + c4; st8(d_, v0); st8(d_ + 16, v1); }
                    else if (g32 < 45) { bf16_t* d_ = VSC + row * 128 + (g32 - 41) * 32 + c4; st8(d_, v0); st8(d_ + 16, v1); }
                    else if (g32 < 49) { if (((g32 - 45) & 1) == 0) nsa_rope(v0); bf16_t* d_ = KWR + row * 128 + (g32 - 45) * 32 + c4; st8(d_, v0); st8(d_ + 16, v1); }
                    else if (g32 < 53) { bf16_t* d_ = VWC + row * 128 + (g32 - 49) * 32 + c4; st8(d_, v0); st8(d_ + 16, v1); }
                    else if (g32 == 53) { f32x4 s0, s1;
#pragma unroll
                        for (int j = 0; j < 4; ++j) { s0[j] = __builtin_amdgcn_rcpf(1.0f + __expf(-v0[j])); s1[j] = __builtin_amdgcn_rcpf(1.0f + __expf(-v1[j])); }
                        *(f32x4*)(GATES + row * 24 + c4) = s0; if (fq < 2) *(f32x4*)(GATES + row * 24 + 16 + c4) = s1; }
                } }
    }
};
struct UpOrder {
    DenseOrder q, kv; int G, c;
    DEV bool next(int i, Unit& u) const {
        const long L = (long)i * G + c;
        if (L < q.nwg) { DenseOrder t = q; t.G = 1; t.c = 0; t.next((int)L, u); u.e = 0; return true; }
        if (L < q.nwg + kv.nwg) { DenseOrder t = kv; t.G = 1; t.c = 0; t.next((int)(L - q.nwg), u); u.e = 1; return true; }
        return false;
    }
};
struct EpiUp {
    static constexpr bool AFTER_DRAIN = false;
    EpiQup eq; EpiKvup ekv;
    DEV void operator()(const f32x4 (&acc)[2][2][4][2], const Unit& u, int wr, int wc, int fr, int fq) const { if (u.e == 0) eq(acc, u, wr, wc, fr, fq); else ekv(acc, u, wr, wc, fr, fq); }
};
}

DEV void transpose_item(const float* W, int Ksrc, int Nsrc, int k0, int n0, bf16_t* WT, int ldk, int drow0, LAS float* scr, int lane) {
    { const int kr = lane >> 3, nc = 4 * (lane & 7); f32x4 v[8];
#pragma unroll
      for (int i = 0; i < 8; ++i) { const int k = k0 + 8 * i + kr; v[i] = (k < Ksrc && n0 + nc < Nsrc) ? __builtin_nontemporal_load((const f32x4*)(W + (size_t)k * Nsrc + n0 + nc)) : (f32x4){0.f, 0.f, 0.f, 0.f}; }
#pragma unroll
      for (int i = 0; i < 8; ++i) { LAS float* d = scr + (8 * i + kr) * 33 + nc; d[0] = v[i].x; d[1] = v[i].y; d[2] = v[i].z; d[3] = v[i].w; } }
    asm volatile("s_waitcnt lgkmcnt(0)" ::: "memory");
    const int c = lane & 7;
#pragma unroll
    for (int j = 0; j < 4; ++j) { const int n = (lane >> 3) + 8 * j; const LAS float* s = scr + (8 * c) * 33 + n;
        u32x4 o; o.x = pk2(s[0 * 33], s[1 * 33]); o.y = pk2(s[2 * 33], s[3 * 33]); o.z = pk2(s[4 * 33], s[5 * 33]); o.w = pk2(s[6 * 33], s[7 * 33]);
        *(u32x4*)(WT + (size_t)(drow0 + n) * ldk + k0 + 8 * c) = o; }
    asm volatile("s_waitcnt lgkmcnt(0)" ::: "memory");
}
DEV void rms_row_to_bf16(const float* xrow, const float* g, bf16_t* orow, int lane) {
    const f32x4* xr = (const f32x4*)xrow + lane; const f32x4* gr = (const f32x4*)g + lane;
    f32x4 v[4]; float s = 0.f;
#pragma unroll
    for (int j = 0; j < 4; ++j) { v[j] = xr[64 * j]; s += (v[j].x * v[j].x + v[j].y * v[j].y) + (v[j].z * v[j].z + v[j].w * v[j].w); }
    const float rstd = rsqrtf(wave_sum(s) * (1.f / 1024.f) + 1e-5f);
    u32x2* o8 = (u32x2*)orow + lane;
#pragma unroll
    for (int j = 0; j < 4; ++j) { const f32x4 gg = gr[64 * j]; u32x2 w; w.x = pk2(v[j].x * rstd * gg.x, v[j].y * rstd * gg.y); w.y = pk2(v[j].z * rstd * gg.z, v[j].w * rstd * gg.w); o8[64 * j] = w; }
}
DEV void w1_quant_item(const float* W, unsigned char* WQ, float* SW, int n0, int drow0, LAS unsigned char* lds, int tid) {
    LAS unsigned* qs = (LAS unsigned*)lds;
    LAS float* red = (LAS float*)(lds + 32 * 1040);
    const int kg = tid >> 3, c = tid & 7, wv = tid >> 6;
    f32x4 v[4][4];
#pragma unroll
    for (int i = 0; i < 4; ++i)
#pragma unroll
        for (int q = 0; q < 4; ++q) v[i][q] = __builtin_nontemporal_load((const f32x4*)(W + (size_t)(4 * (64 * i + kg) + q) * 2048 + n0 + 4 * c));
    float mx[4] = {0.f, 0.f, 0.f, 0.f};
#pragma unroll
    for (int i = 0; i < 4; ++i)
#pragma unroll
        for (int q = 0; q < 4; ++q) { mx[0] = fmaxf(mx[0], fabsf(v[i][q].x)); mx[1] = fmaxf(mx[1], fabsf(v[i][q].y)); mx[2] = fmaxf(mx[2], fabsf(v[i][q].z)); mx[3] = fmaxf(mx[3], fabsf(v[i][q].w)); }
#pragma unroll
    for (int j = 0; j < 4; ++j) { mx[j] = fmaxf(mx[j], __shfl_xor(mx[j], 8)); mx[j] = fmaxf(mx[j], __shfl_xor(mx[j], 16)); mx[j] = fmaxf(mx[j], __shfl_xor(mx[j], 32)); }
    if ((tid & 63) < 8) *(LAS f32x4*)(red + wv * 32 + 4 * c) = (f32x4){mx[0], mx[1], mx[2], mx[3]};
    __syncthreads();
    float inv[4];
    { f32x4 m = *(const LAS f32x4*)(red + 4 * c);
#pragma unroll
      for (int w_ = 1; w_ < 8; ++w_) { const f32x4 o = *(const LAS f32x4*)(red + w_ * 32 + 4 * c); m.x = fmaxf(m.x, o.x); m.y = fmaxf(m.y, o.y); m.z = fmaxf(m.z, o.z); m.w = fmaxf(m.w, o.w); }
      m.x = fmaxf(m.x, 1e-30f); m.y = fmaxf(m.y, 1e-30f); m.z = fmaxf(m.z, 1e-30f); m.w = fmaxf(m.w, 1e-30f);
      inv[0] = 127.0f / m.x; inv[1] = 127.0f / m.y; inv[2] = 127.0f / m.z; inv[3] = 127.0f / m.w;
      if (tid < 8) *(f32x4*)(SW + drow0 + 4 * c) = m * (1.0f / 127.0f); }
#pragma unroll
    for (int i = 0; i < 4; ++i) {
#pragma unroll
        for (int j = 0; j < 4; ++j) { unsigned x = 0u;
#pragma unroll
            for (int q = 0; q < 4; ++q) { const int b = __float2int_rn(v[i][q][j] * inv[j]); x |= ((unsigned)b & 255u) << (8 * q); }
            qs[(4 * c + j) * 260 + 64 * i + kg] = x; } }
    __syncthreads();
#pragma unroll
    for (int t_ = 0; t_ < 4; ++t_) { const int id = tid + 512 * t_, n = id >> 6, ch = id & 63;
        *(u32x4*)(WQ + (size_t)(drow0 + n) * 1024 + ch * 16) = *(const LAS u32x4*)(lds + n * 1040 + ch * 16); }
    __syncthreads();
}
DEV void prep_w1_items(const Params& p, LAS unsigned char* lds) {
    const int tid = opaque_tid();
    unsigned* ctr = (unsigned*)(p.ws + OFF_CNT) + 40; LAS int* slot = (LAS int*)(lds + 40960);
    for (;;) {
        if (tid == 0) *slot = (int)__hip_atomic_fetch_add(ctr, 1u, __ATOMIC_RELAXED, __HIP_MEMORY_SCOPE_AGENT);
        __syncthreads();
        const int it = *slot;
        __syncthreads();
        if (it >= 32 * 64) break;
        const int e = it >> 6, nb = it & 63, n0 = nb * 32;
        const int bj = n0 >> 10, rr = n0 & 1023, drow = 256 * (rr >> 7) + 128 * bj + (rr & 127);
        w1_quant_item(p.moe_w1 + (size_t)e * 1024 * 2048, p.ws + OFF_W1T + (size_t)e * 2048 * 1024, (float*)(p.ws + OFF_SW1) + (size_t)e * 2048, n0, drow, lds, tid); }
}
DEV void prep_w2_items(const Params& p, LAS unsigned char* lds, int firstw, int stridew) {
    const int tid = opaque_tid(), wid = tid >> 6, lane = tid & 63;
    LAS float* scr = (LAS float*)(lds + wid * 16384); bf16_t* W2T = (bf16_t*)(p.ws + OFF_W2T);
    for (int r = firstw + wid; r < 32 * 16 * 32; r += stridew) { const int e = r / (16 * 32), q = r % (16 * 32), kb = q / 32, nb = q % 32;
        transpose_item(p.moe_w2 + (size_t)e * 1024 * 1024, 1024, 1024, kb * 64, nb * 32, W2T + (size_t)e * 1024 * 1024, 1024, nb * 32, scr, lane); }
}
DEV void phase0(const Params& p, LAS unsigned char* lds) {
    const int tid = opaque_tid(), wid = tid >> 6, lane = tid & 63;
    LAS float* scr = (LAS float*)(lds + wid * 16384);
    const int gw = blockIdx.x * 8 + wid, NGW = gridDim.x * 8;
    bf16_t* WINT = (bf16_t*)(p.ws + OFF_WINT);
    bf16_t* WQUPT = (bf16_t*)(p.ws + OFF_WQUPT); bf16_t* WKVUPT = (bf16_t*)(p.ws + OFF_WKVUPT); bf16_t* WOUTT = (bf16_t*)(p.ws + OFF_WOUTT);
    constexpr int I_IN = 16 * 56, I_QUP = 4 * 24, I_KVUP = 4 * 32, I_OUT = 16 * 32, I_CW1 = 2 * 32 * 8, I_ROWS = NTOK;
    constexpr int NITEMS = I_IN + I_QUP + I_KVUP + I_OUT + I_CW1;
    for (int it = gw; it < NITEMS; it += NGW) {
        int r = it;
        if (r < I_IN) { const int kb = r / 56, nb = r % 56; transpose_item(p.w_in, 1024, INC, kb * 64, nb * 32, WINT, 1024, nb * 32, scr, lane); continue; } r -= I_IN;
        if (r < I_QUP) { const int kb = r / 24, nb = r % 24; transpose_item(p.w_q_up, 256, 768, kb * 64, nb * 32, WQUPT, 256, nb * 32, scr, lane); continue; } r -= I_QUP;
        if (r < I_KVUP) { const int kb = r / 32, nb = r % 32; transpose_item(p.w_kv_up, 128, 1024, kb * 64, nb * 32, WKVUPT, 256, nb * 32, scr, lane); continue; } r -= I_KVUP;
        if (r < I_OUT) { const int kb = r / 32, nb = r % 32; transpose_item(p.w_out, 1024, 1024, kb * 64, nb * 32, WOUTT, 1024, nb * 32, scr, lane); continue; } r -= I_OUT;
        if (r < I_CW1) { const int c = r / 256, q = r % 256, kb = q / 8, nb = q % 8; transpose_item(p.cmp_w1 + (size_t)c * 2048 * 128, 2048, 128, kb * 64, nb * 32, (bf16_t*)(p.ws + OFF_CW1T) + (size_t)c * 256 * 2048, 2048, nb * 32, scr, lane); continue; } r -= I_CW1;
        break;
    }
    { const f32x4* gr = (const f32x4*)p.attn_norm + lane; f32x4 gg[4];
#pragma unroll
      for (int j = 0; j < 4; ++j) gg[j] = gr[64 * j];
      for (int r0 = gw * 4; r0 < NTOK; r0 += NGW * 4) { f32x4 v[4][4];
#pragma unroll
          for (int q = 0; q < 4; ++q) { const f32x4* xr = (const f32x4*)(p.x + (size_t)(r0 + q) * DM) + lane;
#pragma unroll
              for (int j = 0; j < 4; ++j) v[q][j] = __builtin_nontemporal_load(xr + 64 * j); }
#pragma unroll
          for (int q = 0; q < 4; ++q) { float s_ = 0.f;
#pragma unroll
              for (int j = 0; j < 4; ++j) s_ += (v[q][j].x * v[q][j].x + v[q][j].y * v[q][j].y) + (v[q][j].z * v[q][j].z + v[q][j].w * v[q][j].w);
              const float rstd = rsqrtf(wave_sum(s_) * (1.f / 1024.f) + 1e-5f); u32x2* o8 = (u32x2*)((bf16_t*)(p.ws + OFF_U) + (size_t)(r0 + q) * DM) + lane;
#pragma unroll
              for (int j = 0; j < 4; ++j) { u32x2 w; w.x = pk2(v[q][j].x * rstd * gg[j].x, v[q][j].y * rstd * gg[j].y); w.y = pk2(v[q][j].z * rstd * gg[j].z, v[q][j].w * rstd * gg[j].w); o8[64 * j] = w; } } } }
    float* cb = (float*)(p.ws + OFF_CB);
    for (int o8 = gw; o8 < 2048; o8 += NGW) { const int o = o8 & 255, part = o8 >> 8, c = o >> 7, h = o & 127; float s = 0.f;
#pragma unroll
        for (int q = 0; q < 4; ++q) { const int i = part * 256 + q * 64 + lane; s += p.cmp_pos[c * 2048 + i] * p.cmp_w1[((size_t)c * 2048 + i) * 128 + h]; }
        s = wave_sum(s); if (lane == 0) cb[part * 256 + o] = s; }
    if (blockIdx.x == 0 && tid < 64) ((unsigned*)(p.ws + OFF_CNT))[tid] = 0u;
}

struct P2In { u32x2 wq; unsigned wkv; unsigned kp; u32x4 wqn; u32x4 wk; u32x4 wc4; unsigned gt; int pos; };
DEV void phase2(const Params& p) {
    const int tid = opaque_tid(), wid = tid >> 6, lane = tid & 63;
    const int gw = blockIdx.x * 8 + wid, NGW = gridDim.x * 8;
    const bf16_t* PROJ = (const bf16_t*)(p.ws + OFF_PROJ);
    bf16_t* QN = (bf16_t*)(p.ws + OFF_QN); bf16_t* KVN = (bf16_t*)(p.ws + OFF_KVN); bf16_t* KM = (bf16_t*)(p.ws + OFF_KM); float* ROPEM = (float*)(p.ws + OFF_ROPEM); bf16_t* NQ = (bf16_t*)(p.ws + OFF_NQ);
    bf16_t* KSR = (bf16_t*)(p.ws + OFF_KSR); bf16_t* KWR = (bf16_t*)(p.ws + OFF_KWR); float* GATES = (float*)(p.ws + OFF_GATES);
    const float invf_m = powf(500000.0f, -(float)(2 * (lane & 15)) / 32.0f);
    const float invf_n = powf(500000.0f, -(float)(2 * (lane & 7)) / 16.0f);
    const f32x4 gq = *(const f32x4*)(p.q_norm + lane * 4); const f32x2 gkv = *(const f32x2*)(p.kv_norm + lane * 2);
    const int l16 = lane & 15, sub = lane & 7, d32 = lane & 31; const int cbase = (lane < 16) ? C_KS : C_KW;
    const int grp4 = lane >> 4; const int ccol4 = (grp4 == 0) ? C_KC : (grp4 == 1) ? C_VC : (grp4 == 2) ? C_VS : C_VW;
    bf16_t* cdst4 = (bf16_t*)(p.ws + (grp4 == 0 ? OFF_KCC : grp4 == 1 ? OFF_VCC : grp4 == 2 ? OFF_VSC : OFF_VWC));
    auto load = [&](int tok) -> P2In { const bf16_t* row = PROJ + (size_t)tok * INP; P2In in;
        in.wq = *(const u32x2*)(row + C_QLAT + lane * 4); in.wkv = *(const unsigned*)(row + C_KVLAT + lane * 2);
        in.kp = (unsigned)row[C_KPE + d32] | ((unsigned)row[C_KPE + (d32 ^ 16)] << 16);
        in.wqn = *(const u32x4*)(row + C_QNSA + lane * 8); in.wk = *(const u32x4*)(row + cbase + l16 * 8); in.wc4 = *(const u32x4*)(row + ccol4 + l16 * 8);
        in.gt = row[C_G + (lane < 24 ? lane : 23)]; in.pos = p.pos[tok]; return in; };
    P2In cur = load(gw < NTOK ? gw : 0);
#pragma unroll 1
    for (int tok = gw; tok < NTOK; tok += NGW) {
        const P2In nxt = load(tok + NGW < NTOK ? tok + NGW : tok);
        const float fpos = (float)cur.pos;
        float cm, sm, cn, sn; __sincosf(fpos * invf_m, &sm, &cm); __sincosf(fpos * invf_n, &sn, &cn);
        { const u32x2 w = cur.wq; const float a = bflo(w.x), b = bfhi(w.x), c = bflo(w.y), d = bfhi(w.y);
          const float rstd = rsqrtf(wave_sum(a * a + b * b + c * c + d * d) * (1.f / 256.f) + 1e-5f);
          u32x2 o; o.x = pk2(a * rstd * gq.x, b * rstd * gq.y); o.y = pk2(c * rstd * gq.z, d * rstd * gq.w); *(u32x2*)(QN + (size_t)tok * 256 + lane * 4) = o; }
        { const unsigned w = cur.wkv; const float a = bflo(w), b = bfhi(w);
          const float rstd = rsqrtf(wave_sum(a * a + b * b) * (1.f / 128.f) + 1e-5f);
          *(unsigned*)(KVN + (size_t)tok * 256 + lane * 2) = pk2(a * rstd * gkv.x, b * rstd * gkv.y); *(unsigned*)(KVN + (size_t)tok * 256 + 128 + lane * 2) = 0u; }
        { const float xs_ = bflo(cur.kp), xo = bfhi(cur.kp); const float val = (d32 < 16) ? xs_ * cm - xo * sm : xs_ * cm + xo * sm;
          const int hh = lane >> 3, part = lane & 7; const float a0 = __shfl(val, 4 * part), a1 = __shfl(val, 4 * part + 1), a2 = __shfl(val, 4 * part + 2), a3 = __shfl(val, 4 * part + 3);
          u32x2 w; w.x = pk2(a0, a1); w.y = pk2(a2, a3); *(u32x2*)(KM + (size_t)tok * 768 + hh * 96 + 64 + 4 * part) = w;
          if (lane < 16) { ROPEM[(size_t)tok * 32 + lane] = cm; ROPEM[(size_t)tok * 32 + 16 + lane] = sm; } }
        { const u32x4 w = cur.wqn; float v[8] = {bflo(w.x), bfhi(w.x), bflo(w.y), bfhi(w.y), bflo(w.z), bfhi(w.z), bflo(w.w), bfhi(w.w)};
#pragma unroll
          for (int i = 0; i < 8; ++i) { const float other = __shfl_xor(v[i], 1); const float c = __shfl(cn, i), s = __shfl(sn, i);
              if (sub == 0) v[i] = v[i] * c - other * s; else if (sub == 1) v[i] = v[i] * c + other * s; }
          u32x4 o; o.x = pk2(v[0] * NSA_QSCALE, v[1] * NSA_QSCALE); o.y = pk2(v[2] * NSA_QSCALE, v[3] * NSA_QSCALE); o.z = pk2(v[4] * NSA_QSCALE, v[5] * NSA_QSCALE); o.w = pk2(v[6] * NSA_QSCALE, v[7] * NSA_QSCALE);
          *(u32x4*)(NQ + (size_t)tok * 512 + lane * 8) = o; }
        { const u32x4 w = cur.wk;
          float v[8] = {bflo(w.x), bfhi(w.x), bflo(w.y), bfhi(w.y), bflo(w.z), bfhi(w.z), bflo(w.w), bfhi(w.w)};
#pragma unroll
          for (int i = 0; i < 8; ++i) { const float other = __shfl_xor(v[i], 1); const float c = __shfl(cn, i), s = __shfl(sn, i);
              if (sub == 0) v[i] = v[i] * c - other * s; else if (sub == 1) v[i] = v[i] * c + other * s; }
          if (lane < 32) { u32x4 o; o.x = pk2(v[0], v[1]); o.y = pk2(v[2], v[3]); o.z = pk2(v[4], v[5]); o.w = pk2(v[6], v[7]);
              *(u32x4*)(((lane < 16) ? KSR : KWR) + (size_t)tok * 128 + l16 * 8) = o; } }
        *(u32x4*)(cdst4 + (size_t)tok * 128 + l16 * 8) = cur.wc4;
        if (lane < 24) GATES[(size_t)tok * 24 + lane] = __builtin_amdgcn_rcpf(1.0f + __expf(-bflo(cur.gt)));
        cur = nxt;
    }
}

DEV void phase4(const Params& p, LAS unsigned char* lds) {
    const int tid = opaque_tid();
    if (blockIdx.x < BATCH * 2 && tid < 128) { const int bb = blockIdx.x >> 1, c_ = blockIdx.x & 1; ((bf16_t*)(p.ws + (c_ == 0 ? OFF_KC : OFF_VC)))[((size_t)(bb * NCMPP + 255) * 2) * 64 + tid] = 0; }
    const bf16_t* PROJ = (const bf16_t*)(p.ws + OFF_PROJ); const float* cb = (const float*)(p.ws + OFF_CB);
    LAS float* hid = (LAS float*)lds;
    const int sub = tid >> 7, h = tid & 127;
    constexpr int NU = 2 * BATCH * NCMP * 2;
    for (int u0 = blockIdx.x * 4; u0 < NU; u0 += gridDim.x * 4) {
        const int u = u0 + sub; const bool act = u < NU;
        int c = 0, b = 0, n = 0, g = 0;
        if (act) { c = u / (BATCH * NCMP * 2); int r = u % (BATCH * NCMP * 2); b = r / (NCMP * 2); r %= (NCMP * 2); n = r >> 1; g = r & 1; }
        float acc = 0.f;
        if (act) {
            const bf16_t* src = PROJ + (size_t)(b * SEQ + n * 16) * INP + (c == 0 ? C_KC : C_VC) + g * 64;
            const float* w1 = p.cmp_w1 + (size_t)c * 2048 * 128 + h;
            for (int l = 0; l < 32; ++l) { const bf16_t* sr = src + (size_t)l * INP;
#pragma unroll 8
                for (int d = 0; d < 64; d += 2) { const unsigned w = *(const unsigned*)(sr + d); acc += bflo(w) * w1[(size_t)(l * 64 + d) * 128] + bfhi(w) * w1[(size_t)(l * 64 + d + 1) * 128]; } }
            acc += cb[c * 128 + h];
            acc = acc / (1.0f + __expf(-acc));
        }
        hid[sub * 128 + h] = acc;
        __syncthreads();
        if (act && h < 64) {
            const float* w2 = p.cmp_w2 + (size_t)c * 128 * 64 + h; float o = 0.f;
            for (int k = 0; k < 128; ++k) o += hid[sub * 128 + k] * w2[k * 64];
            LAS float* ob = (LAS float*)(lds + 4096) + sub * 64; ob[h] = o;
            asm volatile("s_waitcnt lgkmcnt(0)" ::: "memory");
            if (c == 0 && h < 16) { const int i = h & 7; const float fpos = (float)p.pos[b * SEQ + 16 * n + 31]; const float invf = powf(500000.0f, -(float)(2 * i) / 16.0f);
                float cs, sn; sincosf(fpos * invf, &sn, &cs); const float x1 = ob[i], x2 = ob[8 + i]; o = (h < 8) ? (x1 * cs - x2 * sn) : (x2 * cs + x1 * sn); }
            ((bf16_t*)(p.ws + (c == 0 ? OFF_KC : OFF_VC)))[((size_t)(b * NCMPP + n) * 2 + g) * 64 + h] = f2bf(o);
        }
        __syncthreads();
    }
}

template <int DQK, int DV, class KF, class VF, class MF>
DEV void naive_attn_range(const float (&q)[DQK], float (&o)[DV], float& m, float& l, int jlo, int jhi, KF kf, VF vf, MF valid) {
#pragma unroll 1
    for (int j0 = jlo; j0 < jhi; j0 += 2) {
        const int ja = __builtin_amdgcn_readfirstlane(j0), jb = __builtin_amdgcn_readfirstlane((j0 + 1 < jhi) ? j0 + 1 : j0);
        float s0 = 0.f, s1 = 0.f;
#pragma unroll
        for (int i = 0; i < DQK / 2; ++i) { const unsigned w = kf(ja, i); s0 += q[2 * i] * bflo(w); s0 += q[2 * i + 1] * bfhi(w); }
#pragma unroll
        for (int i = 0; i < DQK / 2; ++i) { const unsigned w = kf(jb, i); s1 += q[2 * i] * bflo(w); s1 += q[2 * i + 1] * bfhi(w); }
        if (!valid(ja)) s0 = -INFINITY;
        if (!(j0 + 1 < jhi && valid(jb))) s1 = -INFINITY;
        const float mn = fmaxf(m, fmaxf(s0, s1));
        const bool live = mn != -INFINITY;
        const float alpha = live ? fast_exp2(m - mn) : 1.f, p0 = live ? fast_exp2(s0 - mn) : 0.f, p1 = live ? fast_exp2(s1 - mn) : 0.f;
        l = l * alpha + p0 + p1; m = mn;
#pragma unroll
        for (int i = 0; i < DV / 2; ++i) { const unsigned w0 = vf(ja, i), w1 = vf(jb, i);
            o[2 * i] = o[2 * i] * alpha + p0 * bflo(w0) + p1 * bflo(w1); o[2 * i + 1] = o[2 * i + 1] * alpha + p0 * bfhi(w0) + p1 * bfhi(w1); }
    }
}

DEV void phase3b(const Params& p) {
    const bf16_t* QUP = (const bf16_t*)(p.ws + OFF_QUP); const bf16_t* KVUP = (const bf16_t*)(p.ws + OFF_KVUP); const bf16_t* KPE = (const bf16_t*)(p.ws + OFF_KPE);
    bf16_t* QM = (bf16_t*)(p.ws + OFF_QM); bf16_t* KM = (bf16_t*)(p.ws + OFF_KM);
    for (int id = blockIdx.x * 512 + opaque_tid(); id < NTOK * 8; id += gridDim.x * 512) {
        const int tok = id >> 3, h = id & 7;
        const u32x4* qs = (const u32x4*)(QUP + (size_t)tok * 768 + h * 96); u32x4* qd = (u32x4*)(QM + (size_t)tok * 768 + h * 96);
        const u32x4* ks = (const u32x4*)(KVUP + (size_t)tok * 1024 + h * 128); u32x4* kd = (u32x4*)(KM + (size_t)tok * 768 + h * 96);
#pragma unroll 1
        for (int c = 0; c < 8; ++c) { const u32x4 w = qs[c]; u32x4 o;
            o.x = pk2(bflo(w.x) * MLA_QSCALE, bfhi(w.x) * MLA_QSCALE); o.y = pk2(bflo(w.y) * MLA_QSCALE, bfhi(w.y) * MLA_QSCALE);
            o.z = pk2(bflo(w.z) * MLA_QSCALE, bfhi(w.z) * MLA_QSCALE); o.w = pk2(bflo(w.w) * MLA_QSCALE, bfhi(w.w) * MLA_QSCALE); qd[c] = o; kd[c] = ks[c]; }
        const u32x4* pe = (const u32x4*)(KPE + (size_t)tok * 32);
#pragma unroll 1
        for (int c = 0; c < 4; ++c) kd[8 + c] = pe[c];
        const float fpos = (float)p.pos[tok]; const bf16_t* qr = QUP + (size_t)tok * 768 + h * 96 + 64; bf16_t* qo = QM + (size_t)tok * 768 + h * 96 + 64;
#pragma unroll 1
        for (int i = 0; i < 16; ++i) { const float invf = powf(500000.0f, -(float)(2 * i) / 32.0f); float c, sn; sincosf(fpos * invf, &sn, &c);
            const float x1 = bf2f(qr[i]), x2 = bf2f(qr[16 + i]); qo[i] = f2bf((x1 * c - x2 * sn) * MLA_QSCALE); qo[16 + i] = f2bf((x2 * c + x1 * sn) * MLA_QSCALE); }
    }
}

DEV void phase5_mla(const Params& p) {
    const int tid = opaque_tid(), wid = __builtin_amdgcn_readfirstlane(tid >> 6), lane = tid & 63;
    const int gw = blockIdx.x * 8 + wid, NGW = gridDim.x * 8;
    const bf16_t* QM = (const bf16_t*)(p.ws + OFF_QM); const bf16_t* KM = (const bf16_t*)(p.ws + OFF_KM); const bf16_t* KVUP = (const bf16_t*)(p.ws + OFF_KVUP);
    bf16_t* OCAT = (bf16_t*)(p.ws + OFF_OCAT);
    constexpr int NUNIT = BATCH * 8 * (SEQ / 64);
#pragma unroll 1
    for (int uu = gw; uu < NUNIT; uu += NGW) {
        const int u = (uu & 1) ? (NUNIT - 1 - (uu >> 1)) : (uu >> 1);
        const int tb = u % (SEQ / 64), h = (u / (SEQ / 64)) & 7, b = u / (SEQ / 64 * 8);
        const int t = tb * 64 + lane; const size_t tok = (size_t)b * SEQ + t;
        unsigned qp[48];
        { const bf16_t* qr = QM + tok * 768 + h * 96;
#pragma unroll
          for (int i = 0; i < 48; ++i) qp[i] = *(const unsigned*)(qr + 2 * i); }
        float o[64];
#pragma unroll
        for (int d = 0; d < 64; ++d) o[d] = 0.f;
        float m = -INFINITY, l = 0.f;
        const bf16_t* kb = KM + (size_t)b * SEQ * 768 + h * 96; const bf16_t* vb = KVUP + (size_t)b * SEQ * 1024 + h * 128 + 64;
        const int jhi = tb * 64 + 64;
#pragma unroll 1
        for (int j0 = 0; j0 < jhi; ++j0) {
            const int j = __builtin_amdgcn_readfirstlane(j0);
            const unsigned* kr = (const unsigned*)(kb + (size_t)j * 768); const unsigned* vr = (const unsigned*)(vb + (size_t)j * 1024);
            float s0 = 0.f;
#pragma unroll
            for (int i = 0; i < 48; ++i) { const unsigned w = kr[i]; s0 += bflo(qp[i]) * bflo(w); s0 += bfhi(qp[i]) * bfhi(w); }
            if (j > t) s0 = -INFINITY;
            const float mn = fmaxf(m, s0);
            const float alpha = fast_exp2(m - mn), p0 = fast_exp2(s0 - mn);
            l = l * alpha + p0; m = mn;
#pragma unroll
            for (int i = 0; i < 32; ++i) { const unsigned w0 = vr[i]; o[2 * i] = o[2 * i] * alpha + p0 * bflo(w0); o[2 * i + 1] = o[2 * i + 1] * alpha + p0 * bfhi(w0); }
        }
        const float rl = 1.0f / l;
        bf16_t* orow = OCAT + tok * 1024 + h * 64;
#pragma unroll
        for (int i = 0; i < 32; ++i) *(unsigned*)(orow + 2 * i) = pk2(o[2 * i] * rl, o[2 * i + 1] * rl);
    }
}

namespace fa {
typedef float f32x16 __attribute__((ext_vector_type(16)));
typedef short s16x4 __attribute__((ext_vector_type(4)));
constexpr int KSLOT = 12288, VSLOT = 8192;
constexpr int L_K = 0, L_V = 2 * KSLOT, L_WSF = L_V + 3 * VSLOT, L_OST = L_WSF + 8 * 512, L_MASK = L_OST + 8 * 4096, L_SEQ = L_MASK + 512, L_VAL = L_MASK + 1024, L_IMPH = L_VAL + 0;
constexpr int L_END = L_IMPH + 65536;
#define FA_MFMA(a, b, c) __builtin_amdgcn_mfma_f32_32x32x16_bf16(a, b, c, 0, 0, 0)
DEV int crow(int r, int hi) { return (r & 3) + 8 * (r >> 2) + 4 * hi; }
DEV s16x4 vtr(const LAS unsigned char* p) { return __builtin_bit_cast(s16x4, __builtin_amdgcn_ds_read_tr16_b64_v4i16((LAS s16x4*)p)); }
DEV float xhalf_max(float m) { auto rr = __builtin_amdgcn_permlane32_swap(__float_as_uint(m), __float_as_uint(m), false, false); return fmaxf(__uint_as_float(rr[0]), __uint_as_float(rr[1])); }
DEV float xhalf_sum(float m) { auto rr = __builtin_amdgcn_permlane32_swap(__float_as_uint(m), __float_as_uint(m), false, false); return __uint_as_float(rr[0]) + __uint_as_float(rr[1]); }

template <int NCH> struct KVRegs { u32x4 k0, k1, v; };
template <int NCH> DEV void stage_load(KVRegs<NCH>& r, const bf16_t* Kb, int kpitch, const bf16_t* Vb, int vpitch, int key0, int wid, int lane) {
    r.k0 = *(const u32x4*)(Kb + (size_t)(key0 + lane) * kpitch + wid * 8);
    if (NCH > 8 && wid < NCH - 8) r.k1 = *(const u32x4*)(Kb + (size_t)(key0 + lane) * kpitch + (8 + wid) * 8);
    r.v = *(const u32x4*)(Vb + (size_t)(key0 + 16 * (wid & 3) + (lane >> 2)) * vpitch + (wid >> 2) * 32 + (lane & 3) * 8);
}
template <int NCH> DEV void stage_write(const KVRegs<NCH>& r, LAS unsigned char* lds, int buf, int wid, int lane) {
    *(LAS u32x4*)(lds + L_K + buf * KSLOT + wid * 1024 + lane * 16) = r.k0;
    if (NCH > 8 && wid < NCH - 8) *(LAS u32x4*)(lds + L_K + buf * KSLOT + (8 + wid) * 1024 + lane * 16) = r.k1;
    *(LAS u32x4*)(lds + L_V + buf * VSLOT + wid * 1024 + lane * 16) = r.v;
}
template <int ND0> DEV void qk_tile(const LAS unsigned char* kbuf, int kp0, const bf16x8 (&qr)[ND0], f32x16& p0, f32x16& p1) {
#pragma unroll
    for (int r = 0; r < 16; ++r) { p0[r] = 0.f; p1[r] = 0.f; }
#pragma unroll
    for (int d0 = 0; d0 < ND0; ++d0) { const bf16x8 k0 = *(const LAS bf16x8*)(kbuf + kp0 + d0 * 2048), k1 = *(const LAS bf16x8*)(kbuf + kp0 + d0 * 2048 + 512);
        p0 = FA_MFMA(k0, qr[d0], p0); p1 = FA_MFMA(k1, qr[d0], p1); }
}
DEV float rowmax32(const f32x16& p0, const f32x16& p1) {
    float a = fmaxf(p0[0], p1[0]);
#pragma unroll
    for (int r = 1; r < 16; ++r) a = fmaxf(a, fmaxf(p0[r], p1[r]));
    return xhalf_max(a);
}
struct SmState { float mhat, l; f32x16 o[2]; };
DEV void sm_init(SmState& st) { st.mhat = -1e30f; st.l = 0.f;
#pragma unroll
    for (int r = 0; r < 16; ++r) { st.o[0][r] = 0.f; st.o[1][r] = 0.f; } }
DEV void sm_pv_tile(SmState& st, f32x16& p0, f32x16& p1, const LAS unsigned char* vbuf, int vp0, LAS float* wsf, int r32, int hi) {
    const float rm = rowmax32(p0, p1);
    const float newm = fmaxf(st.mhat, rm);
    if (__any(newm - st.mhat > 8.0f)) {
        const float f = fast_exp2(st.mhat - newm); st.mhat = newm; st.l *= f;
        if (hi == 0) wsf[r32] = f;
        asm volatile("s_waitcnt lgkmcnt(0)" ::: "memory");
#pragma unroll
        for (int r = 0; r < 16; ++r) { const float fr = wsf[crow(r, hi)]; st.o[0][r] *= fr; st.o[1][r] *= fr; }
        asm volatile("s_waitcnt lgkmcnt(0)" ::: "memory");
    }
    const float nm = -st.mhat; float sacc = 0.f;
#pragma unroll
    for (int r = 0; r < 16; ++r) { p0[r] = fast_exp2(p0[r] + nm); p1[r] = fast_exp2(p1[r] + nm); sacc += p0[r] + p1[r]; }
    st.l += sacc;
    u32x4 pw[4];
#pragma unroll
    for (int k = 0; k < 2; ++k) { pw[k] = (u32x4){pk2(p0[8 * k], p0[8 * k + 1]), pk2(p0[8 * k + 2], p0[8 * k + 3]), pk2(p0[8 * k + 4], p0[8 * k + 5]), pk2(p0[8 * k + 6], p0[8 * k + 7])};
        pw[2 + k] = (u32x4){pk2(p1[8 * k], p1[8 * k + 1]), pk2(p1[8 * k + 2], p1[8 * k + 3]), pk2(p1[8 * k + 4], p1[8 * k + 5]), pk2(p1[8 * k + 6], p1[8 * k + 7])}; }
#pragma unroll
    for (int dh = 0; dh < 2; ++dh)
#pragma unroll
        for (int ks = 0; ks < 4; ++ks) { const s16x4 lo = vtr(vbuf + vp0 + dh * 4096 + ks * 1024), hi4 = vtr(vbuf + vp0 + dh * 4096 + ks * 1024 + 512);
            const bf16x8 vf = (bf16x8){lo[0], lo[1], lo[2], lo[3], hi4[0], hi4[1], hi4[2], hi4[3]};
            st.o[dh] = FA_MFMA(__builtin_bit_cast(bf16x8, pw[ks]), vf, st.o[dh]); }
}
#define FA_MX3(a, b, c) __builtin_fmaxf(__builtin_fmaxf((a), (b)), (c))
template <int ND0> DEV void qk_tile_rel(const LAS unsigned char* kbuf, int kp0, const bf16x8 (&qr)[ND0], const f32x16& mC, f32x16& p0, f32x16& p1) {
    p0 = mC; p1 = mC;
#pragma unroll
    for (int d0 = 0; d0 < ND0; ++d0) { const bf16x8 k0 = *(const LAS bf16x8*)(kbuf + kp0 + d0 * 2048), k1 = *(const LAS bf16x8*)(kbuf + kp0 + d0 * 2048 + 512);
        p0 = FA_MFMA(k0, qr[d0], p0); p1 = FA_MFMA(k1, qr[d0], p1); }
}
DEV void sm_decide(SmState& st, f32x16& mC, f32x16& p0, f32x16& p1, bool firsttile, LAS float* wsf, int r32, int hi) {
    float a = FA_MX3(p0[0], p1[0], p0[1]), b = FA_MX3(p1[1], p0[2], p1[2]);
#pragma unroll
    for (int r = 3; r < 15; r += 2) { a = FA_MX3(a, p0[r], p1[r]); b = FA_MX3(b, p0[r + 1], p1[r + 1]); }
    a = FA_MX3(a, p0[15], p1[15]);
    const float rm = xhalf_max(fmaxf(a, b));
    if (firsttile) { const float m0 = (rm > -1e30f) ? rm : 0.f; st.mhat = m0;
#pragma unroll
        for (int r = 0; r < 16; ++r) { p0[r] -= m0; p1[r] -= m0; mC[r] = -m0; }
    } else if (__any(rm > 8.0f)) {
        const float dl = fmaxf(rm, 0.f); const float f = fast_exp2(-dl); st.mhat += dl; st.l *= f;
        if (hi == 0) wsf[r32] = f;
        asm volatile("s_waitcnt lgkmcnt(0)" ::: "memory");
#pragma unroll
        for (int r = 0; r < 16; ++r) { const float fr = wsf[crow(r, hi)]; st.o[0][r] *= fr; st.o[1][r] *= fr; p0[r] -= dl; p1[r] -= dl; mC[r] = -st.mhat; }
        asm volatile("s_waitcnt lgkmcnt(0)" ::: "memory");
    }
}
DEV void sm_exp_pv(SmState& st, f32x16& p0, f32x16& p1, const LAS unsigned char* vbuf, int vp0) {
    float s0 = 0.f, s1 = 0.f;
#pragma unroll
    for (int r = 0; r < 16; ++r) { p0[r] = fast_exp2(p0[r]); p1[r] = fast_exp2(p1[r]); s0 += p0[r]; s1 += p1[r]; }
    st.l += s0 + s1;
    u32x4 pw[4];
#pragma unroll
    for (int k = 0; k < 2; ++k) { pw[k] = (u32x4){pk2(p0[8 * k], p0[8 * k + 1]), pk2(p0[8 * k + 2], p0[8 * k + 3]), pk2(p0[8 * k + 4], p0[8 * k + 5]), pk2(p0[8 * k + 6], p0[8 * k + 7])};
        pw[2 + k] = (u32x4){pk2(p1[8 * k], p1[8 * k + 1]), pk2(p1[8 * k + 2], p1[8 * k + 3]), pk2(p1[8 * k + 4], p1[8 * k + 5]), pk2(p1[8 * k + 6], p1[8 * k + 7])}; }
#pragma unroll
    for (int dh = 0; dh < 2; ++dh)
#pragma unroll
        for (int ks = 0; ks < 4; ++ks) { const s16x4 lo = vtr(vbuf + vp0 + dh * 4096 + ks * 1024), hi4 = vtr(vbuf + vp0 + dh * 4096 + ks * 1024 + 512);
            const bf16x8 vf = (bf16x8){lo[0], lo[1], lo[2], lo[3], hi4[0], hi4[1], hi4[2], hi4[3]};
            st.o[dh] = FA_MFMA(__builtin_bit_cast(bf16x8, pw[ks]), vf, st.o[dh]); }
}
DEV void row_to_olayout(float fq, float (&out)[16], LAS float* wsf, int r32, int hi) {
    if (hi == 0) wsf[32 + r32] = fq;
    asm volatile("s_waitcnt lgkmcnt(0)" ::: "memory");
#pragma unroll
    for (int r = 0; r < 16; ++r) out[r] = wsf[32 + crow(r, hi)];
    asm volatile("s_waitcnt lgkmcnt(0)" ::: "memory");
}
DEV void store_o_rows(const f32x16 (&o)[2], bf16_t* dst, size_t pitch, LAS unsigned char* ost, int lane, int r32, int hi) {
    LAS bf16_t* stg = (LAS bf16_t*)ost;
#pragma unroll
    for (int r = 0; r < 16; ++r) { const int orow = crow(r, hi);
#pragma unroll
        for (int d0 = 0; d0 < 2; ++d0) stg[orow * 64 + d0 * 32 + r32] = f2bf(o[d0][r]); }
    asm volatile("s_waitcnt lgkmcnt(0)" ::: "memory");
#pragma unroll
    for (int i = 0; i < 4; ++i) { const int row = i * 8 + (lane >> 3), ch = lane & 7; *(u32x4*)(dst + (size_t)row * pitch + ch * 8) = *(const LAS u32x4*)(stg + row * 64 + ch * 8); }
    asm volatile("s_waitcnt lgkmcnt(0)" ::: "memory");
}

#define FT_SBAR() __builtin_amdgcn_sched_barrier(0)
#define FT_PIN(x) asm volatile("" : "+v"(x))
#define FT_WAIT_BAR(N) asm volatile("s_waitcnt vmcnt(" #N ") lgkmcnt(0)\n\ts_barrier" ::: "memory")
DEV unsigned ft_cvtpk(float lo, float hi) { unsigned r; asm("v_cvt_pk_bf16_f32 %0, %1, %2" : "=v"(r) : "v"(lo), "v"(hi)); return r; }
DEV void ft_glds16(const void* g, unsigned lds_base) { unsigned sv; asm volatile("s_mov_b32 %0, m0\n\ts_mov_b32 m0, %2\n\ts_nop 0\n\tglobal_load_lds_dwordx4 %1, off\n\ts_mov_b32 m0, %0" : "=&s"(sv) : "v"(g), "s"(lds_base) : "memory"); }
typedef LAS const char* ft_cptr;
DEV void ft_kload2(bf16x8* kf, ft_cptr kp, int d0) { kf[2 * d0] = *(const LAS bf16x8*)(kp + d0 * 2048); kf[2 * d0 + 1] = *(const LAS bf16x8*)(kp + d0 * 2048 + 512); }
DEV s16x4 ft_vtr(ft_cptr p) { return __builtin_bit_cast(s16x4, __builtin_amdgcn_ds_read_tr16_b64_v4i16((LAS s16x4*)p)); }
DEV float ft_rowmax(const f32x16& p0, const f32x16& p1) {
    float a = FA_MX3(p0[0], p0[1], p1[0]), b = FA_MX3(p0[2], p0[3], p1[1]); a = FA_MX3(a, p1[2], p1[3]);
#pragma unroll
    for (int r = 4; r < 16; r += 4) { a = FA_MX3(a, p0[r], p0[r + 1]); b = FA_MX3(b, p0[r + 2], p0[r + 3]); a = FA_MX3(a, p1[r], p1[r + 1]); b = FA_MX3(b, p1[r + 2], p1[r + 3]); }
    return xhalf_max(__builtin_fmaxf(a, b)); }
template <int MODE>
DEV void fa64_tuned(f32x16 (&o)[2], float& l_out, const bf16x8 (&qr)[4], const bf16_t* Kb, int kpitch, const bf16_t* Vb, int vpitch, unsigned long long um, int jlast, int NT,
                    unsigned long long rowmask, int tb, int tokl, LAS unsigned char* lds, LAS float* wsf, int wid, int lane, int r32, int hi) {
    constexpr int SLOTB = 8192; constexpr float THR = 8.0f;
    const unsigned lds0 = (unsigned)(uintptr_t)lds;
    const bf16_t* ksrc = Kb + (size_t)lane * kpitch + wid * 8;
    const bf16_t* vsrc = Vb + (size_t)(16 * (wid & 3) + (lane >> 2)) * vpitch + (wid >> 2) * 32 + (lane & 3) * 8;
    const unsigned kdst = lds0 + L_K + wid * 1024, vdst = lds0 + L_V + wid * 1024;
    unsigned long long rem_ = um; int jn_ = tb;
    auto gen = [&]() -> int { if (MODE == 0) { if (rem_ == 0ull) return 128; const int j = (int)__builtin_ctzll(rem_); rem_ &= rem_ - 1ull; return j; } else { if (jn_ < jlast) return 128; return jn_--; } };
    int w0 = gen(), w1 = gen(), w2 = gen(), w3 = gen();
#define FT_SHIFT() do { w0 = w1; w1 = w2; w2 = w3; w3 = gen(); } while (0)
#define FT_DMA_K(id, slot) ft_glds16(ksrc + (size_t)(((id) & 63) * 64) * kpitch, (unsigned)__builtin_amdgcn_readfirstlane(kdst + (slot)))
#define FT_DMA_V(id, slot) ft_glds16(vsrc + (size_t)(((id) & 63) * 64) * vpitch, (unsigned)__builtin_amdgcn_readfirstlane(vdst + (slot)))
    const ft_cptr vp0 = (ft_cptr)lds + L_V + ((lane >> 4) & 1) * 32 + (lane & 3) * 8 + (4 * hi + ((lane & 15) >> 2)) * 64;
    const ft_cptr kp0 = (ft_cptr)lds + L_K + hi * 1024 + r32 * 16;
    FT_DMA_K(w0, 0); FT_DMA_V(w0, 0); FT_DMA_K(w1, SLOTB); FT_DMA_K(w2, 2 * SLOTB);
    float mhat = 0.f, l_reg = 0.f; o[0] = f32x16{}; o[1] = f32x16{};
    const f32x16 zero16 = f32x16{};
    bool resc = false;
    f32x16 pA0, pA1, pB0, pB1; bf16x8 kf[8]; s16x4 vlo[8], vhi[8]; u32x4 pw0, pw1, pw2, pw3;
    int sl_prev = 0, sl_cur = 0, sl_next = SLOTB;
#define FT_ROT() do { sl_prev = sl_cur; sl_cur = sl_next; sl_next = (sl_next == 2 * SLOTB) ? 0 : sl_next + SLOTB; } while (0)
#define FT_EX(v) __builtin_amdgcn_exp2f((v) + nmh)
#define FT_RESC() do { if (resc) { _Pragma("unroll") for (int d_ = 0; d_ < 2; ++d_) _Pragma("unroll") for (int r = 0; r < 16; ++r) o[d_][r] *= wsf[crow(r, hi)]; } } while (0)
    auto emask = [&](int id, f32x16& p0, f32x16& p1) {
        const int j = id & 63, kb = 4 * hi;
        if (j == tb) {
#pragma unroll
            for (int r = 0; r < 16; ++r) { const int kv_ = kb + (r & 3) + 8 * (r >> 2); if (kv_ > tokl) p0[r] = -INFINITY; if (kv_ + 32 > tokl) p1[r] = -INFINITY; }
        } else if (MODE == 1 && j == tb - 8) {
#pragma unroll
            for (int r = 0; r < 16; ++r) { const int kv_ = kb + (r & 3) + 8 * (r >> 2); if (kv_ <= tokl) p0[r] = -INFINITY; if (kv_ + 32 <= tokl) p1[r] = -INFINITY; } } };
    auto rowsel = [&](int id) -> bool { if (id & 128) return false; if (MODE == 0) return (rowmask >> (id & 63)) & 1ull; return true; };
    FT_WAIT_BAR(3);
    _Pragma("unroll") for (int d0 = 0; d0 < 4; ++d0) ft_kload2(kf, kp0, d0);
    pA0 = FA_MFMA(kf[0], qr[0], zero16); pA1 = FA_MFMA(kf[1], qr[0], zero16); pA0 = FA_MFMA(kf[2], qr[1], pA0); pA1 = FA_MFMA(kf[3], qr[1], pA1);
    pA0 = FA_MFMA(kf[4], qr[2], pA0); pA1 = FA_MFMA(kf[5], qr[2], pA1); pA0 = FA_MFMA(kf[6], qr[3], pA0); pA1 = FA_MFMA(kf[7], qr[3], pA1);
    emask(w0, pA0, pA1);
    { const float rm = ft_rowmax(pA0, pA1); mhat = rm; const float nmh = -mhat;
#pragma unroll
      for (int r = 0; r < 16; ++r) { pA0[r] = FT_EX(pA0[r]); pA1[r] = FT_EX(pA1[r]); } }
    FT_WAIT_BAR(0);
    FT_DMA_K(w3, 0); FT_DMA_V(w1, SLOTB); FT_ROT(); FT_SHIFT();
    _Pragma("unroll") for (int d0 = 0; d0 < 4; ++d0) ft_kload2(kf, kp0 + sl_cur, d0);
    FT_WAIT_BAR(2);
#define FT_PKW(P, i) ft_cvtpk(P[i], P[i + 1])
#define FT_PAF(k) __builtin_bit_cast(bf16x8, pw##k)
#define FT_VFR(i) (bf16x8){vlo[i][0], vlo[i][1], vlo[i][2], vlo[i][3], vhi[i][0], vhi[i][1], vhi[i][2], vhi[i][3]}
#define FT_VRD(i) do { vlo[i] = ft_vtr(vp_ + (((i) >> 2) * 4096 + ((i) & 3) * 1024)); vhi[i] = ft_vtr(vp_ + (((i) >> 2) * 4096 + ((i) & 3) * 1024 + 512)); } while (0)
#define FT_KRD(G, d0) do { if (G) { ft_kload2(kf, kp0 + sl_next, d0); FT_SBAR(); } } while (0)
#define FT_GAPA(MF, a0, a1, a2, a3, W0, W1, PW) do { MF; sacc += a0; sacc += a1; sacc += a2; sacc += a3; W0; W1; FT_PIN(PW); FT_PIN(sacc); FT_SBAR(); } while (0)
#define FT_GAPB(MF, X, i) do { MF; X[i] = FT_EX(X[i]); X[i + 1] = FT_EX(X[i + 1]); X[i + 2] = FT_EX(X[i + 2]); X[i + 3] = FT_EX(X[i + 3]); FT_PIN(X); FT_SBAR(); } while (0)
#define FT_STEP(C0, C1, P0, P1, t, MASK, GK, GV, GL) do { FT_SBAR(); \
    const ft_cptr vp_ = vp0 + sl_prev; const int id_ = w0; \
    FT_VRD(0); FT_SBAR(); float sacc = P0[0] + P0[1]; \
                       FT_GAPA(C0 = FA_MFMA(kf[0], qr[0], zero16), P0[2], P0[3], P0[4], P0[5],     pw0[0] = FT_PKW(P0, 0),  pw0[1] = FT_PKW(P0, 2),  pw0); \
    FT_VRD(4); FT_SBAR(); FT_GAPA(C1 = FA_MFMA(kf[1], qr[0], zero16), P0[6], P0[7], P0[8], P0[9],     pw0[2] = FT_PKW(P0, 4),  pw0[3] = FT_PKW(P0, 6),  pw0); \
    FT_VRD(1); FT_SBAR(); FT_GAPA(C0 = FA_MFMA(kf[2], qr[1], C0),    P0[10], P0[11], P0[12], P0[13], pw1[0] = FT_PKW(P0, 8),  pw1[1] = FT_PKW(P0, 10), pw1); \
    FT_VRD(5); FT_SBAR(); FT_GAPA(C1 = FA_MFMA(kf[3], qr[1], C1),    P0[14], P0[15], P1[0], P1[1],   pw1[2] = FT_PKW(P0, 12), pw1[3] = FT_PKW(P0, 14), pw1); \
    FT_VRD(2); FT_SBAR(); FT_GAPA(C0 = FA_MFMA(kf[4], qr[2], C0),    P1[2], P1[3], P1[4], P1[5],     pw2[0] = FT_PKW(P1, 0),  pw2[1] = FT_PKW(P1, 2),  pw2); \
    FT_VRD(6); FT_SBAR(); FT_GAPA(C1 = FA_MFMA(kf[5], qr[2], C1),    P1[6], P1[7], P1[8], P1[9],     pw2[2] = FT_PKW(P1, 4),  pw2[3] = FT_PKW(P1, 6),  pw2); \
    FT_VRD(3); FT_SBAR(); FT_GAPA(C0 = FA_MFMA(kf[6], qr[3], C0),    P1[10], P1[11], P1[12], P1[13], pw3[0] = FT_PKW(P1, 8),  pw3[1] = FT_PKW(P1, 10), pw3); \
    FT_VRD(7); FT_SBAR(); FT_GAPA(C1 = FA_MFMA(kf[7], qr[3], C1),    P1[14], P1[15], 0.f, 0.f,       pw3[2] = FT_PKW(P1, 12), pw3[3] = FT_PKW(P1, 14), pw3); \
    l_reg += sacc; \
    if (GK) FT_DMA_K(w3, sl_cur); if (GV) FT_DMA_V(w1, sl_next); \
    if (MASK) emask(id_, C0, C1); \
    const bool rs_ = rowsel(id_); \
    { float rmx = ft_rowmax(C0, C1); if (!rs_) rmx = -INFINITY; const float rm = rmx - mhat; resc = false; \
      if (__builtin_expect(__any(rm > THR), 0)) { const float dl = __builtin_fmaxf(rm, 0.f); mhat += dl; \
          const float f = __builtin_amdgcn_exp2f(-dl); l_reg *= f; if (hi == 0) wsf[r32] = f; resc = true; } } \
    const float nmh = rs_ ? -mhat : -INFINITY; FT_SBAR(); \
    FT_GAPB(o[0] = FA_MFMA(FT_PAF(0), FT_VFR(0), o[0]), C0, 0);              FT_GAPB(o[1] = FA_MFMA(FT_PAF(0), FT_VFR(4), o[1]), C0, 4); \
    FT_KRD(GL, 0); FT_GAPB(o[0] = FA_MFMA(FT_PAF(1), FT_VFR(1), o[0]), C0, 8);  FT_KRD(GL, 1); FT_GAPB(o[1] = FA_MFMA(FT_PAF(1), FT_VFR(5), o[1]), C0, 12); \
    FT_KRD(GL, 2); FT_GAPB(o[0] = FA_MFMA(FT_PAF(2), FT_VFR(2), o[0]), C1, 0);  FT_KRD(GL, 3); FT_GAPB(o[1] = FA_MFMA(FT_PAF(2), FT_VFR(6), o[1]), C1, 4); \
    FT_GAPB(o[0] = FA_MFMA(FT_PAF(3), FT_VFR(3), o[0]), C1, 8);              FT_GAPB(o[1] = FA_MFMA(FT_PAF(3), FT_VFR(7), o[1]), C1, 12); \
    } while (0)
    int t = 1;
    for (; t + 5 < NT; t += 2) {
        FT_STEP(pB0, pB1, pA0, pA1, t, false, true, true, true);     FT_WAIT_BAR(2); FT_RESC(); FT_ROT(); FT_SHIFT();
        FT_STEP(pA0, pA1, pB0, pB1, t + 1, false, true, true, true); FT_WAIT_BAR(2); FT_RESC(); FT_ROT(); FT_SHIFT();
    }
#define FT_ENDW(tt) do { if ((tt) + 3 < NT) { FT_WAIT_BAR(2); } else if ((tt) + 2 < NT) { FT_WAIT_BAR(1); } else { FT_WAIT_BAR(0); } } while (0)
    for (; t + 1 < NT; t += 2) {
        FT_STEP(pB0, pB1, pA0, pA1, t, true, (t + 3 < NT), (t + 1 < NT), (t + 1 < NT));         FT_ENDW(t);     FT_RESC(); FT_ROT(); FT_SHIFT();
        FT_STEP(pA0, pA1, pB0, pB1, t + 1, true, (t + 4 < NT), (t + 2 < NT), (t + 2 < NT));     FT_ENDW(t + 1); FT_RESC(); FT_ROT(); FT_SHIFT();
    }
    FT_STEP(pB0, pB1, pA0, pA1, NT - 1, true, false, false, false); FT_RESC();
    { float sacc = pB0[0] + pB0[1];
#pragma unroll
      for (int r = 2; r < 16; ++r) sacc += pB0[r];
#pragma unroll
      for (int r = 0; r < 16; ++r) sacc += pB1[r];
      l_reg += sacc;
      pw0 = (u32x4){FT_PKW(pB0, 0), FT_PKW(pB0, 2), FT_PKW(pB0, 4), FT_PKW(pB0, 6)}; pw1 = (u32x4){FT_PKW(pB0, 8), FT_PKW(pB0, 10), FT_PKW(pB0, 12), FT_PKW(pB0, 14)};
      pw2 = (u32x4){FT_PKW(pB1, 0), FT_PKW(pB1, 2), FT_PKW(pB1, 4), FT_PKW(pB1, 6)}; pw3 = (u32x4){FT_PKW(pB1, 8), FT_PKW(pB1, 10), FT_PKW(pB1, 12), FT_PKW(pB1, 14)};
      const ft_cptr vp_ = vp0 + sl_cur; _Pragma("unroll") for (int i = 0; i < 8; ++i) FT_VRD(i);
      o[0] = FA_MFMA(FT_PAF(0), FT_VFR(0), o[0]); o[1] = FA_MFMA(FT_PAF(0), FT_VFR(4), o[1]); o[0] = FA_MFMA(FT_PAF(1), FT_VFR(1), o[0]); o[1] = FA_MFMA(FT_PAF(1), FT_VFR(5), o[1]);
      o[0] = FA_MFMA(FT_PAF(2), FT_VFR(2), o[0]); o[1] = FA_MFMA(FT_PAF(2), FT_VFR(6), o[1]); o[0] = FA_MFMA(FT_PAF(3), FT_VFR(3), o[0]); o[1] = FA_MFMA(FT_PAF(3), FT_VFR(7), o[1]); }
    l_out = l_reg;
    asm volatile("s_waitcnt lgkmcnt(0)\n\ts_barrier" ::: "memory");
#undef FT_SHIFT
#undef FT_DMA_K
#undef FT_DMA_V
#undef FT_ROT
#undef FT_EX
#undef FT_RESC
#undef FT_PKW
#undef FT_PAF
#undef FT_VFR
#undef FT_VRD
#undef FT_KRD
#undef FT_ENDW
#undef FT_GAPA
#undef FT_GAPB
#undef FT_STEP
}

constexpr int M_KSLOT = 12288, M_LK = 0, M_LV = 4 * M_KSLOT, M_LWSF = M_LV + 3 * 8192, M_LOST = M_LWSF + 8 * 512, M_LEND = M_LOST + 8 * 4096;
DEV void ft_wait_bar(int n) {
    if (n == 0) asm volatile("s_waitcnt vmcnt(0) lgkmcnt(0)\n\ts_barrier" ::: "memory");
    else if (n == 1) asm volatile("s_waitcnt vmcnt(1) lgkmcnt(0)\n\ts_barrier" ::: "memory");
    else if (n == 2) asm volatile("s_waitcnt vmcnt(2) lgkmcnt(0)\n\ts_barrier" ::: "memory");
    else if (n == 3) asm volatile("s_waitcnt vmcnt(3) lgkmcnt(0)\n\ts_barrier" ::: "memory");
    else asm volatile("s_waitcnt vmcnt(5) lgkmcnt(0)\n\ts_barrier" ::: "memory");
}
DEV void fa96_tuned(f32x16 (&o)[2], float& l_out, const bf16x8 (&qr)[6], const bf16_t* Kb, const bf16_t* Vb, int NT, int qrel, LAS unsigned char* lds, LAS float* wsf, int wid, int lane, int r32, int hi) {
    constexpr int SLOTB = 8192; constexpr float THR = 8.0f;
    const unsigned lds0 = (unsigned)(uintptr_t)lds;
    const int kc = (wid < 4) ? 2 : 1;
    const bf16_t* ksrc = Kb + (size_t)lane * 768 + wid * 8;
    const bf16_t* vsrc = Vb + (size_t)(16 * (wid & 3) + (lane >> 2)) * 512 + (wid >> 2) * 32 + (lane & 3) * 8;
    const unsigned kdst = lds0 + M_LK + wid * 1024, vdst = lds0 + M_LV + wid * 1024;
#define MT_DMA_K(t) do { const unsigned sl_ = (unsigned)(((t) & 3) * M_KSLOT); ft_glds16(ksrc + (size_t)(t) * 64 * 768, (unsigned)__builtin_amdgcn_readfirstlane(kdst + sl_)); \
        if (wid < 4) ft_glds16(ksrc + (size_t)(t) * 64 * 768 + 64, (unsigned)__builtin_amdgcn_readfirstlane(kdst + 8192 + sl_)); } while (0)
#define MT_DMA_V(t, slot) ft_glds16(vsrc + (size_t)(t) * 64 * 512, (unsigned)__builtin_amdgcn_readfirstlane(vdst + (slot)))
    const ft_cptr vp0 = (ft_cptr)lds + M_LV + ((lane >> 4) & 1) * 32 + (lane & 3) * 8 + (4 * hi + ((lane & 15) >> 2)) * 64;
    const ft_cptr kp0 = (ft_cptr)lds + M_LK + hi * 1024 + r32 * 16;
#define MT_KFR(kp, f) (*(const LAS bf16x8*)((kp) + ((f) >> 1) * 2048 + ((f) & 1) * 512))
    MT_DMA_K(0); MT_DMA_V(0, 0); MT_DMA_K(1); MT_DMA_K(2);
    float mhat = 0.f, l_reg = 0.f; o[0] = f32x16{}; o[1] = f32x16{};
    const f32x16 zero16 = f32x16{};
    bool resc = false;
    f32x16 pA0, pA1, pB0, pB1; bf16x8 kf[4]; s16x4 vlo[8], vhi[8]; u32x4 pw0, pw1, pw2, pw3;
    int sl_prev = 0, sl_cur = 0, sl_next = SLOTB;
    const int band0 = NT - 4;
#define MT_ROT() do { sl_prev = sl_cur; sl_cur = sl_next; sl_next = (sl_next == 2 * SLOTB) ? 0 : sl_next + SLOTB; } while (0)
#define MT_EX(v) __builtin_amdgcn_exp2f((v) + nmh)
#define MT_RESC() do { if (resc) { _Pragma("unroll") for (int d_ = 0; d_ < 2; ++d_) _Pragma("unroll") for (int r = 0; r < 16; ++r) o[d_][r] *= wsf[crow(r, hi)]; } } while (0)
    auto cmask = [&](int t, f32x16& p0, f32x16& p1) { const int jb = t - band0; if (jb >= 0) { const int kb = 64 * jb + 4 * hi;
#pragma unroll
            for (int r = 0; r < 16; ++r) { const int kv_ = kb + (r & 3) + 8 * (r >> 2); if (kv_ > qrel) p0[r] = -INFINITY; if (kv_ + 32 > qrel) p1[r] = -INFINITY; } } };
    ft_wait_bar(kc == 2 ? 5 : 3);
    { const ft_cptr kp = kp0;
      pA0 = zero16; pA1 = zero16;
#pragma unroll
      for (int d0 = 0; d0 < 6; ++d0) { const bf16x8 k0 = MT_KFR(kp, 2 * d0), k1 = MT_KFR(kp, 2 * d0 + 1); pA0 = FA_MFMA(k0, qr[d0], pA0); pA1 = FA_MFMA(k1, qr[d0], pA1); } }
    cmask(0, pA0, pA1);
    { const float rm = ft_rowmax(pA0, pA1); mhat = rm; const float nmh = -mhat;
#pragma unroll
      for (int r = 0; r < 16; ++r) { pA0[r] = MT_EX(pA0[r]); pA1[r] = MT_EX(pA1[r]); } }
    ft_wait_bar(0);
    MT_DMA_K(3); MT_DMA_V(1, SLOTB); MT_ROT();
    { const ft_cptr kp = kp0 + M_KSLOT;
#pragma unroll
      for (int f = 0; f < 4; ++f) kf[f] = MT_KFR(kp, f); }
    ft_wait_bar(kc + 1);
#define MT_PKW(P, i) ft_cvtpk(P[i], P[i + 1])
#define MT_PAF(k) __builtin_bit_cast(bf16x8, pw##k)
#define MT_VFR(i) (bf16x8){vlo[i][0], vlo[i][1], vlo[i][2], vlo[i][3], vhi[i][0], vhi[i][1], vhi[i][2], vhi[i][3]}
#define MT_VRD(i) do { vlo[i] = ft_vtr(vp_ + (((i) >> 2) * 4096 + ((i) & 3) * 1024)); vhi[i] = ft_vtr(vp_ + (((i) >> 2) * 4096 + ((i) & 3) * 1024 + 512)); } while (0)
#define MT_GAPA(i, C, a0, a1, a2, a3, W0, W1, PW) do { C = FA_MFMA(kf[(i) & 3], qr[(i) >> 1], ((i) < 2) ? zero16 : C); if ((i) + 4 < 12) kf[(i) & 3] = MT_KFR(kp_, (i) + 4); \
        sacc += a0; sacc += a1; sacc += a2; sacc += a3; W0; W1; FT_PIN(PW); FT_PIN(sacc); FT_SBAR(); } while (0)
#define MT_GAPA0(i, C) do { C = FA_MFMA(kf[(i) & 3], qr[(i) >> 1], C); if ((i) + 4 < 12) kf[(i) & 3] = MT_KFR(kp_, (i) + 4); FT_SBAR(); } while (0)
#define MT_GAPB(MF, X, i) do { MF; X[i] = MT_EX(X[i]); X[i + 1] = MT_EX(X[i + 1]); X[i + 2] = MT_EX(X[i + 2]); X[i + 3] = MT_EX(X[i + 3]); FT_PIN(X); FT_SBAR(); } while (0)
#define MT_STEP(C0, C1, P0, P1, t, MASK, GK, GV, GL) do { FT_SBAR(); \
    const ft_cptr vp_ = vp0 + sl_prev; const ft_cptr kp_ = kp0 + ((t) & 3) * M_KSLOT; \
    MT_VRD(0); FT_SBAR(); float sacc = P0[0] + P0[1]; \
                          MT_GAPA(0, C0, P0[2], P0[3], P0[4], P0[5],     pw0[0] = MT_PKW(P0, 0),  pw0[1] = MT_PKW(P0, 2),  pw0); \
    MT_VRD(4); FT_SBAR(); MT_GAPA(1, C1, P0[6], P0[7], P0[8], P0[9],     pw0[2] = MT_PKW(P0, 4),  pw0[3] = MT_PKW(P0, 6),  pw0); \
    MT_VRD(1); FT_SBAR(); MT_GAPA(2, C0, P0[10], P0[11], P0[12], P0[13], pw1[0] = MT_PKW(P0, 8),  pw1[1] = MT_PKW(P0, 10), pw1); \
    MT_VRD(5); FT_SBAR(); MT_GAPA(3, C1, P0[14], P0[15], P1[0], P1[1],   pw1[2] = MT_PKW(P0, 12), pw1[3] = MT_PKW(P0, 14), pw1); \
    MT_VRD(2); FT_SBAR(); MT_GAPA(4, C0, P1[2], P1[3], P1[4], P1[5],     pw2[0] = MT_PKW(P1, 0),  pw2[1] = MT_PKW(P1, 2),  pw2); \
    MT_VRD(6); FT_SBAR(); MT_GAPA(5, C1, P1[6], P1[7], P1[8], P1[9],     pw2[2] = MT_PKW(P1, 4),  pw2[3] = MT_PKW(P1, 6),  pw2); \
    MT_VRD(3); FT_SBAR(); MT_GAPA(6, C0, P1[10], P1[11], P1[12], P1[13], pw3[0] = MT_PKW(P1, 8),  pw3[1] = MT_PKW(P1, 10), pw3); \
    MT_VRD(7); FT_SBAR(); MT_GAPA(7, C1, P1[14], P1[15], 0.f, 0.f,       pw3[2] = MT_PKW(P1, 12), pw3[3] = MT_PKW(P1, 14), pw3); \
    MT_GAPA0(8, C0); MT_GAPA0(9, C1); MT_GAPA0(10, C0); MT_GAPA0(11, C1); \
    l_reg += sacc; \
    if (GK) MT_DMA_K((t) + 3); if (GV) MT_DMA_V((t) + 1, sl_next); \
    if (MASK) cmask((t), C0, C1); \
    { const float rm = ft_rowmax(C0, C1) - mhat; resc = false; \
      if (__builtin_expect(__any(rm > THR), 0)) { const float dl = __builtin_fmaxf(rm, 0.f); mhat += dl; \
          const float f = __builtin_amdgcn_exp2f(-dl); l_reg *= f; if (hi == 0) wsf[r32] = f; resc = true; } } \
    const float nmh = -mhat; FT_SBAR(); \
    MT_GAPB(o[0] = FA_MFMA(MT_PAF(0), MT_VFR(0), o[0]), C0, 0);  MT_GAPB(o[1] = FA_MFMA(MT_PAF(0), MT_VFR(4), o[1]), C0, 4); \
    MT_GAPB(o[0] = FA_MFMA(MT_PAF(1), MT_VFR(1), o[0]), C0, 8);  MT_GAPB(o[1] = FA_MFMA(MT_PAF(1), MT_VFR(5), o[1]), C0, 12); \
    MT_GAPB(o[0] = FA_MFMA(MT_PAF(2), MT_VFR(2), o[0]), C1, 0);  MT_GAPB(o[1] = FA_MFMA(MT_PAF(2), MT_VFR(6), o[1]), C1, 4); \
    MT_GAPB(o[0] = FA_MFMA(MT_PAF(3), MT_VFR(3), o[0]), C1, 8);  MT_GAPB(o[1] = FA_MFMA(MT_PAF(3), MT_VFR(7), o[1]), C1, 12); \
    if (GL) { const ft_cptr kn_ = kp0 + (((t) + 1) & 3) * M_KSLOT; _Pragma("unroll") for (int f = 0; f < 4; ++f) kf[f] = MT_KFR(kn_, f); } \
    } while (0)
#define MT_ENDW(tt) do { if ((tt) + 3 < NT) ft_wait_bar(kc + 1); else if ((tt) + 2 < NT) ft_wait_bar(1); else ft_wait_bar(0); } while (0)
    int t = 1;
    for (; t + 5 < NT; t += 2) {
        MT_STEP(pB0, pB1, pA0, pA1, t, false, true, true, true);     ft_wait_bar(kc + 1); MT_RESC(); MT_ROT();
        MT_STEP(pA0, pA1, pB0, pB1, t + 1, false, true, true, true); ft_wait_bar(kc + 1); MT_RESC(); MT_ROT();
    }
    for (; t + 1 < NT; t += 2) {
        MT_STEP(pB0, pB1, pA0, pA1, t, true, (t + 3 < NT), (t + 1 < NT), (t + 1 < NT));         MT_ENDW(t);     MT_RESC(); MT_ROT();
        MT_STEP(pA0, pA1, pB0, pB1, t + 1, true, (t + 4 < NT), (t + 2 < NT), (t + 2 < NT));     MT_ENDW(t + 1); MT_RESC(); MT_ROT();
    }
    MT_STEP(pB0, pB1, pA0, pA1, NT - 1, true, false, false, false); MT_RESC();
    { float sacc = pB0[0] + pB0[1];
#pragma unroll
      for (int r = 2; r < 16; ++r) sacc += pB0[r];
#pragma unroll
      for (int r = 0; r < 16; ++r) sacc += pB1[r];
      l_reg += sacc;
      pw0 = (u32x4){MT_PKW(pB0, 0), MT_PKW(pB0, 2), MT_PKW(pB0, 4), MT_PKW(pB0, 6)}; pw1 = (u32x4){MT_PKW(pB0, 8), MT_PKW(pB0, 10), MT_PKW(pB0, 12), MT_PKW(pB0, 14)};
      pw2 = (u32x4){MT_PKW(pB1, 0), MT_PKW(pB1, 2), MT_PKW(pB1, 4), MT_PKW(pB1, 6)}; pw3 = (u32x4){MT_PKW(pB1, 8), MT_PKW(pB1, 10), MT_PKW(pB1, 12), MT_PKW(pB1, 14)};
      const ft_cptr vp_ = vp0 + sl_cur; _Pragma("unroll") for (int i = 0; i < 8; ++i) MT_VRD(i);
      o[0] = FA_MFMA(MT_PAF(0), MT_VFR(0), o[0]); o[1] = FA_MFMA(MT_PAF(0), MT_VFR(4), o[1]); o[0] = FA_MFMA(MT_PAF(1), MT_VFR(1), o[0]); o[1] = FA_MFMA(MT_PAF(1), MT_VFR(5), o[1]);
      o[0] = FA_MFMA(MT_PAF(2), MT_VFR(2), o[0]); o[1] = FA_MFMA(MT_PAF(2), MT_VFR(6), o[1]); o[0] = FA_MFMA(MT_PAF(3), MT_VFR(3), o[0]); o[1] = FA_MFMA(MT_PAF(3), MT_VFR(7), o[1]); }
    l_out = l_reg;
    asm volatile("s_waitcnt lgkmcnt(0)\n\ts_barrier" ::: "memory");
#undef MT_DMA_K
#undef MT_DMA_V
#undef MT_KFR
#undef MT_ROT
#undef MT_EX
#undef MT_RESC
#undef MT_PKW
#undef MT_PAF
#undef MT_VFR
#undef MT_VRD
#undef MT_GAPA
#undef MT_GAPA0
#undef MT_GAPB
#undef MT_STEP
#undef MT_ENDW
}
}

DEV void mla_unit(const Params& p, LAS unsigned char* lds, int b, int h, int qb) {
    using namespace fa;
    const int tid = opaque_tid(), wid = __builtin_amdgcn_readfirstlane(tid >> 6), lane = tid & 63, r32 = lane & 31, hi = lane >> 5;
    const bf16_t* QM = (const bf16_t*)(p.ws + OFF_QM); const bf16_t* Kb = (const bf16_t*)(p.ws + OFF_KM) + (size_t)b * SEQ * 768 + h * 96;
    const bf16_t* Vb = (const bf16_t*)(p.ws + OFF_VM) + (size_t)b * SEQ * 512 + h * 64; bf16_t* OCAT = (bf16_t*)(p.ws + OFF_OCAT);
    const int q0 = qb * 256, NT = (q0 + 256) / 64;
    LAS float* wsf = (LAS float*)(lds + M_LWSF) + wid * 128;
    bf16x8 qr[6];
    { const bf16_t* qrow = QM + ((size_t)b * SEQ + q0 + wid * 32 + r32) * 768 + h * 96 + hi * 8;
#pragma unroll
      for (int d0 = 0; d0 < 6; ++d0) qr[d0] = *(const bf16x8*)(qrow + d0 * 16); }
    f32x16 o[2]; float lpart;
    fa96_tuned(o, lpart, qr, Kb, Vb, NT, wid * 32 + r32, lds, wsf, wid, lane, r32, hi);
    const float l = xhalf_sum(lpart); float rl[16]; row_to_olayout(1.0f / l, rl, wsf, r32, hi);
#pragma unroll
    for (int r = 0; r < 16; ++r) { o[0][r] *= rl[r]; o[1][r] *= rl[r]; }
    store_o_rows(o, OCAT + ((size_t)b * SEQ + q0 + wid * 32) * 1024 + h * 64, 1024, lds + M_LOST + wid * 4096, lane, r32, hi);
    __syncthreads();
}
DEV void nsa_unit(const Params& p, LAS unsigned char* lds, int b, int g, int tb) {
    using namespace fa;
    const int tid = opaque_tid(), wid = __builtin_amdgcn_readfirstlane(tid >> 6), lane = tid & 63, r32 = lane & 31, hi = lane >> 5;
    const int hl = wid >> 1, head = 4 * g + hl, q0 = 64 * tb, tokl = 32 * (wid & 1) + r32, t = q0 + tokl;
    const size_t tok = (size_t)b * SEQ + t;
    const bf16_t* PROJ = (const bf16_t*)(p.ws + OFF_PROJ); const float* GATES = (const float*)(p.ws + OFF_GATES);
    LAS float* wsf = (LAS float*)(lds + L_WSF) + wid * 128;
    LAS float* impH = (LAS float*)(lds + L_IMPH);
    const int kp0 = hi * 1024 + r32 * 16;
    const int vp0 = ((lane >> 4) & 1) * 32 + (lane & 3) * 8 + (4 * hi + ((lane & 15) >> 2)) * 64;
    bf16x8 qr[4];
    { const bf16_t* qrow = (const bf16_t*)(p.ws + OFF_NQ) + tok * 512 + head * 64 + hi * 8;
#pragma unroll
      for (int d0 = 0; d0 < 4; ++d0) qr[d0] = *(const bf16x8*)(qrow + d0 * 16); }
    if (hi == 0) { const float* gp_ = GATES + tok * 24 + head * 3; wsf[64 + r32] = gp_[0]; wsf[96 + r32] = gp_[1]; }
    const float g2reg = GATES[tok * 24 + head * 3 + 2];
    { LAS f32x4* z = (LAS f32x4*)impH + tid;
#pragma unroll
      for (int i = 0; i < 8; ++i) z[i * 512] = (f32x4){0.f, 0.f, 0.f, 0.f}; }
    KVRegs<8> kv;
    f32x16 res[2];
    const int cntq = (t >= 31) ? ((t - 31) >> 4) + 1 : 0;
    const int ntc = (4 * tb + 3 + 63) >> 6;
    const bf16_t* Kc = (const bf16_t*)(p.ws + OFF_KC) + ((size_t)b * NCMPP * 2 + g) * 64; const bf16_t* Vc = (const bf16_t*)(p.ws + OFF_VC) + ((size_t)b * NCMPP * 2 + g) * 64;
    float mc = -1e30f, lc = 0.f;
    {   KVRegs<8> kc4[4];
#pragma unroll
        for (int c = 0; c < 4; ++c) if (c < ntc) stage_load<8>(kc4[c], Kc, 128, Vc, 128, c * 64, wid, lane);

#pragma unroll
        for (int c = 0; c < 4; ++c) if (c < ntc) { *(LAS u32x4*)(lds + L_K + c * 8192 + wid * 1024 + lane * 16) = kc4[c].k0; *(LAS u32x4*)(lds + L_OST + c * 8192 + wid * 1024 + lane * 16) = kc4[c].v; } }
    __syncthreads();
#pragma unroll 1
    for (int c = 0; c < ntc; ++c) {
        f32x16 p0, p1; qk_tile<4>(lds + L_K + c * 8192, kp0, qr, p0, p1);
        const int nb = 64 * c + 4 * hi;
#pragma unroll
        for (int r = 0; r < 16; ++r) { const int n = nb + (r & 3) + 8 * (r >> 2); if (n >= cntq) p0[r] = -INFINITY; if (n + 32 >= cntq) p1[r] = -INFINITY; }
        const float newm = fmaxf(mc, rowmax32(p0, p1)); float sacc = 0.f;
#pragma unroll
        for (int r = 0; r < 16; ++r) sacc += fast_exp2(p0[r] - newm) + fast_exp2(p1[r] - newm);
        lc = lc * fast_exp2(mc - newm) + sacc; mc = newm;
    }
    lc = xhalf_sum(lc);
    const float rlc = (lc > 0.f) ? 1.0f / lc : 0.f;
    float carry = 0.f;
    f32x16 oc[2];
#pragma unroll
    for (int r = 0; r < 16; ++r) { oc[0][r] = 0.f; oc[1][r] = 0.f; }
#pragma unroll 1
    for (int c = 0; c < ntc; ++c) {
        f32x16 p0, p1; qk_tile<4>(lds + L_K + c * 8192, kp0, qr, p0, p1);
        const int nb = 64 * c + 4 * hi;
#pragma unroll
        for (int r = 0; r < 16; ++r) { const int n = nb + (r & 3) + 8 * (r >> 2);
            p0[r] = (n >= cntq) ? 0.f : fast_exp2(p0[r] - mc) * rlc; p1[r] = (n + 32 >= cntq) ? 0.f : fast_exp2(p1[r] - mc) * rlc; }
        { LAS float* ih = impH + (size_t)hl * 4096 + tokl; float b0[4], b1[4];
#pragma unroll
          for (int k = 0; k < 4; ++k) { b0[k] = __shfl_xor(p0[4 * k + 3], 32); b1[k] = __shfl_xor(p1[4 * k + 3], 32); }
#pragma unroll
          for (int k = 0; k < 4; ++k) { const int j0 = 16 * c + 2 * k + hi, j1 = j0 + 8;
              const float G0 = (p0[4 * k] + p0[4 * k + 1]) + (p0[4 * k + 2] + p0[4 * k + 3]), G1 = (p1[4 * k] + p1[4 * k + 1]) + (p1[4 * k + 2] + p1[4 * k + 3]);
              const float e0 = hi ? b0[k] : (k ? b0[k > 0 ? k - 1 : 0] : carry), e1 = hi ? b1[k] : (k ? b1[k > 0 ? k - 1 : 0] : b0[3]);
              ih[j0 * 64] = G0 + e0; ih[j1 * 64] = G1 + e1; }
          carry = b1[3]; }
        u32x4 pw[4];
#pragma unroll
        for (int k = 0; k < 2; ++k) { pw[k] = (u32x4){pk2(p0[8 * k], p0[8 * k + 1]), pk2(p0[8 * k + 2], p0[8 * k + 3]), pk2(p0[8 * k + 4], p0[8 * k + 5]), pk2(p0[8 * k + 6], p0[8 * k + 7])};
            pw[2 + k] = (u32x4){pk2(p1[8 * k], p1[8 * k + 1]), pk2(p1[8 * k + 2], p1[8 * k + 3]), pk2(p1[8 * k + 4], p1[8 * k + 5]), pk2(p1[8 * k + 6], p1[8 * k + 7])}; }
        const LAS unsigned char* vbuf = lds + L_OST + c * 8192;
#pragma unroll
        for (int dh = 0; dh < 2; ++dh)
#pragma unroll
            for (int ks = 0; ks < 4; ++ks) { const s16x4 lo = vtr(vbuf + vp0 + dh * 4096 + ks * 1024), hi4 = vtr(vbuf + vp0 + dh * 4096 + ks * 1024 + 512);
                const bf16x8 vf = (bf16x8){lo[0], lo[1], lo[2], lo[3], hi4[0], hi4[1], hi4[2], hi4[3]};
                oc[dh] = FA_MFMA(__builtin_bit_cast(bf16x8, pw[ks]), vf, oc[dh]); }
    }
    __syncthreads();
    {   const int tk = tid & 63; const int cur = tb;
        float v[8];
#pragma unroll
        for (int k = 0; k < 8; ++k) { const int j = 8 * wid + k; const LAS float* q_ = impH + j * 64 + tk;
            const float s4 = ((q_[0] + q_[4096]) + q_[2 * 4096]) + q_[3 * 4096]; const bool forced = (j == 0) || (j <= cur && j > cur - 2); v[k] = forced ? 1e30f : s4; }
#pragma unroll
        for (int k = 0; k < 8; ++k) impH[(8 * wid + k) * 64 + tk] = v[k];
        __syncthreads();
        unsigned bits = 0u; int rank[8];
#pragma unroll
        for (int k = 0; k < 8; ++k) rank[k] = 0;
        if (cur >= 16)
#pragma unroll 4
        for (int q_ = 0; q_ <= cur; ++q_) { const float vq = impH[q_ * 64 + tk];
#pragma unroll
            for (int k = 0; k < 8; ++k) rank[k] += (vq > v[k] || (vq == v[k] && q_ < 8 * wid + k)) ? 1 : 0; }
#pragma unroll
        for (int k = 0; k < 8; ++k) if (8 * wid + k <= cur && rank[k] < 16) bits |= (1u << k);
        ((LAS unsigned char*)(lds + L_MASK))[tk * 8 + wid] = (unsigned char)bits;
        __syncthreads();
    }
    LAS float* resL = impH + wid * 2048 + lane;
    { float f[16]; row_to_olayout(wsf[64 + r32], f, wsf, r32, hi);
#pragma unroll
      for (int r = 0; r < 16; ++r) { resL[r * 64] = oc[0][r] * f[r]; resL[(16 + r) * 64] = oc[1][r] * f[r]; } }
    const unsigned long long mymask = *(const LAS unsigned long long*)(lds + L_MASK + tokl * 8);
    unsigned long long um;
    { const unsigned long long mm = *(const LAS unsigned long long*)(lds + L_MASK + lane * 8); unsigned ulo = (unsigned)mm, uhi = (unsigned)(mm >> 32);
#pragma unroll
      for (int o_ = 1; o_ < 64; o_ <<= 1) { ulo |= __shfl_xor(ulo, o_); uhi |= __shfl_xor(uhi, o_); }
      um = ((unsigned long long)(unsigned)__builtin_amdgcn_readfirstlane(uhi) << 32) | (unsigned)__builtin_amdgcn_readfirstlane(ulo); }
    {   const bf16_t* Kb = (const bf16_t*)(p.ws + OFF_KSR) + (size_t)b * SEQ * 128 + g * 64; const bf16_t* Vb = (const bf16_t*)(p.ws + OFF_VSC) + (size_t)b * SEQ * 128 + g * 64;
        int nt = __builtin_popcountll(um);
        while (nt < 4 || (nt & 1)) ++nt;
        f32x16 o[2]; float lpart;
        fa64_tuned<0>(o, lpart, qr, Kb, 128, Vb, 128, um, 0, nt, mymask, tb, tokl, lds, wsf, wid, lane, r32, hi);
        const float l = xhalf_sum(lpart); float f[16]; row_to_olayout(wsf[96 + r32] / l, f, wsf, r32, hi);
#pragma unroll
        for (int r = 0; r < 16; ++r) { resL[r * 64] += o[0][r] * f[r]; resL[(16 + r) * 64] += o[1][r] * f[r]; }
    }
    {   const bf16_t* Kb = (const bf16_t*)(p.ws + OFF_KWR) + (size_t)b * SEQ * 128 + g * 64; const bf16_t* Vb = (const bf16_t*)(p.ws + OFF_VWC) + (size_t)b * SEQ * 128 + g * 64;
        const int jlast = (tb - 8 > 0) ? tb - 8 : 0; int nt = tb - jlast + 1;
        while (nt < 4 || (nt & 1)) ++nt;
        f32x16 o[2]; float lpart;
        fa64_tuned<1>(o, lpart, qr, Kb, 128, Vb, 128, 0ull, jlast, nt, 0ull, tb, tokl, lds, wsf, wid, lane, r32, hi);
        const float l = xhalf_sum(lpart); float f[16]; row_to_olayout(g2reg / l, f, wsf, r32, hi);
#pragma unroll
        for (int r = 0; r < 16; ++r) { res[0][r] = resL[r * 64] + o[0][r] * f[r]; res[1][r] = resL[(16 + r) * 64] + o[1][r] * f[r]; }
        asm volatile("s_waitcnt lgkmcnt(0)" ::: "memory");
    }
    store_o_rows(res, (bf16_t*)(p.ws + OFF_OCAT) + ((size_t)b * SEQ + q0 + 32 * (wid & 1)) * 1024 + 512 + head * 64, 1024, lds + L_OST + wid * 4096, lane, r32, hi);
    __syncthreads();
}
DEV void phase5_nsa_fa(const Params& p, LAS unsigned char* lds) {
    constexpr int NU = BATCH * 2 * 64;
    const int G = gridDim.x;
    for (int r = 0; r * G < NU; ++r) {
        const int k = r * G + ((r & 1) ? (G - 1 - (int)blockIdx.x) : (int)blockIdx.x);
        if (k >= NU) continue;
        const int tb = 63 - k / 16, bg = k % 16;
        nsa_unit(p, lds, bg >> 1, bg & 1, tb);
    }
}
DEV void phase5_mla_fa(const Params& p, LAS unsigned char* lds) {
    constexpr int NU = BATCH * 8 * 16;
    const int G = gridDim.x;
    for (int r = 0; r * G < NU; ++r) {
        const int k = r * G + ((r & 1) ? (G - 1 - (int)blockIdx.x) : (int)blockIdx.x);
        if (k >= NU) continue;
        const int qb = 15 - k / 64, bh = k % 64;
        mla_unit(p, lds, bh >> 3, bh & 7, qb);
    }
}

DEV void phase5_cmp(const Params& p, LAS unsigned char* lds) {
    const int tid = opaque_tid(), hl = tid >> 7, tl = tid & 127;
    const bf16_t* NQ = (const bf16_t*)(p.ws + OFF_NQ); const bf16_t* KC = (const bf16_t*)(p.ws + OFF_KC); const bf16_t* VC = (const bf16_t*)(p.ws + OFF_VC);
    float* OCMP = (float*)(p.ws + OFF_OCMP); unsigned long long* SELM = (unsigned long long*)(p.ws + OFF_SELM);
    LAS float* imp = (LAS float*)lds;
    constexpr int NU = BATCH * 2 * (SEQ / 128);
    for (int u = blockIdx.x; u < NU; u += gridDim.x) {
        const int tb = u % (SEQ / 128), g = (u / (SEQ / 128)) & 1, b = u / (SEQ / 128 * 2);
        const int t = tb * 128 + tl, head = g * 4 + hl; const size_t tok = (size_t)b * SEQ + t;
        float q[64];
        { const bf16_t* qr = NQ + tok * 512 + head * 64;
#pragma unroll
          for (int i = 0; i < 32; ++i) { const unsigned w = *(const unsigned*)(qr + 2 * i); q[2 * i] = bflo(w); q[2 * i + 1] = bfhi(w); } }
        for (int j = 0; j < 64; ++j) imp[(hl * 64 + j) * 128 + tl] = 0.f;
        const int cnt = (t >= 31) ? ((t - 31) / 16 + 1) : 0;
        const int tmaxw = tb * 128 + (tl | 63); const int cntw = (tmaxw >= 31) ? ((tmaxw - 31) / 16 + 1) : 0;
        const bf16_t* kb = KC + ((size_t)b * NCMPP * 2 + g) * 64; const bf16_t* vb = VC + ((size_t)b * NCMPP * 2 + g) * 64;
        float m = -INFINITY, l = 0.f;
        for (int n = 0; n < cntw; ++n) { float a = 0.f;
#pragma unroll
            for (int i = 0; i < 32; ++i) { const unsigned w = *(const unsigned*)(kb + (size_t)n * 128 + 2 * i); a += q[2 * i] * bflo(w); a += q[2 * i + 1] * bfhi(w); }
            if (n < cnt) { const float mn = fmaxf(m, a); l = l * fast_exp2(m - mn) + fast_exp2(a - mn); m = mn; } }
        const float rl = (cnt > 0) ? 1.0f / l : 0.f;
        float o[64];
#pragma unroll
        for (int d = 0; d < 64; ++d) o[d] = 0.f;
        for (int n = 0; n < cntw; ++n) { float a = 0.f;
#pragma unroll
            for (int i = 0; i < 32; ++i) { const unsigned w = *(const unsigned*)(kb + (size_t)n * 128 + 2 * i); a += q[2 * i] * bflo(w); a += q[2 * i + 1] * bfhi(w); }
            const float pr = (n < cnt) ? fast_exp2(a - m) * rl : 0.f;
#pragma unroll
            for (int i = 0; i < 32; ++i) { const unsigned w = *(const unsigned*)(vb + (size_t)n * 128 + 2 * i); o[2 * i] += pr * bflo(w); o[2 * i + 1] += pr * bfhi(w); }
            const int jj = n >> 2; imp[(hl * 64 + jj) * 128 + tl] += pr; if ((n & 3) == 3 && jj + 1 < 64) imp[(hl * 64 + jj + 1) * 128 + tl] += pr; }
        { float* orow = OCMP + tok * 512 + head * 64; const float g0 = ((const float*)(p.ws + OFF_GATES))[tok * 24 + head * 3 + 0];
#pragma unroll
          for (int i = 0; i < 16; ++i) *(f32x4*)(orow + 4 * i) = (f32x4){g0 * o[4 * i], g0 * o[4 * i + 1], g0 * o[4 * i + 2], g0 * o[4 * i + 3]}; }
        __syncthreads();
        if (tid < 128) {
            const int cur = t >> 6;
            for (int j = 0; j < 64; ++j) { const float v = ((imp[(0 * 64 + j) * 128 + tl] + imp[(1 * 64 + j) * 128 + tl]) + imp[(2 * 64 + j) * 128 + tl]) + imp[(3 * 64 + j) * 128 + tl];
                const bool forced = (j == 0) || (j <= cur && j > cur - 2);
                imp[j * 128 + tl] = forced ? 1e30f : v; }
            unsigned long long mask = 0ull;
            for (int j = 0; j <= cur; ++j) { const float vj = imp[j * 128 + tl]; int rank = 0;
                for (int k = 0; k <= cur; ++k) { const float vk = imp[k * 128 + tl]; rank += (vk > vj || (vk == vj && k < j)) ? 1 : 0; }
                if (rank < 16) mask |= (1ull << j); }
            SELM[((size_t)b * 2 + g) * SEQ + t] = mask;
        }
        __syncthreads();
    }
}

DEV void phase5_selwin(const Params& p) {
    const int tid = opaque_tid(), wid = __builtin_amdgcn_readfirstlane(tid >> 6), lane = tid & 63;
    const int gw = blockIdx.x * 8 + wid, NGW = gridDim.x * 8;
    const bf16_t* NQ = (const bf16_t*)(p.ws + OFF_NQ); const bf16_t* KSR = (const bf16_t*)(p.ws + OFF_KSR); const bf16_t* KWR = (const bf16_t*)(p.ws + OFF_KWR);
    const bf16_t* PROJ = (const bf16_t*)(p.ws + OFF_PROJ); float* OCMP = (float*)(p.ws + OFF_OCMP); const float* GATES = (const float*)(p.ws + OFF_GATES);
    const unsigned long long* SELM = (const unsigned long long*)(p.ws + OFF_SELM); bf16_t* OCAT = (bf16_t*)(p.ws + OFF_OCAT);
    constexpr int NUNIT = BATCH * 8 * (SEQ / 64);
#pragma unroll 1
    for (int uu = gw; uu < NUNIT; uu += NGW) {
        const int u = (uu & 1) ? (NUNIT - 1 - (uu >> 1)) : (uu >> 1);
        const int tb = u % (SEQ / 64), head = (u / (SEQ / 64)) & 7, b = u / (SEQ / 64 * 8), g = head >> 2;
        const int t = tb * 64 + lane; const size_t tok = (size_t)b * SEQ + t;
        float q[64];
        { const bf16_t* qr = NQ + tok * 512 + head * 64;
#pragma unroll
          for (int i = 0; i < 32; ++i) { const unsigned w = *(const unsigned*)(qr + 2 * i); q[2 * i] = bflo(w); q[2 * i + 1] = bfhi(w); } }
        const unsigned long long mask = SELM[((size_t)b * 2 + g) * SEQ + t];
        unsigned ulo = (unsigned)mask, uhi = (unsigned)(mask >> 32);
#pragma unroll
        for (int o_ = 1; o_ < 64; o_ <<= 1) { ulo |= __shfl_xor(ulo, o_); uhi |= __shfl_xor(uhi, o_); }
        const unsigned long long um = ((unsigned long long)__builtin_amdgcn_readfirstlane(uhi) << 32) | (unsigned)__builtin_amdgcn_readfirstlane(ulo);
        float* oc = OCMP + tok * 512 + head * 64;
        { float o[64];
#pragma unroll
          for (int d = 0; d < 64; ++d) o[d] = 0.f;
          float m = -INFINITY, l = 0.f;
          const bf16_t* kb = KSR + (size_t)b * SEQ * 128 + g * 64; const bf16_t* vb = PROJ + (size_t)b * SEQ * INP + C_VS + g * 64;
#pragma unroll 1
          for (int blk = 0; blk <= tb; ++blk) { if (!((um >> blk) & 1ull)) continue; const bool sel = (mask >> blk) & 1ull;
              naive_attn_range<64, 64>(q, o, m, l, blk * 64, blk * 64 + 64,
                  [&](int j, int i) -> unsigned { return *(const unsigned*)(kb + (size_t)j * 128 + 2 * i); },
                  [&](int j, int i) -> unsigned { return *(const unsigned*)(vb + (size_t)j * INP + 2 * i); },
                  [&](int j) -> bool { return sel && j <= t; }); }
          const float g1 = GATES[tok * 24 + head * 3 + 1] / l;
#pragma unroll
          for (int i = 0; i < 16; ++i) { f32x4 c4 = *(f32x4*)(oc + 4 * i); c4.x += g1 * o[4 * i]; c4.y += g1 * o[4 * i + 1]; c4.z += g1 * o[4 * i + 2]; c4.w += g1 * o[4 * i + 3]; *(f32x4*)(oc + 4 * i) = c4; } }
        { float o[64];
#pragma unroll
          for (int d = 0; d < 64; ++d) o[d] = 0.f;
          float m = -INFINITY, l = 0.f;
          const bf16_t* kb = KWR + (size_t)b * SEQ * 128 + g * 64; const bf16_t* vb = PROJ + (size_t)b * SEQ * INP + C_VW + g * 64;
          const int jlo = (tb * 64 - 511 > 0) ? tb * 64 - 511 : 0;
          naive_attn_range<64, 64>(q, o, m, l, jlo, tb * 64 + 64,
              [&](int j, int i) -> unsigned { return *(const unsigned*)(kb + (size_t)j * 128 + 2 * i); },
              [&](int j, int i) -> unsigned { return *(const unsigned*)(vb + (size_t)j * INP + 2 * i); },
              [&](int j) -> bool { return j <= t && j > t - 512; });
          const float g2 = GATES[tok * 24 + head * 3 + 2] / l; bf16_t* orow = OCAT + tok * 1024 + 512 + head * 64;
#pragma unroll
          for (int i = 0; i < 16; ++i) { const f32x4 c4 = *(const f32x4*)(oc + 4 * i); u32x2 w; w.x = pk2(c4.x + g2 * o[4 * i], c4.y + g2 * o[4 * i + 1]); w.y = pk2(c4.z + g2 * o[4 * i + 2], c4.w + g2 * o[4 * i + 3]);
              *(u32x2*)(orow + 4 * i) = w; } }
    }
}

DEV void phase7(const Params& p, LAS unsigned char* lds) {
    const int tid = opaque_tid(), wid = __builtin_amdgcn_readfirstlane(tid >> 6), lane = tid & 63;
    const float* H1 = (const float*)(p.ws + OFF_H1); unsigned char* XN = p.ws + OFF_XN; float* SXTOK = (float*)(p.ws + OFF_SXTOK);
    int* TOPI = (int*)(p.ws + OFF_TOPI); float* TOPG = (float*)(p.ws + OFF_TOPG); int* POS = (int*)(p.ws + OFF_POS); unsigned* CNT = (unsigned*)(p.ws + OFF_CNT);
    LAS float* xt = (LAS float*)lds;
    LAS float* part = (LAS float*)(lds + 16 * 1028 * 4);
    LAS unsigned* lcnt = (LAS unsigned*)(lds + 16 * 1028 * 4 + 16384);
    const int ej = lane & 15, kq = lane >> 4, k0_ = 128 * wid + 32 * kq;
    float rw0[32], rw1[32];
#pragma unroll
    for (int i = 0; i < 32; ++i) { rw0[i] = p.router_w[(size_t)(k0_ + i) * 32 + ej]; rw1[i] = p.router_w[(size_t)(k0_ + i) * 32 + 16 + ej]; }
    const f32x4* gr = (const f32x4*)p.ffn_norm + lane;
    f32x4 gg[4];
#pragma unroll
    for (int j = 0; j < 4; ++j) gg[j] = gr[64 * j];
    for (int ch = blockIdx.x; ch < NTOK / 128; ch += gridDim.x) {
        if (tid < 32) lcnt[tid] = 0u;
        f32x4 nx[2][4];
#pragma unroll
        for (int rr = 0; rr < 2; ++rr) { const f32x4* xr = (const f32x4*)(H1 + (size_t)(ch * 128 + 2 * wid + rr) * DM) + lane;
#pragma unroll
            for (int j = 0; j < 4; ++j) nx[rr][j] = xr[64 * j]; }
        __syncthreads();
#pragma unroll 1
        for (int sub = 0; sub < 8; ++sub) {
            const int tok0 = ch * 128 + sub * 16;
#pragma unroll
            for (int rr = 0; rr < 2; ++rr) { const int row = 2 * wid + rr, tok = tok0 + row;
                f32x4 v[4]; float s_ = 0.f;
#pragma unroll
                for (int j = 0; j < 4; ++j) { v[j] = nx[rr][j]; s_ += (v[j].x * v[j].x + v[j].y * v[j].y) + (v[j].z * v[j].z + v[j].w * v[j].w); }
                if (sub + 1 < 8) { const f32x4* xr = (const f32x4*)(H1 + (size_t)(tok + 16) * DM) + lane;
#pragma unroll
                    for (int j = 0; j < 4; ++j) nx[rr][j] = xr[64 * j]; }
                const float rstd = rsqrtf(wave_sum(s_) * (1.f / 1024.f) + 1e-5f);
                float amax = 0.f;
#pragma unroll
                for (int j = 0; j < 4; ++j) { v[j].x *= rstd * gg[j].x; v[j].y *= rstd * gg[j].y; v[j].z *= rstd * gg[j].z; v[j].w *= rstd * gg[j].w;
                    amax = fmaxf(fmaxf(amax, fmaxf(fabsf(v[j].x), fabsf(v[j].y))), fmaxf(fabsf(v[j].z), fabsf(v[j].w))); *(LAS f32x4*)(xt + row * 1028 + 256 * j + 4 * lane) = v[j]; }
#pragma unroll
                for (int o_ = 1; o_ < 64; o_ <<= 1) amax = fmaxf(amax, __shfl_xor(amax, o_));
                amax = fmaxf(amax, 1e-30f); const float qinv = 127.0f / amax; if (lane == 0) SXTOK[tok] = amax * (1.0f / 127.0f);
                unsigned* o4 = (unsigned*)(XN + (size_t)tok * DM) + lane;
#pragma unroll
                for (int j = 0; j < 4; ++j) { const unsigned q0 = (unsigned)__float2int_rn(v[j].x * qinv) & 255u, q1 = (unsigned)__float2int_rn(v[j].y * qinv) & 255u, q2 = (unsigned)__float2int_rn(v[j].z * qinv) & 255u, q3 = (unsigned)__float2int_rn(v[j].w * qinv) & 255u;
                    o4[64 * j] = q0 | (q1 << 8) | (q2 << 16) | (q3 << 24); } }
            __syncthreads();
            { f32x4 acc0 = (f32x4){0.f, 0.f, 0.f, 0.f}, acc1 = acc0; const LAS float* xrow = xt + ej * 1028 + k0_;
#pragma unroll
              for (int s4 = 0; s4 < 8; ++s4) { const f32x4 xv = *(const LAS f32x4*)(xrow + 4 * s4);
#pragma unroll
                  for (int i = 0; i < 4; ++i) { acc0 = __builtin_amdgcn_mfma_f32_16x16x4f32(xv[i], rw0[4 * s4 + i], acc0, 0, 0, 0); acc1 = __builtin_amdgcn_mfma_f32_16x16x4f32(xv[i], rw1[4 * s4 + i], acc1, 0, 0, 0); } }
#pragma unroll
              for (int r = 0; r < 4; ++r) { part[(wid * 16 + 4 * kq + r) * 32 + ej] = acc0[r]; part[(wid * 16 + 4 * kq + r) * 32 + 16 + ej] = acc1[r]; } }
            __syncthreads();
            { const int tk = tid >> 5, e = tid & 31, tok = tok0 + tk; float logit = p.router_b[e];
#pragma unroll
              for (int w_ = 0; w_ < 8; ++w_) logit += part[(w_ * 16 + tk) * 32 + e];
              int ti[4]; float tv[4]; float cur = logit;
#pragma unroll
              for (int r = 0; r < 4; ++r) { float bv = cur; int bi = e;
#pragma unroll
                  for (int o_ = 1; o_ < 32; o_ <<= 1) { const float ov = __shfl_xor(bv, o_); const int oi = __shfl_xor(bi, o_); if (ov > bv || (ov == bv && oi < bi)) { bv = ov; bi = oi; } }
                  ti[r] = bi; tv[r] = bv; if (e == bi) cur = -INFINITY; }
              const float e1 = __expf(tv[1] - tv[0]), e2 = __expf(tv[2] - tv[0]), e3 = __expf(tv[3] - tv[0]); const float inv = 1.0f / (1.0f + e1 + e2 + e3);
              if (e == 0) {
                  *(f32x4*)(TOPG + (size_t)tok * 4) = (f32x4){inv, e1 * inv, e2 * inv, e3 * inv};
                  int ps[4];
#pragma unroll
                  for (int r = 0; r < 4; ++r) ps[r] = (int)__hip_atomic_fetch_add(&lcnt[ti[r]], 1u, __ATOMIC_RELAXED, __HIP_MEMORY_SCOPE_WORKGROUP);
                  int* ti_o = TOPI + (size_t)tok * 4; int* ps_o = POS + (size_t)tok * 4;
#pragma unroll
                  for (int r = 0; r < 4; ++r) { ti_o[r] = ti[r]; ps_o[r] = ps[r]; }
              } }
            __syncthreads();
        }
        if (tid < 32) lcnt[32 + tid] = atomicAdd(&CNT[tid], lcnt[tid]);
        __syncthreads();
        if (tid < 128) { const int tok = ch * 128 + tid; const int* ti_o = TOPI + (size_t)tok * 4; int* ps_o = POS + (size_t)tok * 4;
#pragma unroll
            for (int r = 0; r < 4; ++r) ps_o[r] += (int)lcnt[32 + ti_o[r]]; }
        __syncthreads();
    }
}

DEV void moe_offsets(const Params& p, LAS unsigned* tab) {
    const unsigned* CNT = (const unsigned*)(p.ws + OFF_CNT);
    const int tid = opaque_tid();
    if (tid < 64) {
        const int e = tid & 31; const unsigned c = __hip_atomic_load(&CNT[e], __ATOMIC_RELAXED, __HIP_MEMORY_SCOPE_AGENT);
        const unsigned pad = ((c + 255u) >> 8) << 8; unsigned inc = pad;
#pragma unroll
        for (int o_ = 1; o_ < 32; o_ <<= 1) { const unsigned v = __shfl_up(inc, o_, 32); if (e >= o_) inc += v; }
        if (tid < 32) { tab[e] = inc - pad; tab[32 + e] = inc >> 8; if (e == 31) tab[64] = inc; }
    }
    __syncthreads();
}
typedef int i32x4_ __attribute__((ext_vector_type(4)));
DEV void phase8(const Params& p, LAS unsigned char* lds) {
    const int tid = opaque_tid();
    LAS unsigned* tab = (LAS unsigned*)lds; moe_offsets(p, tab);
    const int* TOPI = (const int*)(p.ws + OFF_TOPI); const float* TOPG = (const float*)(p.ws + OFF_TOPG); int* POS = (int*)(p.ws + OFF_POS); float* RG = (float*)(p.ws + OFF_ROWGATE);
    const float* SXTOK = (const float*)(p.ws + OFF_SXTOK); float* SXROW = (float*)(p.ws + OFF_SXROW); int* ROWTOK = (int*)(p.ws + OFF_ROWTOK); const unsigned* CNT = (const unsigned*)(p.ws + OFF_CNT);
    for (int id = blockIdx.x * 512 + tid; id < NTOK * 4; id += gridDim.x * 512) { const int tok = id >> 2;
        const int e = TOPI[id]; const int slot = (int)tab[e] + POS[id];
        ROWTOK[slot] = tok; RG[slot] = TOPG[id]; SXROW[slot] = SXTOK[tok]; POS[id] = slot; }
    if (blockIdx.x < NEXP) { const int e = blockIdx.x; const int beg = (int)tab[e] + (int)__hip_atomic_load(&CNT[e], __ATOMIC_RELAXED, __HIP_MEMORY_SCOPE_AGENT), end = (int)tab[32 + e] * 256;
        for (int s_ = beg + tid; s_ < end; s_ += 512) ROWTOK[s_] = 0; }
}

DEV void phase11(const Params& p) {
    const int tid = opaque_tid(), wid = tid >> 6, lane = tid & 63;
    const int gw = blockIdx.x * 8 + wid, NGW = gridDim.x * 8;
    const float* H1 = (const float*)(p.ws + OFF_H1); const bf16_t* Y = (const bf16_t*)(p.ws + OFF_Y); const int* POS = (const int*)(p.ws + OFF_POS);
    const f32x4* gr = (const f32x4*)p.final_norm + lane; f32x4 gg[4];
#pragma unroll
    for (int j = 0; j < 4; ++j) gg[j] = gr[64 * j];
    i32x4_ slot[2];
#pragma unroll
    for (int q = 0; q < 2; ++q) { const int t0 = 2 * gw + q; slot[q] = *(const i32x4_*)(POS + (size_t)(t0 < NTOK ? t0 : 0) * 4); }
#pragma unroll 1
    for (int tok2 = gw * 2; tok2 < NTOK; tok2 += NGW * 2) {
        f32x4 v[2][4]; u32x2 y[2][4][4];
#pragma unroll
        for (int q = 0; q < 2; ++q) { const f32x4* xr = (const f32x4*)(H1 + (size_t)(tok2 + q) * DM) + lane;
#pragma unroll
            for (int j = 0; j < 4; ++j) v[q][j] = __builtin_nontemporal_load(xr + 64 * j);
#pragma unroll
            for (int r = 0; r < 4; ++r) { const u32x2* yr = (const u32x2*)(Y + (size_t)slot[q][r] * DM) + lane;
#pragma unroll
                for (int j = 0; j < 4; ++j) y[q][r][j] = __builtin_nontemporal_load(yr + 64 * j); } }
        i32x4_ nslot[2];
#pragma unroll
        for (int q = 0; q < 2; ++q) { const int t1 = tok2 + NGW * 2 + q; nslot[q] = *(const i32x4_*)(POS + (size_t)(t1 < NTOK ? t1 : 0) * 4); }
#pragma unroll
        for (int q = 0; q < 2; ++q) {
#pragma unroll
            for (int r = 0; r < 4; ++r)
#pragma unroll
                for (int j = 0; j < 4; ++j) { const u32x2 w = y[q][r][j]; v[q][j].x += bflo(w.x); v[q][j].y += bfhi(w.x); v[q][j].z += bflo(w.y); v[q][j].w += bfhi(w.y); }
            float s = 0.f;
#pragma unroll
            for (int j = 0; j < 4; ++j) s += (v[q][j].x * v[q][j].x + v[q][j].y * v[q][j].y) + (v[q][j].z * v[q][j].z + v[q][j].w * v[q][j].w);
            const float rstd = rsqrtf(wave_sum(s) * (1.f / 1024.f) + 1e-5f);
            f32x4* orow = (f32x4*)(p.out + (size_t)(tok2 + q) * DM) + lane;
#pragma unroll
            for (int j = 0; j < 4; ++j) __builtin_nontemporal_store((f32x4){v[q][j].x * rstd * gg[j].x, v[q][j].y * rstd * gg[j].y, v[q][j].z * rstd * gg[j].z, v[q][j].w * rstd * gg[j].w}, orow + 64 * j); }
        slot[0] = nslot[0]; slot[1] = nslot[1];
    }
}

constexpr int NPHASE = 14;
constexpr int LDS_BYTES = 163840;
template <int PH> DEV void run_phase(const Params& p, LAS unsigned char* lds) {
    using namespace pg8;
    const int G = gridDim.x, bid = blockIdx.x;
    if constexpr (PH == 0) phase0(p, lds);
    if constexpr (PH == 1) { Gemm g{1024, 0}; DenseOrder S; S.init(p.ws + OFF_U, p.ws + OFF_WINT, 1024, NTOK, INP, G, bid);
        EpiProj E{p.pos, p.q_norm, p.kv_norm, (bf16_t*)(p.ws + OFF_QN), (bf16_t*)(p.ws + OFF_KVN), (bf16_t*)(p.ws + OFF_KM), (bf16_t*)(p.ws + OFF_NQ), (bf16_t*)(p.ws + OFF_KSR), (bf16_t*)(p.ws + OFF_KWR),
                  (bf16_t*)(p.ws + OFF_KCC), (bf16_t*)(p.ws + OFF_VCC), (bf16_t*)(p.ws + OFF_VSC), (bf16_t*)(p.ws + OFF_VWC), (float*)(p.ws + OFF_GATES), (float*)(p.ws + OFF_ROPEM), (LAS float*)(lds + STAGE_BYTES + 1024)};
        gemm_phase(lds, g, S, E);
        const int rem = S.nwg % G;
        if (rem > 0 && rem < G) { if (bid >= rem) prep_w2_items(p, lds, (bid - rem) * 8, (G - rem) * 8); } else prep_w2_items(p, lds, bid * 8, G * 8);
    }
    if constexpr (PH == 2) phase2(p);
    if constexpr (PH == 3) {
        const int NC = (G >= 64) ? 32 : 0;
        if (bid < NC) { Gemm g{2048, 1}; CmpOrder S{(const char*)(p.ws + OFF_KCC), (const char*)(p.ws + OFF_VCC), (const char*)(p.ws + OFF_CW1T), bid};
            EpiCmp E{(const float*)(p.ws + OFF_CB), p.cmp_w2, p.pos, (bf16_t*)(p.ws + OFF_KC), (bf16_t*)(p.ws + OFF_VC)}; gemm_phase(lds, g, S, E); }
        else {
            { Gemm g{256, 0}; UpOrder S; S.q.init(p.ws + OFF_QN, p.ws + OFF_WQUPT, 256, NTOK, 768, 1, 0); S.kv.init(p.ws + OFF_KVN, p.ws + OFF_WKVUPT, 256, NTOK, 1024, 1, 0); S.G = G - NC; S.c = bid - NC;
              EpiUp E{EpiQup{(bf16_t*)(p.ws + OFF_QM), (const float*)(p.ws + OFF_ROPEM)}, EpiKvup{(bf16_t*)(p.ws + OFF_KM), (bf16_t*)(p.ws + OFF_VM)}}; gemm_phase(lds, g, S, E); }
        }
        if (NC == 0) for (int k = bid; k < 32; k += G) { Gemm g{2048, 1}; CmpOrder S{(const char*)(p.ws + OFF_KCC), (const char*)(p.ws + OFF_VCC), (const char*)(p.ws + OFF_CW1T), k};
            EpiCmp E{(const float*)(p.ws + OFF_CB), p.cmp_w2, p.pos, (bf16_t*)(p.ws + OFF_KC), (bf16_t*)(p.ws + OFF_VC)}; gemm_phase(lds, g, S, E); }
        prep_w1_items(p, lds);
    }
    if constexpr (PH == 5) phase5_mla_fa(p, lds);
    if constexpr (PH == 6) phase5_nsa_fa(p, lds);
    if constexpr (PH == 8) { Gemm g{1024, 0}; DenseOrder S; S.init(p.ws + OFF_OCAT, p.ws + OFF_WOUTT, 1024, NTOK, 1024, G, bid);
        EpiResF32 E{p.x, (float*)(p.ws + OFF_H1), 1024}; gemm_phase(lds, g, S, E); }
    if constexpr (PH == 9) phase7(p, lds);
    if constexpr (PH == 10) phase8(p, lds);
    if constexpr (PH == 11) { LAS unsigned* tab = (LAS unsigned*)(lds + STAGE_BYTES); moe_offsets(p, tab);
        MoeOrder S; S.d.init(p.ws + OFF_XN, p.ws + OFF_W1T, 512, (int)tab[64], 2048, G, bid); S.tend = tab + 32; S.nNt = 8; S.gatherA = true;
        LAS int* rt = (LAS int*)(lds + STAGE_BYTES + 2048);
        { const int* ROWTOK = (const int*)(p.ws + OFF_ROWTOK); const int tid_ = opaque_tid(); Unit u_;
          for (int i = 0; S.next(i, u_); ++i) if (tid_ < 256) rt[i * 256 + tid_] = ROWTOK[u_.pm * 256 + tid_];
          __syncthreads(); }
        Gemm g{512, 2, rt};
        EpiMoe1 E{(bf16_t*)(p.ws + OFF_HMID), p.moe_b1, (const float*)(p.ws + OFF_SW1), (const float*)(p.ws + OFF_SXROW)}; gemm_phase<EpiMoe1, MoeOrder, true>(lds, g, S, E); }
    if constexpr (PH == 12) { LAS unsigned* tab = (LAS unsigned*)(lds + STAGE_BYTES); moe_offsets(p, tab);
        Gemm g{1024, 0}; MoeOrder S; S.d.init(p.ws + OFF_HMID, p.ws + OFF_W2T, 1024, (int)tab[64], 1024, G, bid); S.tend = tab + 32; S.nNt = 4;
        EpiMoe2 E{(bf16_t*)(p.ws + OFF_Y), p.moe_b2, (const float*)(p.ws + OFF_ROWGATE)}; gemm_phase(lds, g, S, E); }
    if constexpr (PH == 13) phase11(p);
}

template <int PH> __global__ void __launch_bounds__(512) phase_kernel(Params p) {
    extern __shared__ __attribute__((aligned(16))) unsigned char smem[];
    run_phase<PH>(p, (LAS unsigned char*)smem);
}

#if MK_ONE_LAUNCH
__global__ void __launch_bounds__(512) mega_kernel(Params p) {
    extern __shared__ __attribute__((aligned(16))) unsigned char smem[];
    LAS unsigned char* lds = (LAS unsigned char*)smem;
    cg::grid_group grid = cg::this_grid();
    volatile LAS unsigned* st = (volatile LAS unsigned*)(lds + LDS_BYTES - 16);
    if (threadIdx.x == 0) { st[0] = 0u; st[1] = 0u; }
    __syncthreads();
    const XcdBarrier xb = xcd_barrier_post((unsigned*)(p.ws + OFF_BAR), st);
#define GSYNC() xcd_barrier(xb)
    if (p.ws == nullptr) grid.sync();
    run_phase<0>(p, lds); GSYNC();
    run_phase<1>(p, lds); GSYNC();
    run_phase<3>(p, lds); GSYNC();
    run_phase<5>(p, lds); run_phase<6>(p, lds); GSYNC();
    run_phase<8>(p, lds); GSYNC();
    run_phase<9>(p, lds); GSYNC();
    run_phase<10>(p, lds); GSYNC();
    run_phase<11>(p, lds); GSYNC();
    run_phase<12>(p, lds); GSYNC();
    run_phase<13>(p, lds);
}
#endif

template <int PH> static void launch_phase(const Params& p, int grid, hipStream_t stream) {
    static bool attr = false;
    if (!attr) { (void)hipFuncSetAttribute((const void*)phase_kernel<PH>, hipFuncAttributeMaxDynamicSharedMemorySize, LDS_BYTES); attr = true; }
    hipLaunchKernelGGL(phase_kernel<PH>, dim3(grid), dim3(512), LDS_BYTES, stream, p);
}

extern "C" void kernel_launch(void* const* d_in, const int* in_sizes, int n_in, void* d_out, int out_size, void* d_ws, size_t ws_size, hipStream_t stream) {
    static int grid = 0;
    if (grid == 0) {
        if (n_in != 20 || out_size != NTOK * DM || ws_size < WS_END) { fprintf(stderr, "kernel_launch: unexpected shapes (n_in %d, out %d, ws %zu < %zu)\n", n_in, out_size, ws_size, (size_t)WS_END); grid = -1; return; }
        int dev = 0, cus = 0, per_cu = 0;
        (void)hipGetDevice(&dev); (void)hipDeviceGetAttribute(&cus, hipDeviceAttributeMultiprocessorCount, dev);
#if MK_ONE_LAUNCH
        (void)hipFuncSetAttribute((const void*)mega_kernel, hipFuncAttributeMaxDynamicSharedMemorySize, LDS_BYTES);
        (void)hipOccupancyMaxActiveBlocksPerMultiprocessor(&per_cu, (const void*)mega_kernel, 512, LDS_BYTES);
        if (per_cu < 1) { fprintf(stderr, "kernel_launch: occupancy query says %d blocks per CU\n", per_cu); per_cu = 1; }
#endif
        (void)hipGetLastError();
        grid = cus * 1;
        if (grid <= 0) grid = 256;
    }
    if (grid < 0) return;
    Params p; memset(&p, 0, sizeof(p));
    p.x = (const float*)d_in[0]; p.pos = (const int*)d_in[1]; p.attn_norm = (const float*)d_in[2]; p.w_in = (const float*)d_in[3]; p.q_norm = (const float*)d_in[4];
    p.w_q_up = (const float*)d_in[5]; p.kv_norm = (const float*)d_in[6]; p.w_kv_up = (const float*)d_in[7]; p.cmp_pos = (const float*)d_in[8]; p.cmp_w1 = (const float*)d_in[9];
    p.cmp_w2 = (const float*)d_in[10]; p.w_out = (const float*)d_in[11]; p.ffn_norm = (const float*)d_in[12]; p.router_w = (const float*)d_in[13]; p.router_b = (const float*)d_in[14];
    p.moe_w1 = (const float*)d_in[15]; p.moe_b1 = (const float*)d_in[16]; p.moe_w2 = (const float*)d_in[17]; p.moe_b2 = (const float*)d_in[18]; p.final_norm = (const float*)d_in[19];
    p.out = (float*)d_out; p.ws = (unsigned char*)d_ws;
#if MK_ONE_LAUNCH
    (void)hipMemsetAsync((unsigned char*)d_ws + OFF_BAR, 0, XCD_BAR_WORDS * 4, stream);
    void* args[] = {&p};
    hipError_t e = hipLaunchCooperativeKernel((const void*)mega_kernel, dim3(grid), dim3(512), args, LDS_BYTES, stream);
    if (e != hipSuccess) fprintf(stderr, "cooperative launch failed: %s (grid %d)\n", hipGetErrorString(e), grid);
#else
    launch_phase<0>(p, grid, stream); launch_phase<1>(p, grid, stream); launch_phase<2>(p, grid, stream); launch_phase<3>(p, grid, stream); launch_phase<4>(p, grid, stream);
    launch_phase<5>(p, grid, stream); launch_phase<6>(p, grid, stream); launch_phase<7>(p, grid, stream); launch_phase<8>(p, grid, stream); launch_phase<9>(p, grid, stream);
    launch_phase<10>(p, grid, stream); launch_phase<11>(p, grid, stream); launch_phase<12>(p, grid, stream); launch_phase<13>(p, grid, stream);
#endif
}
```
